# Optimizing an MI355X kernel written in HIP

```python
import jax, jax.numpy as jnp
from jax import lax
import numpy as np

D_MODEL = 1024
BATCH = 2
SEQ = 16384
DEPTH = 4

EPS = 1e-6
NEG_INF = -1e30
FORCE = 1e4
HEAD_DIM = 64
D_MIX = D_MODEL
GDN_HEADS = D_MIX // 4 // HEAD_DIM
GDN_WIDTH = GDN_HEADS * HEAD_DIM
GDN_CONV = 4
GDN_CHUNK = 64
NSA_HEADS = D_MIX // 2 // HEAD_DIM
NSA_WIDTH = NSA_HEADS * HEAD_DIM
NSA_KV_HEADS = 2
NSA_GROUP = NSA_HEADS // NSA_KV_HEADS
NSA_KV_WIDTH = NSA_KV_HEADS * HEAD_DIM
CMP_STRIDE = 16
CMP_LEN = 2 * CMP_STRIDE
SLC_BLOCK = 64
N_SELECT = 16
WINDOW = 512
Q_BLOCK = 128
CONV_WIDTH = D_MIX - GDN_WIDTH - NSA_WIDTH
CONV_GROUPS = 4
CONV_K = 3
ROPE_THETA = 500000.0
ROT_DIM = HEAD_DIM // 4
D_FF = ((8 * D_MODEL + 3 * 256 - 1) // (3 * 256)) * 256
IN_SIZES = (GDN_WIDTH, GDN_WIDTH, GDN_WIDTH, GDN_WIDTH, GDN_HEADS, GDN_HEADS,
            NSA_WIDTH, NSA_KV_WIDTH, NSA_KV_WIDTH, NSA_KV_WIDTH, NSA_KV_WIDTH, NSA_KV_WIDTH, NSA_KV_WIDTH,
            3 * NSA_HEADS, CONV_WIDTH, CONV_WIDTH, CONV_WIDTH)
D_IN = sum(IN_SIZES)

kernel_name = "hymba_style_gdn_nsa_shortconv_trunk"


def rms_norm(x, gain):
    xf = x.astype(jnp.float32)
    y = xf * lax.rsqrt(jnp.mean(xf * xf, axis=-1, keepdims=True) + EPS)
    return (y * gain.astype(jnp.float32)).astype(x.dtype)


def l2_norm(x):
    return x * lax.rsqrt(jnp.sum(x * x, axis=-1, keepdims=True) + EPS)


def causal_depthwise_conv(x, w):
    k = w.shape[0]
    return lax.conv_general_dilated(x, w[:, None, :].astype(x.dtype), window_strides=(1,),
                                    padding=[(k - 1, 0)], dimension_numbers=("NWC", "WIO", "NWC"),
                                    feature_group_count=x.shape[-1])


def rope_tables(positions):
    inv = jnp.float32(ROPE_THETA) ** (-jnp.arange(0, ROT_DIM, 2, dtype=jnp.float32) / ROT_DIM)
    ang = positions.astype(jnp.float32)[..., None] * inv
    return jnp.cos(ang), jnp.sin(ang)


def apply_partial_rope(x, cos, sin):
    extra = x.ndim - 3
    shp = cos.shape[:2] + (1,) * extra + cos.shape[-1:]
    c, s = cos.reshape(shp), sin.reshape(shp)
    half = ROT_DIM // 2
    x1 = x[..., :half].astype(jnp.float32)
    x2 = x[..., half:ROT_DIM].astype(jnp.float32)
    rot = jnp.concatenate([x1 * c - x2 * s, x2 * c + x1 * s], axis=-1).astype(x.dtype)
    return jnp.concatenate([rot, x[..., ROT_DIM:]], axis=-1)


def masked_softmax(scores, mask):
    s = jnp.where(mask, scores.astype(jnp.float32), NEG_INF)
    return jnp.where(mask, jax.nn.softmax(s, axis=-1), 0.0)


def gated_delta_rule(q, k, v, g, beta):
    b, T, h, dk = q.shape
    dv = v.shape[-1]
    n = T // GDN_CHUNK
    q = l2_norm(q.astype(jnp.float32)) * (dk ** -0.5)
    k = l2_norm(k.astype(jnp.float32))
    v = v.astype(jnp.float32)

    def chunks(t):
        return t.reshape(b, n, GDN_CHUNK, h, t.shape[-1]).transpose(0, 3, 1, 2, 4)

    qc, kc, vc = chunks(q), chunks(k), chunks(v)
    gc = g.astype(jnp.float32).reshape(b, n, GDN_CHUNK, h).transpose(0, 3, 1, 2)
    bc = beta.astype(jnp.float32).reshape(b, n, GDN_CHUNK, h).transpose(0, 3, 1, 2)
    gcum = jnp.cumsum(gc, axis=-1)
    tril = jnp.tril(jnp.ones((GDN_CHUNK, GDN_CHUNK), dtype=bool))
    strict = jnp.tril(jnp.ones((GDN_CHUNK, GDN_CHUNK), dtype=bool), -1)
    diff = gcum[..., :, None] - gcum[..., None, :]
    decay = jnp.where(tril, jnp.exp(jnp.where(tril, diff, 0.0)), 0.0)
    kb = kc * bc[..., None]
    a = jnp.where(strict, jnp.einsum("bhncd,bhnsd->bhncs", kb, kc) * decay, 0.0)
    ia = a + jnp.eye(GDN_CHUNK, dtype=jnp.float32)
    rhs = jnp.concatenate([vc * bc[..., None], kb * jnp.exp(gcum)[..., None]], axis=-1)
    sol = lax.linalg.triangular_solve(ia, rhs, left_side=True, lower=True, unit_diagonal=True)
    u, w = sol[..., :dv], sol[..., dv:]
    qk = jnp.where(tril, jnp.einsum("bhncd,bhnsd->bhncs", qc, kc) * decay, 0.0)
    q_dec = qc * jnp.exp(gcum)[..., None]
    k_dec = kc * jnp.exp(gcum[..., -1:] - gcum)[..., None]
    g_last = jnp.exp(gcum[..., -1])

    def step(state, xs):
        u_i, w_i, qd_i, kd_i, qk_i, gl_i = xs
        v_new = u_i - w_i @ state
        o_i = qd_i @ state + qk_i @ v_new
        state = state * gl_i[..., None, None] + jnp.einsum("bhck,bhcv->bhkv", kd_i, v_new)
        return state, o_i

    xs = tuple(jnp.moveaxis(t, 2, 0) for t in (u, w, q_dec, k_dec, qk, g_last))
    s0 = jnp.zeros((b, h, dk, dv), jnp.float32)
    _, o = lax.scan(step, s0, xs)
    return o.transpose(1, 0, 3, 2, 4).reshape(b, T, h, dv)


def compress_blocks(t, pe, w1, w2):
    b, T, g, d = t.shape
    nb = T // CMP_STRIDE
    blk = t.reshape(b, nb, CMP_STRIDE, g, d)
    win = jnp.concatenate([blk[:, :-1], blk[:, 1:]], axis=2) + pe[:, None, :].astype(t.dtype)
    flat = win.transpose(0, 1, 3, 2, 4).reshape(b, nb - 1, g, CMP_LEN * d)
    return jax.nn.gelu(flat @ w1) @ w2


def nsa_attention(q, k_cmp, v_cmp, k_slc, v_slc, k_win, v_win, gate_logits, cos, sin,
                  q_gain, k_gain, cmp_pe, cmp_w1, cmp_w2):
    b, T = q.shape[:2]
    G, R, dh = NSA_KV_HEADS, NSA_GROUP, HEAD_DIM
    kv = lambda t: t.reshape(b, T, G, dh)
    qn = rms_norm(q.reshape(b, T, G, R, dh), q_gain)
    qr = apply_partial_rope(qn, cos, sin)
    kc = rms_norm(compress_blocks(kv(k_cmp), cmp_pe[0], cmp_w1[0], cmp_w2[0]), k_gain[0])
    vc = compress_blocks(kv(v_cmp), cmp_pe[1], cmp_w1[1], cmp_w2[1])
    ks = apply_partial_rope(rms_norm(kv(k_slc), k_gain[1]), cos, sin)
    kw = apply_partial_rope(rms_norm(kv(k_win), k_gain[2]), cos, sin)
    nslc = T // SLC_BLOCK
    n_sel = min(N_SELECT, nslc)
    ks_blk = ks.reshape(b, nslc, SLC_BLOCK, G, dh).transpose(0, 3, 1, 2, 4)
    vs_blk = kv(v_slc).reshape(b, nslc, SLC_BLOCK, G, dh).transpose(0, 3, 1, 2, 4)
    pad = ((0, 0), (WINDOW, 0), (0, 0), (0, 0))
    kw_pad, vw_pad = jnp.pad(kw, pad), jnp.pad(kv(v_win), pad)
    gates = jax.nn.sigmoid(gate_logits.astype(jnp.float32)).reshape(b, T, G, R, 3)
    nc = kc.shape[1]
    cmp_end = jnp.arange(nc) * CMP_STRIDE + CMP_LEN - 1
    ratio = SLC_BLOCK // CMP_STRIDE
    frac = jnp.minimum(CMP_LEN, SLC_BLOCK - CMP_STRIDE * jnp.arange(ratio)).astype(jnp.float32) / CMP_LEN
    scale = dh ** -0.5
    b_ix = jnp.arange(b)[:, None, None, None]
    g_ix = jnp.arange(G)[None, :, None, None]

    def block(i):
        s = i * Q_BLOCK
        tq = s + jnp.arange(Q_BLOCK)
        q_n = lax.dynamic_slice_in_dim(qn, s, Q_BLOCK, 1)
        q_r = lax.dynamic_slice_in_dim(qr, s, Q_BLOCK, 1)
        gt = lax.dynamic_slice_in_dim(gates, s, Q_BLOCK, 1)
        cmask = cmp_end[None, :] <= tq[:, None]
        p_c = masked_softmax(jnp.einsum("bqgrd,bcgd->bgrqc", q_n, kc) * scale, cmask)
        o_c = jnp.einsum("bgrqc,bcgd->bqgrd", p_c.astype(vc.dtype), vc)
        imp = jnp.pad(p_c.sum(axis=2), ((0, 0), (0, 0), (0, 0), (0, 1))).reshape(b, G, Q_BLOCK, nslc, ratio)
        own, spill = imp @ frac, imp @ (1.0 - frac)
        slc = own + jnp.pad(spill[..., :-1], ((0, 0), (0, 0), (0, 0), (1, 0)))
        cur = (tq // SLC_BLOCK)[:, None]
        j = jnp.arange(nslc)[None, :]
        forced = (j == 0) | (j == cur) | (j == cur - 1)
        score = jnp.where(forced, FORCE, jnp.where(j <= cur, slc, -FORCE))
        _, idx = lax.top_k(score, n_sel)
        k_g = ks_blk[b_ix, g_ix, idx].reshape(b, G, Q_BLOCK, n_sel * SLC_BLOCK, dh)
        v_g = vs_blk[b_ix, g_ix, idx].reshape(b, G, Q_BLOCK, n_sel * SLC_BLOCK, dh)
        kpos = (idx[..., None] * SLC_BLOCK + jnp.arange(SLC_BLOCK)).reshape(b, G, Q_BLOCK, -1)
        smask = (kpos <= tq[:, None])[:, :, None]
        p_s = masked_softmax(jnp.einsum("bqgrd,bgqkd->bgrqk", q_r, k_g) * scale, smask)
        o_s = jnp.einsum("bgrqk,bgqkd->bqgrd", p_s.astype(v_g.dtype), v_g)
        kb = lax.dynamic_slice_in_dim(kw_pad, s, Q_BLOCK + WINDOW, 1)
        vb = lax.dynamic_slice_in_dim(vw_pad, s, Q_BLOCK + WINDOW, 1)
        kpos_w = s - WINDOW + jnp.arange(Q_BLOCK + WINDOW)
        dist = tq[:, None] - kpos_w[None, :]
        wmask = (dist >= 0) & (dist < WINDOW) & (kpos_w >= 0)[None, :]
        p_w = masked_softmax(jnp.einsum("bqgrd,bkgd->bgrqk", q_r, kb) * scale, wmask)
        o_w = jnp.einsum("bgrqk,bkgd->bqgrd", p_w.astype(vb.dtype), vb)
        return (gt[..., 0:1] * o_c + gt[..., 1:2] * o_s + gt[..., 2:3] * o_w).astype(q.dtype)

    out = lax.map(block, jnp.arange(T // Q_BLOCK))
    return out.transpose(1, 0, 2, 3, 4, 5).reshape(b, T, NSA_WIDTH)


def setup_inputs(seed: int = 0) -> dict:
    key = jax.random.key(seed)
    ks = jax.random.split(key, 20)
    f32 = jnp.float32
    nrm = lambda k, shp, sc: jax.random.normal(k, shp, f32) * sc
    gain = lambda k, shp: 1.0 + 0.02 * jax.random.normal(k, shp, f32)
    dt = jnp.exp(jax.random.uniform(ks[5], (DEPTH, GDN_HEADS), f32) * (jnp.log(0.1) - jnp.log(0.001)) + jnp.log(0.001))
    return {
        "x": nrm(ks[0], (BATCH, SEQ, D_MODEL), 1.0),
        "positions": jnp.tile(jnp.arange(SEQ, dtype=jnp.int32)[None, :], (BATCH, 1)),
        "attn_norm": gain(ks[1], (DEPTH, D_MODEL)),
        "w_in": nrm(ks[2], (DEPTH, D_MODEL, D_IN), D_MODEL ** -0.5),
        "gdn_conv_w": nrm(ks[3], (DEPTH, GDN_CONV, 3 * GDN_WIDTH), GDN_CONV ** -0.5),
        "gdn_a_log": jnp.log(jax.random.uniform(ks[4], (DEPTH, GDN_HEADS), f32, 1.0, 16.0)),
        "gdn_dt_bias": dt + jnp.log(-jnp.expm1(-dt)),
        "gdn_norm": gain(ks[6], (DEPTH, HEAD_DIM)),
        "nsa_q_norm": gain(ks[7], (DEPTH, HEAD_DIM)),
        "nsa_k_norm": gain(ks[8], (DEPTH, 3, HEAD_DIM)),
        "nsa_cmp_pe": nrm(ks[9], (DEPTH, 2, CMP_LEN, HEAD_DIM), 0.1),
        "nsa_cmp_w1": nrm(ks[10], (DEPTH, 2, CMP_LEN * HEAD_DIM, HEAD_DIM), (CMP_LEN * HEAD_DIM) ** -0.5),
        "nsa_cmp_w2": nrm(ks[11], (DEPTH, 2, HEAD_DIM, HEAD_DIM), HEAD_DIM ** -0.5),
        "conv_w": nrm(ks[12], (DEPTH, CONV_K, CONV_WIDTH), CONV_K ** -0.5),
        "w_out": nrm(ks[13], (DEPTH, D_MIX, D_MODEL), D_MIX ** -0.5),
        "ffn_norm": gain(ks[14], (DEPTH, D_MODEL)),
        "w_gate_up": nrm(ks[15], (DEPTH, D_MODEL, 2 * D_FF), D_MODEL ** -0.5),
        "w_down": nrm(ks[16], (DEPTH, D_FF, D_MODEL), D_FF ** -0.5),
    }


def reference(x, positions, attn_norm, w_in, gdn_conv_w, gdn_a_log, gdn_dt_bias, gdn_norm,
              nsa_q_norm, nsa_k_norm, nsa_cmp_pe, nsa_cmp_w1, nsa_cmp_w2, conv_w, w_out,
              ffn_norm, w_gate_up, w_down):
    b, T, _ = x.shape
    cos, sin = rope_tables(positions)
    split_at = [int(v) for v in np.cumsum(IN_SIZES)[:-1]]
    for l in range(DEPTH):
        h = rms_norm(x, attn_norm[l])
        proj = h @ w_in[l]
        (gq, gk, gv, gz, gb, ga, nq, kcmp, vcmp, kslc, vslc, kwin, vwin, ngate,
         cb, cc, cx) = jnp.split(proj, split_at, axis=-1)
        qkv = jax.nn.silu(causal_depthwise_conv(jnp.concatenate([gq, gk, gv], axis=-1), gdn_conv_w[l]))
        hq, hk, hv = jnp.split(qkv, 3, axis=-1)
        heads = lambda t: t.reshape(b, T, GDN_HEADS, HEAD_DIM)
        g = -jnp.exp(gdn_a_log[l].astype(jnp.float32)) * jax.nn.softplus(
            ga.astype(jnp.float32) + gdn_dt_bias[l].astype(jnp.float32))
        beta = jax.nn.sigmoid(gb.astype(jnp.float32))
        o_gdn = gated_delta_rule(heads(hq), heads(hk), heads(hv), g, beta)
        o_gdn = (rms_norm(o_gdn, gdn_norm[l]) * jax.nn.silu(heads(gz).astype(jnp.float32)))
        o_gdn = o_gdn.reshape(b, T, GDN_WIDTH).astype(x.dtype)
        o_nsa = nsa_attention(nq, kcmp, vcmp, kslc, vslc, kwin, vwin, ngate, cos, sin,
                              nsa_q_norm[l], nsa_k_norm[l], nsa_cmp_pe[l], nsa_cmp_w1[l], nsa_cmp_w2[l])
        o_conv = cb * causal_depthwise_conv(cc * cx, conv_w[l])
        mix = jnp.concatenate([o_gdn, o_nsa.astype(x.dtype), o_conv.astype(x.dtype)], axis=-1)
        x = x + mix @ w_out[l]
        h2 = rms_norm(x, ffn_norm[l])
        gate, up = jnp.split(h2 @ w_gate_up[l], 2, axis=-1)
        x = x + (jax.nn.silu(gate) * up) @ w_down[l]
    return x
```

```cpp
#include <hip/hip_runtime.h>
#include <hip/hip_cooperative_groups.h>
#include <cstdio>
#include <cstring>
namespace cg = cooperative_groups;

typedef unsigned short u16;
typedef unsigned int u32;
typedef __attribute__((ext_vector_type(8))) short bf16x8;
typedef __attribute__((ext_vector_type(4))) short bf16x4;
typedef __attribute__((ext_vector_type(4))) float f32x4;

constexpr int NB = 2, T = 16384, NTOK = NB * T, DM = 1024, DFF = 2816, DEPTH = 4;
constexpr int PJ = 3072;
constexpr int C_GQ = 0, C_GK = 256, C_GV = 512, C_GZ = 768, C_NQ = 1024, C_KCMP = 1536, C_VCMP = 1664,
              C_KSLC = 1792, C_VSLC = 1920, C_KWIN = 2048, C_VWIN = 2176, C_CB = 2304, C_CC = 2560, C_CX = 2816;
constexpr size_t MiB = 1ull << 20;
constexpr size_t OFF_H = 0, OFF_PROJ = 64 * MiB, OFF_SMALL = 256 * MiB, OFF_W = 260 * MiB, OFF_GDN = 288 * MiB,
                 OFF_OG = 384 * MiB, OFF_OC = 416 * MiB, OFF_VT = 480 * MiB, OFF_KC = 496 * MiB, OFF_SEL = 497 * MiB,
                 OFF_ROPE = 499 * MiB, OFF_GL = 501 * MiB, OFF_CNT = 501 * MiB + 65536;
constexpr size_t W_IN = 0, W_OUT = 6553600, W_GU = 8650752, W_DOWN = 20185088, W_C1 = 25952256, W_C2 = 26476544;
constexpr int CHUNK_B = 49152;
constexpr float SC2 = 0.125f * 1.4426950408889634f;

struct Params {
  const float* x_in; const int* positions; const float* attn_norm; const float* w_in; const float* gdn_conv_w;
  const float* gdn_a_log; const float* gdn_dt_bias; const float* gdn_norm; const float* nsa_q_norm;
  const float* nsa_k_norm; const float* cmp_pe; const float* cmp_w1; const float* cmp_w2; const float* conv_w;
  const float* w_out; const float* ffn_norm; const float* w_gate_up; const float* w_down;
  float* out; char* ws;
};


__device__ __forceinline__ int otid() { int t = threadIdx.x; asm volatile("" : "+v"(t)); return t; }
__device__ __forceinline__ int obid() { int t = blockIdx.x; asm volatile("" : "+s"(t)); return t; }
typedef const __attribute__((address_space(4))) Params* KP;
__device__ __forceinline__ KP kargs() {
  KP k = (KP)__builtin_amdgcn_kernarg_segment_ptr();
  asm volatile("" : "+s"(k));
  return k;
}

__device__ __forceinline__ u16 f2bf(float f) {
  u32 u = __float_as_uint(f);
  u += 0x7fffu + ((u >> 16) & 1u);
  return (u16)(u >> 16);
}
__device__ __forceinline__ float bf2f(u16 h) { return __uint_as_float(((u32)h) << 16); }
__device__ __forceinline__ u32 pack2(float a, float b) { return (u32)f2bf(a) | ((u32)f2bf(b) << 16); }
__device__ __forceinline__ float wave_sum(float v) {
#pragma unroll
  for (int o = 32; o; o >>= 1) v += __shfl_xor(v, o);
  return v;
}
__device__ __forceinline__ float sigmoidf_(float x) { return 1.f / (1.f + __expf(-x)); }
__device__ __forceinline__ f32x4 mfma16(bf16x8 a, bf16x8 b, f32x4 c) {
  return __builtin_amdgcn_mfma_f32_16x16x32_bf16(a, b, c, 0, 0, 0);
}
__device__ __forceinline__ bf16x8 pack8(f32x4 a, f32x4 b) {
  union { bf16x8 v; u32 u[4]; } r;
  r.u[0] = pack2(a[0], a[1]); r.u[1] = pack2(a[2], a[3]);
  r.u[2] = pack2(b[0], b[1]); r.u[3] = pack2(b[2], b[3]);
  return r.v;
}

__device__ __forceinline__ void rmsnorm_rows(const float* __restrict__ x, const float* __restrict__ gain, u16* __restrict__ h) {
  int lane = otid() & 63;
  int gw = obid() * 4 + (otid() >> 6), nw = gridDim.x * 4;
  for (int row = gw; row < NTOK; row += nw) {
    const float4* xr = (const float4*)(x + (size_t)row * DM);
    float4 v[4];
    float ss = 0.f;
#pragma unroll
    for (int i = 0; i < 4; ++i) {
      v[i] = xr[lane + 64 * i];
      ss += v[i].x * v[i].x + v[i].y * v[i].y + v[i].z * v[i].z + v[i].w * v[i].w;
    }
    ss = wave_sum(ss);
    float rs = rsqrtf(ss * (1.f / DM) + 1e-6f);
#pragma unroll
    for (int i = 0; i < 4; ++i) {
      float4 g = ((const float4*)gain)[lane + 64 * i];
      uint2 o;
      o.x = pack2(v[i].x * rs * g.x, v[i].y * rs * g.y);
      o.y = pack2(v[i].z * rs * g.z, v[i].w * rs * g.w);
      *(uint2*)(h + (size_t)row * DM + (lane + 64 * i) * 4) = o;
    }
  }
}

struct MapId { __device__ int operator()(int n) const { return n; } };
struct MapIn {
  __device__ int operator()(int n) const {
    if (n < 1024) return n;
    if (n < 2304) return n + 8;
    if (n < 3072) return n + 32;
    if (n < 3080) return n - 3072 + 1024;
    if (n < 3104) return n - 3080 + 2312;
    return -1;
  }
};
struct MapGU {
  __device__ int operator()(int n) const {
    int grp = n >> 6, r = n & 63;
    return r < 32 ? grp * 32 + r : DFF + grp * 32 + (r - 32);
  }
};
template <class Map>
__device__ __forceinline__ void transpose_tile(const float* __restrict__ src, int lds_, Map map, u16* __restrict__ dst, int ldd, int n0,
                               int k0, float* t) {
  int tid = otid();
#pragma unroll 4
  for (int i = 0; i < 16; ++i) {
    int k = i * 4 + (tid >> 6), n = tid & 63;
    int sn = map(n0 + n);
    t[k * 65 + n] = sn >= 0 ? src[(size_t)(k0 + k) * lds_ + sn] : 0.f;
  }
  __syncthreads();
#pragma unroll 4
  for (int i = 0; i < 16; ++i) {
    int n = i * 4 + (tid >> 6), k = tid & 63;
    dst[(size_t)(n0 + n) * ldd + k0 + k] = f2bf(t[k * 65 + n]);
  }
  __syncthreads();
}

__device__ __forceinline__ void convert_weights(KP p, int l, char* smem) {
  float* t = (float*)smem;
  char* W = p->ws + OFF_W;
  const int J0 = 800, J1 = J0 + 256, J2 = J1 + 1408, J3 = J2 + 704, J4 = J3 + 64, J5 = J4 + 2;
  for (int job = obid(); job < J5; job += gridDim.x) {
    if (job < J0) {
      transpose_tile(p->w_in + (size_t)l * DM * 3104, 3104, MapIn(), (u16*)(W + W_IN), 1024, (job >> 4) * 64,
                     (job & 15) * 64, t);
    } else if (job < J1) {
      int j = job - J0;
      transpose_tile(p->w_out + (size_t)l * DM * DM, 1024, MapId(), (u16*)(W + W_OUT), 1024, (j >> 4) * 64,
                     (j & 15) * 64, t);
    } else if (job < J2) {
      int j = job - J1;
      transpose_tile(p->w_gate_up + (size_t)l * DM * 2 * DFF, 2 * DFF, MapGU(), (u16*)(W + W_GU), 1024, (j >> 4) * 64,
                     (j & 15) * 64, t);
    } else if (job < J3) {
      int j = job - J2;
      transpose_tile(p->w_down + (size_t)l * DFF * DM, 1024, MapId(), (u16*)(W + W_DOWN), DFF, (j / 44) * 64,
                     (j % 44) * 64, t);
    } else if (job < J4) {
      int j = job - J3;
      int which = j >> 5, kt = j & 31;
      transpose_tile(p->cmp_w1 + (size_t)(l * 2 + which) * 2048 * 64, 64, MapId(),
                     (u16*)(W + W_C1) + (size_t)which * 64 * 2048, 2048, 0, kt * 64, t);
    } else {
      int which = job - J4;
      transpose_tile(p->cmp_w2 + (size_t)(l * 2 + which) * 64 * 64, 64, MapId(), (u16*)(W + W_C2) + which * 4096, 64, 0,
                     0, t);
    }
  }
}

template <class Epi>
__device__ __forceinline__ void gemm_phase(const u16* __restrict__ A, int lda, const u16* __restrict__ Bt, int ldb, int K, int ntm,
                           int ntn, char* smem, Epi epi) {
  u16* sa = (u16*)smem;
  u16* sb = sa + 2 * 128 * 72;
  const int tid = otid(), lane = tid & 63, wv = tid >> 6;
  const int wm = wv >> 1, wn = wv & 1, l15 = lane & 15, quad = lane >> 4;
  const int ntiles = ntm * ntn, nk = K >> 6;
  for (int id = obid(); id < ntiles; id += gridDim.x) {
    int xcd = id & 7, loc = id >> 3;
    int tm = (loc / ntn) * 8 + xcd, tn = loc % ntn;
    int row0 = tm * 128, col0 = tn * 128;
    const u16* Ag = A + (size_t)row0 * lda;
    const u16* Bg = Bt + (size_t)col0 * ldb;
    f32x4 acc[4][4];
#pragma unroll
    for (int m = 0; m < 4; ++m)
#pragma unroll
      for (int n = 0; n < 4; ++n) acc[m][n] = f32x4{0.f, 0.f, 0.f, 0.f};
    uint4 ra[4], rb[4];
#pragma unroll
    for (int i = 0; i < 4; ++i) {
      int c = tid + i * 256, r = c >> 3, cc = c & 7;
      ra[i] = *(const uint4*)(Ag + (size_t)r * lda + cc * 8);
      rb[i] = *(const uint4*)(Bg + (size_t)r * ldb + cc * 8);
    }
#pragma unroll
    for (int i = 0; i < 4; ++i) {
      int c = tid + i * 256, r = c >> 3, cc = c & 7;
      *(uint4*)(sa + r * 72 + cc * 8) = ra[i];
      *(uint4*)(sb + r * 72 + cc * 8) = rb[i];
    }
    __syncthreads();
    for (int kt = 0; kt < nk; ++kt) {
      if (kt + 1 < nk) {
#pragma unroll
        for (int i = 0; i < 4; ++i) {
          int c = tid + i * 256, r = c >> 3, cc = c & 7;
          ra[i] = *(const uint4*)(Ag + (size_t)r * lda + (kt + 1) * 64 + cc * 8);
          rb[i] = *(const uint4*)(Bg + (size_t)r * ldb + (kt + 1) * 64 + cc * 8);
        }
      }
      const u16* pa = sa + (kt & 1) * 128 * 72 + (wm * 64 + l15) * 72 + quad * 8;
      const u16* pb = sb + (kt & 1) * 128 * 72 + (wn * 64 + l15) * 72 + quad * 8;
#pragma unroll
      for (int ks = 0; ks < 2; ++ks) {
        bf16x8 af[4], bfr[4];
#pragma unroll
        for (int m = 0; m < 4; ++m) af[m] = *(const bf16x8*)(pa + m * 16 * 72 + ks * 32);
#pragma unroll
        for (int n = 0; n < 4; ++n) bfr[n] = *(const bf16x8*)(pb + n * 16 * 72 + ks * 32);
#pragma unroll
        for (int m = 0; m < 4; ++m)
#pragma unroll
          for (int n = 0; n < 4; ++n) acc[m][n] = mfma16(af[m], bfr[n], acc[m][n]);
      }
      if (kt + 1 < nk) {
        int nb = (kt + 1) & 1;
#pragma unroll
        for (int i = 0; i < 4; ++i) {
          int c = tid + i * 256, r = c >> 3, cc = c & 7;
          *(uint4*)(sa + nb * 128 * 72 + r * 72 + cc * 8) = ra[i];
          *(uint4*)(sb + nb * 128 * 72 + r * 72 + cc * 8) = rb[i];
        }
      }
      __syncthreads();
    }
    epi(acc, row0 + wm * 64 + quad * 4, col0 + wn * 64 + l15, tn);
  }
}

struct EpiInProj {
  u16* proj; float* small_;
  __device__ __forceinline__ void operator()(f32x4 (&acc)[4][4], int rbase, int cbase, int tn) const {
    if (tn < 24) {
#pragma unroll
      for (int m = 0; m < 4; ++m)
#pragma unroll
        for (int n = 0; n < 4; ++n)
#pragma unroll
          for (int r = 0; r < 4; ++r)
            proj[(size_t)(rbase + m * 16 + r) * PJ + cbase + n * 16] = f2bf(acc[m][n][r]);
    } else {
#pragma unroll
      for (int m = 0; m < 4; ++m)
#pragma unroll
        for (int n = 0; n < 4; ++n) {
          int c = cbase + n * 16 - 3072;
          if (c < 32) {
#pragma unroll
            for (int r = 0; r < 4; ++r) small_[(size_t)(rbase + m * 16 + r) * 32 + c] = acc[m][n][r];
          }
        }
    }
  }
};
struct EpiResid {
  const float* xin; float* xout;
  __device__ __forceinline__ void operator()(f32x4 (&acc)[4][4], int rbase, int cbase, int tn) const {
#pragma unroll
    for (int m = 0; m < 4; ++m)
#pragma unroll
      for (int n = 0; n < 4; ++n)
#pragma unroll
        for (int r = 0; r < 4; ++r) {
          size_t idx = (size_t)(rbase + m * 16 + r) * DM + cbase + n * 16;
          xout[idx] = xin[idx] + acc[m][n][r];
        }
  }
};
struct EpiSwiGLU {
  u16* act;
  __device__ __forceinline__ void operator()(f32x4 (&acc)[4][4], int rbase, int cbase, int tn) const {
    int grp = cbase >> 6, l15 = cbase & 15;
#pragma unroll
    for (int m = 0; m < 4; ++m)
#pragma unroll
      for (int n = 0; n < 2; ++n)
#pragma unroll
        for (int r = 0; r < 4; ++r) {
          float gt = acc[m][n][r], up = acc[m][n + 2][r];
          float v = gt / (1.f + __expf(-gt)) * up;
          act[(size_t)(rbase + m * 16 + r) * DFF + grp * 32 + n * 16 + l15] = f2bf(v);
        }
  }
};

__device__ __forceinline__ void gdn_chunk_prep(KP p, int l, char* smem, int job) {
  const int b = job >> 10, h = (job >> 8) & 3, c = job & 255;
  const int tid = otid(), lane = tid & 63, wv = tid >> 6;
  float* sq = (float*)smem;
  float* sk = sq + 64 * 65;
  float* sv = sk + 64 * 65;
  float* sA = sv + 64 * 65;
  float* sgc = sA + 64 * 64;
  float* sbeta = sgc + 64;
  float* seg = sbeta + 64;
  float* sf2 = seg + 64;
  const u16* proj = (const u16*)(p->ws + OFF_PROJ);
  const float* small_ = (const float*)(p->ws + OFF_SMALL);
  const size_t tok0 = (size_t)b * T + c * 64;
  char* cb = p->ws + OFF_GDN + (size_t)((b * 4 + h) * 256 + c) * CHUNK_B;
  float* UT = (float*)cb;
  u16* NW = (u16*)(cb + 16384);
  u16* QD = (u16*)(cb + 24576);
  u16* KDT = (u16*)(cb + 32768);
  u16* QKM = (u16*)(cb + 40960);
  {
    int d = lane, i0 = wv * 16;
#pragma unroll
    for (int seg_ = 0; seg_ < 3; ++seg_) {
      int ch = seg_ * 256 + h * 64 + d;
      const float* cw = p->gdn_conv_w + (size_t)l * 4 * 768 + ch;
      float w0 = cw[0], w1 = cw[768], w2 = cw[1536], w3 = cw[2304];
      float* dst = seg_ == 0 ? sq : (seg_ == 1 ? sk : sv);
      float x0 = 0, x1 = 0, x2 = 0;
      int tl = c * 64 + i0;
      if (tl - 3 >= 0) x0 = bf2f(proj[(tok0 + i0 - 3) * PJ + ch]);
      if (tl - 2 >= 0) x1 = bf2f(proj[(tok0 + i0 - 2) * PJ + ch]);
      if (tl - 1 >= 0) x2 = bf2f(proj[(tok0 + i0 - 1) * PJ + ch]);
      for (int i = 0; i < 16; ++i) {
        float x3 = bf2f(proj[(tok0 + i0 + i) * PJ + ch]);
        float y = w0 * x0 + w1 * x1 + w2 * x2 + w3 * x3;
        dst[(i0 + i) * 65 + d] = y / (1.f + __expf(-y));
        x0 = x1; x1 = x2; x2 = x3;
      }
    }
  }
  if (tid < 64) {
    float gb = small_[(tok0 + tid) * 32 + h], ga = small_[(tok0 + tid) * 32 + 4 + h];
    float xx = ga + p->gdn_dt_bias[l * 4 + h];
    float sp = fmaxf(xx, 0.f) + log1pf(__expf(-fabsf(xx)));
    float g = -__expf(p->gdn_a_log[l * 4 + h]) * sp;
#pragma unroll
    for (int o = 1; o < 64; o <<= 1) {
      float t = __shfl_up(g, o);
      if (lane >= o) g += t;
    }
    float beta = sigmoidf_(gb);
    float eg = __expf(g);
    sgc[tid] = g; sbeta[tid] = beta; seg[tid] = eg; sf2[tid] = beta * eg;
    if (tid == 63) ((float*)(p->ws + OFF_GL))[(b * 4 + h) * 256 + c] = eg;
  }
  __syncthreads();
  for (int i = wv * 16; i < wv * 16 + 16; ++i) {
    float q = sq[i * 65 + lane], k = sk[i * 65 + lane];
    float sq2 = wave_sum(q * q), sk2 = wave_sum(k * k);
    sq[i * 65 + lane] = q * rsqrtf(sq2 + 1e-6f) * 0.125f;
    sk[i * 65 + lane] = k * rsqrtf(sk2 + 1e-6f);
  }
  __syncthreads();
  {
    int ti = tid >> 4, tj = tid & 15;
    float kk[4][4], qk[4][4];
#pragma unroll
    for (int a = 0; a < 4; ++a)
#pragma unroll
      for (int bb = 0; bb < 4; ++bb) { kk[a][bb] = 0.f; qk[a][bb] = 0.f; }
    if (tj <= ti) {
      for (int d = 0; d < 64; ++d) {
        float ki[4], kj[4], qi[4];
#pragma unroll
        for (int a = 0; a < 4; ++a) {
          ki[a] = sk[(ti * 4 + a) * 65 + d];
          qi[a] = sq[(ti * 4 + a) * 65 + d];
          kj[a] = sk[(tj * 4 + a) * 65 + d];
        }
#pragma unroll
        for (int a = 0; a < 4; ++a)
#pragma unroll
          for (int bb = 0; bb < 4; ++bb) { kk[a][bb] += ki[a] * kj[bb]; qk[a][bb] += qi[a] * kj[bb]; }
      }
    }
#pragma unroll
    for (int a = 0; a < 4; ++a) {
      int i = ti * 4 + a;
      float gi = sgc[i], bi = sbeta[i];
      uint2 o;
      float qv[4];
#pragma unroll
      for (int bb = 0; bb < 4; ++bb) {
        int j = tj * 4 + bb;
        float dec = (j <= i) ? __expf(gi - sgc[j]) : 0.f;
        sA[i * 64 + j] = (j < i) ? bi * kk[a][bb] * dec : 0.f;
        qv[bb] = qk[a][bb] * dec;
      }
      o.x = pack2(qv[0], qv[1]); o.y = pack2(qv[2], qv[3]);
      *(uint2*)(QKM + i * 64 + tj * 4) = o;
    }
  }
  {
    float gl = sgc[63];
    for (int idx = tid; idx < 4096; idx += 256) {
      int i = idx >> 6, d = idx & 63;
      QD[idx] = f2bf(sq[i * 65 + d] * seg[i]);
      KDT[idx] = f2bf(sk[d * 65 + i] * __expf(gl - sgc[d]));
    }
  }
  __syncthreads();
  if (tid < 128) {
    int cidx = tid;
    const float* src = cidx < 64 ? sv + cidx : sk + (cidx - 64);
    const float* fac = cidx < 64 ? sbeta : sf2;
    float x[64];
#pragma unroll
    for (int i = 0; i < 64; ++i) {
      float s = src[i * 65] * fac[i];
#pragma unroll
      for (int j = 0; j < i; ++j) s -= sA[i * 64 + j] * x[j];
      x[i] = s;
    }
    if (cidx < 64) {
#pragma unroll
      for (int i = 0; i < 64; i += 4) *(float4*)(UT + cidx * 64 + i) = make_float4(x[i], x[i + 1], x[i + 2], x[i + 3]);
    } else {
#pragma unroll
      for (int i = 0; i < 64; ++i) NW[i * 64 + (cidx - 64)] = f2bf(-x[i]);
    }
  }
  __syncthreads();
}

__device__ __forceinline__ void gdn_scan(KP p, char* smem, int sid) {
  const int b = sid >> 4, h = (sid >> 2) & 3, v0 = (sid & 3) * 16;
  const int tid = otid(), lane = tid & 63, wv = tid >> 6, l15 = lane & 15, quad = lane >> 4;
  u16* Sb = (u16*)smem;
  u16* Vb = Sb + 16 * 72;
  f32x4 S = {0.f, 0.f, 0.f, 0.f};
  *(uint2*)(Sb + l15 * 72 + 16 * wv + quad * 4) = make_uint2(0u, 0u);
  __syncthreads();
  const char* gbase = p->ws + OFF_GDN + (size_t)((b * 4 + h) * 256) * CHUNK_B;
  const float* GL = (const float*)(p->ws + OFF_GL) + (b * 4 + h) * 256;
  float* OG = (float*)(p->ws + OFF_OG);
  const int arow = (16 * wv + l15) * 64 + quad * 8;
  f32x4 u, un;
  bf16x8 wA[2], qdA[2], qkA[2], kdA[2], wAn[2], qdAn[2], qkAn[2], kdAn[2];
  float gl, gln;
  {
    const char* cb = gbase;
    u = *(const f32x4*)((const float*)cb + (v0 + l15) * 64 + 16 * wv + quad * 4);
#pragma unroll
    for (int ks = 0; ks < 2; ++ks) {
      wA[ks] = *(const bf16x8*)((const u16*)(cb + 16384) + arow + ks * 32);
      qdA[ks] = *(const bf16x8*)((const u16*)(cb + 24576) + arow + ks * 32);
      kdA[ks] = *(const bf16x8*)((const u16*)(cb + 32768) + arow + ks * 32);
      qkA[ks] = *(const bf16x8*)((const u16*)(cb + 40960) + arow + ks * 32);
    }
    gl = GL[0];
  }
  for (int c = 0; c < 256; ++c) {
    if (c + 1 < 256) {
      const char* cb = gbase + (size_t)(c + 1) * CHUNK_B;
      un = *(const f32x4*)((const float*)cb + (v0 + l15) * 64 + 16 * wv + quad * 4);
#pragma unroll
      for (int ks = 0; ks < 2; ++ks) {
        wAn[ks] = *(const bf16x8*)((const u16*)(cb + 16384) + arow + ks * 32);
        qdAn[ks] = *(const bf16x8*)((const u16*)(cb + 24576) + arow + ks * 32);
        kdAn[ks] = *(const bf16x8*)((const u16*)(cb + 32768) + arow + ks * 32);
        qkAn[ks] = *(const bf16x8*)((const u16*)(cb + 40960) + arow + ks * 32);
      }
      gln = GL[c + 1];
    }
    bf16x8 sB0 = *(const bf16x8*)(Sb + l15 * 72 + quad * 8);
    bf16x8 sB1 = *(const bf16x8*)(Sb + l15 * 72 + 32 + quad * 8);
    f32x4 vn = u;
    vn = mfma16(wA[0], sB0, vn);
    vn = mfma16(wA[1], sB1, vn);
    f32x4 o = {0.f, 0.f, 0.f, 0.f};
    o = mfma16(qdA[0], sB0, o);
    o = mfma16(qdA[1], sB1, o);
    *(uint2*)(Vb + l15 * 72 + 16 * wv + quad * 4) = make_uint2(pack2(vn[0], vn[1]), pack2(vn[2], vn[3]));
    __syncthreads();
    bf16x8 vB0 = *(const bf16x8*)(Vb + l15 * 72 + quad * 8);
    bf16x8 vB1 = *(const bf16x8*)(Vb + l15 * 72 + 32 + quad * 8);
    o = mfma16(qkA[0], vB0, o);
    o = mfma16(qkA[1], vB1, o);
    S[0] *= gl; S[1] *= gl; S[2] *= gl; S[3] *= gl;
    S = mfma16(kdA[0], vB0, S);
    S = mfma16(kdA[1], vB1, S);
    *(uint2*)(Sb + l15 * 72 + 16 * wv + quad * 4) = make_uint2(pack2(S[0], S[1]), pack2(S[2], S[3]));
    size_t orow = (size_t)b * T + c * 64 + 16 * wv + quad * 4;
#pragma unroll
    for (int r = 0; r < 4; ++r) OG[(orow + r) * 256 + h * 64 + v0 + l15] = o[r];
    __syncthreads();
    u = un; gl = gln;
#pragma unroll
    for (int ks = 0; ks < 2; ++ks) { wA[ks] = wAn[ks]; qdA[ks] = qdAn[ks]; kdA[ks] = kdAn[ks]; qkA[ks] = qkAn[ks]; }
  }
}

__device__ __forceinline__ void gdn_finalize(KP p, int l) {
  const int lane = otid() & 63;
  int gw = obid() * 4 + (otid() >> 6), nw = gridDim.x * 4;
  const float* OG = (const float*)(p->ws + OFF_OG);
  const u16* proj = (const u16*)(p->ws + OFF_PROJ);
  u16* mix = (u16*)(p->ws + OFF_H);
  float gn = p->gdn_norm[l * 64 + lane];
  for (int row = gw; row < NTOK * 4; row += nw) {
    int t = row >> 2, h = row & 3;
    float o = OG[(size_t)t * 256 + h * 64 + lane];
    float ss = wave_sum(o * o);
    float z = bf2f(proj[(size_t)t * PJ + C_GZ + h * 64 + lane]);
    float y = o * rsqrtf(ss * (1.f / 64.f) + 1e-6f) * gn * (z / (1.f + __expf(-z)));
    mix[(size_t)t * DM + h * 64 + lane] = f2bf(y);
  }
}

__device__ __forceinline__ void rope_table(KP p) {
  float* rp = (float*)(p->ws + OFF_ROPE);
  int gt = obid() * blockDim.x + otid(), nt = gridDim.x * blockDim.x;
  for (int idx = gt; idx < NTOK * 8; idx += nt) {
    int t = idx >> 3, i = idx & 7;
    float inv = (float)pow(500000.0, -(double)i / 8.0);
    float ang = (float)p->positions[t] * inv;
    rp[t * 16 + i] = (float)cos((double)ang);
    rp[t * 16 + 8 + i] = (float)sin((double)ang);
  }
}

__device__ __forceinline__ void nsa_token_prep(KP p, int l, char* smem, int tb) {
  const int tid = otid(), lane = tid & 63, wv = tid >> 6;
  const int b = tb >> 8, blk = tb & 255;
  u16* proj = (u16*)(p->ws + OFF_PROJ);
  const float* rope = (const float*)(p->ws + OFF_ROPE);
  const size_t tok0 = (size_t)tb * 64;
  for (int r = wv; r < 768; r += 4) {
    int i = r / 12, which = r % 12;
    size_t t = tok0 + i;
    int col; const float* gain;
    if (which < 8) { col = C_NQ + which * 64; gain = p->nsa_q_norm + l * 64; }
    else if (which < 10) { col = C_KSLC + (which - 8) * 64; gain = p->nsa_k_norm + (l * 3 + 1) * 64; }
    else { col = C_KWIN + (which - 10) * 64; gain = p->nsa_k_norm + (l * 3 + 2) * 64; }
    float x = bf2f(proj[t * PJ + col + lane]);
    float ss = wave_sum(x * x);
    float y = x * rsqrtf(ss * (1.f / 64.f) + 1e-6f) * gain[lane];
    if (which >= 8) {
      float other = __shfl_xor(y, 8);
      if (lane < 16) {
        float c = rope[t * 16 + (lane & 7)], s = rope[t * 16 + 8 + (lane & 7)];
        y = lane < 8 ? y * c - other * s : y * c + other * s;
      }
    }
    proj[t * PJ + col + lane] = f2bf(y);
  }
  u16* tt = (u16*)smem;
  for (int z = 0; z < 4; ++z) {
    int tensor = z >> 1, g = z & 1;
    int col = (tensor ? C_VWIN : C_VSLC) + g * 64;
    for (int idx = tid; idx < 4096; idx += 256) {
      int i = idx >> 6, d = idx & 63;
      tt[i * 66 + d] = proj[(tok0 + i) * PJ + col + d];
    }
    __syncthreads();
    u16* dst = (u16*)(p->ws + OFF_VT + (size_t)tensor * 8 * MiB) + ((size_t)((b * 2 + g) * 256 + blk)) * 4096;
    for (int idx = tid; idx < 4096; idx += 256) {
      int d = idx >> 6, i = idx & 63;
      dst[idx] = tt[i * 66 + d];
    }
    __syncthreads();
  }
  {
    int ch = tid;
    const float* cw = p->conv_w + (size_t)l * 3 * 256 + ch;
    float w0 = cw[0], w1 = cw[256], w2 = cw[512];
    u16* mix = (u16*)(p->ws + OFF_H);
    float p0 = 0.f, p1 = 0.f;
    if (blk > 0) {
      p0 = bf2f(proj[(tok0 - 2) * PJ + C_CC + ch]) * bf2f(proj[(tok0 - 2) * PJ + C_CX + ch]);
      p1 = bf2f(proj[(tok0 - 1) * PJ + C_CC + ch]) * bf2f(proj[(tok0 - 1) * PJ + C_CX + ch]);
    }
    for (int i = 0; i < 64; ++i) {
      size_t t = tok0 + i;
      float p2 = bf2f(proj[t * PJ + C_CC + ch]) * bf2f(proj[t * PJ + C_CX + ch]);
      float y = w0 * p0 + w1 * p1 + w2 * p2;
      mix[t * DM + 768 + ch] = f2bf(bf2f(proj[t * PJ + C_CB + ch]) * y);
      p0 = p1; p1 = p2;
    }
  }
}

__device__ __forceinline__ void nsa_compress(KP p, int l, char* smem, int job) {
  const int tid = otid(), lane = tid & 63, wv = tid >> 6, l15 = lane & 15, quad = lane >> 4;
  const int which = job >> 6, b = (job >> 5) & 1, g = (job >> 4) & 1, tile = job & 15;
  const u16* proj = (const u16*)(p->ws + OFF_PROJ);
  const u16* W1T = (const u16*)(p->ws + OFF_W + W_C1) + (size_t)which * 64 * 2048;
  const u16* W2T = (const u16*)(p->ws + OFF_W + W_C2) + which * 4096;
  const float* pe = p->cmp_pe + (size_t)(l * 2 + which) * 32 * 64;
  const int blk0 = tile * 64 + wv * 16;
  int blk = blk0 + l15;
  int blkc = blk < 1023 ? blk : 1022;
  const u16* arow = proj + ((size_t)b * T + blkc * 16) * PJ + (which ? C_VCMP : C_KCMP) + g * 64;
  f32x4 acc[4];
#pragma unroll
  for (int n = 0; n < 4; ++n) acc[n] = f32x4{0.f, 0.f, 0.f, 0.f};
  for (int ks = 0; ks < 64; ++ks) {
    int tok = ks >> 1, d0 = (ks & 1) * 32 + quad * 8;
    uint4 raw = *(const uint4*)(arow + (size_t)tok * PJ + d0);
    float4 pe0 = *(const float4*)(pe + tok * 64 + d0), pe1 = *(const float4*)(pe + tok * 64 + d0 + 4);
    union { bf16x8 v; u32 u[4]; } af;
    af.u[0] = pack2(bf2f(raw.x & 0xffff) + pe0.x, bf2f(raw.x >> 16) + pe0.y);
    af.u[1] = pack2(bf2f(raw.y & 0xffff) + pe0.z, bf2f(raw.y >> 16) + pe0.w);
    af.u[2] = pack2(bf2f(raw.z & 0xffff) + pe1.x, bf2f(raw.z >> 16) + pe1.y);
    af.u[3] = pack2(bf2f(raw.w & 0xffff) + pe1.z, bf2f(raw.w >> 16) + pe1.w);
#pragma unroll
    for (int n = 0; n < 4; ++n) {
      bf16x8 bfr = *(const bf16x8*)(W1T + (size_t)(n * 16 + l15) * 2048 + ks * 32 + quad * 8);
      acc[n] = mfma16(af.v, bfr, acc[n]);
    }
  }
  u16* hid = (u16*)smem + wv * 16 * 72;
#pragma unroll
  for (int n = 0; n < 4; ++n)
#pragma unroll
    for (int r = 0; r < 4; ++r) {
      float x = acc[n][r];
      float u = 0.7978845608028654f * (x + 0.044715f * x * x * x);
      float gl = 0.5f * x * (1.f + tanhf(u));
      hid[(quad * 4 + r) * 72 + n * 16 + l15] = f2bf(gl);
    }
  __syncthreads();
  f32x4 o2[4];
#pragma unroll
  for (int n = 0; n < 4; ++n) o2[n] = f32x4{0.f, 0.f, 0.f, 0.f};
#pragma unroll
  for (int ks = 0; ks < 2; ++ks) {
    bf16x8 af = *(const bf16x8*)(hid + l15 * 72 + ks * 32 + quad * 8);
#pragma unroll
    for (int n = 0; n < 4; ++n) {
      bf16x8 bfr = *(const bf16x8*)(W2T + (n * 16 + l15) * 64 + ks * 32 + quad * 8);
      o2[n] = mfma16(af, bfr, o2[n]);
    }
  }
  __syncthreads();
  if (which == 0) {
    u16* KC = (u16*)(p->ws + OFF_KC) + (size_t)(b * 2 + g) * 1024 * 64;
    const float* kg = p->nsa_k_norm + (l * 3 + 0) * 64;
#pragma unroll
    for (int r = 0; r < 4; ++r) {
      float ss = 0.f;
#pragma unroll
      for (int n = 0; n < 4; ++n) ss += o2[n][r] * o2[n][r];
      ss += __shfl_xor(ss, 1); ss += __shfl_xor(ss, 2); ss += __shfl_xor(ss, 4); ss += __shfl_xor(ss, 8);
      float rs = rsqrtf(ss * (1.f / 64.f) + 1e-6f);
      int row = blk0 + quad * 4 + r;
#pragma unroll
      for (int n = 0; n < 4; ++n) {
        float v = row < 1023 ? o2[n][r] * rs * kg[n * 16 + l15] : 0.f;
        KC[(size_t)row * 64 + n * 16 + l15] = f2bf(v);
      }
    }
  } else {
    u16* VCT = (u16*)(p->ws + OFF_KC + 524288) + (size_t)(b * 2 + g) * 64 * 1024;
#pragma unroll
    for (int r = 0; r < 4; ++r) {
      int row = blk0 + quad * 4 + r;
#pragma unroll
      for (int n = 0; n < 4; ++n) {
        float v = row < 1023 ? o2[n][r] : 0.f;
        VCT[(size_t)(n * 16 + l15) * 1024 + row] = f2bf(v);
      }
    }
  }
}

__device__ __forceinline__ void nsa_phase_c(KP p, int l, char* smem) {
  const int tid = otid(), lane = tid & 63, wv = tid >> 6, l15 = lane & 15, quad = lane >> 4;
  float* own = (float*)smem + wv * 2048;
  float* spl = own + 1024;
  const u16* proj = (const u16*)(p->ws + OFF_PROJ);
  const float* small_ = (const float*)(p->ws + OFF_SMALL);
  float* OC = (float*)(p->ws + OFF_OC);
  u32* SEL = (u32*)(p->ws + OFF_SEL);
  const int gw = obid() * 4 + wv, nw = gridDim.x * 4;
  for (int job = gw; job < 16384; job += nw) {
    const int qq = 4095 - (job >> 2), bg = job & 3, b = bg >> 1, g = bg & 1;
    const int t0 = qq * 4;
    const int ql = l15 >> 2, r_ = l15 & 3, head = g * 4 + r_;
    const int t = t0 + ql;
    const size_t tok = (size_t)b * T + t;
    const u16* KC = (const u16*)(p->ws + OFF_KC) + (size_t)bg * 1024 * 64;
    const u16* VCT = (const u16*)(p->ws + OFF_KC + 524288) + (size_t)bg * 64 * 1024;
    bf16x8 bq[2];
    bq[0] = *(const bf16x8*)(proj + tok * PJ + C_NQ + head * 64 + quad * 8);
    bq[1] = *(const bf16x8*)(proj + tok * PJ + C_NQ + head * 64 + 32 + quad * 8);
    const int nv = t >= 31 ? ((t - 31) >> 4) + 1 : 0;
    const int tmax = t0 + 3;
    const int nvmax = tmax >= 31 ? ((tmax - 31) >> 4) + 1 : 0;
    const int npair = (nvmax + 31) >> 5;
    float lsum = 0.f;
    for (int pr = 0; pr < npair; ++pr) {
#pragma unroll
      for (int hh = 0; hh < 2; ++hh) {
        int kb = pr * 32 + hh * 16;
        f32x4 s = {0.f, 0.f, 0.f, 0.f};
        s = mfma16(*(const bf16x8*)(KC + (size_t)(kb + l15) * 64 + quad * 8), bq[0], s);
        s = mfma16(*(const bf16x8*)(KC + (size_t)(kb + l15) * 64 + 32 + quad * 8), bq[1], s);
#pragma unroll
        for (int r = 0; r < 4; ++r) lsum += (kb + quad * 4 + r < nv) ? exp2f(s[r] * SC2) : 0.f;
      }
    }
    lsum += __shfl_xor(lsum, 16);
    lsum += __shfl_xor(lsum, 32);
    const float inv = lsum > 0.f ? 1.f / lsum : 0.f;
    f32x4 O[4];
#pragma unroll
    for (int dt = 0; dt < 4; ++dt) O[dt] = f32x4{0.f, 0.f, 0.f, 0.f};
    for (int pr = 0; pr < npair; ++pr) {
      f32x4 pp[2];
#pragma unroll
      for (int hh = 0; hh < 2; ++hh) {
        int kb = pr * 32 + hh * 16;
        f32x4 s = {0.f, 0.f, 0.f, 0.f};
        s = mfma16(*(const bf16x8*)(KC + (size_t)(kb + l15) * 64 + quad * 8), bq[0], s);
        s = mfma16(*(const bf16x8*)(KC + (size_t)(kb + l15) * 64 + 32 + quad * 8), bq[1], s);
#pragma unroll
        for (int r = 0; r < 4; ++r) pp[hh][r] = (kb + quad * 4 + r < nv) ? exp2f(s[r] * SC2) * inv : 0.f;
        float ow = pp[hh][0] + pp[hh][1] + pp[hh][2] + 0.5f * pp[hh][3];
        float sp = 0.5f * pp[hh][3];
        ow += __shfl_xor(ow, 1); ow += __shfl_xor(ow, 2);
        sp += __shfl_xor(sp, 1); sp += __shfl_xor(sp, 2);
        int j = (kb >> 2) + quad;
        if (r_ == 0) {
          own[ql * 256 + j] = ow;
          if (j + 1 < 256) spl[ql * 256 + j + 1] = sp;
        }
      }
      bf16x8 P = pack8(pp[0], pp[1]);
#pragma unroll
      for (int dt = 0; dt < 4; ++dt) {
        union { bf16x8 v; uint2 h[2]; } vf;
        const u16* vp = VCT + (size_t)(dt * 16 + l15) * 1024 + pr * 32 + quad * 4;
        vf.h[0] = *(const uint2*)vp;
        vf.h[1] = *(const uint2*)(vp + 16);
        O[dt] = mfma16(vf.v, P, O[dt]);
      }
    }
    {
      float gc = sigmoidf_(small_[tok * 32 + 8 + head * 3 + 0]);
#pragma unroll
      for (int dt = 0; dt < 4; ++dt) {
        float4 o = make_float4(O[dt][0] * gc, O[dt][1] * gc, O[dt][2] * gc, O[dt][3] * gc);
        *(float4*)(OC + tok * 512 + head * 64 + dt * 16 + quad * 4) = o;
      }
    }
    __builtin_amdgcn_s_waitcnt(0);
    __builtin_amdgcn_wave_barrier();
    for (int q = 0; q < 4; ++q) {
      const int tq = t0 + q, cur = tq >> 6;
      u32 word = 0;
      if (cur <= 15) {
        if (lane == 0) word = (cur == 31) ? 0xffffffffu : ((2u << cur) - 1u);
      } else {
        float vals[4];
#pragma unroll
        for (int k = 0; k < 4; ++k) {
          int j = lane + 64 * k;
          vals[k] = (j >= 1 && j <= cur - 2) ? own[q * 256 + j] + spl[q * 256 + j] : -1.f;
        }
        for (int it = 0; it < 13; ++it) {
          float bv = vals[0]; int bi = lane;
#pragma unroll
          for (int k = 1; k < 4; ++k) if (vals[k] > bv) { bv = vals[k]; bi = lane + 64 * k; }
#pragma unroll
          for (int o = 32; o; o >>= 1) {
            float ov = __shfl_xor(bv, o); int oi = __shfl_xor(bi, o);
            if (ov > bv || (ov == bv && oi < bi)) { bv = ov; bi = oi; }
          }
          if ((bi >> 5) == lane) word |= 1u << (bi & 31);
          if ((bi & 63) == lane) {
#pragma unroll
            for (int k = 0; k < 4; ++k) if ((bi >> 6) == k) vals[k] = -2.f;
          }
        }
        if (lane == 0) word |= 1u;
        if (lane == (cur >> 5)) word |= 1u << (cur & 31);
        if (lane == ((cur - 1) >> 5)) word |= 1u << ((cur - 1) & 31);
      }
      if (lane < 8) SEL[(((size_t)b * T + tq) * 2 + g) * 8 + lane] = word;
    }
    __builtin_amdgcn_wave_barrier();
  }
}

template <int MODE>
__device__ __forceinline__ void flash_blocks(const u16* __restrict__ Kg, const u16* __restrict__ VTg, int jb0, int jb1,
                                             u16* sK, u16* sV, const u16* sQw, f32x4 (&O)[4][4],
                                             float (&lsum)[4], const u32* __restrict__ selp, int tq0) {
  const int tid = otid(), lane = tid & 63, l15 = lane & 15, quad = lane >> 4;
  const int ldrow = tid >> 3, ldcc = tid & 7;
  const u16* kptr = Kg + (size_t)ldrow * PJ + ldcc * 8;
  const u16* vptr = VTg + ldrow * 64 + ldcc * 8;
  const int ldoff = ldrow * 72 + ldcc * 8;
  uint4 rk0, rk1, rv0, rv1;
  rk0 = *(const uint4*)(kptr + (size_t)(jb0 * 64) * PJ);
  rk1 = *(const uint4*)(kptr + (size_t)(jb0 * 64 + 32) * PJ);
  rv0 = *(const uint4*)(vptr + (size_t)jb0 * 4096);
  rv1 = *(const uint4*)(vptr + (size_t)jb0 * 4096 + 2048);
  *(uint4*)(sK + ldoff) = rk0;
  *(uint4*)(sK + ldoff + 32 * 72) = rk1;
  *(uint4*)(sV + ldoff) = rv0;
  *(uint4*)(sV + ldoff + 32 * 72) = rv1;
  __syncthreads();
  u32 selw[4] = {0u, 0u, 0u, 0u};
  for (int jb = jb0; jb <= jb1; ++jb) {
    const int buf = (jb - jb0) & 1;
    if (jb < jb1) {
      rk0 = *(const uint4*)(kptr + (size_t)((jb + 1) * 64) * PJ);
      rk1 = *(const uint4*)(kptr + (size_t)((jb + 1) * 64 + 32) * PJ);
      rv0 = *(const uint4*)(vptr + (size_t)(jb + 1) * 4096);
      rv1 = *(const uint4*)(vptr + (size_t)(jb + 1) * 4096 + 2048);
    }
    bool bv[4], an[4];
    bool anyw = false;
#pragma unroll
    for (int nt = 0; nt < 4; ++nt) {
      if (MODE == 1) {
        if (jb == jb0 || (jb & 31) == 0) selw[nt] = selp[(size_t)(nt * 4) * 16 + (jb >> 5)];
        bv[nt] = (selw[nt] >> (jb & 31)) & 1u;
      } else {
        bv[nt] = true;
      }
      an[nt] = __any(bv[nt]);
      anyw |= an[nt];
    }
    if (anyw) {
      const u16* pk = sK + buf * 64 * 72 + l15 * 72 + quad * 8;
      const u16* pv = sV + buf * 64 * 72 + l15 * 72 + quad * 4;
#pragma unroll
      for (int kp = 0; kp < 2; ++kp) {
        bf16x8 kf[2][2], vf[4];
#pragma unroll
        for (int m2 = 0; m2 < 2; ++m2)
#pragma unroll
          for (int ks = 0; ks < 2; ++ks) kf[m2][ks] = *(const bf16x8*)(pk + (kp * 2 + m2) * 16 * 72 + ks * 32);
#pragma unroll
        for (int dt = 0; dt < 4; ++dt) {
          union { bf16x8 v; uint2 h[2]; } u;
          u.h[0] = *(const uint2*)(pv + dt * 16 * 72 + kp * 32);
          u.h[1] = *(const uint2*)(pv + dt * 16 * 72 + kp * 32 + 16);
          vf[dt] = u.v;
        }
#pragma unroll
        for (int nt = 0; nt < 4; ++nt) {
          if (!an[nt]) continue;
          const int t = tq0 + nt * 4 + (l15 >> 2);
          const bf16x8 bq0 = *(const bf16x8*)(sQw + (nt * 16 + l15) * 72 + quad * 8);
          const bf16x8 bq1 = *(const bf16x8*)(sQw + (nt * 16 + l15) * 72 + 32 + quad * 8);
          f32x4 s[2];
#pragma unroll
          for (int m2 = 0; m2 < 2; ++m2) {
            s[m2] = f32x4{0.f, 0.f, 0.f, 0.f};
            s[m2] = mfma16(kf[m2][0], bq0, s[m2]);
            s[m2] = mfma16(kf[m2][1], bq1, s[m2]);
          }
          float ls = 0.f;
          int base = jb * 64 + quad * 4 - t;
          asm volatile("" : "+v"(base));
#pragma unroll
          for (int m2 = 0; m2 < 2; ++m2)
#pragma unroll
            for (int r = 0; r < 4; ++r) {
              const int C = (kp * 2 + m2) * 16 + r;
              bool valid = MODE == 1 ? (bv[nt] && base <= -C) : (base <= -C && base > -512 - C);
              float pvv = valid ? exp2f(s[m2][r] * SC2) : 0.f;
              s[m2][r] = pvv;
              ls += pvv;
            }
          lsum[nt] += ls;
          bf16x8 P = pack8(s[0], s[1]);
#pragma unroll
          for (int dt = 0; dt < 4; ++dt) O[dt][nt] = mfma16(vf[dt], P, O[dt][nt]);
        }
      }
    }
    if (jb < jb1) {
      const int nb = (buf ^ 1) * 64 * 72;
      *(uint4*)(sK + nb + ldoff) = rk0;
      *(uint4*)(sK + nb + ldoff + 32 * 72) = rk1;
      *(uint4*)(sV + nb + ldoff) = rv0;
      *(uint4*)(sV + nb + ldoff + 32 * 72) = rv1;
    }
    __syncthreads();
  }
}

__device__ __forceinline__ void nsa_s_tile(KP p, int l, char* smem, int tile) {
  const int cur = 255 - (tile >> 2), bg = tile & 3, b = bg >> 1, g = bg & 1;
  const int tid = otid(), lane = tid & 63, wv = tid >> 6, l15 = lane & 15, quad = lane >> 4;
  u16* sK = (u16*)smem;
  u16* sV = sK + 2 * 64 * 72;
  u16* sQw = sV + 2 * 64 * 72 + wv * 64 * 72;
  const u16* proj = (const u16*)(p->ws + OFF_PROJ);
  const float* small_ = (const float*)(p->ws + OFF_SMALL);
  const float* rope = (const float*)(p->ws + OFF_ROPE);
  float* OC = (float*)(p->ws + OFF_OC);
  u16* mix = (u16*)(p->ws + OFF_H);
  const size_t tokb = (size_t)b * T;
  const int tq0 = cur * 64 + wv * 16;
  const int r_ = l15 & 3, head = g * 4 + r_;
#pragma unroll
  for (int nt = 0; nt < 4; ++nt) {
    const size_t tok = tokb + tq0 + nt * 4 + (l15 >> 2);
    const u16* qrow = proj + tok * PJ + C_NQ + head * 64;
    u16* qd = sQw + (nt * 16 + l15) * 72;
    *(bf16x8*)(qd + 32 + quad * 8) = *(const bf16x8*)(qrow + 32 + quad * 8);
    if (quad >= 2) {
      *(bf16x8*)(qd + quad * 8) = *(const bf16x8*)(qrow + quad * 8);
    } else {
      union { bf16x8 v; u16 h[8]; } x1, x2, o;
      x1.v = *(const bf16x8*)(qrow);
      x2.v = *(const bf16x8*)(qrow + 8);
      const float* rp = rope + tok * 16;
#pragma unroll
      for (int i = 0; i < 8; ++i) {
        float a = bf2f(x1.h[i]), bb = bf2f(x2.h[i]), c = rp[i], s = rp[8 + i];
        o.h[i] = f2bf(quad == 0 ? a * c - bb * s : bb * c + a * s);
      }
      *(bf16x8*)(qd + quad * 8) = o.v;
    }
  }
  f32x4 O[4][4];
  float lsum[4];
#pragma unroll
  for (int dt = 0; dt < 4; ++dt)
#pragma unroll
    for (int nt = 0; nt < 4; ++nt) O[dt][nt] = f32x4{0.f, 0.f, 0.f, 0.f};
#pragma unroll
  for (int nt = 0; nt < 4; ++nt) lsum[nt] = 0.f;
  {
    const u16* Kg = proj + tokb * PJ + C_KWIN + g * 64;
    const u16* VTg = (const u16*)(p->ws + OFF_VT + 8 * MiB) + (size_t)(bg * 256) * 4096;
    int jb0 = cur - 8 < 0 ? 0 : cur - 8;
    flash_blocks<0>(Kg, VTg, jb0, cur, sK, sV, sQw, O, lsum, nullptr, tq0);
  }
#pragma unroll
  for (int nt = 0; nt < 4; ++nt) {
    const size_t tok = tokb + tq0 + nt * 4 + (l15 >> 2);
    float ls = lsum[nt];
    ls += __shfl_xor(ls, 16);
    ls += __shfl_xor(ls, 32);
    float sc = sigmoidf_(small_[tok * 32 + 8 + head * 3 + 2]) / ls;
#pragma unroll
    for (int dt = 0; dt < 4; ++dt) {
      float4* op = (float4*)(OC + tok * 512 + head * 64 + dt * 16 + quad * 4);
      float4 o = *op;
      o.x += O[dt][nt][0] * sc; o.y += O[dt][nt][1] * sc; o.z += O[dt][nt][2] * sc; o.w += O[dt][nt][3] * sc;
      *op = o;
      O[dt][nt] = f32x4{0.f, 0.f, 0.f, 0.f};
    }
    lsum[nt] = 0.f;
  }
  {
    const u16* Kg = proj + tokb * PJ + C_KSLC + g * 64;
    const u16* VTg = (const u16*)(p->ws + OFF_VT) + (size_t)(bg * 256) * 4096;
    const u32* selp = (const u32*)(p->ws + OFF_SEL) + ((tokb + tq0 + (l15 >> 2)) * 2 + g) * 8;
    flash_blocks<1>(Kg, VTg, 0, cur, sK, sV, sQw, O, lsum, selp, tq0);
  }
#pragma unroll
  for (int nt = 0; nt < 4; ++nt) {
    const size_t tok = tokb + tq0 + nt * 4 + (l15 >> 2);
    float ls = lsum[nt];
    ls += __shfl_xor(ls, 16);
    ls += __shfl_xor(ls, 32);
    float sc = sigmoidf_(small_[tok * 32 + 8 + head * 3 + 1]) / ls;
#pragma unroll
    for (int dt = 0; dt < 4; ++dt) {
      float4 o = *(const float4*)(OC + tok * 512 + head * 64 + dt * 16 + quad * 4);
      uint2 w;
      w.x = pack2(o.x + O[dt][nt][0] * sc, o.y + O[dt][nt][1] * sc);
      w.y = pack2(o.z + O[dt][nt][2] * sc, o.w + O[dt][nt][3] * sc);
      *(uint2*)(mix + tok * DM + 256 + head * 64 + dt * 16 + quad * 4) = w;
    }
  }
}

__global__ void __launch_bounds__(256, 2) hymba_mega(Params p_unused) {
  cg::grid_group grid = cg::this_grid();
  __shared__ __attribute__((aligned(16))) char smem[73728];
  __shared__ int s_tile;
  { KP p = kargs(); rope_table(p); }
#pragma unroll 1
  for (int l = 0; l < DEPTH; ++l) {
    {
      KP p = kargs();
      if (blockIdx.x == 0 && threadIdx.x == 0) ((u32*)(p->ws + OFF_CNT))[0] = 0u;
      convert_weights(p, l, smem);
      rmsnorm_rows(l == 0 ? p->x_in : p->out, p->attn_norm + l * DM, (u16*)(p->ws + OFF_H));
    }
    grid.sync();
    {
      KP p = kargs();
      gemm_phase((const u16*)(p->ws + OFF_H), DM, (const u16*)(p->ws + OFF_W + W_IN), DM, DM, 256, 25, smem,
                 EpiInProj{(u16*)(p->ws + OFF_PROJ), (float*)(p->ws + OFF_SMALL)});
    }
    grid.sync();
    {
      KP p = kargs();
      for (int job = obid(); job < 2048 + 512 + 128; job += gridDim.x) {
        if (job < 2048) gdn_chunk_prep(p, l, smem, job);
        else if (job < 2560) nsa_token_prep(p, l, smem, job - 2048);
        else nsa_compress(p, l, smem, job - 2560);
      }
    }
    grid.sync();
    {
      KP p = kargs();
      nsa_phase_c(p, l, smem);
    }
    grid.sync();
    {
      KP p = kargs();
      if (obid() < 32) gdn_scan(p, smem, obid());
      u32* CNT = (u32*)(p->ws + OFF_CNT);
      for (;;) {
        __syncthreads();
        if (threadIdx.x == 0) s_tile = (int)atomicAdd(&CNT[0], 1u);
        __syncthreads();
        int tile = s_tile;
        if (tile >= 1024) break;
        nsa_s_tile(p, l, smem, tile);
      }
    }
    grid.sync();
    {
      KP p = kargs();
      gdn_finalize(p, l);
    }
    grid.sync();
    {
      KP p = kargs();
      gemm_phase((const u16*)(p->ws + OFF_H), DM, (const u16*)(p->ws + OFF_W + W_OUT), DM, DM, 256, 8, smem,
                 EpiResid{l == 0 ? p->x_in : p->out, p->out});
    }
    grid.sync();
    {
      KP p = kargs();
      rmsnorm_rows(p->out, p->ffn_norm + l * DM, (u16*)(p->ws + OFF_H));
    }
    grid.sync();
    {
      KP p = kargs();
      gemm_phase((const u16*)(p->ws + OFF_H), DM, (const u16*)(p->ws + OFF_W + W_GU), DM, DM, 256, 44, smem,
                 EpiSwiGLU{(u16*)(p->ws + OFF_PROJ)});
    }
    grid.sync();
    {
      KP p = kargs();
      gemm_phase((const u16*)(p->ws + OFF_PROJ), DFF, (const u16*)(p->ws + OFF_W + W_DOWN), DFF, DFF, 256, 8, smem,
                 EpiResid{p->out, p->out});
    }
    grid.sync();
  }
}

extern "C" void kernel_launch(void* const* d_in, const int* in_sizes, int n_in, void* d_out, int out_size, void* d_ws,
                              size_t ws_size, hipStream_t stream) {
  static int grid_blocks = 0;
  if (!grid_blocks) {
    int dev = 0, cus = 0, per_cu = 0;
    hipGetDevice(&dev);
    hipDeviceGetAttribute(&cus, hipDeviceAttributeMultiprocessorCount, dev);
    hipOccupancyMaxActiveBlocksPerMultiprocessor(&per_cu, hymba_mega, 256, 0);
    if (per_cu > 2) per_cu = 2;
    if (per_cu < 1) per_cu = 1;
    grid_blocks = cus * per_cu;
    grid_blocks &= ~7;
  }
  Params p;
  memset(&p, 0, sizeof(p));
  p.x_in = (const float*)d_in[0]; p.positions = (const int*)d_in[1]; p.attn_norm = (const float*)d_in[2];
  p.w_in = (const float*)d_in[3]; p.gdn_conv_w = (const float*)d_in[4]; p.gdn_a_log = (const float*)d_in[5];
  p.gdn_dt_bias = (const float*)d_in[6]; p.gdn_norm = (const float*)d_in[7]; p.nsa_q_norm = (const float*)d_in[8];
  p.nsa_k_norm = (const float*)d_in[9]; p.cmp_pe = (const float*)d_in[10]; p.cmp_w1 = (const float*)d_in[11];
  p.cmp_w2 = (const float*)d_in[12]; p.conv_w = (const float*)d_in[13]; p.w_out = (const float*)d_in[14];
  p.ffn_norm = (const float*)d_in[15]; p.w_gate_up = (const float*)d_in[16]; p.w_down = (const float*)d_in[17];
  p.out = (float*)d_out; p.ws = (char*)d_ws;
  void* args[] = {&p};
  hipError_t e = hipLaunchCooperativeKernel((void*)hymba_mega, dim3(grid_blocks), dim3(256), args, 0, stream);
  if (e != hipSuccess) fprintf(stderr, "cooperative launch failed: %s (grid %d)\n", hipGetErrorString(e), grid_blocks);
}
```

```cpp
#include <hip/hip_runtime.h>
#include <hip/hip_cooperative_groups.h>
#include <cstdio>
#include <cstring>
namespace cg = cooperative_groups;

typedef unsigned short u16;
typedef unsigned int u32;
typedef __attribute__((ext_vector_type(8))) short bf16x8;
typedef __attribute__((ext_vector_type(4))) short bf16x4;
typedef __attribute__((ext_vector_type(4))) float f32x4;

constexpr int NB = 2, T = 16384, NTOK = NB * T, DM = 1024, DFF = 2816, DEPTH = 4;
constexpr int PJ = 3072;
constexpr int C_GQ = 0, C_GK = 256, C_GV = 512, C_GZ = 768, C_NQ = 1024, C_KCMP = 1536, C_VCMP = 1664,
              C_KSLC = 1792, C_VSLC = 1920, C_KWIN = 2048, C_VWIN = 2176, C_CB = 2304, C_CC = 2560, C_CX = 2816;
constexpr size_t MiB = 1ull << 20;
constexpr size_t OFF_H = 0, OFF_PROJ = 64 * MiB, OFF_SMALL = 256 * MiB, OFF_W = 260 * MiB, OFF_GDN = 288 * MiB,
                 OFF_OG = 384 * MiB, OFF_OC = 416 * MiB, OFF_VT = 480 * MiB, OFF_KC = 496 * MiB, OFF_SEL = 497 * MiB,
                 OFF_ROPE = 499 * MiB, OFF_GL = 501 * MiB, OFF_CNT = 501 * MiB + 65536;
constexpr size_t W_IN = 0, W_OUT = 6553600, W_GU = 8650752, W_DOWN = 20185088, W_C1 = 25952256, W_C2 = 26476544;
constexpr int CHUNK_B = 49152;
constexpr float SC2 = 0.125f * 1.4426950408889634f;

struct Params {
  const float* x_in; const int* positions; const float* attn_norm; const float* w_in; const float* gdn_conv_w;
  const float* gdn_a_log; const float* gdn_dt_bias; const float* gdn_norm; const float* nsa_q_norm;
  const float* nsa_k_norm; const float* cmp_pe; const float* cmp_w1; const float* cmp_w2; const float* conv_w;
  const float* w_out; const float* ffn_norm; const float* w_gate_up; const float* w_down;
  float* out; char* ws;
};


__device__ __forceinline__ int otid() { int t = threadIdx.x; asm volatile("" : "+v"(t)); return t; }
__device__ __forceinline__ int obid() { int t = blockIdx.x; asm volatile("" : "+s"(t)); return t; }
typedef const __attribute__((address_space(4))) Params* KP;
__device__ __forceinline__ KP kargs() {
  KP k = (KP)__builtin_amdgcn_kernarg_segment_ptr();
  asm volatile("" : "+s"(k));
  return k;
}

__device__ __forceinline__ u16 f2bf(float f) {
  u32 u = __float_as_uint(f);
  u += 0x7fffu + ((u >> 16) & 1u);
  return (u16)(u >> 16);
}
__device__ __forceinline__ float bf2f(u16 h) { return __uint_as_float(((u32)h) << 16); }
__device__ __forceinline__ u32 pack2(float a, float b) { return (u32)f2bf(a) | ((u32)f2bf(b) << 16); }
__device__ __forceinline__ float wave_sum(float v) {
#pragma unroll
  for (int o = 32; o; o >>= 1) v += __shfl_xor(v, o);
  return v;
}
__device__ __forceinline__ float sigmoidf_(float x) { return 1.f / (1.f + __expf(-x)); }
__device__ __forceinline__ f32x4 mfma16(bf16x8 a, bf16x8 b, f32x4 c) {
  return __builtin_amdgcn_mfma_f32_16x16x32_bf16(a, b, c, 0, 0, 0);
}
__device__ __forceinline__ bf16x8 pack8(f32x4 a, f32x4 b) {
  union { bf16x8 v; u32 u[4]; } r;
  r.u[0] = pack2(a[0], a[1]); r.u[1] = pack2(a[2], a[3]);
  r.u[2] = pack2(b[0], b[1]); r.u[3] = pack2(b[2], b[3]);
  return r.v;
}

__device__ __forceinline__ void rmsnorm_rows(const float* __restrict__ x, const float* __restrict__ gain, u16* __restrict__ h) {
  int lane = otid() & 63;
  int gw = obid() * 4 + (otid() >> 6), nw = gridDim.x * 4;
  for (int row = gw; row < NTOK; row += nw) {
    const float4* xr = (const float4*)(x + (size_t)row * DM);
    float4 v[4];
    float ss = 0.f;
#pragma unroll
    for (int i = 0; i < 4; ++i) {
      v[i] = xr[lane + 64 * i];
      ss += v[i].x * v[i].x + v[i].y * v[i].y + v[i].z * v[i].z + v[i].w * v[i].w;
    }
    ss = wave_sum(ss);
    float rs = rsqrtf(ss * (1.f / DM) + 1e-6f);
#pragma unroll
    for (int i = 0; i < 4; ++i) {
      float4 g = ((const float4*)gain)[lane + 64 * i];
      uint2 o;
      o.x = pack2(v[i].x * rs * g.x, v[i].y * rs * g.y);
      o.y = pack2(v[i].z * rs * g.z, v[i].w * rs * g.w);
      *(uint2*)(h + (size_t)row * DM + (lane + 64 * i) * 4) = o;
    }
  }
}

struct MapId { __device__ int operator()(int n) const { return n; } };
struct MapIn {
  __device__ int operator()(int n) const {
    if (n < 1024) return n;
    if (n < 2304) return n + 8;
    if (n < 3072) return n + 32;
    if (n < 3080) return n - 3072 + 1024;
    if (n < 3104) return n - 3080 + 2312;
    return -1;
  }
};
struct MapGU {
  __device__ int operator()(int n) const {
    int grp = n >> 6, r = n & 63;
    return r < 32 ? grp * 32 + r : DFF + grp * 32 + (r - 32);
  }
};
template <class Map>
__device__ __forceinline__ void transpose_tile(const float* __restrict__ src, int lds_, Map map, u16* __restrict__ dst, int ldd, int n0,
                               int k0, float* t) {
  int tid = otid();
#pragma unroll 4
  for (int i = 0; i < 16; ++i) {
    int k = i * 4 + (tid >> 6), n = tid & 63;
    int sn = map(n0 + n);
    t[k * 65 + n] = sn >= 0 ? src[(size_t)(k0 + k) * lds_ + sn] : 0.f;
  }
  __syncthreads();
#pragma unroll 4
  for (int i = 0; i < 16; ++i) {
    int n = i * 4 + (tid >> 6), k = tid & 63;
    dst[(size_t)(n0 + n) * ldd + k0 + k] = f2bf(t[k * 65 + n]);
  }
  __syncthreads();
}

__device__ __forceinline__ void convert_weights(KP p, int l, char* smem) {
  float* t = (float*)smem;
  char* W = p->ws + OFF_W;
  const int J0 = 800, J1 = J0 + 256, J2 = J1 + 1408, J3 = J2 + 704, J4 = J3 + 64, J5 = J4 + 2;
  for (int job = obid(); job < J5; job += gridDim.x) {
    if (job < J0) {
      transpose_tile(p->w_in + (size_t)l * DM * 3104, 3104, MapIn(), (u16*)(W + W_IN), 1024, (job >> 4) * 64,
                     (job & 15) * 64, t);
    } else if (job < J1) {
      int j = job - J0;
      transpose_tile(p->w_out + (size_t)l * DM * DM, 1024, MapId(), (u16*)(W + W_OUT), 1024, (j >> 4) * 64,
                     (j & 15) * 64, t);
    } else if (job < J2) {
      int j = job - J1;
      transpose_tile(p->w_gate_up + (size_t)l * DM * 2 * DFF, 2 * DFF, MapGU(), (u16*)(W + W_GU), 1024, (j >> 4) * 64,
                     (j & 15) * 64, t);
    } else if (job < J3) {
      int j = job - J2;
      transpose_tile(p->w_down + (size_t)l * DFF * DM, 1024, MapId(), (u16*)(W + W_DOWN), DFF, (j / 44) * 64,
                     (j % 44) * 64, t);
    } else if (job < J4) {
      int j = job - J3;
      int which = j >> 5, kt = j & 31;
      transpose_tile(p->cmp_w1 + (size_t)(l * 2 + which) * 2048 * 64, 64, MapId(),
                     (u16*)(W + W_C1) + (size_t)which * 64 * 2048, 2048, 0, kt * 64, t);
    } else {
      int which = job - J4;
      transpose_tile(p->cmp_w2 + (size_t)(l * 2 + which) * 64 * 64, 64, MapId(), (u16*)(W + W_C2) + which * 4096, 64, 0,
                     0, t);
    }
  }
}

#define WAIT_VM(n) asm volatile("s_waitcnt vmcnt(" #n ")" ::: "memory")
#define RAW_BAR() do { asm volatile("s_waitcnt lgkmcnt(0)" ::: "memory"); __builtin_amdgcn_s_barrier(); } while (0)
template <class Epi>
__device__ __forceinline__ void gemm_phase(const u16* __restrict__ A, int lda, const u16* __restrict__ Bt, int ldb, int K, int ntm,
                           int ntn, char* smem, Epi epi) {
  const int tid = otid(), lane = tid & 63, wv = tid >> 6;
  const int wm = wv >> 1, wn = wv & 1, l15 = lane & 15, quad = lane >> 4;
  const int ntiles = ntm * ntn, nk = K >> 5;
  const int lrow = lane >> 2, lchunk = (lane & 3) ^ ((lane >> 4) & 3);
  const int fpos = (quad ^ ((l15 >> 2) & 3)) * 16;
  const int aoff = (wm * 64 + l15) * 64 + fpos;
  const int boff = 8192 + (wn * 64 + l15) * 64 + fpos;
  for (int id = obid(); id < ntiles; id += gridDim.x) {
    WAIT_VM(0);
    int xcd = id & 7, loc = id >> 3;
    int tm_l, tn;
    {
      int per_rb = 8 * ntn;
      int rb = loc / per_rb, rem = loc % per_rb;
      int cb = rem >> 6, rem2 = rem & 63;
      int width = (cb + 1) * 8 <= ntn ? 8 : ntn - cb * 8;
      tm_l = rb * 8 + rem2 / width;
      tn = cb * 8 + rem2 % width;
    }
    int tm = tm_l * 8 + xcd;
    int row0 = tm * 128, col0 = tn * 128;
    const u16* gA = A + (size_t)(row0 + wv * 32 + lrow) * lda + lchunk * 8;
    const u16* gB = Bt + (size_t)(col0 + wv * 32 + lrow) * ldb + lchunk * 8;
    const size_t a16 = (size_t)16 * lda, b16 = (size_t)16 * ldb;
    f32x4 acc[4][4];
#pragma unroll
    for (int m = 0; m < 4; ++m)
#pragma unroll
      for (int n = 0; n < 4; ++n) acc[m][n] = f32x4{0.f, 0.f, 0.f, 0.f};
    char* lbase = smem + wv * 2048;
#define GLDS_STAGE(kt)                                                                                      \
  do {                                                                                                      \
    char* st_ = lbase + ((kt) & 3) * 16384;                                                                 \
    __builtin_amdgcn_global_load_lds((const u32*)(gA + (kt) * 32), (u32*)(st_), 16, 0, 0);                  \
    __builtin_amdgcn_global_load_lds((const u32*)(gA + a16 + (kt) * 32), (u32*)(st_ + 1024), 16, 0, 0);    \
    __builtin_amdgcn_global_load_lds((const u32*)(gB + (kt) * 32), (u32*)(st_ + 8192), 16, 0, 0);          \
    __builtin_amdgcn_global_load_lds((const u32*)(gB + b16 + (kt) * 32), (u32*)(st_ + 9216), 16, 0, 0);    \
  } while (0)
    GLDS_STAGE(0);
    GLDS_STAGE(1);
    GLDS_STAGE(2);
    for (int kt = 0; kt < nk; ++kt) {
      if (kt + 2 < nk) WAIT_VM(8);
      else if (kt + 1 < nk) WAIT_VM(4);
      else WAIT_VM(0);
      RAW_BAR();
      if (kt + 3 < nk) GLDS_STAGE(kt + 3);
      const char* st = smem + (kt & 3) * 16384;
      bf16x8 af[4], bfr[4];
#pragma unroll
      for (int m = 0; m < 4; ++m) af[m] = *(const bf16x8*)(st + aoff + m * 1024);
#pragma unroll
      for (int n = 0; n < 4; ++n) bfr[n] = *(const bf16x8*)(st + boff + n * 1024);
#pragma unroll
      for (int m = 0; m < 4; ++m)
#pragma unroll
        for (int n = 0; n < 4; ++n) acc[m][n] = mfma16(af[m], bfr[n], acc[m][n]);
    }
    RAW_BAR();
    epi(acc, row0 + wm * 64 + quad * 4, col0 + wn * 64 + l15, tn);
  }
}

struct EpiInProj {
  u16* proj; float* small_;
  __device__ __forceinline__ void operator()(f32x4 (&acc)[4][4], int rbase, int cbase, int tn) const {
    if (tn < 24) {
#pragma unroll
      for (int m = 0; m < 4; ++m)
#pragma unroll
        for (int n = 0; n < 4; ++n)
#pragma unroll
          for (int r = 0; r < 4; ++r)
            proj[(size_t)(rbase + m * 16 + r) * PJ + cbase + n * 16] = f2bf(acc[m][n][r]);
    } else {
#pragma unroll
      for (int m = 0; m < 4; ++m)
#pragma unroll
        for (int n = 0; n < 4; ++n) {
          int c = cbase + n * 16 - 3072;
          if (c < 32) {
#pragma unroll
            for (int r = 0; r < 4; ++r) small_[(size_t)(rbase + m * 16 + r) * 32 + c] = acc[m][n][r];
          }
        }
    }
  }
};
struct EpiResid {
  const float* xin; float* xout;
  __device__ __forceinline__ void operator()(f32x4 (&acc)[4][4], int rbase, int cbase, int tn) const {
#pragma unroll
    for (int m = 0; m < 4; ++m)
#pragma unroll
      for (int n = 0; n < 4; ++n)
#pragma unroll
        for (int r = 0; r < 4; ++r) {
          size_t idx = (size_t)(rbase + m * 16 + r) * DM + cbase + n * 16;
          xout[idx] = xin[idx] + acc[m][n][r];
        }
  }
};
struct EpiSwiGLU {
  u16* act;
  __device__ __forceinline__ void operator()(f32x4 (&acc)[4][4], int rbase, int cbase, int tn) const {
    int grp = cbase >> 6, l15 = cbase & 15;
#pragma unroll
    for (int m = 0; m < 4; ++m)
#pragma unroll
      for (int n = 0; n < 2; ++n)
#pragma unroll
        for (int r = 0; r < 4; ++r) {
          float gt = acc[m][n][r], up = acc[m][n + 2][r];
          float v = gt / (1.f + __expf(-gt)) * up;
          act[(size_t)(rbase + m * 16 + r) * DFF + grp * 32 + n * 16 + l15] = f2bf(v);
        }
  }
};

__device__ __forceinline__ void gdn_chunk_prep(KP p, int l, char* smem, int job) {
  const int b = job >> 10, h = (job >> 8) & 3, c = job & 255;
  const int tid = otid(), lane = tid & 63, wv = tid >> 6;
  float* sq = (float*)smem;
  float* sk = sq + 64 * 65;
  float* sv = sk + 64 * 65;
  float* sA = sv + 64 * 65;
  float* sgc = sA + 64 * 64;
  float* sbeta = sgc + 64;
  float* seg = sbeta + 64;
  float* sf2 = seg + 64;
  const u16* proj = (const u16*)(p->ws + OFF_PROJ);
  const float* small_ = (const float*)(p->ws + OFF_SMALL);
  const size_t tok0 = (size_t)b * T + c * 64;
  char* cb = p->ws + OFF_GDN + (size_t)((b * 4 + h) * 256 + c) * CHUNK_B;
  float* UT = (float*)cb;
  u16* NW = (u16*)(cb + 16384);
  u16* QD = (u16*)(cb + 24576);
  u16* KDT = (u16*)(cb + 32768);
  u16* QKM = (u16*)(cb + 40960);
  {
    int d = lane, i0 = wv * 16;
#pragma unroll
    for (int seg_ = 0; seg_ < 3; ++seg_) {
      int ch = seg_ * 256 + h * 64 + d;
      const float* cw = p->gdn_conv_w + (size_t)l * 4 * 768 + ch;
      float w0 = cw[0], w1 = cw[768], w2 = cw[1536], w3 = cw[2304];
      float* dst = seg_ == 0 ? sq : (seg_ == 1 ? sk : sv);
      float x0 = 0, x1 = 0, x2 = 0;
      int tl = c * 64 + i0;
      if (tl - 3 >= 0) x0 = bf2f(proj[(tok0 + i0 - 3) * PJ + ch]);
      if (tl - 2 >= 0) x1 = bf2f(proj[(tok0 + i0 - 2) * PJ + ch]);
      if (tl - 1 >= 0) x2 = bf2f(proj[(tok0 + i0 - 1) * PJ + ch]);
      for (int i = 0; i < 16; ++i) {
        float x3 = bf2f(proj[(tok0 + i0 + i) * PJ + ch]);
        float y = w0 * x0 + w1 * x1 + w2 * x2 + w3 * x3;
        dst[(i0 + i) * 65 + d] = y / (1.f + __expf(-y));
        x0 = x1; x1 = x2; x2 = x3;
      }
    }
  }
  if (tid < 64) {
    float gb = small_[(tok0 + tid) * 32 + h], ga = small_[(tok0 + tid) * 32 + 4 + h];
    float xx = ga + p->gdn_dt_bias[l * 4 + h];
    float sp = fmaxf(xx, 0.f) + log1pf(__expf(-fabsf(xx)));
    float g = -__expf(p->gdn_a_log[l * 4 + h]) * sp;
#pragma unroll
    for (int o = 1; o < 64; o <<= 1) {
      float t = __shfl_up(g, o);
      if (lane >= o) g += t;
    }
    float beta = sigmoidf_(gb);
    float eg = __expf(g);
    sgc[tid] = g; sbeta[tid] = beta; seg[tid] = eg; sf2[tid] = beta * eg;
    if (tid == 63) ((float*)(p->ws + OFF_GL))[(b * 4 + h) * 256 + c] = eg;
  }
  __syncthreads();
  for (int i = wv * 16; i < wv * 16 + 16; ++i) {
    float q = sq[i * 65 + lane], k = sk[i * 65 + lane];
    float sq2 = wave_sum(q * q), sk2 = wave_sum(k * k);
    sq[i * 65 + lane] = q * rsqrtf(sq2 + 1e-6f) * 0.125f;
    sk[i * 65 + lane] = k * rsqrtf(sk2 + 1e-6f);
  }
  __syncthreads();
  {
    int ti = tid >> 4, tj = tid & 15;
    float kk[4][4], qk[4][4];
#pragma unroll
    for (int a = 0; a < 4; ++a)
#pragma unroll
      for (int bb = 0; bb < 4; ++bb) { kk[a][bb] = 0.f; qk[a][bb] = 0.f; }
    if (tj <= ti) {
      for (int d = 0; d < 64; ++d) {
        float ki[4], kj[4], qi[4];
#pragma unroll
        for (int a = 0; a < 4; ++a) {
          ki[a] = sk[(ti * 4 + a) * 65 + d];
          qi[a] = sq[(ti * 4 + a) * 65 + d];
          kj[a] = sk[(tj * 4 + a) * 65 + d];
        }
#pragma unroll
        for (int a = 0; a < 4; ++a)
#pragma unroll
          for (int bb = 0; bb < 4; ++bb) { kk[a][bb] += ki[a] * kj[bb]; qk[a][bb] += qi[a] * kj[bb]; }
      }
    }
#pragma unroll
    for (int a = 0; a < 4; ++a) {
      int i = ti * 4 + a;
      float gi = sgc[i], bi = sbeta[i];
      uint2 o;
      float qv[4];
#pragma unroll
      for (int bb = 0; bb < 4; ++bb) {
        int j = tj * 4 + bb;
        float dec = (j <= i) ? __expf(gi - sgc[j]) : 0.f;
        sA[i * 64 + j] = (j < i) ? bi * kk[a][bb] * dec : 0.f;
        qv[bb] = qk[a][bb] * dec;
      }
      o.x = pack2(qv[0], qv[1]); o.y = pack2(qv[2], qv[3]);
      *(uint2*)(QKM + i * 64 + tj * 4) = o;
    }
  }
  {
    float gl = sgc[63];
    for (int idx = tid; idx < 4096; idx += 256) {
      int i = idx >> 6, d = idx & 63;
      QD[idx] = f2bf(sq[i * 65 + d] * seg[i]);
      KDT[idx] = f2bf(sk[d * 65 + i] * __expf(gl - sgc[d]));
    }
  }
  __syncthreads();
  if (tid < 128) {
    int cidx = tid;
    const float* src = cidx < 64 ? sv + cidx : sk + (cidx - 64);
    const float* fac = cidx < 64 ? sbeta : sf2;
    float x[64];
#pragma unroll
    for (int i = 0; i < 64; ++i) {
      float s = src[i * 65] * fac[i];
#pragma unroll
      for (int j = 0; j < i; ++j) s -= sA[i * 64 + j] * x[j];
      x[i] = s;
    }
    if (cidx < 64) {
#pragma unroll
      for (int i = 0; i < 64; i += 4) *(float4*)(UT + cidx * 64 + i) = make_float4(x[i], x[i + 1], x[i + 2], x[i + 3]);
    } else {
#pragma unroll
      for (int i = 0; i < 64; ++i) NW[i * 64 + (cidx - 64)] = f2bf(-x[i]);
    }
  }
  __syncthreads();
}

__device__ __forceinline__ void gdn_scan(KP p, char* smem, int sid) {
  const int b = sid >> 4, h = (sid >> 2) & 3, v0 = (sid & 3) * 16;
  const int tid = otid(), lane = tid & 63, wv = tid >> 6, l15 = lane & 15, quad = lane >> 4;
  u16* Sb = (u16*)smem;
  u16* Vb = Sb + 16 * 72;
  f32x4 S = {0.f, 0.f, 0.f, 0.f};
  *(uint2*)(Sb + l15 * 72 + 16 * wv + quad * 4) = make_uint2(0u, 0u);
  __syncthreads();
  const char* gbase = p->ws + OFF_GDN + (size_t)((b * 4 + h) * 256) * CHUNK_B;
  const float* GL = (const float*)(p->ws + OFF_GL) + (b * 4 + h) * 256;
  float* OG = (float*)(p->ws + OFF_OG);
  const int arow = (16 * wv + l15) * 64 + quad * 8;
  f32x4 u, un;
  bf16x8 wA[2], qdA[2], qkA[2], kdA[2], wAn[2], qdAn[2], qkAn[2], kdAn[2];
  float gl, gln;
  {
    const char* cb = gbase;
    u = *(const f32x4*)((const float*)cb + (v0 + l15) * 64 + 16 * wv + quad * 4);
#pragma unroll
    for (int ks = 0; ks < 2; ++ks) {
      wA[ks] = *(const bf16x8*)((const u16*)(cb + 16384) + arow + ks * 32);
      qdA[ks] = *(const bf16x8*)((const u16*)(cb + 24576) + arow + ks * 32);
      kdA[ks] = *(const bf16x8*)((const u16*)(cb + 32768) + arow + ks * 32);
      qkA[ks] = *(const bf16x8*)((const u16*)(cb + 40960) + arow + ks * 32);
    }
    gl = GL[0];
  }
  for (int c = 0; c < 256; ++c) {
    if (c + 1 < 256) {
      const char* cb = gbase + (size_t)(c + 1) * CHUNK_B;
      un = *(const f32x4*)((const float*)cb + (v0 + l15) * 64 + 16 * wv + quad * 4);
#pragma unroll
      for (int ks = 0; ks < 2; ++ks) {
        wAn[ks] = *(const bf16x8*)((const u16*)(cb + 16384) + arow + ks * 32);
        qdAn[ks] = *(const bf16x8*)((const u16*)(cb + 24576) + arow + ks * 32);
        kdAn[ks] = *(const bf16x8*)((const u16*)(cb + 32768) + arow + ks * 32);
        qkAn[ks] = *(const bf16x8*)((const u16*)(cb + 40960) + arow + ks * 32);
      }
      gln = GL[c + 1];
    }
    bf16x8 sB0 = *(const bf16x8*)(Sb + l15 * 72 + quad * 8);
    bf16x8 sB1 = *(const bf16x8*)(Sb + l15 * 72 + 32 + quad * 8);
    f32x4 vn = u;
    vn = mfma16(wA[0], sB0, vn);
    vn = mfma16(wA[1], sB1, vn);
    f32x4 o = {0.f, 0.f, 0.f, 0.f};
    o = mfma16(qdA[0], sB0, o);
    o = mfma16(qdA[1], sB1, o);
    *(uint2*)(Vb + l15 * 72 + 16 * wv + quad * 4) = make_uint2(pack2(vn[0], vn[1]), pack2(vn[2], vn[3]));
    __syncthreads();
    bf16x8 vB0 = *(const bf16x8*)(Vb + l15 * 72 + quad * 8);
    bf16x8 vB1 = *(const bf16x8*)(Vb + l15 * 72 + 32 + quad * 8);
    o = mfma16(qkA[0], vB0, o);
    o = mfma16(qkA[1], vB1, o);
    S[0] *= gl; S[1] *= gl; S[2] *= gl; S[3] *= gl;
    S = mfma16(kdA[0], vB0, S);
    S = mfma16(kdA[1], vB1, S);
    *(uint2*)(Sb + l15 * 72 + 16 * wv + quad * 4) = make_uint2(pack2(S[0], S[1]), pack2(S[2], S[3]));
    size_t orow = (size_t)b * T + c * 64 + 16 * wv + quad * 4;
#pragma unroll
    for (int r = 0; r < 4; ++r) OG[(orow + r) * 256 + h * 64 + v0 + l15] = o[r];
    __syncthreads();
    u = un; gl = gln;
#pragma unroll
    for (int ks = 0; ks < 2; ++ks) { wA[ks] = wAn[ks]; qdA[ks] = qdAn[ks]; kdA[ks] = kdAn[ks]; qkA[ks] = qkAn[ks]; }
  }
}

__device__ __forceinline__ void gdn_finalize(KP p, int l) {
  const int lane = otid() & 63;
  int gw = obid() * 4 + (otid() >> 6), nw = gridDim.x * 4;
  const float* OG = (const float*)(p->ws + OFF_OG);
  const u16* proj = (const u16*)(p->ws + OFF_PROJ);
  u16* mix = (u16*)(p->ws + OFF_H);
  float gn = p->gdn_norm[l * 64 + lane];
  for (int row = gw; row < NTOK * 4; row += nw) {
    int t = row >> 2, h = row & 3;
    float o = OG[(size_t)t * 256 + h * 64 + lane];
    float ss = wave_sum(o * o);
    float z = bf2f(proj[(size_t)t * PJ + C_GZ + h * 64 + lane]);
    float y = o * rsqrtf(ss * (1.f / 64.f) + 1e-6f) * gn * (z / (1.f + __expf(-z)));
    mix[(size_t)t * DM + h * 64 + lane] = f2bf(y);
  }
}

__device__ __forceinline__ void rope_table(KP p) {
  float* rp = (float*)(p->ws + OFF_ROPE);
  int gt = obid() * blockDim.x + otid(), nt = gridDim.x * blockDim.x;
  for (int idx = gt; idx < NTOK * 8; idx += nt) {
    int t = idx >> 3, i = idx & 7;
    float inv = (float)pow(500000.0, -(double)i / 8.0);
    float ang = (float)p->positions[t] * inv;
    rp[t * 16 + i] = (float)cos((double)ang);
    rp[t * 16 + 8 + i] = (float)sin((double)ang);
  }
}

__device__ __forceinline__ void nsa_token_prep(KP p, int l, char* smem, int tb) {
  const int tid = otid(), lane = tid & 63, wv = tid >> 6;
  const int b = tb >> 8, blk = tb & 255;
  u16* proj = (u16*)(p->ws + OFF_PROJ);
  const float* rope = (const float*)(p->ws + OFF_ROPE);
  const size_t tok0 = (size_t)tb * 64;
  for (int r = wv; r < 768; r += 4) {
    int i = r / 12, which = r % 12;
    size_t t = tok0 + i;
    int col; const float* gain;
    if (which < 8) { col = C_NQ + which * 64; gain = p->nsa_q_norm + l * 64; }
    else if (which < 10) { col = C_KSLC + (which - 8) * 64; gain = p->nsa_k_norm + (l * 3 + 1) * 64; }
    else { col = C_KWIN + (which - 10) * 64; gain = p->nsa_k_norm + (l * 3 + 2) * 64; }
    float x = bf2f(proj[t * PJ + col + lane]);
    float ss = wave_sum(x * x);
    float y = x * rsqrtf(ss * (1.f / 64.f) + 1e-6f) * gain[lane];
    if (which >= 8) {
      float other = __shfl_xor(y, 8);
      if (lane < 16) {
        float c = rope[t * 16 + (lane & 7)], s = rope[t * 16 + 8 + (lane & 7)];
        y = lane < 8 ? y * c - other * s : y * c + other * s;
      }
    }
    proj[t * PJ + col + lane] = f2bf(y);
  }
  u16* tt = (u16*)smem;
  for (int z = 0; z < 4; ++z) {
    int tensor = z >> 1, g = z & 1;
    int col = (tensor ? C_VWIN : C_VSLC) + g * 64;
    for (int idx = tid; idx < 4096; idx += 256) {
      int i = idx >> 6, d = idx & 63;
      tt[i * 66 + d] = proj[(tok0 + i) * PJ + col + d];
    }
    __syncthreads();
    u16* dst = (u16*)(p->ws + OFF_VT + (size_t)tensor * 8 * MiB) + ((size_t)((b * 2 + g) * 256 + blk)) * 4096;
    for (int idx = tid; idx < 4096; idx += 256) {
      int d = idx >> 6, i = idx & 63;
      dst[idx] = tt[i * 66 + d];
    }
    __syncthreads();
  }
  {
    int ch = tid;
    const float* cw = p->conv_w + (size_t)l * 3 * 256 + ch;
    float w0 = cw[0], w1 = cw[256], w2 = cw[512];
    u16* mix = (u16*)(p->ws + OFF_H);
    float p0 = 0.f, p1 = 0.f;
    if (blk > 0) {
      p0 = bf2f(proj[(tok0 - 2) * PJ + C_CC + ch]) * bf2f(proj[(tok0 - 2) * PJ + C_CX + ch]);
      p1 = bf2f(proj[(tok0 - 1) * PJ + C_CC + ch]) * bf2f(proj[(tok0 - 1) * PJ + C_CX + ch]);
    }
    for (int i = 0; i < 64; ++i) {
      size_t t = tok0 + i;
      float p2 = bf2f(proj[t * PJ + C_CC + ch]) * bf2f(proj[t * PJ + C_CX + ch]);
      float y = w0 * p0 + w1 * p1 + w2 * p2;
      mix[t * DM + 768 + ch] = f2bf(bf2f(proj[t * PJ + C_CB + ch]) * y);
      p0 = p1; p1 = p2;
    }
  }
}

__device__ __forceinline__ void nsa_compress(KP p, int l, char* smem, int job) {
  const int tid = otid(), lane = tid & 63, wv = tid >> 6, l15 = lane & 15, quad = lane >> 4;
  const int which = job >> 6, b = (job >> 5) & 1, g = (job >> 4) & 1, tile = job & 15;
  const u16* proj = (const u16*)(p->ws + OFF_PROJ);
  const u16* W1T = (const u16*)(p->ws + OFF_W + W_C1) + (size_t)which * 64 * 2048;
  const u16* W2T = (const u16*)(p->ws + OFF_W + W_C2) + which * 4096;
  const float* pe = p->cmp_pe + (size_t)(l * 2 + which) * 32 * 64;
  const int blk0 = tile * 64 + wv * 16;
  int blk = blk0 + l15;
  int blkc = blk < 1023 ? blk : 1022;
  const u16* arow = proj + ((size_t)b * T + blkc * 16) * PJ + (which ? C_VCMP : C_KCMP) + g * 64;
  f32x4 acc[4];
#pragma unroll
  for (int n = 0; n < 4; ++n) acc[n] = f32x4{0.f, 0.f, 0.f, 0.f};
  for (int ks = 0; ks < 64; ++ks) {
    int tok = ks >> 1, d0 = (ks & 1) * 32 + quad * 8;
    uint4 raw = *(const uint4*)(arow + (size_t)tok * PJ + d0);
    float4 pe0 = *(const float4*)(pe + tok * 64 + d0), pe1 = *(const float4*)(pe + tok * 64 + d0 + 4);
    union { bf16x8 v; u32 u[4]; } af;
    af.u[0] = pack2(bf2f(raw.x & 0xffff) + pe0.x, bf2f(raw.x >> 16) + pe0.y);
    af.u[1] = pack2(bf2f(raw.y & 0xffff) + pe0.z, bf2f(raw.y >> 16) + pe0.w);
    af.u[2] = pack2(bf2f(raw.z & 0xffff) + pe1.x, bf2f(raw.z >> 16) + pe1.y);
    af.u[3] = pack2(bf2f(raw.w & 0xffff) + pe1.z, bf2f(raw.w >> 16) + pe1.w);
#pragma unroll
    for (int n = 0; n < 4; ++n) {
      bf16x8 bfr = *(const bf16x8*)(W1T + (size_t)(n * 16 + l15) * 2048 + ks * 32 + quad * 8);
      acc[n] = mfma16(af.v, bfr, acc[n]);
    }
  }
  u16* hid = (u16*)smem + wv * 16 * 72;
#pragma unroll
  for (int n = 0; n < 4; ++n)
#pragma unroll
    for (int r = 0; r < 4; ++r) {
      float x = acc[n][r];
      float u = 0.7978845608028654f * (x + 0.044715f * x * x * x);
      float gl = 0.5f * x * (1.f + tanhf(u));
      hid[(quad * 4 + r) * 72 + n * 16 + l15] = f2bf(gl);
    }
  __syncthreads();
  f32x4 o2[4];
#pragma unroll
  for (int n = 0; n < 4; ++n) o2[n] = f32x4{0.f, 0.f, 0.f, 0.f};
#pragma unroll
  for (int ks = 0; ks < 2; ++ks) {
    bf16x8 af = *(const bf16x8*)(hid + l15 * 72 + ks * 32 + quad * 8);
#pragma unroll
    for (int n = 0; n < 4; ++n) {
      bf16x8 bfr = *(const bf16x8*)(W2T + (n * 16 + l15) * 64 + ks * 32 + quad * 8);
      o2[n] = mfma16(af, bfr, o2[n]);
    }
  }
  __syncthreads();
  if (which == 0) {
    u16* KC = (u16*)(p->ws + OFF_KC) + (size_t)(b * 2 + g) * 1024 * 64;
    const float* kg = p->nsa_k_norm + (l * 3 + 0) * 64;
#pragma unroll
    for (int r = 0; r < 4; ++r) {
      float ss = 0.f;
#pragma unroll
      for (int n = 0; n < 4; ++n) ss += o2[n][r] * o2[n][r];
      ss += __shfl_xor(ss, 1); ss += __shfl_xor(ss, 2); ss += __shfl_xor(ss, 4); ss += __shfl_xor(ss, 8);
      float rs = rsqrtf(ss * (1.f / 64.f) + 1e-6f);
      int row = blk0 + quad * 4 + r;
#pragma unroll
      for (int n = 0; n < 4; ++n) {
        float v = row < 1023 ? o2[n][r] * rs * kg[n * 16 + l15] : 0.f;
        KC[(size_t)row * 64 + n * 16 + l15] = f2bf(v);
      }
    }
  } else {
    u16* VCT = (u16*)(p->ws + OFF_KC + 524288) + (size_t)(b * 2 + g) * 64 * 1024;
#pragma unroll
    for (int r = 0; r < 4; ++r) {
      int row = blk0 + quad * 4 + r;
#pragma unroll
      for (int n = 0; n < 4; ++n) {
        float v = row < 1023 ? o2[n][r] : 0.f;
        VCT[(size_t)(n * 16 + l15) * 1024 + row] = f2bf(v);
      }
    }
  }
}

__device__ __forceinline__ void nsa_phase_c(KP p, int l, char* smem) {
  const int tid = otid(), lane = tid & 63, wv = tid >> 6, l15 = lane & 15, quad = lane >> 4;
  float* own = (float*)smem + wv * 2048;
  float* spl = own + 1024;
  const u16* proj = (const u16*)(p->ws + OFF_PROJ);
  const float* small_ = (const float*)(p->ws + OFF_SMALL);
  float* OC = (float*)(p->ws + OFF_OC);
  u32* SEL = (u32*)(p->ws + OFF_SEL);
  const int gw = obid() * 4 + wv, nw = gridDim.x * 4;
  for (int job = gw; job < 16384; job += nw) {
    const int qq = 4095 - (job >> 2), bg = job & 3, b = bg >> 1, g = bg & 1;
    const int t0 = qq * 4;
    const int ql = l15 >> 2, r_ = l15 & 3, head = g * 4 + r_;
    const int t = t0 + ql;
    const size_t tok = (size_t)b * T + t;
    const u16* KC = (const u16*)(p->ws + OFF_KC) + (size_t)bg * 1024 * 64;
    const u16* VCT = (const u16*)(p->ws + OFF_KC + 524288) + (size_t)bg * 64 * 1024;
    bf16x8 bq[2];
    bq[0] = *(const bf16x8*)(proj + tok * PJ + C_NQ + head * 64 + quad * 8);
    bq[1] = *(const bf16x8*)(proj + tok * PJ + C_NQ + head * 64 + 32 + quad * 8);
    const int nv = t >= 31 ? ((t - 31) >> 4) + 1 : 0;
    const int tmax = t0 + 3;
    const int nvmax = tmax >= 31 ? ((tmax - 31) >> 4) + 1 : 0;
    const int npair = (nvmax + 31) >> 5;
    float lsum = 0.f;
    for (int pr = 0; pr < npair; ++pr) {
#pragma unroll
      for (int hh = 0; hh < 2; ++hh) {
        int kb = pr * 32 + hh * 16;
        f32x4 s = {0.f, 0.f, 0.f, 0.f};
        s = mfma16(*(const bf16x8*)(KC + (size_t)(kb + l15) * 64 + quad * 8), bq[0], s);
        s = mfma16(*(const bf16x8*)(KC + (size_t)(kb + l15) * 64 + 32 + quad * 8), bq[1], s);
#pragma unroll
        for (int r = 0; r < 4; ++r) lsum += (kb + quad * 4 + r < nv) ? exp2f(s[r] * SC2) : 0.f;
      }
    }
    lsum += __shfl_xor(lsum, 16);
    lsum += __shfl_xor(lsum, 32);
    const float inv = lsum > 0.f ? 1.f / lsum : 0.f;
    f32x4 O[4];
#pragma unroll
    for (int dt = 0; dt < 4; ++dt) O[dt] = f32x4{0.f, 0.f, 0.f, 0.f};
    for (int pr = 0; pr < npair; ++pr) {
      f32x4 pp[2];
#pragma unroll
      for (int hh = 0; hh < 2; ++hh) {
        int kb = pr * 32 + hh * 16;
        f32x4 s = {0.f, 0.f, 0.f, 0.f};
        s = mfma16(*(const bf16x8*)(KC + (size_t)(kb + l15) * 64 + quad * 8), bq[0], s);
        s = mfma16(*(const bf16x8*)(KC + (size_t)(kb + l15) * 64 + 32 + quad * 8), bq[1], s);
#pragma unroll
        for (int r = 0; r < 4; ++r) pp[hh][r] = (kb + quad * 4 + r < nv) ? exp2f(s[r] * SC2) * inv : 0.f;
        float ow = pp[hh][0] + pp[hh][1] + pp[hh][2] + 0.5f * pp[hh][3];
        float sp = 0.5f * pp[hh][3];
        ow += __shfl_xor(ow, 1); ow += __shfl_xor(ow, 2);
        sp += __shfl_xor(sp, 1); sp += __shfl_xor(sp, 2);
        int j = (kb >> 2) + quad;
        if (r_ == 0) {
          own[ql * 256 + j] = ow;
          if (j + 1 < 256) spl[ql * 256 + j + 1] = sp;
        }
      }
      bf16x8 P = pack8(pp[0], pp[1]);
#pragma unroll
      for (int dt = 0; dt < 4; ++dt) {
        union { bf16x8 v; uint2 h[2]; } vf;
        const u16* vp = VCT + (size_t)(dt * 16 + l15) * 1024 + pr * 32 + quad * 4;
        vf.h[0] = *(const uint2*)vp;
        vf.h[1] = *(const uint2*)(vp + 16);
        O[dt] = mfma16(vf.v, P, O[dt]);
      }
    }
    {
      float gc = sigmoidf_(small_[tok * 32 + 8 + head * 3 + 0]);
#pragma unroll
      for (int dt = 0; dt < 4; ++dt) {
        float4 o = make_float4(O[dt][0] * gc, O[dt][1] * gc, O[dt][2] * gc, O[dt][3] * gc);
        *(float4*)(OC + tok * 512 + head * 64 + dt * 16 + quad * 4) = o;
      }
    }
    __builtin_amdgcn_s_waitcnt(0);
    __builtin_amdgcn_wave_barrier();
    for (int q = 0; q < 4; ++q) {
      const int tq = t0 + q, cur = tq >> 6;
      u32 word = 0;
      if (cur <= 15) {
        if (lane == 0) word = (cur == 31) ? 0xffffffffu : ((2u << cur) - 1u);
      } else {
        float vals[4];
#pragma unroll
        for (int k = 0; k < 4; ++k) {
          int j = lane + 64 * k;
          vals[k] = (j >= 1 && j <= cur - 2) ? own[q * 256 + j] + spl[q * 256 + j] : -1.f;
        }
        for (int it = 0; it < 13; ++it) {
          float bv = vals[0]; int bi = lane;
#pragma unroll
          for (int k = 1; k < 4; ++k) if (vals[k] > bv) { bv = vals[k]; bi = lane + 64 * k; }
#pragma unroll
          for (int o = 32; o; o >>= 1) {
            float ov = __shfl_xor(bv, o); int oi = __shfl_xor(bi, o);
            if (ov > bv || (ov == bv && oi < bi)) { bv = ov; bi = oi; }
          }
          if ((bi >> 5) == lane) word |= 1u << (bi & 31);
          if ((bi & 63) == lane) {
#pragma unroll
            for (int k = 0; k < 4; ++k) if ((bi >> 6) == k) vals[k] = -2.f;
          }
        }
        if (lane == 0) word |= 1u;
        if (lane == (cur >> 5)) word |= 1u << (cur & 31);
        if (lane == ((cur - 1) >> 5)) word |= 1u << ((cur - 1) & 31);
      }
      if (lane < 8) SEL[(((size_t)b * T + tq) * 2 + g) * 8 + lane] = word;
    }
    __builtin_amdgcn_wave_barrier();
  }
}

template <int MODE>
__device__ __forceinline__ void flash_blocks(const u16* __restrict__ Kg, const u16* __restrict__ VTg, int jb0, int jb1,
                                             u16* sK, u16* sV, const u16* sQw, f32x4 (&O)[4][4],
                                             float (&lsum)[4], const u32* __restrict__ selp, int tq0) {
  const int tid = otid(), lane = tid & 63, l15 = lane & 15, quad = lane >> 4;
  const int ldrow = tid >> 3, ldcc = tid & 7;
  const u16* kptr = Kg + (size_t)ldrow * PJ + ldcc * 8;
  const u16* vptr = VTg + ldrow * 64 + ldcc * 8;
  const int ldoff = ldrow * 72 + ldcc * 8;
  uint4 rk0, rk1, rv0, rv1;
  rk0 = *(const uint4*)(kptr + (size_t)(jb0 * 64) * PJ);
  rk1 = *(const uint4*)(kptr + (size_t)(jb0 * 64 + 32) * PJ);
  rv0 = *(const uint4*)(vptr + (size_t)jb0 * 4096);
  rv1 = *(const uint4*)(vptr + (size_t)jb0 * 4096 + 2048);
  *(uint4*)(sK + ldoff) = rk0;
  *(uint4*)(sK + ldoff + 32 * 72) = rk1;
  *(uint4*)(sV + ldoff) = rv0;
  *(uint4*)(sV + ldoff + 32 * 72) = rv1;
  __syncthreads();
  u32 selw[4] = {0u, 0u, 0u, 0u};
  for (int jb = jb0; jb <= jb1; ++jb) {
    const int buf = (jb - jb0) & 1;
    if (jb < jb1) {
      rk0 = *(const uint4*)(kptr + (size_t)((jb + 1) * 64) * PJ);
      rk1 = *(const uint4*)(kptr + (size_t)((jb + 1) * 64 + 32) * PJ);
      rv0 = *(const uint4*)(vptr + (size_t)(jb + 1) * 4096);
      rv1 = *(const uint4*)(vptr + (size_t)(jb + 1) * 4096 + 2048);
    }
    bool bv[4], an[4];
    bool anyw = false;
#pragma unroll
    for (int nt = 0; nt < 4; ++nt) {
      if (MODE == 1) {
        if (jb == jb0 || (jb & 31) == 0) selw[nt] = selp[(size_t)(nt * 4) * 16 + (jb >> 5)];
        bv[nt] = (selw[nt] >> (jb & 31)) & 1u;
      } else {
        bv[nt] = true;
      }
      an[nt] = __any(bv[nt]);
      anyw |= an[nt];
    }
    if (anyw) {
      const u16* pk = sK + buf * 64 * 72 + l15 * 72 + quad * 8;
      const u16* pv = sV + buf * 64 * 72 + l15 * 72 + quad * 4;
#pragma unroll
      for (int kp = 0; kp < 2; ++kp) {
        bf16x8 kf[2][2], vf[4];
#pragma unroll
        for (int m2 = 0; m2 < 2; ++m2)
#pragma unroll
          for (int ks = 0; ks < 2; ++ks) kf[m2][ks] = *(const bf16x8*)(pk + (kp * 2 + m2) * 16 * 72 + ks * 32);
#pragma unroll
        for (int dt = 0; dt < 4; ++dt) {
          union { bf16x8 v; uint2 h[2]; } u;
          u.h[0] = *(const uint2*)(pv + dt * 16 * 72 + kp * 32);
          u.h[1] = *(const uint2*)(pv + dt * 16 * 72 + kp * 32 + 16);
          vf[dt] = u.v;
        }
#pragma unroll
        for (int nt = 0; nt < 4; ++nt) {
          if (!an[nt]) continue;
          const int t = tq0 + nt * 4 + (l15 >> 2);
          const bf16x8 bq0 = *(const bf16x8*)(sQw + (nt * 16 + l15) * 72 + quad * 8);
          const bf16x8 bq1 = *(const bf16x8*)(sQw + (nt * 16 + l15) * 72 + 32 + quad * 8);
          f32x4 s[2];
#pragma unroll
          for (int m2 = 0; m2 < 2; ++m2) {
            s[m2] = f32x4{0.f, 0.f, 0.f, 0.f};
            s[m2] = mfma16(kf[m2][0], bq0, s[m2]);
            s[m2] = mfma16(kf[m2][1], bq1, s[m2]);
          }
          float ls = 0.f;
          int base = jb * 64 + quad * 4 - t;
          asm volatile("" : "+v"(base));
#pragma unroll
          for (int m2 = 0; m2 < 2; ++m2)
#pragma unroll
            for (int r = 0; r < 4; ++r) {
              const int C = (kp * 2 + m2) * 16 + r;
              bool valid = MODE == 1 ? (bv[nt] && base <= -C) : (base <= -C && base > -512 - C);
              float pvv = valid ? exp2f(s[m2][r] * SC2) : 0.f;
              s[m2][r] = pvv;
              ls += pvv;
            }
          lsum[nt] += ls;
          bf16x8 P = pack8(s[0], s[1]);
#pragma unroll
          for (int dt = 0; dt < 4; ++dt) O[dt][nt] = mfma16(vf[dt], P, O[dt][nt]);
        }
      }
    }
    if (jb < jb1) {
      const int nb = (buf ^ 1) * 64 * 72;
      *(uint4*)(sK + nb + ldoff) = rk0;
      *(uint4*)(sK + nb + ldoff + 32 * 72) = rk1;
      *(uint4*)(sV + nb + ldoff) = rv0;
      *(uint4*)(sV + nb + ldoff + 32 * 72) = rv1;
    }
    __syncthreads();
  }
}

__device__ __forceinline__ void nsa_s_tile(KP p, int l, char* smem, int tile) {
  const int cur = 255 - (tile >> 2), bg = tile & 3, b = bg >> 1, g = bg & 1;
  const int tid = otid(), lane = tid & 63, wv = tid >> 6, l15 = lane & 15, quad = lane >> 4;
  u16* sK = (u16*)smem;
  u16* sV = sK + 2 * 64 * 72;
  u16* sQw = sV + 2 * 64 * 72 + wv * 64 * 72;
  const u16* proj = (const u16*)(p->ws + OFF_PROJ);
  const float* small_ = (const float*)(p->ws + OFF_SMALL);
  const float* rope = (const float*)(p->ws + OFF_ROPE);
  float* OC = (float*)(p->ws + OFF_OC);
  u16* mix = (u16*)(p->ws + OFF_H);
  const size_t tokb = (size_t)b * T;
  const int tq0 = cur * 64 + wv * 16;
  const int r_ = l15 & 3, head = g * 4 + r_;
#pragma unroll
  for (int nt = 0; nt < 4; ++nt) {
    const size_t tok = tokb + tq0 + nt * 4 + (l15 >> 2);
    const u16* qrow = proj + tok * PJ + C_NQ + head * 64;
    u16* qd = sQw + (nt * 16 + l15) * 72;
    *(bf16x8*)(qd + 32 + quad * 8) = *(const bf16x8*)(qrow + 32 + quad * 8);
    if (quad >= 2) {
      *(bf16x8*)(qd + quad * 8) = *(const bf16x8*)(qrow + quad * 8);
    } else {
      union { bf16x8 v; u16 h[8]; } x1, x2, o;
      x1.v = *(const bf16x8*)(qrow);
      x2.v = *(const bf16x8*)(qrow + 8);
      const float* rp = rope + tok * 16;
#pragma unroll
      for (int i = 0; i < 8; ++i) {
        float a = bf2f(x1.h[i]), bb = bf2f(x2.h[i]), c = rp[i], s = rp[8 + i];
        o.h[i] = f2bf(quad == 0 ? a * c - bb * s : bb * c + a * s);
      }
      *(bf16x8*)(qd + quad * 8) = o.v;
    }
  }
  f32x4 O[4][4];
  float lsum[4];
#pragma unroll
  for (int dt = 0; dt < 4; ++dt)
#pragma unroll
    for (int nt = 0; nt < 4; ++nt) O[dt][nt] = f32x4{0.f, 0.f, 0.f, 0.f};
#pragma unroll
  for (int nt = 0; nt < 4; ++nt) lsum[nt] = 0.f;
  {
    const u16* Kg = proj + tokb * PJ + C_KWIN + g * 64;
    const u16* VTg = (const u16*)(p->ws + OFF_VT + 8 * MiB) + (size_t)(bg * 256) * 4096;
    int jb0 = cur - 8 < 0 ? 0 : cur - 8;
    flash_blocks<0>(Kg, VTg, jb0, cur, sK, sV, sQw, O, lsum, nullptr, tq0);
  }
#pragma unroll
  for (int nt = 0; nt < 4; ++nt) {
    const size_t tok = tokb + tq0 + nt * 4 + (l15 >> 2);
    float ls = lsum[nt];
    ls += __shfl_xor(ls, 16);
    ls += __shfl_xor(ls, 32);
    float sc = sigmoidf_(small_[tok * 32 + 8 + head * 3 + 2]) / ls;
#pragma unroll
    for (int dt = 0; dt < 4; ++dt) {
      float4* op = (float4*)(OC + tok * 512 + head * 64 + dt * 16 + quad * 4);
      float4 o = *op;
      o.x += O[dt][nt][0] * sc; o.y += O[dt][nt][1] * sc; o.z += O[dt][nt][2] * sc; o.w += O[dt][nt][3] * sc;
      *op = o;
      O[dt][nt] = f32x4{0.f, 0.f, 0.f, 0.f};
    }
    lsum[nt] = 0.f;
  }
  {
    const u16* Kg = proj + tokb * PJ + C_KSLC + g * 64;
    const u16* VTg = (const u16*)(p->ws + OFF_VT) + (size_t)(bg * 256) * 4096;
    const u32* selp = (const u32*)(p->ws + OFF_SEL) + ((tokb + tq0 + (l15 >> 2)) * 2 + g) * 8;
    flash_blocks<1>(Kg, VTg, 0, cur, sK, sV, sQw, O, lsum, selp, tq0);
  }
#pragma unroll
  for (int nt = 0; nt < 4; ++nt) {
    const size_t tok = tokb + tq0 + nt * 4 + (l15 >> 2);
    float ls = lsum[nt];
    ls += __shfl_xor(ls, 16);
    ls += __shfl_xor(ls, 32);
    float sc = sigmoidf_(small_[tok * 32 + 8 + head * 3 + 1]) / ls;
#pragma unroll
    for (int dt = 0; dt < 4; ++dt) {
      float4 o = *(const float4*)(OC + tok * 512 + head * 64 + dt * 16 + quad * 4);
      uint2 w;
      w.x = pack2(o.x + O[dt][nt][0] * sc, o.y + O[dt][nt][1] * sc);
      w.y = pack2(o.z + O[dt][nt][2] * sc, o.w + O[dt][nt][3] * sc);
      *(uint2*)(mix + tok * DM + 256 + head * 64 + dt * 16 + quad * 4) = w;
    }
  }
}

#ifndef REPG
#define REPG 1
#endif
__global__ void __launch_bounds__(256, 2) hymba_mega(Params p_unused) {
  cg::grid_group grid = cg::this_grid();
  __shared__ __attribute__((aligned(16))) char smem[73728];
  __shared__ int s_tile;
  { KP p = kargs(); rope_table(p); }
#pragma unroll 1
  for (int l = 0; l < DEPTH; ++l) {
    {
      KP p = kargs();
      if (blockIdx.x == 0 && threadIdx.x == 0) ((u32*)(p->ws + OFF_CNT))[0] = 0u;
      convert_weights(p, l, smem);
      rmsnorm_rows(l == 0 ? p->x_in : p->out, p->attn_norm + l * DM, (u16*)(p->ws + OFF_H));
    }
    grid.sync();
    {
      KP p = kargs();
      for (int rep = 0; rep < REPG; ++rep)
      gemm_phase((const u16*)(p->ws + OFF_H), DM, (const u16*)(p->ws + OFF_W + W_IN), DM, DM, 256, 25, smem,
                 EpiInProj{(u16*)(p->ws + OFF_PROJ), (float*)(p->ws + OFF_SMALL)});
    }
    grid.sync();
    {
      KP p = kargs();
      for (int job = obid(); job < 2048 + 512 + 128; job += gridDim.x) {
        if (job < 2048) gdn_chunk_prep(p, l, smem, job);
        else if (job < 2560) nsa_token_prep(p, l, smem, job - 2048);
        else nsa_compress(p, l, smem, job - 2560);
      }
    }
    grid.sync();
#ifndef REP45
#define REP45 1
#endif
    for (int rep = 0; rep < REP45; ++rep) {
    {
      KP p = kargs();
      if (blockIdx.x == 0 && threadIdx.x == 0) ((u32*)(p->ws + OFF_CNT))[0] = 0u;
      nsa_phase_c(p, l, smem);
    }
    grid.sync();
    {
      KP p = kargs();
      if (obid() < 32) gdn_scan(p, smem, obid());
      u32* CNT = (u32*)(p->ws + OFF_CNT);
      for (;;) {
        __syncthreads();
        if (threadIdx.x == 0) s_tile = (int)atomicAdd(&CNT[0], 1u);
        __syncthreads();
        int tile = s_tile;
        if (tile >= 1024) break;
        nsa_s_tile(p, l, smem, tile);
      }
    }
    grid.sync();
    }
    {
      KP p = kargs();
      gdn_finalize(p, l);
    }
    grid.sync();
    {
      KP p = kargs();
      gemm_phase((const u16*)(p->ws + OFF_H), DM, (const u16*)(p->ws + OFF_W + W_OUT), DM, DM, 256, 8, smem,
                 EpiResid{l == 0 ? p->x_in : p->out, p->out});
    }
    grid.sync();
    {
      KP p = kargs();
      rmsnorm_rows(p->out, p->ffn_norm + l * DM, (u16*)(p->ws + OFF_H));
    }
    grid.sync();
    {
      KP p = kargs();
      for (int rep = 0; rep < REPG; ++rep)
      gemm_phase((const u16*)(p->ws + OFF_H), DM, (const u16*)(p->ws + OFF_W + W_GU), DM, DM, 256, 44, smem,
                 EpiSwiGLU{(u16*)(p->ws + OFF_PROJ)});
    }
    grid.sync();
    {
      KP p = kargs();
      gemm_phase((const u16*)(p->ws + OFF_PROJ), DFF, (const u16*)(p->ws + OFF_W + W_DOWN), DFF, DFF, 256, 8, smem,
                 EpiResid{p->out, p->out});
    }
    grid.sync();
  }
}

extern "C" void kernel_launch(void* const* d_in, const int* in_sizes, int n_in, void* d_out, int out_size, void* d_ws,
                              size_t ws_size, hipStream_t stream) {
  static int grid_blocks = 0;
  if (!grid_blocks) {
    int dev = 0, cus = 0, per_cu = 0;
    hipGetDevice(&dev);
    hipDeviceGetAttribute(&cus, hipDeviceAttributeMultiprocessorCount, dev);
    hipOccupancyMaxActiveBlocksPerMultiprocessor(&per_cu, hymba_mega, 256, 0);
    if (per_cu > 2) per_cu = 2;
    if (per_cu < 1) per_cu = 1;
    grid_blocks = cus * per_cu;
    grid_blocks &= ~7;
  }
  Params p;
  memset(&p, 0, sizeof(p));
  p.x_in = (const float*)d_in[0]; p.positions = (const int*)d_in[1]; p.attn_norm = (const float*)d_in[2];
  p.w_in = (const float*)d_in[3]; p.gdn_conv_w = (const float*)d_in[4]; p.gdn_a_log = (const float*)d_in[5];
  p.gdn_dt_bias = (const float*)d_in[6]; p.gdn_norm = (const float*)d_in[7]; p.nsa_q_norm = (const float*)d_in[8];
  p.nsa_k_norm = (const float*)d_in[9]; p.cmp_pe = (const float*)d_in[10]; p.cmp_w1 = (const float*)d_in[11];
  p.cmp_w2 = (const float*)d_in[12]; p.conv_w = (const float*)d_in[13]; p.w_out = (const float*)d_in[14];
  p.ffn_norm = (const float*)d_in[15]; p.w_gate_up = (const float*)d_in[16]; p.w_down = (const float*)d_in[17];
  p.out = (float*)d_out; p.ws = (char*)d_ws;
  void* args[] = {&p};
  hipError_t e = hipLaunchCooperativeKernel((void*)hymba_mega, dim3(grid_blocks), dim3(256), args, 0, stream);
  if (e != hipSuccess) fprintf(stderr, "cooperative launch failed: %s (grid %d)\n", hipGetErrorString(e), grid_blocks);
}
```

```cpp
#include <hip/hip_runtime.h>
#include <hip/hip_cooperative_groups.h>
#include <cstdio>
#include <cstring>
namespace cg = cooperative_groups;

typedef unsigned short u16;
typedef unsigned int u32;
typedef __attribute__((ext_vector_type(8))) short bf16x8;
typedef __attribute__((ext_vector_type(4))) short bf16x4;
typedef __attribute__((ext_vector_type(4))) float f32x4;

constexpr int NB = 2, T = 16384, NTOK = NB * T, DM = 1024, DFF = 2816, DEPTH = 4;
constexpr int PJ = 3072;
constexpr int C_GQ = 0, C_GK = 256, C_GV = 512, C_GZ = 768, C_NQ = 1024, C_KCMP = 1536, C_VCMP = 1664,
              C_KSLC = 1792, C_VSLC = 1920, C_KWIN = 2048, C_VWIN = 2176, C_CB = 2304, C_CC = 2560, C_CX = 2816;
constexpr size_t MiB = 1ull << 20;
constexpr size_t OFF_H = 0, OFF_PROJ = 64 * MiB, OFF_SMALL = 256 * MiB, OFF_W = 260 * MiB, OFF_GDN = 288 * MiB,
                 OFF_OG = 384 * MiB, OFF_OC = 416 * MiB, OFF_VT = 480 * MiB, OFF_KC = 496 * MiB, OFF_SEL = 497 * MiB,
                 OFF_ROPE = 499 * MiB, OFF_GL = 501 * MiB, OFF_CNT = 501 * MiB + 65536;
constexpr size_t W_IN = 0, W_OUT = 6553600, W_GU = 8650752, W_DOWN = 20185088, W_C1 = 25952256, W_C2 = 26476544;
constexpr int CHUNK_B = 49152;
constexpr float SC2 = 0.125f * 1.4426950408889634f;

struct Params {
  const float* x_in; const int* positions; const float* attn_norm; const float* w_in; const float* gdn_conv_w;
  const float* gdn_a_log; const float* gdn_dt_bias; const float* gdn_norm; const float* nsa_q_norm;
  const float* nsa_k_norm; const float* cmp_pe; const float* cmp_w1; const float* cmp_w2; const float* conv_w;
  const float* w_out; const float* ffn_norm; const float* w_gate_up; const float* w_down;
  float* out; char* ws;
};


__device__ __forceinline__ int otid() { int t = threadIdx.x; asm volatile("" : "+v"(t)); return t; }
__device__ __forceinline__ int obid() { int t = blockIdx.x; asm volatile("" : "+s"(t)); return t; }
typedef const __attribute__((address_space(4))) Params* KP;
__device__ __forceinline__ KP kargs() {
  KP k = (KP)__builtin_amdgcn_kernarg_segment_ptr();
  asm volatile("" : "+s"(k));
  return k;
}

typedef __bf16 bf2_t __attribute__((ext_vector_type(2)));
typedef float f2_t __attribute__((ext_vector_type(2)));
__device__ __forceinline__ u32 pack2(float a, float b) {
  f2_t v = {a, b};
  bf2_t r = __builtin_convertvector(v, bf2_t);
  return __builtin_bit_cast(u32, r);
}
__device__ __forceinline__ u16 f2bf(float f) { return (u16)(pack2(f, 0.f) & 0xffffu); }
__device__ __forceinline__ float bf2f(u16 h) { return __uint_as_float(((u32)h) << 16); }
__device__ __forceinline__ float wave_sum(float v) {
#pragma unroll
  for (int o = 32; o; o >>= 1) v += __shfl_xor(v, o);
  return v;
}
__device__ __forceinline__ float sigmoidf_(float x) { return 1.f / (1.f + __expf(-x)); }
__device__ __forceinline__ f32x4 mfma16(bf16x8 a, bf16x8 b, f32x4 c) {
  return __builtin_amdgcn_mfma_f32_16x16x32_bf16(a, b, c, 0, 0, 0);
}
__device__ __forceinline__ bf16x8 pack8(f32x4 a, f32x4 b) {
  union { bf16x8 v; u32 u[4]; } r;
  r.u[0] = pack2(a[0], a[1]); r.u[1] = pack2(a[2], a[3]);
  r.u[2] = pack2(b[0], b[1]); r.u[3] = pack2(b[2], b[3]);
  return r.v;
}

__device__ __forceinline__ void rmsnorm_rows(const float* __restrict__ x, const float* __restrict__ gain, u16* __restrict__ h) {
  int lane = otid() & 63;
  int gw = obid() * 4 + (otid() >> 6), nw = gridDim.x * 4;
  for (int row = gw; row < NTOK; row += nw) {
    const float4* xr = (const float4*)(x + (size_t)row * DM);
    float4 v[4];
    float ss = 0.f;
#pragma unroll
    for (int i = 0; i < 4; ++i) {
      v[i] = xr[lane + 64 * i];
      ss += v[i].x * v[i].x + v[i].y * v[i].y + v[i].z * v[i].z + v[i].w * v[i].w;
    }
    ss = wave_sum(ss);
    float rs = rsqrtf(ss * (1.f / DM) + 1e-6f);
#pragma unroll
    for (int i = 0; i < 4; ++i) {
      float4 g = ((const float4*)gain)[lane + 64 * i];
      uint2 o;
      o.x = pack2(v[i].x * rs * g.x, v[i].y * rs * g.y);
      o.y = pack2(v[i].z * rs * g.z, v[i].w * rs * g.w);
      *(uint2*)(h + (size_t)row * DM + (lane + 64 * i) * 4) = o;
    }
  }
}

struct MapId { __device__ int operator()(int n) const { return n; } };
struct MapIn {
  __device__ int operator()(int n) const {
    if (n < 1024) return n;
    if (n < 2304) return n + 8;
    if (n < 3072) return n + 32;
    if (n < 3080) return n - 3072 + 1024;
    if (n < 3104) return n - 3080 + 2312;
    return -1;
  }
};
struct MapGU {
  __device__ int operator()(int n) const {
    int grp = n >> 6, r = n & 63;
    return r < 32 ? grp * 32 + r : DFF + grp * 32 + (r - 32);
  }
};
template <class Map>
__device__ __forceinline__ void transpose_tile(const float* __restrict__ src, int lds_, Map map, u16* __restrict__ dst, int ldd, int n0,
                               int k0, float* t) {
  int tid = otid();
#pragma unroll 4
  for (int i = 0; i < 16; ++i) {
    int k = i * 4 + (tid >> 6), n = tid & 63;
    int sn = map(n0 + n);
    t[k * 65 + n] = sn >= 0 ? src[(size_t)(k0 + k) * lds_ + sn] : 0.f;
  }
  __syncthreads();
#pragma unroll 4
  for (int i = 0; i < 16; ++i) {
    int n = i * 4 + (tid >> 6), k = tid & 63;
    dst[(size_t)(n0 + n) * ldd + k0 + k] = f2bf(t[k * 65 + n]);
  }
  __syncthreads();
}

__device__ __forceinline__ void convert_weights(KP p, int l, char* smem) {
  float* t = (float*)smem;
  char* W = p->ws + OFF_W;
  const int J0 = 800, J1 = J0 + 256, J2 = J1 + 1408, J3 = J2 + 704, J4 = J3 + 64, J5 = J4 + 2;
  for (int job = obid(); job < J5; job += gridDim.x) {
    if (job < J0) {
      transpose_tile(p->w_in + (size_t)l * DM * 3104, 3104, MapIn(), (u16*)(W + W_IN), 1024, (job >> 4) * 64,
                     (job & 15) * 64, t);
    } else if (job < J1) {
      int j = job - J0;
      transpose_tile(p->w_out + (size_t)l * DM * DM, 1024, MapId(), (u16*)(W + W_OUT), 1024, (j >> 4) * 64,
                     (j & 15) * 64, t);
    } else if (job < J2) {
      int j = job - J1;
      transpose_tile(p->w_gate_up + (size_t)l * DM * 2 * DFF, 2 * DFF, MapGU(), (u16*)(W + W_GU), 1024, (j >> 4) * 64,
                     (j & 15) * 64, t);
    } else if (job < J3) {
      int j = job - J2;
      transpose_tile(p->w_down + (size_t)l * DFF * DM, 1024, MapId(), (u16*)(W + W_DOWN), DFF, (j / 44) * 64,
                     (j % 44) * 64, t);
    } else if (job < J4) {
      int j = job - J3;
      int which = j >> 5, kt = j & 31;
      transpose_tile(p->cmp_w1 + (size_t)(l * 2 + which) * 2048 * 64, 64, MapId(),
                     (u16*)(W + W_C1) + (size_t)which * 64 * 2048, 2048, 0, kt * 64, t);
    } else {
      int which = job - J4;
      transpose_tile(p->cmp_w2 + (size_t)(l * 2 + which) * 64 * 64, 64, MapId(), (u16*)(W + W_C2) + which * 4096, 64, 0,
                     0, t);
    }
  }
}

#define WAIT_VM(n) asm volatile("s_waitcnt vmcnt(" #n ")" ::: "memory")
#define RAW_BAR() do { asm volatile("s_waitcnt lgkmcnt(0)" ::: "memory"); __builtin_amdgcn_s_barrier(); } while (0)
template <class Epi>
__device__ __forceinline__ void gemm_phase(const u16* __restrict__ A, int lda, const u16* __restrict__ Bt, int ldb, int K, int ntm,
                           int ntn, char* smem, Epi epi) {
  const int tid = otid(), lane = tid & 63, wv = tid >> 6;
  const int wm = wv >> 1, wn = wv & 1, l15 = lane & 15, quad = lane >> 4;
  const int ntiles = ntm * ntn, nk = K >> 5;
  const int lrow = lane >> 2, lchunk = (lane & 3) ^ ((lane >> 4) & 3);
  const int fpos = (quad ^ ((l15 >> 2) & 3)) * 16;
  const int aoff = (wm * 64 + l15) * 64 + fpos;
  const int boff = 8192 + (wn * 64 + l15) * 64 + fpos;
  for (int id = obid(); id < ntiles; id += gridDim.x) {
    WAIT_VM(0);
    int xcd = id & 7, loc = id >> 3;
    int tm_l, tn;
    {
      int per_rb = 8 * ntn;
      int rb = loc / per_rb, rem = loc % per_rb;
      int cb = rem >> 6, rem2 = rem & 63;
      int width = (cb + 1) * 8 <= ntn ? 8 : ntn - cb * 8;
      tm_l = rb * 8 + rem2 / width;
      tn = cb * 8 + rem2 % width;
    }
    int tm = tm_l * 8 + xcd;
    int row0 = tm * 128, col0 = tn * 128;
    const u16* gA = A + (size_t)(row0 + wv * 32 + lrow) * lda + lchunk * 8;
    const u16* gB = Bt + (size_t)(col0 + wv * 32 + lrow) * ldb + lchunk * 8;
    const size_t a16 = (size_t)16 * lda, b16 = (size_t)16 * ldb;
    f32x4 acc[4][4];
#pragma unroll
    for (int m = 0; m < 4; ++m)
#pragma unroll
      for (int n = 0; n < 4; ++n) acc[m][n] = f32x4{0.f, 0.f, 0.f, 0.f};
    char* lbase = smem + wv * 2048;
#define GLDS_STAGE(kt)                                                                                      \
  do {                                                                                                      \
    char* st_ = lbase + ((kt) & 3) * 16384;                                                                 \
    __builtin_amdgcn_global_load_lds((const u32*)(gA + (kt) * 32), (u32*)(st_), 16, 0, 0);                  \
    __builtin_amdgcn_global_load_lds((const u32*)(gA + a16 + (kt) * 32), (u32*)(st_ + 1024), 16, 0, 0);    \
    __builtin_amdgcn_global_load_lds((const u32*)(gB + (kt) * 32), (u32*)(st_ + 8192), 16, 0, 0);          \
    __builtin_amdgcn_global_load_lds((const u32*)(gB + b16 + (kt) * 32), (u32*)(st_ + 9216), 16, 0, 0);    \
  } while (0)
    GLDS_STAGE(0);
    GLDS_STAGE(1);
    GLDS_STAGE(2);
    for (int kt = 0; kt < nk; ++kt) {
      if (kt + 2 < nk) WAIT_VM(8);
      else if (kt + 1 < nk) WAIT_VM(4);
      else WAIT_VM(0);
      RAW_BAR();
      if (kt + 3 < nk) GLDS_STAGE(kt + 3);
      const char* st = smem + (kt & 3) * 16384;
      bf16x8 af[4], bfr[4];
#pragma unroll
      for (int m = 0; m < 4; ++m) af[m] = *(const bf16x8*)(st + aoff + m * 1024);
#pragma unroll
      for (int n = 0; n < 4; ++n) bfr[n] = *(const bf16x8*)(st + boff + n * 1024);
#pragma unroll
      for (int m = 0; m < 4; ++m)
#pragma unroll
        for (int n = 0; n < 4; ++n) acc[m][n] = mfma16(af[m], bfr[n], acc[m][n]);
    }
    RAW_BAR();
    epi(acc, row0 + wm * 64 + quad * 4, col0 + wn * 64 + l15, tn);
  }
}

struct EpiInProj {
  u16* proj; float* small_;
  __device__ __forceinline__ void operator()(f32x4 (&acc)[4][4], int rbase, int cbase, int tn) const {
    if (tn < 24) {
#pragma unroll
      for (int m = 0; m < 4; ++m)
#pragma unroll
        for (int n = 0; n < 4; ++n)
#pragma unroll
          for (int r = 0; r < 4; ++r)
            proj[(size_t)(rbase + m * 16 + r) * PJ + cbase + n * 16] = f2bf(acc[m][n][r]);
    } else {
#pragma unroll
      for (int m = 0; m < 4; ++m)
#pragma unroll
        for (int n = 0; n < 4; ++n) {
          int c = cbase + n * 16 - 3072;
          if (c < 32) {
#pragma unroll
            for (int r = 0; r < 4; ++r) small_[(size_t)(rbase + m * 16 + r) * 32 + c] = acc[m][n][r];
          }
        }
    }
  }
};
struct EpiResid {
  const float* xin; float* xout;
  __device__ __forceinline__ void operator()(f32x4 (&acc)[4][4], int rbase, int cbase, int tn) const {
#pragma unroll
    for (int m = 0; m < 4; ++m)
#pragma unroll
      for (int n = 0; n < 4; ++n)
#pragma unroll
        for (int r = 0; r < 4; ++r) {
          size_t idx = (size_t)(rbase + m * 16 + r) * DM + cbase + n * 16;
          xout[idx] = xin[idx] + acc[m][n][r];
        }
  }
};
struct EpiSwiGLU {
  u16* act;
  __device__ __forceinline__ void operator()(f32x4 (&acc)[4][4], int rbase, int cbase, int tn) const {
    int grp = cbase >> 6, l15 = cbase & 15;
#pragma unroll
    for (int m = 0; m < 4; ++m)
#pragma unroll
      for (int n = 0; n < 2; ++n)
#pragma unroll
        for (int r = 0; r < 4; ++r) {
          float gt = acc[m][n][r], up = acc[m][n + 2][r];
          float v = gt / (1.f + __expf(-gt)) * up;
          act[(size_t)(rbase + m * 16 + r) * DFF + grp * 32 + n * 16 + l15] = f2bf(v);
        }
  }
};

__device__ __forceinline__ void gdn_chunk_prep(KP p, int l, char* smem, int job) {
  const int b = job >> 10, h = (job >> 8) & 3, c = job & 255;
  const int tid = otid(), lane = tid & 63, wv = tid >> 6;
  float* sq = (float*)smem;
  float* sk = sq + 64 * 65;
  float* sv = sk + 64 * 65;
  float* sA = sv + 64 * 65;
  float* sgc = sA + 64 * 64;
  float* sbeta = sgc + 64;
  float* seg = sbeta + 64;
  float* sf2 = seg + 64;
  const u16* proj = (const u16*)(p->ws + OFF_PROJ);
  const float* small_ = (const float*)(p->ws + OFF_SMALL);
  const size_t tok0 = (size_t)b * T + c * 64;
  char* cb = p->ws + OFF_GDN + (size_t)((b * 4 + h) * 256 + c) * CHUNK_B;
  float* UT = (float*)cb;
  u16* NW = (u16*)(cb + 16384);
  u16* QD = (u16*)(cb + 24576);
  u16* KDT = (u16*)(cb + 32768);
  u16* QKM = (u16*)(cb + 40960);
  {
    int d = lane, i0 = wv * 16;
#pragma unroll
    for (int seg_ = 0; seg_ < 3; ++seg_) {
      int ch = seg_ * 256 + h * 64 + d;
      const float* cw = p->gdn_conv_w + (size_t)l * 4 * 768 + ch;
      float w0 = cw[0], w1 = cw[768], w2 = cw[1536], w3 = cw[2304];
      float* dst = seg_ == 0 ? sq : (seg_ == 1 ? sk : sv);
      float x0 = 0, x1 = 0, x2 = 0;
      int tl = c * 64 + i0;
      if (tl - 3 >= 0) x0 = bf2f(proj[(tok0 + i0 - 3) * PJ + ch]);
      if (tl - 2 >= 0) x1 = bf2f(proj[(tok0 + i0 - 2) * PJ + ch]);
      if (tl - 1 >= 0) x2 = bf2f(proj[(tok0 + i0 - 1) * PJ + ch]);
      for (int i = 0; i < 16; ++i) {
        float x3 = bf2f(proj[(tok0 + i0 + i) * PJ + ch]);
        float y = w0 * x0 + w1 * x1 + w2 * x2 + w3 * x3;
        dst[(i0 + i) * 65 + d] = y / (1.f + __expf(-y));
        x0 = x1; x1 = x2; x2 = x3;
      }
    }
  }
  if (tid < 64) {
    float gb = small_[(tok0 + tid) * 32 + h], ga = small_[(tok0 + tid) * 32 + 4 + h];
    float xx = ga + p->gdn_dt_bias[l * 4 + h];
    float sp = fmaxf(xx, 0.f) + log1pf(__expf(-fabsf(xx)));
    float g = -__expf(p->gdn_a_log[l * 4 + h]) * sp;
#pragma unroll
    for (int o = 1; o < 64; o <<= 1) {
      float t = __shfl_up(g, o);
      if (lane >= o) g += t;
    }
    float beta = sigmoidf_(gb);
    float eg = __expf(g);
    sgc[tid] = g; sbeta[tid] = beta; seg[tid] = eg; sf2[tid] = beta * eg;
    if (tid == 63) ((float*)(p->ws + OFF_GL))[(b * 4 + h) * 256 + c] = eg;
  }
  __syncthreads();
  for (int i = wv * 16; i < wv * 16 + 16; ++i) {
    float q = sq[i * 65 + lane], k = sk[i * 65 + lane];
    float sq2 = wave_sum(q * q), sk2 = wave_sum(k * k);
    sq[i * 65 + lane] = q * rsqrtf(sq2 + 1e-6f) * 0.125f;
    sk[i * 65 + lane] = k * rsqrtf(sk2 + 1e-6f);
  }
  __syncthreads();
  {
    int ti = tid >> 4, tj = tid & 15;
    float kk[4][4], qk[4][4];
#pragma unroll
    for (int a = 0; a < 4; ++a)
#pragma unroll
      for (int bb = 0; bb < 4; ++bb) { kk[a][bb] = 0.f; qk[a][bb] = 0.f; }
    if (tj <= ti) {
      for (int d = 0; d < 64; ++d) {
        float ki[4], kj[4], qi[4];
#pragma unroll
        for (int a = 0; a < 4; ++a) {
          ki[a] = sk[(ti * 4 + a) * 65 + d];
          qi[a] = sq[(ti * 4 + a) * 65 + d];
          kj[a] = sk[(tj * 4 + a) * 65 + d];
        }
#pragma unroll
        for (int a = 0; a < 4; ++a)
#pragma unroll
          for (int bb = 0; bb < 4; ++bb) { kk[a][bb] += ki[a] * kj[bb]; qk[a][bb] += qi[a] * kj[bb]; }
      }
    }
#pragma unroll
    for (int a = 0; a < 4; ++a) {
      int i = ti * 4 + a;
      float gi = sgc[i], bi = sbeta[i];
      uint2 o;
      float qv[4];
#pragma unroll
      for (int bb = 0; bb < 4; ++bb) {
        int j = tj * 4 + bb;
        float dec = (j <= i) ? __expf(gi - sgc[j]) : 0.f;
        sA[i * 64 + j] = (j < i) ? bi * kk[a][bb] * dec : 0.f;
        qv[bb] = qk[a][bb] * dec;
      }
      o.x = pack2(qv[0], qv[1]); o.y = pack2(qv[2], qv[3]);
      *(uint2*)(QKM + i * 64 + tj * 4) = o;
    }
  }
  {
    float gl = sgc[63];
    for (int idx = tid; idx < 4096; idx += 256) {
      int i = idx >> 6, d = idx & 63;
      QD[idx] = f2bf(sq[i * 65 + d] * seg[i]);
      KDT[idx] = f2bf(sk[d * 65 + i] * __expf(gl - sgc[d]));
    }
  }
  __syncthreads();
  if (tid < 128) {
    int cidx = tid;
    const float* src = cidx < 64 ? sv + cidx : sk + (cidx - 64);
    const float* fac = cidx < 64 ? sbeta : sf2;
    float x[64];
#pragma unroll
    for (int i = 0; i < 64; ++i) {
      float s = src[i * 65] * fac[i];
#pragma unroll
      for (int j = 0; j < i; ++j) s -= sA[i * 64 + j] * x[j];
      x[i] = s;
    }
    if (cidx < 64) {
#pragma unroll
      for (int i = 0; i < 64; i += 4) *(float4*)(UT + cidx * 64 + i) = make_float4(x[i], x[i + 1], x[i + 2], x[i + 3]);
    } else {
#pragma unroll
      for (int i = 0; i < 64; ++i) NW[i * 64 + (cidx - 64)] = f2bf(-x[i]);
    }
  }
  __syncthreads();
}

__device__ __forceinline__ void gdn_scan(KP p, char* smem, int sid) {
  const int b = sid >> 4, h = (sid >> 2) & 3, v0 = (sid & 3) * 16;
  const int tid = otid(), lane = tid & 63, wv = tid >> 6, l15 = lane & 15, quad = lane >> 4;
  u16* Sb = (u16*)smem;
  u16* Vb = Sb + 16 * 72;
  f32x4 S = {0.f, 0.f, 0.f, 0.f};
  *(uint2*)(Sb + l15 * 72 + 16 * wv + quad * 4) = make_uint2(0u, 0u);
  __syncthreads();
  const char* gbase = p->ws + OFF_GDN + (size_t)((b * 4 + h) * 256) * CHUNK_B;
  const float* GL = (const float*)(p->ws + OFF_GL) + (b * 4 + h) * 256;
  float* OG = (float*)(p->ws + OFF_OG);
  const int arow = (16 * wv + l15) * 64 + quad * 8;
  f32x4 u, un;
  bf16x8 wA[2], qdA[2], qkA[2], kdA[2], wAn[2], qdAn[2], qkAn[2], kdAn[2];
  float gl, gln;
  {
    const char* cb = gbase;
    u = *(const f32x4*)((const float*)cb + (v0 + l15) * 64 + 16 * wv + quad * 4);
#pragma unroll
    for (int ks = 0; ks < 2; ++ks) {
      wA[ks] = *(const bf16x8*)((const u16*)(cb + 16384) + arow + ks * 32);
      qdA[ks] = *(const bf16x8*)((const u16*)(cb + 24576) + arow + ks * 32);
      kdA[ks] = *(const bf16x8*)((const u16*)(cb + 32768) + arow + ks * 32);
      qkA[ks] = *(const bf16x8*)((const u16*)(cb + 40960) + arow + ks * 32);
    }
    gl = GL[0];
  }
  for (int c = 0; c < 256; ++c) {
    if (c + 1 < 256) {
      const char* cb = gbase + (size_t)(c + 1) * CHUNK_B;
      un = *(const f32x4*)((const float*)cb + (v0 + l15) * 64 + 16 * wv + quad * 4);
#pragma unroll
      for (int ks = 0; ks < 2; ++ks) {
        wAn[ks] = *(const bf16x8*)((const u16*)(cb + 16384) + arow + ks * 32);
        qdAn[ks] = *(const bf16x8*)((const u16*)(cb + 24576) + arow + ks * 32);
        kdAn[ks] = *(const bf16x8*)((const u16*)(cb + 32768) + arow + ks * 32);
        qkAn[ks] = *(const bf16x8*)((const u16*)(cb + 40960) + arow + ks * 32);
      }
      gln = GL[c + 1];
    }
    bf16x8 sB0 = *(const bf16x8*)(Sb + l15 * 72 + quad * 8);
    bf16x8 sB1 = *(const bf16x8*)(Sb + l15 * 72 + 32 + quad * 8);
    f32x4 vn = u;
    vn = mfma16(wA[0], sB0, vn);
    vn = mfma16(wA[1], sB1, vn);
    f32x4 o = {0.f, 0.f, 0.f, 0.f};
    o = mfma16(qdA[0], sB0, o);
    o = mfma16(qdA[1], sB1, o);
    *(uint2*)(Vb + l15 * 72 + 16 * wv + quad * 4) = make_uint2(pack2(vn[0], vn[1]), pack2(vn[2], vn[3]));
    __syncthreads();
    bf16x8 vB0 = *(const bf16x8*)(Vb + l15 * 72 + quad * 8);
    bf16x8 vB1 = *(const bf16x8*)(Vb + l15 * 72 + 32 + quad * 8);
    o = mfma16(qkA[0], vB0, o);
    o = mfma16(qkA[1], vB1, o);
    S[0] *= gl; S[1] *= gl; S[2] *= gl; S[3] *= gl;
    S = mfma16(kdA[0], vB0, S);
    S = mfma16(kdA[1], vB1, S);
    *(uint2*)(Sb + l15 * 72 + 16 * wv + quad * 4) = make_uint2(pack2(S[0], S[1]), pack2(S[2], S[3]));
    size_t orow = (size_t)b * T + c * 64 + 16 * wv + quad * 4;
#pragma unroll
    for (int r = 0; r < 4; ++r) OG[(orow + r) * 256 + h * 64 + v0 + l15] = o[r];
    __syncthreads();
    u = un; gl = gln;
#pragma unroll
    for (int ks = 0; ks < 2; ++ks) { wA[ks] = wAn[ks]; qdA[ks] = qdAn[ks]; kdA[ks] = kdAn[ks]; qkA[ks] = qkAn[ks]; }
  }
}

__device__ __forceinline__ void gdn_finalize(KP p, int l) {
  const int lane = otid() & 63;
  int gw = obid() * 4 + (otid() >> 6), nw = gridDim.x * 4;
  const float* OG = (const float*)(p->ws + OFF_OG);
  const u16* proj = (const u16*)(p->ws + OFF_PROJ);
  u16* mix = (u16*)(p->ws + OFF_H);
  float gn = p->gdn_norm[l * 64 + lane];
  for (int row = gw; row < NTOK * 4; row += nw) {
    int t = row >> 2, h = row & 3;
    float o = OG[(size_t)t * 256 + h * 64 + lane];
    float ss = wave_sum(o * o);
    float z = bf2f(proj[(size_t)t * PJ + C_GZ + h * 64 + lane]);
    float y = o * rsqrtf(ss * (1.f / 64.f) + 1e-6f) * gn * (z / (1.f + __expf(-z)));
    mix[(size_t)t * DM + h * 64 + lane] = f2bf(y);
  }
}

__device__ __forceinline__ void rope_table(KP p) {
  float* rp = (float*)(p->ws + OFF_ROPE);
  int gt = obid() * blockDim.x + otid(), nt = gridDim.x * blockDim.x;
  for (int idx = gt; idx < NTOK * 8; idx += nt) {
    int t = idx >> 3, i = idx & 7;
    float inv = (float)pow(500000.0, -(double)i / 8.0);
    float ang = (float)p->positions[t] * inv;
    rp[t * 16 + i] = (float)cos((double)ang);
    rp[t * 16 + 8 + i] = (float)sin((double)ang);
  }
}

__device__ __forceinline__ void nsa_token_prep(KP p, int l, char* smem, int tb) {
  const int tid = otid(), lane = tid & 63, wv = tid >> 6;
  const int b = tb >> 8, blk = tb & 255;
  u16* proj = (u16*)(p->ws + OFF_PROJ);
  const float* rope = (const float*)(p->ws + OFF_ROPE);
  const size_t tok0 = (size_t)tb * 64;
  for (int r = wv; r < 768; r += 4) {
    int i = r / 12, which = r % 12;
    size_t t = tok0 + i;
    int col; const float* gain;
    if (which < 8) { col = C_NQ + which * 64; gain = p->nsa_q_norm + l * 64; }
    else if (which < 10) { col = C_KSLC + (which - 8) * 64; gain = p->nsa_k_norm + (l * 3 + 1) * 64; }
    else { col = C_KWIN + (which - 10) * 64; gain = p->nsa_k_norm + (l * 3 + 2) * 64; }
    float x = bf2f(proj[t * PJ + col + lane]);
    float ss = wave_sum(x * x);
    float y = x * rsqrtf(ss * (1.f / 64.f) + 1e-6f) * gain[lane];
    if (which >= 8) {
      float other = __shfl_xor(y, 8);
      if (lane < 16) {
        float c = rope[t * 16 + (lane & 7)], s = rope[t * 16 + 8 + (lane & 7)];
        y = lane < 8 ? y * c - other * s : y * c + other * s;
      }
    }
    proj[t * PJ + col + lane] = f2bf(y);
  }
  u16* tt = (u16*)smem;
  for (int z = 0; z < 4; ++z) {
    int tensor = z >> 1, g = z & 1;
    int col = (tensor ? C_VWIN : C_VSLC) + g * 64;
    for (int idx = tid; idx < 4096; idx += 256) {
      int i = idx >> 6, d = idx & 63;
      tt[i * 66 + d] = proj[(tok0 + i) * PJ + col + d];
    }
    __syncthreads();
    u16* dst = (u16*)(p->ws + OFF_VT + (size_t)tensor * 8 * MiB) + ((size_t)((b * 2 + g) * 256 + blk)) * 4096;
    for (int idx = tid; idx < 4096; idx += 256) {
      int d = idx >> 6, i = idx & 63;
      dst[idx] = tt[i * 66 + d];
    }
    __syncthreads();
  }
  {
    int ch = tid;
    const float* cw = p->conv_w + (size_t)l * 3 * 256 + ch;
    float w0 = cw[0], w1 = cw[256], w2 = cw[512];
    u16* mix = (u16*)(p->ws + OFF_H);
    float p0 = 0.f, p1 = 0.f;
    if (blk > 0) {
      p0 = bf2f(proj[(tok0 - 2) * PJ + C_CC + ch]) * bf2f(proj[(tok0 - 2) * PJ + C_CX + ch]);
      p1 = bf2f(proj[(tok0 - 1) * PJ + C_CC + ch]) * bf2f(proj[(tok0 - 1) * PJ + C_CX + ch]);
    }
    for (int i = 0; i < 64; ++i) {
      size_t t = tok0 + i;
      float p2 = bf2f(proj[t * PJ + C_CC + ch]) * bf2f(proj[t * PJ + C_CX + ch]);
      float y = w0 * p0 + w1 * p1 + w2 * p2;
      mix[t * DM + 768 + ch] = f2bf(bf2f(proj[t * PJ + C_CB + ch]) * y);
      p0 = p1; p1 = p2;
    }
  }
}

__device__ __forceinline__ void nsa_compress(KP p, int l, char* smem, int job) {
  const int tid = otid(), lane = tid & 63, wv = tid >> 6, l15 = lane & 15, quad = lane >> 4;
  const int which = job >> 6, b = (job >> 5) & 1, g = (job >> 4) & 1, tile = job & 15;
  const u16* proj = (const u16*)(p->ws + OFF_PROJ);
  const u16* W1T = (const u16*)(p->ws + OFF_W + W_C1) + (size_t)which * 64 * 2048;
  const u16* W2T = (const u16*)(p->ws + OFF_W + W_C2) + which * 4096;
  const float* pe = p->cmp_pe + (size_t)(l * 2 + which) * 32 * 64;
  const int blk0 = tile * 64 + wv * 16;
  int blk = blk0 + l15;
  int blkc = blk < 1023 ? blk : 1022;
  const u16* arow = proj + ((size_t)b * T + blkc * 16) * PJ + (which ? C_VCMP : C_KCMP) + g * 64;
  f32x4 acc[4];
#pragma unroll
  for (int n = 0; n < 4; ++n) acc[n] = f32x4{0.f, 0.f, 0.f, 0.f};
  for (int ks = 0; ks < 64; ++ks) {
    int tok = ks >> 1, d0 = (ks & 1) * 32 + quad * 8;
    uint4 raw = *(const uint4*)(arow + (size_t)tok * PJ + d0);
    float4 pe0 = *(const float4*)(pe + tok * 64 + d0), pe1 = *(const float4*)(pe + tok * 64 + d0 + 4);
    union { bf16x8 v; u32 u[4]; } af;
    af.u[0] = pack2(bf2f(raw.x & 0xffff) + pe0.x, bf2f(raw.x >> 16) + pe0.y);
    af.u[1] = pack2(bf2f(raw.y & 0xffff) + pe0.z, bf2f(raw.y >> 16) + pe0.w);
    af.u[2] = pack2(bf2f(raw.z & 0xffff) + pe1.x, bf2f(raw.z >> 16) + pe1.y);
    af.u[3] = pack2(bf2f(raw.w & 0xffff) + pe1.z, bf2f(raw.w >> 16) + pe1.w);
#pragma unroll
    for (int n = 0; n < 4; ++n) {
      bf16x8 bfr = *(const bf16x8*)(W1T + (size_t)(n * 16 + l15) * 2048 + ks * 32 + quad * 8);
      acc[n] = mfma16(af.v, bfr, acc[n]);
    }
  }
  u16* hid = (u16*)smem + wv * 16 * 72;
#pragma unroll
  for (int n = 0; n < 4; ++n)
#pragma unroll
    for (int r = 0; r < 4; ++r) {
      float x = acc[n][r];
      float u = 0.7978845608028654f * (x + 0.044715f * x * x * x);
      float gl = 0.5f * x * (1.f + tanhf(u));
      hid[(quad * 4 + r) * 72 + n * 16 + l15] = f2bf(gl);
    }
  __syncthreads();
  f32x4 o2[4];
#pragma unroll
  for (int n = 0; n < 4; ++n) o2[n] = f32x4{0.f, 0.f, 0.f, 0.f};
#pragma unroll
  for (int ks = 0; ks < 2; ++ks) {
    bf16x8 af = *(const bf16x8*)(hid + l15 * 72 + ks * 32 + quad * 8);
#pragma unroll
    for (int n = 0; n < 4; ++n) {
      bf16x8 bfr = *(const bf16x8*)(W2T + (n * 16 + l15) * 64 + ks * 32 + quad * 8);
      o2[n] = mfma16(af, bfr, o2[n]);
    }
  }
  __syncthreads();
  if (which == 0) {
    u16* KC = (u16*)(p->ws + OFF_KC) + (size_t)(b * 2 + g) * 1024 * 64;
    const float* kg = p->nsa_k_norm + (l * 3 + 0) * 64;
#pragma unroll
    for (int r = 0; r < 4; ++r) {
      float ss = 0.f;
#pragma unroll
      for (int n = 0; n < 4; ++n) ss += o2[n][r] * o2[n][r];
      ss += __shfl_xor(ss, 1); ss += __shfl_xor(ss, 2); ss += __shfl_xor(ss, 4); ss += __shfl_xor(ss, 8);
      float rs = rsqrtf(ss * (1.f / 64.f) + 1e-6f);
      int row = blk0 + quad * 4 + r;
#pragma unroll
      for (int n = 0; n < 4; ++n) {
        float v = row < 1023 ? o2[n][r] * rs * kg[n * 16 + l15] : 0.f;
        KC[(size_t)row * 64 + n * 16 + l15] = f2bf(v);
      }
    }
  } else {
    u16* VCT = (u16*)(p->ws + OFF_KC + 524288) + (size_t)(b * 2 + g) * 64 * 1024;
#pragma unroll
    for (int r = 0; r < 4; ++r) {
      int row = blk0 + quad * 4 + r;
#pragma unroll
      for (int n = 0; n < 4; ++n) {
        float v = row < 1023 ? o2[n][r] : 0.f;
        VCT[(size_t)(n * 16 + l15) * 1024 + row] = f2bf(v);
      }
    }
  }
}

template <int MODE, int NT>
__device__ __forceinline__ void flash2(const u16* __restrict__ Kg, int kld, const u16* __restrict__ VTg, int vblk,
                                       int vld, int h0, int h1, char* sStage, const u16* sQw, f32x4 (&O)[4][NT],
                                       float (&lsum)[NT], const float (&inv)[NT], const u32* sSelw, float* slc,
                                       int tq0) {
  const int tid = otid(), lane = tid & 63, wv = tid >> 6, l15 = lane & 15, quad = lane >> 4;
  constexpr int LPS = MODE == 2 ? 1 : 2;
  const int krow = wv * 8 + (lane >> 3);
  const int kc = (lane & 7) ^ ((wv * 4 + (lane >> 4)) & 7);
  const u16* kptr = Kg + (size_t)krow * kld + kc * 8;
  const int vd = wv * 16 + (lane >> 2);
  const int vc = (lane & 3) ^ ((lane >> 4) & 3);
  const u16* vptr = VTg + (size_t)vd * vld + vc * 8;
  char* lb = sStage + wv * 1024;
  const int nst = h1 - h0 + 1;
#define F2_ISSUE(i_)                                                                                              \
  do {                                                                                                            \
    int h_ = h0 + (i_);                                                                                           \
    char* st_ = lb + ((i_) & 3) * 8192;                                                                           \
    __builtin_amdgcn_global_load_lds((const u32*)(kptr + (size_t)(h_ * 32) * kld), (u32*)st_, 16, 0, 0);          \
    if (MODE != 2)                                                                                                \
      __builtin_amdgcn_global_load_lds((const u32*)(vptr + (size_t)(h_ >> 1) * vblk + (h_ & 1) * 32),            \
                                       (u32*)(st_ + 4096), 16, 0, 0);                                             \
  } while (0)
  WAIT_VM(0);
  if (0 < nst) F2_ISSUE(0);
  if (1 < nst) F2_ISSUE(1);
  if (2 < nst) F2_ISSUE(2);
  const int koff = l15 * 128;
  const int ksw = (l15 >> 1) & 7;
  const int voff = 4096 + l15 * 64 + (quad & 1) * 8;
  const int vsw = (l15 >> 2) & 3;
  float carry = 0.f;
  const int tq0u = __builtin_amdgcn_readfirstlane(tq0);
  const int lim0u = tq0u >= 31 ? ((tq0u - 31) >> 4) : -1;
  for (int i = 0; i < nst; ++i) {
    if (i + 2 < nst) { if (LPS == 2) WAIT_VM(4); else WAIT_VM(2); }
    else if (i + 1 < nst) { if (LPS == 2) WAIT_VM(2); else WAIT_VM(1); }
    else WAIT_VM(0);
    RAW_BAR();
    if (i + 3 < nst) F2_ISSUE(i + 3);
    const int h = h0 + i;
    const char* st = sStage + (i & 3) * 8192;
    bool interior;
    if (MODE == 0) interior = (h * 32 + 31 <= tq0u) && (h * 32 > tq0u + NT * 4 - 1 - 512);
    else if (MODE == 1) interior = (h * 32 + 31 <= tq0u);
    else interior = (h * 32 + 31 <= lim0u);
    bool bv[NT], an[NT];
    bool anyw = false;
#pragma unroll
    for (int nt = 0; nt < NT; ++nt) {
      if (MODE == 1) {
        u32 w = sSelw[(nt * 4 + (l15 >> 2)) * 8 + (h >> 6)];
        bv[nt] = (w >> ((h >> 1) & 31)) & 1u;
      } else {
        bv[nt] = true;
      }
      an[nt] = MODE == 1 ? (bool)__any(bv[nt]) : true;
      anyw |= an[nt];
    }
    if (anyw) {
      bf16x8 kf[2][2], vf[4];
#pragma unroll
      for (int m2 = 0; m2 < 2; ++m2)
#pragma unroll
        for (int ks = 0; ks < 2; ++ks)
          kf[m2][ks] = *(const bf16x8*)(st + koff + m2 * 2048 + (((ks * 4 + quad) ^ ksw) * 16));
      if (MODE != 2) {
#pragma unroll
        for (int dt = 0; dt < 4; ++dt) {
          union { bf16x8 v; uint2 h2[2]; } u;
          u.h2[0] = *(const uint2*)(st + voff + dt * 1024 + (((quad >> 1) ^ vsw) * 16));
          u.h2[1] = *(const uint2*)(st + voff + dt * 1024 + (((2 + (quad >> 1)) ^ vsw) * 16));
          vf[dt] = u.v;
        }
      }
#pragma unroll
      for (int nt = 0; nt < NT; ++nt) {
        if (!an[nt]) continue;
        const int t = tq0 + nt * 4 + (l15 >> 2);
        const bf16x8 bq0 = *(const bf16x8*)(sQw + (nt * 16 + l15) * 72 + quad * 8);
        const bf16x8 bq1 = *(const bf16x8*)(sQw + (nt * 16 + l15) * 72 + 32 + quad * 8);
        f32x4 s[2];
#pragma unroll
        for (int m2 = 0; m2 < 2; ++m2) {
          s[m2] = f32x4{0.f, 0.f, 0.f, 0.f};
          s[m2] = mfma16(kf[m2][0], bq0, s[m2]);
          s[m2] = mfma16(kf[m2][1], bq1, s[m2]);
        }
        const float bias = MODE == 1 ? (bv[nt] ? 0.f : -1000.f) : (MODE == 3 ? inv[nt] : 0.f);
        if (interior) {
#pragma unroll
          for (int m2 = 0; m2 < 2; ++m2)
#pragma unroll
            for (int r = 0; r < 4; ++r) s[m2][r] = __builtin_amdgcn_exp2f(fmaf(s[m2][r], SC2, bias));
        } else {
          int base;
          if (MODE <= 1) base = h * 32 + quad * 4 - t;
          else base = h * 32 + quad * 4 - (t >= 31 ? ((t - 31) >> 4) : -1);
          asm volatile("" : "+v"(base));
#pragma unroll
          for (int m2 = 0; m2 < 2; ++m2)
#pragma unroll
            for (int r = 0; r < 4; ++r) {
              const int C = m2 * 16 + r;
              bool valid;
              if (MODE == 0) valid = base <= -C && base > -512 - C;
              else valid = base <= -C;
              float pvv = __builtin_amdgcn_exp2f(fmaf(s[m2][r], SC2, bias));
              s[m2][r] = valid ? pvv : 0.f;
            }
        }
        float ls = ((s[0][0] + s[0][1]) + (s[0][2] + s[0][3])) + ((s[1][0] + s[1][1]) + (s[1][2] + s[1][3]));
        if (MODE != 3) lsum[nt] += ls;
        if (MODE == 3) {
#pragma unroll
          for (int m2 = 0; m2 < 2; ++m2) {
            float ow = s[m2][0] + s[m2][1] + s[m2][2] + 0.5f * s[m2][3];
            float sp = 0.5f * s[m2][3];
            ow += __shfl_xor(ow, 1); ow += __shfl_xor(ow, 2);
            sp += __shfl_xor(sp, 1); sp += __shfl_xor(sp, 2);
            float spp = __shfl_up(sp, 16);
            float prev = quad == 0 ? carry : spp;
            carry = __shfl(sp, 48 + l15);
            if ((l15 & 3) == 0) slc[(nt * 4 + (l15 >> 2)) * 256 + h * 8 + m2 * 4 + quad] = ow + prev;
          }
        }
        if (MODE != 2) {
          bf16x8 P = pack8(s[0], s[1]);
#pragma unroll
          for (int dt = 0; dt < 4; ++dt) O[dt][nt] = mfma16(vf[dt], P, O[dt][nt]);
        }
      }
    }
  }
  RAW_BAR();
}

__device__ __forceinline__ void nsa_phase_c(KP p, int l, char* smem) {
  const int tid = otid(), lane = tid & 63, wv = tid >> 6, l15 = lane & 15, quad = lane >> 4;
  char* sStage = smem;
  u16* sQw = (u16*)(smem + 32768) + wv * 16 * 72;
  float* slc = (float*)(smem + 32768 + 9216) + wv * 1024;
  const u16* proj = (const u16*)(p->ws + OFF_PROJ);
  const float* small_ = (const float*)(p->ws + OFF_SMALL);
  float* OC = (float*)(p->ws + OFF_OC);
  u32* SEL = (u32*)(p->ws + OFF_SEL);
  for (int job = obid(); job < 4096; job += gridDim.x) {
    const int qt = 1023 - (job >> 2), bg = job & 3, b = bg >> 1, g = bg & 1;
    const int t0 = qt * 16 + wv * 4;
    const int ql = l15 >> 2, r_ = l15 & 3, head = g * 4 + r_;
    const int t = t0 + ql;
    const size_t tok = (size_t)b * T + t;
    const u16* KC = (const u16*)(p->ws + OFF_KC) + (size_t)bg * 1024 * 64;
    const u16* VCT = (const u16*)(p->ws + OFF_KC + 524288) + (size_t)bg * 64 * 1024;
    {
      const u16* qrow = proj + tok * PJ + C_NQ + head * 64;
      *(bf16x8*)(sQw + l15 * 72 + quad * 8) = *(const bf16x8*)(qrow + quad * 8);
      *(bf16x8*)(sQw + l15 * 72 + 32 + quad * 8) = *(const bf16x8*)(qrow + 32 + quad * 8);
    }
    const int tmax = qt * 16 + 15;
    const int nvmax = tmax >= 31 ? ((tmax - 31) >> 4) + 1 : 0;
    const int h1 = ((nvmax + 31) >> 5) - 1;
    f32x4 O[4][1];
    float lsum[1] = {0.f}, inv[1] = {0.f};
#pragma unroll
    for (int dt = 0; dt < 4; ++dt) O[dt][0] = f32x4{0.f, 0.f, 0.f, 0.f};
    if (h1 >= 0) {
      flash2<2, 1>(KC, 64, VCT, 64, 1024, 0, h1, sStage, sQw, O, lsum, inv, nullptr, slc, t0);
      float ls = lsum[0];
      ls += __shfl_xor(ls, 16);
      ls += __shfl_xor(ls, 32);
      inv[0] = ls > 0.f ? -log2f(ls) : -1000.f;
      flash2<3, 1>(KC, 64, VCT, 64, 1024, 0, h1, sStage, sQw, O, lsum, inv, nullptr, slc, t0);
    }
    {
      float gc = sigmoidf_(small_[tok * 32 + 8 + head * 3 + 0]);
#pragma unroll
      for (int dt = 0; dt < 4; ++dt) {
        float4 o = make_float4(O[dt][0][0] * gc, O[dt][0][1] * gc, O[dt][0][2] * gc, O[dt][0][3] * gc);
        *(float4*)(OC + tok * 512 + head * 64 + dt * 16 + quad * 4) = o;
      }
    }
    __builtin_amdgcn_wave_barrier();
    for (int q = 0; q < 4; ++q) {
      const int tq = t0 + q, cur = tq >> 6;
      u32 word = 0;
      if (cur <= 15) {
        if (lane == 0) word = (2u << cur) - 1u;
      } else {
        float vals[4];
#pragma unroll
        for (int k = 0; k < 4; ++k) {
          int j = lane + 64 * k;
          vals[k] = (j >= 1 && j <= cur - 2) ? slc[q * 256 + j] : -1.f;
        }
        for (int it = 0; it < 13; ++it) {
          float bvv = vals[0]; int bi = lane;
#pragma unroll
          for (int k = 1; k < 4; ++k) if (vals[k] > bvv) { bvv = vals[k]; bi = lane + 64 * k; }
#pragma unroll
          for (int o = 32; o; o >>= 1) {
            float ov = __shfl_xor(bvv, o); int oi = __shfl_xor(bi, o);
            if (ov > bvv || (ov == bvv && oi < bi)) { bvv = ov; bi = oi; }
          }
          if ((bi >> 5) == lane) word |= 1u << (bi & 31);
          if ((bi & 63) == lane) {
#pragma unroll
            for (int k = 0; k < 4; ++k) if ((bi >> 6) == k) vals[k] = -2.f;
          }
        }
        if (lane == 0) word |= 1u;
        if (lane == (cur >> 5)) word |= 1u << (cur & 31);
        if (lane == ((cur - 1) >> 5)) word |= 1u << ((cur - 1) & 31);
      }
      if (lane < 8) SEL[(((size_t)b * T + tq) * 2 + g) * 8 + lane] = word;
    }
    __builtin_amdgcn_wave_barrier();
  }
}

__device__ __forceinline__ void nsa_s_tile(KP p, int l, char* smem, int tile) {
  const int cur = 255 - (tile >> 2), bg = tile & 3, b = bg >> 1, g = bg & 1;
  const int tid = otid(), lane = tid & 63, wv = tid >> 6, l15 = lane & 15, quad = lane >> 4;
  char* sStage = smem;
  u16* sQw = (u16*)(smem + 32768) + wv * 64 * 72;
  u32* sSel = (u32*)(smem + 32768 + 36864);
  const u32* sSelw = sSel + wv * 16 * 8;
  const u16* proj = (const u16*)(p->ws + OFF_PROJ);
  const float* small_ = (const float*)(p->ws + OFF_SMALL);
  const float* rope = (const float*)(p->ws + OFF_ROPE);
  float* OC = (float*)(p->ws + OFF_OC);
  u16* mix = (u16*)(p->ws + OFF_H);
  const size_t tokb = (size_t)b * T;
  const int tq0 = cur * 64 + wv * 16;
  const int r_ = l15 & 3, head = g * 4 + r_;
  {
    const u32* SEL = (const u32*)(p->ws + OFF_SEL);
    int q = tid >> 2, w2 = (tid & 3) * 2;
    uint2 v = *(const uint2*)(SEL + ((tokb + cur * 64 + q) * 2 + g) * 8 + w2);
    *(uint2*)(sSel + q * 8 + w2) = v;
  }
#pragma unroll
  for (int nt = 0; nt < 4; ++nt) {
    const size_t tok = tokb + tq0 + nt * 4 + (l15 >> 2);
    const u16* qrow = proj + tok * PJ + C_NQ + head * 64;
    u16* qd = sQw + (nt * 16 + l15) * 72;
    *(bf16x8*)(qd + 32 + quad * 8) = *(const bf16x8*)(qrow + 32 + quad * 8);
    if (quad >= 2) {
      *(bf16x8*)(qd + quad * 8) = *(const bf16x8*)(qrow + quad * 8);
    } else {
      union { bf16x8 v; u16 h[8]; } x1, x2, o;
      x1.v = *(const bf16x8*)(qrow);
      x2.v = *(const bf16x8*)(qrow + 8);
      const float* rp = rope + tok * 16;
#pragma unroll
      for (int i = 0; i < 8; ++i) {
        float a = bf2f(x1.h[i]), bb = bf2f(x2.h[i]), c = rp[i], s = rp[8 + i];
        o.h[i] = f2bf(quad == 0 ? a * c - bb * s : bb * c + a * s);
      }
      *(bf16x8*)(qd + quad * 8) = o.v;
    }
  }
  f32x4 O[4][4];
  float lsum[4], inv[4] = {0.f, 0.f, 0.f, 0.f};
#pragma unroll
  for (int dt = 0; dt < 4; ++dt)
#pragma unroll
    for (int nt = 0; nt < 4; ++nt) O[dt][nt] = f32x4{0.f, 0.f, 0.f, 0.f};
#pragma unroll
  for (int nt = 0; nt < 4; ++nt) lsum[nt] = 0.f;
  {
    const u16* Kg = proj + tokb * PJ + C_KWIN + g * 64;
    const u16* VTg = (const u16*)(p->ws + OFF_VT + 8 * MiB) + (size_t)(bg * 256) * 4096;
    int h0 = 2 * cur - 16 < 0 ? 0 : 2 * cur - 16;
    flash2<0, 4>(Kg, PJ, VTg, 4096, 64, h0, 2 * cur + 1, sStage, sQw, O, lsum, inv, sSelw, nullptr, tq0);
  }
#pragma unroll
  for (int nt = 0; nt < 4; ++nt) {
    const size_t tok = tokb + tq0 + nt * 4 + (l15 >> 2);
    float ls = lsum[nt];
    ls += __shfl_xor(ls, 16);
    ls += __shfl_xor(ls, 32);
    float sc = sigmoidf_(small_[tok * 32 + 8 + head * 3 + 2]) / ls;
#pragma unroll
    for (int dt = 0; dt < 4; ++dt) {
      float4* op = (float4*)(OC + tok * 512 + head * 64 + dt * 16 + quad * 4);
      float4 o = *op;
      o.x += O[dt][nt][0] * sc; o.y += O[dt][nt][1] * sc; o.z += O[dt][nt][2] * sc; o.w += O[dt][nt][3] * sc;
      *op = o;
      O[dt][nt] = f32x4{0.f, 0.f, 0.f, 0.f};
    }
    lsum[nt] = 0.f;
  }
  {
    const u16* Kg = proj + tokb * PJ + C_KSLC + g * 64;
    const u16* VTg = (const u16*)(p->ws + OFF_VT) + (size_t)(bg * 256) * 4096;
    flash2<1, 4>(Kg, PJ, VTg, 4096, 64, 0, 2 * cur + 1, sStage, sQw, O, lsum, inv, sSelw, nullptr, tq0);
  }
#pragma unroll
  for (int nt = 0; nt < 4; ++nt) {
    const size_t tok = tokb + tq0 + nt * 4 + (l15 >> 2);
    float ls = lsum[nt];
    ls += __shfl_xor(ls, 16);
    ls += __shfl_xor(ls, 32);
    float sc = sigmoidf_(small_[tok * 32 + 8 + head * 3 + 1]) / ls;
#pragma unroll
    for (int dt = 0; dt < 4; ++dt) {
      float4 o = *(const float4*)(OC + tok * 512 + head * 64 + dt * 16 + quad * 4);
      uint2 w;
      w.x = pack2(o.x + O[dt][nt][0] * sc, o.y + O[dt][nt][1] * sc);
      w.y = pack2(o.z + O[dt][nt][2] * sc, o.w + O[dt][nt][3] * sc);
      *(uint2*)(mix + tok * DM + 256 + head * 64 + dt * 16 + quad * 4) = w;
    }
  }
}


#define XB_TMO      128
#define XB_XCNT(j)  (256  + 64 * (j))
#define XB_XSUB(j)  (1280 + 64 * (j))
#define XB_XGEN(j)  (2304 + 64 * (j))
#define XB_TOP      3328
#define XB_TOPGEN   3392
#define XCD_BAR_WORDS 3456
#define XB_SPIN_CAP (1u << 18)
#define LAS __attribute__((address_space(3)))
__device__ __forceinline__ unsigned xb_ld(unsigned* p) { return __hip_atomic_load(p, __ATOMIC_RELAXED, __HIP_MEMORY_SCOPE_AGENT); }
__device__ __forceinline__ unsigned xb_add(unsigned* p, unsigned v) { return __hip_atomic_fetch_add(p, v, __ATOMIC_RELAXED, __HIP_MEMORY_SCOPE_AGENT); }
__device__ __forceinline__ unsigned xb_xcc_id() { return (unsigned)__builtin_amdgcn_s_getreg((3 << 11) | 20) & 0xFu; }
#define XB_SPIN(cond, bar) do { unsigned _sp = 0; while (cond) { __builtin_amdgcn_s_sleep(1); \
    if ((++_sp & 255u) == 0u) { if (xb_ld(&(bar)[XB_TMO])) break; if (_sp > XB_SPIN_CAP) { atomicAdd(&(bar)[XB_TMO], 1u); break; } } } } while (0)
struct XcdBarrier { unsigned* bar; unsigned x; volatile LAS unsigned* st; };
__device__ __forceinline__ XcdBarrier xcd_barrier_post(unsigned* bar, volatile LAS unsigned* st) {
  XcdBarrier b; b.bar = bar; b.x = xb_xcc_id(); b.st = st;
  if (threadIdx.x == 0) (void)xb_add(&bar[XB_XCNT(b.x)], 1u);
  return b;
}
__device__ __forceinline__ void xcd_barrier_complete(unsigned* bar, unsigned x, unsigned& nloc, unsigned& nx) {
  const unsigned G = gridDim.x * gridDim.y * gridDim.z;
  unsigned sum, cnt, mine, sp = 0u;
  for (;;) {
    sum = 0u; cnt = 0u; mine = 0u;
#pragma unroll
    for (unsigned j = 0; j < 16; ++j) { const unsigned c = xb_ld(&bar[XB_XCNT(j)]); sum += c; cnt += (c > 0u) ? 1u : 0u; mine = (j == x) ? c : mine; }
    if (sum == G) break;
    __builtin_amdgcn_s_sleep(1);
    if ((++sp & 255u) == 0u) { if (xb_ld(&bar[XB_TMO])) break; if (sp > XB_SPIN_CAP) { atomicAdd(&bar[XB_TMO], 1u); break; } }
  }
  nloc = mine > 0u ? mine : 1u; nx = cnt > 0u ? cnt : 1u;
}
__device__ __forceinline__ void xcd_barrier(const XcdBarrier& b) {
  asm volatile("s_waitcnt vmcnt(0)" ::: "memory");
  __syncthreads();
  if (threadIdx.x == 0) {
    unsigned* bar = b.bar;
    __builtin_amdgcn_s_waitcnt(0);
    unsigned nloc = b.st[0], nx = b.st[1];
    if (nloc == 0u) { xcd_barrier_complete(bar, b.x, nloc, nx); b.st[0] = nloc; b.st[1] = nx; }
    const unsigned old = xb_add(&bar[XB_XSUB(b.x)], 1u);
    const unsigned gen = old / nloc;
    if (old + 1u == (gen + 1u) * nloc) {
      __builtin_amdgcn_fence(__ATOMIC_RELEASE, "agent");
      asm volatile("s_waitcnt vmcnt(0)" ::: "memory");
      const unsigned og = xb_add(&bar[XB_TOP], 1u);
      const unsigned tg = og / nx;
      if (og + 1u == (tg + 1u) * nx) xb_add(&bar[XB_TOPGEN], 1u);
      else XB_SPIN(xb_ld(&bar[XB_TOPGEN]) == tg, bar);
      __builtin_amdgcn_fence(__ATOMIC_ACQUIRE, "agent");
      xb_add(&bar[XB_XGEN(b.x)], 1u);
      asm volatile("s_waitcnt vmcnt(0)" ::: "memory");
    } else {
      XB_SPIN(xb_ld(&bar[XB_XGEN(b.x)]) == gen, bar);
      __builtin_amdgcn_fence(__ATOMIC_ACQUIRE, "agent");
      asm volatile("s_waitcnt vmcnt(0)" ::: "memory");
    }
  }
  __syncthreads();
}
#ifndef REPE
#define REPE 1
#endif
#ifndef REP3
#define REP3 1
#endif
#ifndef XSYNC
#define XSYNC 0
#endif
#ifndef REP4
#define REP4 1
#endif
#ifndef REPSCAN
#define REPSCAN 1
#endif
#ifndef REPG
#define REPG 1
#endif
__global__ void __launch_bounds__(256, 2) hymba_mega(Params p_unused) {
  cg::grid_group grid = cg::this_grid();
  __shared__ uint4 xb_words;
  if (threadIdx.x == 0) xb_words = make_uint4(0u, 0u, 0u, 0u);
  __syncthreads();
  XcdBarrier xb = xcd_barrier_post((unsigned*)(kargs()->ws + OFF_CNT + 4096), (volatile LAS unsigned*)&xb_words);
  __shared__ __attribute__((aligned(16))) char smem[73728];
  __shared__ int s_tile;
  { KP p = kargs(); rope_table(p); }
  grid.sync();
#pragma unroll 1
  for (int l = 0; l < DEPTH; ++l) {
    {
      KP p = kargs();
      if (blockIdx.x == 0 && threadIdx.x == 0) ((u32*)(p->ws + OFF_CNT))[0] = 0u;
      for (int re = 0; re < REPE; ++re) {
      convert_weights(p, l, smem);
      rmsnorm_rows(l == 0 ? p->x_in : p->out, p->attn_norm + l * DM, (u16*)(p->ws + OFF_H));
      }
    }
    xcd_barrier(xb);
    {
      KP p = kargs();
      for (int rep = 0; rep < REPG; ++rep)
      gemm_phase((const u16*)(p->ws + OFF_H), DM, (const u16*)(p->ws + OFF_W + W_IN), DM, DM, 256, 25, smem,
                 EpiInProj{(u16*)(p->ws + OFF_PROJ), (float*)(p->ws + OFF_SMALL)});
    }
    xcd_barrier(xb);
    {
      KP p = kargs();
      for (int r3 = 0; r3 < REP3; ++r3)
      for (int job = obid(); job < 2048 + 512 + 128; job += gridDim.x) {
        if (job < 2048) gdn_chunk_prep(p, l, smem, job);
        else if (job < 2560) { if (r3 == 0) nsa_token_prep(p, l, smem, job - 2048); }
        else nsa_compress(p, l, smem, job - 2560);
      }
    }
    xcd_barrier(xb);
#ifndef REP45
#define REP45 1
#endif
    for (int rep = 0; rep < REP45; ++rep) {
    {
      KP p = kargs();
      if (blockIdx.x == 0 && threadIdx.x == 0) ((u32*)(p->ws + OFF_CNT))[0] = 0u;
      for (int r4 = 0; r4 < REP4; ++r4) nsa_phase_c(p, l, smem);
    }
    xcd_barrier(xb);
    {
      KP p = kargs();
      if (obid() < 32) for (int rs = 0; rs < REPSCAN; ++rs) gdn_scan(p, smem, obid());
      u32* CNT = (u32*)(p->ws + OFF_CNT);
      for (;;) {
        __syncthreads();
        if (threadIdx.x == 0) s_tile = (int)atomicAdd(&CNT[0], 1u);
        __syncthreads();
        int tile = s_tile;
        if (tile >= 1024) break;
        nsa_s_tile(p, l, smem, tile);
      }
    }
    xcd_barrier(xb);
    }
    {
      KP p = kargs();
      for (int re = 0; re < REPE; ++re) gdn_finalize(p, l);
      for (int xs = 0; xs < XSYNC; ++xs) xcd_barrier(xb);
    }
    xcd_barrier(xb);
    {
      KP p = kargs();
      gemm_phase((const u16*)(p->ws + OFF_H), DM, (const u16*)(p->ws + OFF_W + W_OUT), DM, DM, 256, 8, smem,
                 EpiResid{l == 0 ? p->x_in : p->out, p->out});
    }
    xcd_barrier(xb);
    {
      KP p = kargs();
      for (int re = 0; re < REPE; ++re) rmsnorm_rows(p->out, p->ffn_norm + l * DM, (u16*)(p->ws + OFF_H));
    }
    xcd_barrier(xb);
    {
      KP p = kargs();
      for (int rep = 0; rep < REPG; ++rep)
      gemm_phase((const u16*)(p->ws + OFF_H), DM, (const u16*)(p->ws + OFF_W + W_GU), DM, DM, 256, 44, smem,
                 EpiSwiGLU{(u16*)(p->ws + OFF_PROJ)});
    }
    xcd_barrier(xb);
    {
      KP p = kargs();
      gemm_phase((const u16*)(p->ws + OFF_PROJ), DFF, (const u16*)(p->ws + OFF_W + W_DOWN), DFF, DFF, 256, 8, smem,
                 EpiResid{p->out, p->out});
    }
    xcd_barrier(xb);
  }
}

extern "C" void kernel_launch(void* const* d_in, const int* in_sizes, int n_in, void* d_out, int out_size, void* d_ws,
                              size_t ws_size, hipStream_t stream) {
  static int grid_blocks = 0;
  if (!grid_blocks) {
    int dev = 0, cus = 0, per_cu = 0;
    hipGetDevice(&dev);
    hipDeviceGetAttribute(&cus, hipDeviceAttributeMultiprocessorCount, dev);
    hipOccupancyMaxActiveBlocksPerMultiprocessor(&per_cu, hymba_mega, 256, 0);
    if (per_cu > 2) per_cu = 2;
    if (per_cu < 1) per_cu = 1;
    grid_blocks = cus * per_cu;
    grid_blocks &= ~7;
  }
  Params p;
  memset(&p, 0, sizeof(p));
  p.x_in = (const float*)d_in[0]; p.positions = (const int*)d_in[1]; p.attn_norm = (const float*)d_in[2];
  p.w_in = (const float*)d_in[3]; p.gdn_conv_w = (const float*)d_in[4]; p.gdn_a_log = (const float*)d_in[5];
  p.gdn_dt_bias = (const float*)d_in[6]; p.gdn_norm = (const float*)d_in[7]; p.nsa_q_norm = (const float*)d_in[8];
  p.nsa_k_norm = (const float*)d_in[9]; p.cmp_pe = (const float*)d_in[10]; p.cmp_w1 = (const float*)d_in[11];
  p.cmp_w2 = (const float*)d_in[12]; p.conv_w = (const float*)d_in[13]; p.w_out = (const float*)d_in[14];
  p.ffn_norm = (const float*)d_in[15]; p.w_gate_up = (const float*)d_in[16]; p.w_down = (const float*)d_in[17];
  p.out = (float*)d_out; p.ws = (char*)d_ws;
  hipMemsetAsync((char*)d_ws + OFF_CNT, 0, 4096 + XCD_BAR_WORDS * 4, stream);
  void* args[] = {&p};
  hipError_t e = hipLaunchCooperativeKernel((void*)hymba_mega, dim3(grid_blocks), dim3(256), args, 0, stream);
  if (e != hipSuccess) fprintf(stderr, "cooperative launch failed: %s (grid %d)\n", hipGetErrorString(e), grid_blocks);
}
```

```cpp
#include <hip/hip_runtime.h>
#include <hip/hip_cooperative_groups.h>
#include <cstdio>
#include <cstring>
namespace cg = cooperative_groups;

#ifndef ZTEST
#define ZTEST 0
#endif
typedef unsigned short u16;
typedef unsigned int u32;
typedef __attribute__((ext_vector_type(8))) short bf16x8;
typedef __attribute__((ext_vector_type(4))) short bf16x4;
typedef __attribute__((ext_vector_type(4))) float f32x4;

constexpr int NB = 2, T = 16384, NTOK = NB * T, DM = 1024, DFF = 2816, DEPTH = 4;
constexpr int PJ = 3072;
constexpr int C_GQ = 0, C_GK = 256, C_GV = 512, C_GZ = 768, C_NQ = 1024, C_KCMP = 1536, C_VCMP = 1664,
              C_KSLC = 1792, C_VSLC = 1920, C_KWIN = 2048, C_VWIN = 2176, C_CB = 2304, C_CC = 2560, C_CX = 2816;
constexpr size_t MiB = 1ull << 20;
constexpr size_t OFF_H = 0, OFF_PROJ = 64 * MiB, OFF_SMALL = 256 * MiB, OFF_W = 260 * MiB, OFF_GDN = 288 * MiB,
                 OFF_OG = 384 * MiB, OFF_OC = 416 * MiB, OFF_VT = 480 * MiB, OFF_KC = 496 * MiB, OFF_SEL = 497 * MiB,
                 OFF_ROPE = 499 * MiB, OFF_GL = 501 * MiB, OFF_CNT = 501 * MiB + 65536;
constexpr size_t W_IN = 0, W_OUT = 6553600, W_GU = 8650752, W_DOWN = 20185088, W_C1 = 25952256, W_C2 = 26476544;
constexpr int CHUNK_B = 49152;
constexpr float SC2 = 0.125f * 1.4426950408889634f;

struct Params {
  const float* x_in; const int* positions; const float* attn_norm; const float* w_in; const float* gdn_conv_w;
  const float* gdn_a_log; const float* gdn_dt_bias; const float* gdn_norm; const float* nsa_q_norm;
  const float* nsa_k_norm; const float* cmp_pe; const float* cmp_w1; const float* cmp_w2; const float* conv_w;
  const float* w_out; const float* ffn_norm; const float* w_gate_up; const float* w_down;
  float* out; char* ws;
};


__device__ __forceinline__ int otid() { int t = threadIdx.x; asm volatile("" : "+v"(t)); return t; }
__device__ __forceinline__ int obid() { int t = blockIdx.x; asm volatile("" : "+s"(t)); return t; }
typedef const __attribute__((address_space(4))) Params* KP;
__device__ __forceinline__ KP kargs() {
  KP k = (KP)__builtin_amdgcn_kernarg_segment_ptr();
  asm volatile("" : "+s"(k));
  return k;
}

typedef __bf16 bf2_t __attribute__((ext_vector_type(2)));
typedef float f2_t __attribute__((ext_vector_type(2)));
__device__ __forceinline__ u32 pack2(float a, float b) {
  f2_t v = {a, b};
  bf2_t r = __builtin_convertvector(v, bf2_t);
  return __builtin_bit_cast(u32, r);
}
__device__ __forceinline__ u16 f2bf(float f) { return (u16)(pack2(f, 0.f) & 0xffffu); }
__device__ __forceinline__ float bf2f(u16 h) { return __uint_as_float(((u32)h) << 16); }
__device__ __forceinline__ float wave_sum(float v) {
#pragma unroll
  for (int o = 32; o; o >>= 1) v += __shfl_xor(v, o);
  return v;
}
__device__ __forceinline__ float sigmoidf_(float x) { return 1.f / (1.f + __expf(-x)); }
__device__ __forceinline__ f32x4 mfma16(bf16x8 a, bf16x8 b, f32x4 c) {
  return __builtin_amdgcn_mfma_f32_16x16x32_bf16(a, b, c, 0, 0, 0);
}
__device__ __forceinline__ bf16x8 pack8(f32x4 a, f32x4 b) {
  union { bf16x8 v; u32 u[4]; } r;
  r.u[0] = pack2(a[0], a[1]); r.u[1] = pack2(a[2], a[3]);
  r.u[2] = pack2(b[0], b[1]); r.u[3] = pack2(b[2], b[3]);
  return r.v;
}

__device__ __forceinline__ void rmsnorm_rows(const float* __restrict__ x, const float* __restrict__ gain, u16* __restrict__ h) {
  int lane = otid() & 63;
  int gw = obid() * 4 + (otid() >> 6), nw = gridDim.x * 4;
  for (int row = gw; row < NTOK; row += nw) {
    const float4* xr = (const float4*)(x + (size_t)row * DM);
    float4 v[4];
    float ss = 0.f;
#pragma unroll
    for (int i = 0; i < 4; ++i) {
      v[i] = xr[lane + 64 * i];
      ss += v[i].x * v[i].x + v[i].y * v[i].y + v[i].z * v[i].z + v[i].w * v[i].w;
    }
    ss = wave_sum(ss);
    float rs = rsqrtf(ss * (1.f / DM) + 1e-6f);
#pragma unroll
    for (int i = 0; i < 4; ++i) {
      float4 g = ((const float4*)gain)[lane + 64 * i];
      uint2 o;
      o.x = pack2(v[i].x * rs * g.x, v[i].y * rs * g.y);
      o.y = pack2(v[i].z * rs * g.z, v[i].w * rs * g.w);
      *(uint2*)(h + (size_t)row * DM + (lane + 64 * i) * 4) = o;
    }
  }
}

struct MapId { __device__ int operator()(int n) const { return n; } };
struct MapIn {
  __device__ int operator()(int n) const {
    if (n < 1024) return n;
    if (n < 2304) return n + 8;
    if (n < 3072) return n + 32;
    if (n < 3080) return n - 3072 + 1024;
    if (n < 3104) return n - 3080 + 2312;
    return -1;
  }
};
struct MapGU {
  __device__ int operator()(int n) const {
    int grp = n >> 6, r = n & 63;
    return r < 32 ? grp * 32 + r : DFF + grp * 32 + (r - 32);
  }
};
template <class Map>
__device__ __forceinline__ void transpose_tile(const float* __restrict__ src, int lds_, Map map, u16* __restrict__ dst, int ldd, int n0,
                               int k0, float* t) {
  int tid = otid();
#pragma unroll 4
  for (int i = 0; i < 16; ++i) {
    int k = i * 4 + (tid >> 6), n = tid & 63;
    int sn = map(n0 + n);
    t[k * 65 + n] = sn >= 0 ? src[(size_t)(k0 + k) * lds_ + sn] : 0.f;
  }
  __syncthreads();
#pragma unroll 4
  for (int i = 0; i < 16; ++i) {
    int n = i * 4 + (tid >> 6), k = tid & 63;
    dst[(size_t)(n0 + n) * ldd + k0 + k] = f2bf(t[k * 65 + n]);
  }
  __syncthreads();
}

__device__ __forceinline__ void convert_weights(KP p, int l, char* smem) {
  float* t = (float*)smem;
  char* W = p->ws + OFF_W;
  const int J0 = 800, J1 = J0 + 256, J2 = J1 + 1408, J3 = J2 + 704, J4 = J3 + 64, J5 = J4 + 2;
  for (int job = obid(); job < J5; job += gridDim.x) {
    if (job < J0) {
      transpose_tile(p->w_in + (size_t)l * DM * 3104, 3104, MapIn(), (u16*)(W + W_IN), 1024, (job >> 4) * 64,
                     (job & 15) * 64, t);
    } else if (job < J1) {
      int j = job - J0;
      transpose_tile(p->w_out + (size_t)l * DM * DM, 1024, MapId(), (u16*)(W + W_OUT), 1024, (j >> 4) * 64,
                     (j & 15) * 64, t);
    } else if (job < J2) {
      int j = job - J1;
      transpose_tile(p->w_gate_up + (size_t)l * DM * 2 * DFF, 2 * DFF, MapGU(), (u16*)(W + W_GU), 1024, (j >> 4) * 64,
                     (j & 15) * 64, t);
    } else if (job < J3) {
      int j = job - J2;
      transpose_tile(p->w_down + (size_t)l * DFF * DM, 1024, MapId(), (u16*)(W + W_DOWN), DFF, (j / 44) * 64,
                     (j % 44) * 64, t);
    } else if (job < J4) {
      int j = job - J3;
      int which = j >> 5, kt = j & 31;
      transpose_tile(p->cmp_w1 + (size_t)(l * 2 + which) * 2048 * 64, 64, MapId(),
                     (u16*)(W + W_C1) + (size_t)which * 64 * 2048, 2048, 0, kt * 64, t);
    } else {
      int which = job - J4;
      transpose_tile(p->cmp_w2 + (size_t)(l * 2 + which) * 64 * 64, 64, MapId(), (u16*)(W + W_C2) + which * 4096, 64, 0,
                     0, t);
    }
  }
}

#define WAIT_VM(n) asm volatile("s_waitcnt vmcnt(" #n ")" ::: "memory")
#define RAW_BAR() do { asm volatile("s_waitcnt lgkmcnt(0)" ::: "memory"); __builtin_amdgcn_s_barrier(); } while (0)
typedef __attribute__((ext_vector_type(16))) float f32x16;
template <class Epi>
__device__ __forceinline__ void gemm_phase(const u16* __restrict__ A, int lda, const u16* __restrict__ Bt, int ldb, int K, int ntm,
                           int ntn, char* smem, Epi epi) {
  const int tid = otid(), lane = tid & 63, wv = tid >> 6;
  const int wm = wv >> 1, wn = wv & 1, l31 = lane & 31, hi = lane >> 5;
  const int ntiles = ntm * ntn, nk = K >> 6;
  const int lrow = tid >> 3, lc = tid & 7;
  const int woff = lrow * 128 + ((lc ^ ((lrow >> 1) & 7)) * 16);
  const int sw = (l31 >> 1) & 7;
  const int arow = (wm * 64 + l31) * 128, brow = 16384 + (wn * 64 + l31) * 128;
#define TILE_DECODE(id_, row0_, col0_, tn_)                                                  \
  do {                                                                                       \
    int xcd_ = (id_) & 7, loc_ = (id_) >> 3;                                                 \
    int per_rb_ = 8 * ntn;                                                                   \
    int rb_ = loc_ / per_rb_, rem_ = loc_ % per_rb_;                                         \
    int cb_ = rem_ >> 6, rem2_ = rem_ & 63;                                                  \
    int width_ = (cb_ + 1) * 8 <= ntn ? 8 : ntn - cb_ * 8;                                   \
    int tm_l_ = rb_ * 8 + rem2_ / width_;                                                    \
    tn_ = cb_ * 8 + rem2_ % width_;                                                          \
    row0_ = (tm_l_ * 8 + xcd_) * 128;                                                        \
    col0_ = tn_ * 128;                                                                       \
  } while (0)
#define G_LOAD(R, kt_)                                                       \
  do {                                                                       \
    R##a0 = *(const uint4*)(gA + (kt_) * 64);                                \
    R##a1 = *(const uint4*)(gA + a32 + (kt_) * 64);                          \
    R##a2 = *(const uint4*)(gA + 2 * a32 + (kt_) * 64);                      \
    R##a3 = *(const uint4*)(gA + 3 * a32 + (kt_) * 64);                      \
    R##b0 = *(const uint4*)(gB + (kt_) * 64);                                \
    R##b1 = *(const uint4*)(gB + b32 + (kt_) * 64);                          \
    R##b2 = *(const uint4*)(gB + 2 * b32 + (kt_) * 64);                      \
    R##b3 = *(const uint4*)(gB + 3 * b32 + (kt_) * 64);                      \
  } while (0)
#define G_WRITE(R, slot_)                                                    \
  do {                                                                       \
    char* st_ = smem + (slot_) * 32768 + woff;                               \
    *(uint4*)(st_) = R##a0;                                                  \
    *(uint4*)(st_ + 4096) = R##a1;                                           \
    *(uint4*)(st_ + 8192) = R##a2;                                           \
    *(uint4*)(st_ + 12288) = R##a3;                                          \
    *(uint4*)(st_ + 16384) = R##b0;                                          \
    *(uint4*)(st_ + 20480) = R##b1;                                          \
    *(uint4*)(st_ + 24576) = R##b2;                                          \
    *(uint4*)(st_ + 28672) = R##b3;                                          \
  } while (0)
#define G_KSTEP(st_, ks_)                                                                        \
  do {                                                                                           \
    const int po_ = (((ks_) * 2 + hi) ^ sw) * 16;                                                \
    bf16x8 a0_ = *(const bf16x8*)(st_ + arow + po_), a1_ = *(const bf16x8*)(st_ + arow + 4096 + po_); \
    bf16x8 b0_ = *(const bf16x8*)(st_ + brow + po_), b1_ = *(const bf16x8*)(st_ + brow + 4096 + po_); \
    acc[0][0] = __builtin_amdgcn_mfma_f32_32x32x16_bf16(b0_, a0_, acc[0][0], 0, 0, 0);           \
    acc[0][1] = __builtin_amdgcn_mfma_f32_32x32x16_bf16(b1_, a0_, acc[0][1], 0, 0, 0);           \
    acc[1][0] = __builtin_amdgcn_mfma_f32_32x32x16_bf16(b0_, a1_, acc[1][0], 0, 0, 0);           \
    acc[1][1] = __builtin_amdgcn_mfma_f32_32x32x16_bf16(b1_, a1_, acc[1][1], 0, 0, 0);           \
  } while (0)
#define G_COMPUTE(slot_)                                   \
  do {                                                     \
    const char* st_ = smem + (slot_) * 32768;              \
    __builtin_amdgcn_s_setprio(1);                         \
    G_KSTEP(st_, 0); G_KSTEP(st_, 1); G_KSTEP(st_, 2); G_KSTEP(st_, 3); \
    __builtin_amdgcn_s_setprio(0);                         \
  } while (0)
#define G_ITER(u_, RN, sn_)                                                   \
  if (kt + (u_) < nk) {                                                       \
    const int k_ = kt + (u_);                                                 \
    if (k_ + 1 < nk) G_WRITE(RN, sn_);                                        \
    if (k_ + 3 < nk) G_LOAD(RN, k_ + 3);                                      \
    G_COMPUTE(u_);                                                            \
    RAW_BAR();                                                                \
  }
  const size_t a32 = (size_t)32 * lda, b32 = (size_t)32 * ldb;
  int id = obid();
  int row0 = 0, col0 = 0, tn = 0;
  const u16 *gA = A, *gB = Bt;
  uint4 R0a0, R0a1, R0a2, R0a3, R0b0, R0b1, R0b2, R0b3, R1a0, R1a1, R1a2, R1a3, R1b0, R1b1, R1b2, R1b3;
  if (id < ntiles) {
    TILE_DECODE(id, row0, col0, tn);
    gA = A + (size_t)(row0 + lrow) * lda + lc * 8;
    gB = Bt + (size_t)(col0 + lrow) * ldb + lc * 8;
    G_LOAD(R0, 0);
    G_LOAD(R1, 1);
  }
  while (id < ntiles) {
    f32x16 acc[2][2];
#pragma unroll
    for (int m = 0; m < 2; ++m)
#pragma unroll
      for (int n = 0; n < 2; ++n)
#pragma unroll
        for (int r = 0; r < 16; ++r) acc[m][n][r] = 0.f;
    G_WRITE(R0, 0);
    G_LOAD(R0, 2);
    RAW_BAR();
    for (int kt = 0; kt < nk; kt += 2) {
      G_ITER(0, R1, 1)
      G_ITER(1, R0, 0)
    }
    const int erow = row0 + wm * 64 + l31, ecol = col0 + wn * 64 + hi * 4, etn = tn;
    id += gridDim.x;
    if (id < ntiles) {
      TILE_DECODE(id, row0, col0, tn);
      gA = A + (size_t)(row0 + lrow) * lda + lc * 8;
      gB = Bt + (size_t)(col0 + lrow) * ldb + lc * 8;
      G_LOAD(R0, 0);
      G_LOAD(R1, 1);
    }
    epi(acc, erow, ecol, etn);
  }
}

struct EpiInProj {
  u16* proj; float* small_;
  __device__ __forceinline__ void operator()(f32x16 (&acc)[2][2], int rbase, int cbase, int tn) const {
    if (tn < 24) {
#pragma unroll
      for (int m = 0; m < 2; ++m)
#pragma unroll
        for (int n = 0; n < 2; ++n)
#pragma unroll
          for (int g = 0; g < 4; ++g) {
            uint2 o;
            o.x = pack2(acc[m][n][g * 4 + 0], acc[m][n][g * 4 + 1]);
            o.y = pack2(acc[m][n][g * 4 + 2], acc[m][n][g * 4 + 3]);
            *(uint2*)(proj + (size_t)(rbase + m * 32) * PJ + cbase + n * 32 + g * 8) = o;
          }
    } else {
#pragma unroll
      for (int m = 0; m < 2; ++m)
#pragma unroll
        for (int g = 0; g < 4; ++g) {
          int c = cbase + g * 8 - 3072;
          if (c < 32)
            *(float4*)(small_ + (size_t)(rbase + m * 32) * 32 + c) =
                make_float4(acc[m][0][g * 4 + 0], acc[m][0][g * 4 + 1], acc[m][0][g * 4 + 2], acc[m][0][g * 4 + 3]);
        }
    }
  }
};
struct EpiResid {
  const float* xin; float* xout;
  __device__ __forceinline__ void operator()(f32x16 (&acc)[2][2], int rbase, int cbase, int tn) const {
#pragma unroll
    for (int m = 0; m < 2; ++m)
#pragma unroll
      for (int n = 0; n < 2; ++n)
#pragma unroll
        for (int g = 0; g < 4; ++g) {
          size_t idx = (size_t)(rbase + m * 32) * DM + cbase + n * 32 + g * 8;
          float4 x = *(const float4*)(xin + idx);
          x.x += acc[m][n][g * 4 + 0]; x.y += acc[m][n][g * 4 + 1]; x.z += acc[m][n][g * 4 + 2]; x.w += acc[m][n][g * 4 + 3];
          *(float4*)(xout + idx) = x;
        }
  }
};
struct EpiSwiGLU {
  u16* act;
  __device__ __forceinline__ void operator()(f32x16 (&acc)[2][2], int rbase, int cbase, int tn) const {
    int grp = cbase >> 6, c4 = cbase & 7;
#pragma unroll
    for (int m = 0; m < 2; ++m)
#pragma unroll
      for (int g = 0; g < 4; ++g) {
        float v[4];
#pragma unroll
        for (int r = 0; r < 4; ++r) {
          float gt = acc[m][0][g * 4 + r], up = acc[m][1][g * 4 + r];
          v[r] = gt / (1.f + __expf(-gt)) * up;
        }
        uint2 o;
        o.x = pack2(v[0], v[1]);
        o.y = pack2(v[2], v[3]);
        *(uint2*)(act + (size_t)(rbase + m * 32) * DFF + grp * 32 + g * 8 + c4) = o;
      }
  }
};

__device__ __forceinline__ void gdn_chunk_prep(KP p, int l, char* smem, int job) {
  const int b = job >> 10, h = (job >> 8) & 3, c = job & 255;
  const int tid = otid(), lane = tid & 63, wv = tid >> 6;
  float* sq = (float*)smem;
  float* sk = sq + 64 * 65;
  float* sv = sk + 64 * 65;
  float* sA = sv + 64 * 65;
  float* sgc = sA + 64 * 64;
  float* sbeta = sgc + 64;
  float* seg = sbeta + 64;
  float* sf2 = seg + 64;
  const u16* proj = (const u16*)(p->ws + OFF_PROJ);
  const float* small_ = (const float*)(p->ws + OFF_SMALL);
  const size_t tok0 = (size_t)b * T + c * 64;
  char* cb = p->ws + OFF_GDN + (size_t)((b * 4 + h) * 256 + c) * CHUNK_B;
  float* UT = (float*)cb;
  u16* NW = (u16*)(cb + 16384);
  u16* QD = (u16*)(cb + 24576);
  u16* KDT = (u16*)(cb + 32768);
  u16* QKM = (u16*)(cb + 40960);
  {
    int d = lane, i0 = wv * 16;
#pragma unroll
    for (int seg_ = 0; seg_ < 3; ++seg_) {
      int ch = seg_ * 256 + h * 64 + d;
      const float* cw = p->gdn_conv_w + (size_t)l * 4 * 768 + ch;
      float w0 = cw[0], w1 = cw[768], w2 = cw[1536], w3 = cw[2304];
      float* dst = seg_ == 0 ? sq : (seg_ == 1 ? sk : sv);
      float x0 = 0, x1 = 0, x2 = 0;
      int tl = c * 64 + i0;
      if (tl - 3 >= 0) x0 = bf2f(proj[(tok0 + i0 - 3) * PJ + ch]);
      if (tl - 2 >= 0) x1 = bf2f(proj[(tok0 + i0 - 2) * PJ + ch]);
      if (tl - 1 >= 0) x2 = bf2f(proj[(tok0 + i0 - 1) * PJ + ch]);
      for (int i = 0; i < 16; ++i) {
        float x3 = bf2f(proj[(tok0 + i0 + i) * PJ + ch]);
        float y = w0 * x0 + w1 * x1 + w2 * x2 + w3 * x3;
        dst[(i0 + i) * 65 + d] = y / (1.f + __expf(-y));
        x0 = x1; x1 = x2; x2 = x3;
      }
    }
  }
  if (tid < 64) {
    float gb = small_[(tok0 + tid) * 32 + h], ga = small_[(tok0 + tid) * 32 + 4 + h];
    float xx = ga + p->gdn_dt_bias[l * 4 + h];
    float sp = fmaxf(xx, 0.f) + log1pf(__expf(-fabsf(xx)));
    float g = -__expf(p->gdn_a_log[l * 4 + h]) * sp;
#pragma unroll
    for (int o = 1; o < 64; o <<= 1) {
      float t = __shfl_up(g, o);
      if (lane >= o) g += t;
    }
    float beta = sigmoidf_(gb);
    float eg = __expf(g);
    sgc[tid] = g; sbeta[tid] = beta; seg[tid] = eg; sf2[tid] = beta * eg;
    if (tid == 63) ((float*)(p->ws + OFF_GL))[(b * 4 + h) * 256 + c] = eg;
  }
  __syncthreads();
  if (tid < 128) {
    float* rowp = (tid < 64 ? sq : sk) + (tid & 63) * 65;
    float ss = 0.f;
#pragma unroll 16
    for (int d = 0; d < 64; ++d) ss += rowp[d] * rowp[d];
    const float sc = rsqrtf(ss + 1e-6f) * (tid < 64 ? 0.125f : 1.f);
#pragma unroll 16
    for (int d = 0; d < 64; ++d) rowp[d] *= sc;
  }
  __syncthreads();
  {
    int ti = tid >> 4, tj = tid & 15;
    float kk[4][4], qk[4][4];
#pragma unroll
    for (int a = 0; a < 4; ++a)
#pragma unroll
      for (int bb = 0; bb < 4; ++bb) { kk[a][bb] = 0.f; qk[a][bb] = 0.f; }
    if (tj <= ti) {
      for (int d = 0; d < 64; ++d) {
        float ki[4], kj[4], qi[4];
#pragma unroll
        for (int a = 0; a < 4; ++a) {
          ki[a] = sk[(ti * 4 + a) * 65 + d];
          qi[a] = sq[(ti * 4 + a) * 65 + d];
          kj[a] = sk[(tj * 4 + a) * 65 + d];
        }
#pragma unroll
        for (int a = 0; a < 4; ++a)
#pragma unroll
          for (int bb = 0; bb < 4; ++bb) { kk[a][bb] += ki[a] * kj[bb]; qk[a][bb] += qi[a] * kj[bb]; }
      }
    }
#pragma unroll
    for (int a = 0; a < 4; ++a) {
      int i = ti * 4 + a;
      float gi = sgc[i], bi = sbeta[i];
      uint2 o;
      float qv[4];
#pragma unroll
      for (int bb = 0; bb < 4; ++bb) {
        int j = tj * 4 + bb;
        float dec = (j <= i) ? __expf(gi - sgc[j]) : 0.f;
        sA[i * 64 + j] = (j < i) ? bi * kk[a][bb] * dec : 0.f;
        qv[bb] = qk[a][bb] * dec;
      }
      o.x = pack2(qv[0], qv[1]); o.y = pack2(qv[2], qv[3]);
      *(uint2*)(QKM + i * 64 + tj * 4) = o;
    }
  }
  {
    float gl = sgc[63];
    for (int idx = tid; idx < 4096; idx += 256) {
      int i = idx >> 6, d = idx & 63;
      QD[idx] = f2bf(sq[i * 65 + d] * seg[i]);
      KDT[idx] = f2bf(sk[d * 65 + i] * __expf(gl - sgc[d]));
    }
  }
  __syncthreads();
  if (tid < 128) {
    int cidx = tid;
    const float* src = cidx < 64 ? sv + cidx : sk + (cidx - 64);
    const float* fac = cidx < 64 ? sbeta : sf2;
    float x[64];
#pragma unroll
    for (int i = 0; i < 64; ++i) {
      float s0 = src[i * 65] * fac[i], s1 = 0.f, s2 = 0.f, s3 = 0.f;
#pragma unroll
      for (int j = 0; j < i; ++j) {
        if ((j & 3) == 0) s0 -= sA[i * 64 + j] * x[j];
        else if ((j & 3) == 1) s1 -= sA[i * 64 + j] * x[j];
        else if ((j & 3) == 2) s2 -= sA[i * 64 + j] * x[j];
        else s3 -= sA[i * 64 + j] * x[j];
      }
      x[i] = (s0 + s1) + (s2 + s3);
    }
    if (cidx < 64) {
#pragma unroll
      for (int i = 0; i < 64; i += 4) *(float4*)(UT + cidx * 64 + i) = make_float4(x[i], x[i + 1], x[i + 2], x[i + 3]);
    } else {
#pragma unroll
      for (int i = 0; i < 64; ++i) NW[i * 64 + (cidx - 64)] = f2bf(-x[i]);
    }
  }
  __syncthreads();
}

__device__ __forceinline__ void gdn_scan(KP p, char* smem, int sid) {
  const int b = sid >> 4, h = (sid >> 2) & 3, v0 = (sid & 3) * 16;
  const int tid = otid(), lane = tid & 63, wv = tid >> 6, l15 = lane & 15, quad = lane >> 4;
  u16* Sb = (u16*)smem;
  u16* Vb = Sb + 16 * 72;
  f32x4 S = {0.f, 0.f, 0.f, 0.f};
  { u32 z0 = 0u; asm volatile("" : "+v"(z0)); *(uint2*)(Sb + l15 * 72 + 16 * wv + quad * 4) = make_uint2(z0, z0); }
  __syncthreads();
  const char* gbase = p->ws + OFF_GDN + (size_t)((b * 4 + h) * 256) * CHUNK_B;
  const float* GL = (const float*)(p->ws + OFF_GL) + (b * 4 + h) * 256;
  float* OG = (float*)(p->ws + OFF_OG);
  const int arow = (16 * wv + l15) * 64 + quad * 8;
  f32x4 u, un;
  bf16x8 wA[2], qdA[2], qkA[2], kdA[2], wAn[2], qdAn[2], qkAn[2], kdAn[2];
  float gl, gln;
  {
    const char* cb = gbase;
    u = *(const f32x4*)((const float*)cb + (v0 + l15) * 64 + 16 * wv + quad * 4);
#pragma unroll
    for (int ks = 0; ks < 2; ++ks) {
      wA[ks] = *(const bf16x8*)((const u16*)(cb + 16384) + arow + ks * 32);
      qdA[ks] = *(const bf16x8*)((const u16*)(cb + 24576) + arow + ks * 32);
      kdA[ks] = *(const bf16x8*)((const u16*)(cb + 32768) + arow + ks * 32);
      qkA[ks] = *(const bf16x8*)((const u16*)(cb + 40960) + arow + ks * 32);
    }
    gl = GL[0];
  }
  for (int c = 0; c < 256; ++c) {
    if (c + 1 < 256) {
      const char* cb = gbase + (size_t)(c + 1) * CHUNK_B;
      un = *(const f32x4*)((const float*)cb + (v0 + l15) * 64 + 16 * wv + quad * 4);
#pragma unroll
      for (int ks = 0; ks < 2; ++ks) {
        wAn[ks] = *(const bf16x8*)((const u16*)(cb + 16384) + arow + ks * 32);
        qdAn[ks] = *(const bf16x8*)((const u16*)(cb + 24576) + arow + ks * 32);
        kdAn[ks] = *(const bf16x8*)((const u16*)(cb + 32768) + arow + ks * 32);
        qkAn[ks] = *(const bf16x8*)((const u16*)(cb + 40960) + arow + ks * 32);
      }
      gln = GL[c + 1];
    }
    bf16x8 sB0 = *(const bf16x8*)(Sb + l15 * 72 + quad * 8);
    bf16x8 sB1 = *(const bf16x8*)(Sb + l15 * 72 + 32 + quad * 8);
    f32x4 vn = u;
    vn = mfma16(wA[0], sB0, vn);
    vn = mfma16(wA[1], sB1, vn);
    f32x4 o = {0.f, 0.f, 0.f, 0.f};
    o = mfma16(qdA[0], sB0, o);
    o = mfma16(qdA[1], sB1, o);
    *(uint2*)(Vb + l15 * 72 + 16 * wv + quad * 4) = make_uint2(pack2(vn[0], vn[1]), pack2(vn[2], vn[3]));
    __syncthreads();
    bf16x8 vB0 = *(const bf16x8*)(Vb + l15 * 72 + quad * 8);
    bf16x8 vB1 = *(const bf16x8*)(Vb + l15 * 72 + 32 + quad * 8);
    o = mfma16(qkA[0], vB0, o);
    o = mfma16(qkA[1], vB1, o);
    S[0] *= gl; S[1] *= gl; S[2] *= gl; S[3] *= gl;
    S = mfma16(kdA[0], vB0, S);
    S = mfma16(kdA[1], vB1, S);
    *(uint2*)(Sb + l15 * 72 + 16 * wv + quad * 4) = make_uint2(pack2(S[0], S[1]), pack2(S[2], S[3]));
    size_t orow = (size_t)b * T + c * 64 + 16 * wv + quad * 4;
#pragma unroll
    for (int r = 0; r < 4; ++r) OG[(orow + r) * 256 + h * 64 + v0 + l15] = o[r];
    __syncthreads();
    u = un; gl = gln;
#pragma unroll
    for (int ks = 0; ks < 2; ++ks) { wA[ks] = wAn[ks]; qdA[ks] = qdAn[ks]; kdA[ks] = kdAn[ks]; qkA[ks] = qkAn[ks]; }
  }
}

__device__ __forceinline__ void gdn_finalize(KP p, int l) {
  const int lane = otid() & 63;
  int gw = obid() * 4 + (otid() >> 6), nw = gridDim.x * 4;
  const float* OG = (const float*)(p->ws + OFF_OG);
  const u16* proj = (const u16*)(p->ws + OFF_PROJ);
  u16* mix = (u16*)(p->ws + OFF_H);
  float gn = p->gdn_norm[l * 64 + lane];
  for (int row = gw; row < NTOK * 4; row += nw) {
    int t = row >> 2, h = row & 3;
    float o = OG[(size_t)t * 256 + h * 64 + lane];
    float ss = wave_sum(o * o);
    float z = bf2f(proj[(size_t)t * PJ + C_GZ + h * 64 + lane]);
    float y = o * rsqrtf(ss * (1.f / 64.f) + 1e-6f) * gn * (z / (1.f + __expf(-z)));
    mix[(size_t)t * DM + h * 64 + lane] = f2bf(ZTEST == 4 ? 0.f : y);
  }
}

__device__ __forceinline__ void rope_table(KP p) {
  float* rp = (float*)(p->ws + OFF_ROPE);
  int gt = obid() * blockDim.x + otid(), nt = gridDim.x * blockDim.x;
  for (int idx = gt; idx < NTOK * 8; idx += nt) {
    int t = idx >> 3, i = idx & 7;
    float inv = (float)pow(500000.0, -(double)i / 8.0);
    float ang = (float)p->positions[t] * inv;
    rp[t * 16 + i] = (float)cos((double)ang);
    rp[t * 16 + 8 + i] = (float)sin((double)ang);
  }
}

__device__ __forceinline__ void nsa_token_prep(KP p, int l, char* smem, int tb) {
  const int tid = otid(), lane = tid & 63, wv = tid >> 6;
  const int b = tb >> 8, blk = tb & 255;
  u16* proj = (u16*)(p->ws + OFF_PROJ);
  const float* rope = (const float*)(p->ws + OFF_ROPE);
  const size_t tok0 = (size_t)tb * 64;
  for (int r = tid; r < 768; r += 256) {
    int i = r / 12, which = r % 12;
    size_t t = tok0 + i;
    int col; const float* gain;
    if (which < 8) { col = C_NQ + which * 64; gain = p->nsa_q_norm + l * 64; }
    else if (which < 10) { col = C_KSLC + (which - 8) * 64; gain = p->nsa_k_norm + (l * 3 + 1) * 64; }
    else { col = C_KWIN + (which - 10) * 64; gain = p->nsa_k_norm + (l * 3 + 2) * 64; }
    u16* rowp = proj + t * PJ + col;
    union { uint4 q; u16 h[8]; } v[8];
    float ss = 0.f;
#pragma unroll
    for (int c = 0; c < 8; ++c) {
      v[c].q = *(const uint4*)(rowp + c * 8);
#pragma unroll
      for (int e = 0; e < 8; ++e) { float x = bf2f(v[c].h[e]); ss += x * x; }
    }
    const float rs = rsqrtf(ss * (1.f / 64.f) + 1e-6f);
    float y0[16];
#pragma unroll
    for (int e = 0; e < 16; ++e) y0[e] = bf2f(v[e >> 3].h[e & 7]) * rs * gain[e];
    if (which >= 8) {
      const float* rp = rope + t * 16;
#pragma unroll
      for (int e = 0; e < 8; ++e) {
        float c = rp[e], sn = rp[8 + e];
        float a1 = y0[e], a2 = y0[8 + e];
        y0[e] = a1 * c - a2 * sn;
        y0[8 + e] = a2 * c + a1 * sn;
      }
    }
#pragma unroll
    for (int c = 0; c < 8; ++c) {
      uint4 o;
      float y[8];
#pragma unroll
      for (int e = 0; e < 8; ++e) y[e] = c < 2 ? y0[c * 8 + e] : bf2f(v[c].h[e]) * rs * gain[c * 8 + e];
      o.x = pack2(y[0], y[1]); o.y = pack2(y[2], y[3]); o.z = pack2(y[4], y[5]); o.w = pack2(y[6], y[7]);
      *(uint4*)(rowp + c * 8) = o;
    }
  }
  u16* tt = (u16*)smem;
  for (int z = 0; z < 4; ++z) {
    int tensor = z >> 1, g = z & 1;
    int col = (tensor ? C_VWIN : C_VSLC) + g * 64;
    for (int idx = tid; idx < 4096; idx += 256) {
      int i = idx >> 6, d = idx & 63;
      tt[i * 66 + d] = proj[(tok0 + i) * PJ + col + d];
    }
    __syncthreads();
    u16* dst = (u16*)(p->ws + OFF_VT + (size_t)tensor * 8 * MiB) + ((size_t)((b * 2 + g) * 256 + blk)) * 4096;
    for (int idx = tid; idx < 4096; idx += 256) {
      int d = idx >> 6, i = idx & 63;
      dst[idx] = tt[i * 66 + d];
    }
    __syncthreads();
  }
  {
    int ch = tid;
    const float* cw = p->conv_w + (size_t)l * 3 * 256 + ch;
    float w0 = cw[0], w1 = cw[256], w2 = cw[512];
    u16* mix = (u16*)(p->ws + OFF_H);
    float p0 = 0.f, p1 = 0.f;
    if (blk > 0) {
      p0 = bf2f(proj[(tok0 - 2) * PJ + C_CC + ch]) * bf2f(proj[(tok0 - 2) * PJ + C_CX + ch]);
      p1 = bf2f(proj[(tok0 - 1) * PJ + C_CC + ch]) * bf2f(proj[(tok0 - 1) * PJ + C_CX + ch]);
    }
    for (int i = 0; i < 64; ++i) {
      size_t t = tok0 + i;
      float p2 = bf2f(proj[t * PJ + C_CC + ch]) * bf2f(proj[t * PJ + C_CX + ch]);
      float y = w0 * p0 + w1 * p1 + w2 * p2;
      mix[t * DM + 768 + ch] = f2bf(ZTEST == 5 ? 0.f : bf2f(proj[t * PJ + C_CB + ch]) * y);
      p0 = p1; p1 = p2;
    }
  }
}

__device__ __forceinline__ void nsa_compress(KP p, int l, char* smem, int job) {
  const int tid = otid(), lane = tid & 63, wv = tid >> 6, l15 = lane & 15, quad = lane >> 4;
  const int which = job >> 6, b = (job >> 5) & 1, g = (job >> 4) & 1, tile = job & 15;
  const u16* proj = (const u16*)(p->ws + OFF_PROJ);
  const u16* W1T = (const u16*)(p->ws + OFF_W + W_C1) + (size_t)which * 64 * 2048;
  const u16* W2T = (const u16*)(p->ws + OFF_W + W_C2) + which * 4096;
  const float* pe = p->cmp_pe + (size_t)(l * 2 + which) * 32 * 64;
  const int blk0 = tile * 64 + wv * 16;
  int blk = blk0 + l15;
  int blkc = blk < 1023 ? blk : 1022;
  const u16* arow = proj + ((size_t)b * T + blkc * 16) * PJ + (which ? C_VCMP : C_KCMP) + g * 64;
  f32x4 acc[4];
#pragma unroll
  for (int n = 0; n < 4; ++n) acc[n] = f32x4{0.f, 0.f, 0.f, 0.f};
  for (int ks = 0; ks < 64; ++ks) {
    int tok = ks >> 1, d0 = (ks & 1) * 32 + quad * 8;
    uint4 raw = *(const uint4*)(arow + (size_t)tok * PJ + d0);
    float4 pe0 = *(const float4*)(pe + tok * 64 + d0), pe1 = *(const float4*)(pe + tok * 64 + d0 + 4);
    union { bf16x8 v; u32 u[4]; } af;
    af.u[0] = pack2(bf2f(raw.x & 0xffff) + pe0.x, bf2f(raw.x >> 16) + pe0.y);
    af.u[1] = pack2(bf2f(raw.y & 0xffff) + pe0.z, bf2f(raw.y >> 16) + pe0.w);
    af.u[2] = pack2(bf2f(raw.z & 0xffff) + pe1.x, bf2f(raw.z >> 16) + pe1.y);
    af.u[3] = pack2(bf2f(raw.w & 0xffff) + pe1.z, bf2f(raw.w >> 16) + pe1.w);
#pragma unroll
    for (int n = 0; n < 4; ++n) {
      bf16x8 bfr = *(const bf16x8*)(W1T + (size_t)(n * 16 + l15) * 2048 + ks * 32 + quad * 8);
      acc[n] = mfma16(af.v, bfr, acc[n]);
    }
  }
  u16* hid = (u16*)smem + wv * 16 * 72;
#pragma unroll
  for (int n = 0; n < 4; ++n)
#pragma unroll
    for (int r = 0; r < 4; ++r) {
      float x = acc[n][r];
      float u = 0.7978845608028654f * (x + 0.044715f * x * x * x);
      float gl = 0.5f * x * (1.f + tanhf(u));
      hid[(quad * 4 + r) * 72 + n * 16 + l15] = f2bf(gl);
    }
  __syncthreads();
  f32x4 o2[4];
#pragma unroll
  for (int n = 0; n < 4; ++n) o2[n] = f32x4{0.f, 0.f, 0.f, 0.f};
#pragma unroll
  for (int ks = 0; ks < 2; ++ks) {
    bf16x8 af = *(const bf16x8*)(hid + l15 * 72 + ks * 32 + quad * 8);
#pragma unroll
    for (int n = 0; n < 4; ++n) {
      bf16x8 bfr = *(const bf16x8*)(W2T + (n * 16 + l15) * 64 + ks * 32 + quad * 8);
      o2[n] = mfma16(af, bfr, o2[n]);
    }
  }
  __syncthreads();
  if (which == 0) {
    u16* KC = (u16*)(p->ws + OFF_KC) + (size_t)(b * 2 + g) * 1024 * 64;
    const float* kg = p->nsa_k_norm + (l * 3 + 0) * 64;
#pragma unroll
    for (int r = 0; r < 4; ++r) {
      float ss = 0.f;
#pragma unroll
      for (int n = 0; n < 4; ++n) ss += o2[n][r] * o2[n][r];
      ss += __shfl_xor(ss, 1); ss += __shfl_xor(ss, 2); ss += __shfl_xor(ss, 4); ss += __shfl_xor(ss, 8);
      float rs = rsqrtf(ss * (1.f / 64.f) + 1e-6f);
      int row = blk0 + quad * 4 + r;
#pragma unroll
      for (int n = 0; n < 4; ++n) {
        float v = row < 1023 ? o2[n][r] * rs * kg[n * 16 + l15] : 0.f;
        KC[(size_t)row * 64 + n * 16 + l15] = f2bf(v);
      }
    }
  } else {
    u16* VCT = (u16*)(p->ws + OFF_KC + 524288) + (size_t)(b * 2 + g) * 64 * 1024;
#pragma unroll
    for (int r = 0; r < 4; ++r) {
      int row = blk0 + quad * 4 + r;
#pragma unroll
      for (int n = 0; n < 4; ++n) {
        float v = row < 1023 ? o2[n][r] : 0.f;
        VCT[(size_t)(n * 16 + l15) * 1024 + row] = f2bf(v);
      }
    }
  }
}

template <int MODE, int NT>
__device__ __forceinline__ void flash2(const u16* __restrict__ Kg, int kld, const u16* __restrict__ VTg, int vblk,
                                       int vld, int h0, int h1, char* sStage, const u16* sQw, f32x4 (&O)[4][NT],
                                       float (&lsum)[NT], const float (&inv)[NT], const u32* sSelw, float* slc,
                                       int tq0) {
  const int tid = otid(), lane = tid & 63, wv = tid >> 6, l15 = lane & 15, quad = lane >> 4;
  constexpr int LPS = MODE == 2 ? 1 : 2;
  const int krow = wv * 8 + (lane >> 3);
  const int kc = (lane & 7) ^ ((wv * 4 + (lane >> 4)) & 7);
  const u16* kptr = Kg + (size_t)krow * kld + kc * 8;
  const int vd = wv * 16 + (lane >> 2);
  const int vc = (lane & 3) ^ ((lane >> 4) & 3);
  const u16* vptr = VTg + (size_t)vd * vld + vc * 8;
  char* lb = sStage + wv * 1024;
  const int nst = h1 - h0 + 1;
#define F2_ISSUE(i_)                                                                                              \
  do {                                                                                                            \
    int h_ = h0 + (i_);                                                                                           \
    char* st_ = lb + ((i_) & 3) * 8192;                                                                           \
    __builtin_amdgcn_global_load_lds((const u32*)(kptr + (size_t)(h_ * 32) * kld), (u32*)st_, 16, 0, 0);          \
    if (MODE != 2)                                                                                                \
      __builtin_amdgcn_global_load_lds((const u32*)(vptr + (size_t)(h_ >> 1) * vblk + (h_ & 1) * 32),            \
                                       (u32*)(st_ + 4096), 16, 0, 0);                                             \
  } while (0)
  WAIT_VM(0);
  if (0 < nst) F2_ISSUE(0);
  if (1 < nst) F2_ISSUE(1);
  if (2 < nst) F2_ISSUE(2);
  const int koff = l15 * 128;
  const int ksw = (l15 >> 1) & 7;
  const int voff = 4096 + l15 * 64 + (quad & 1) * 8;
  const int vsw = (l15 >> 2) & 3;
  float carry = 0.f;
  const int tq0u = __builtin_amdgcn_readfirstlane(tq0);
  const int lim0u = tq0u >= 31 ? ((tq0u - 31) >> 4) : -1;
  for (int i = 0; i < nst; ++i) {
    if (i + 2 < nst) { if (LPS == 2) WAIT_VM(4); else WAIT_VM(2); }
    else if (i + 1 < nst) { if (LPS == 2) WAIT_VM(2); else WAIT_VM(1); }
    else WAIT_VM(0);
    RAW_BAR();
    if (i + 3 < nst) F2_ISSUE(i + 3);
    const int h = h0 + i;
    const char* st = sStage + (i & 3) * 8192;
    bool interior;
    if (MODE == 0) interior = (h * 32 + 31 <= tq0u) && (h * 32 > tq0u + NT * 4 - 1 - 512);
    else if (MODE == 1) interior = (h * 32 + 31 <= tq0u);
    else interior = (h * 32 + 31 <= lim0u);
    bool bv[NT], an[NT];
    bool anyw = false;
#pragma unroll
    for (int nt = 0; nt < NT; ++nt) {
      if (MODE == 1) {
        u32 w = sSelw[(nt * 4 + (l15 >> 2)) * 8 + (h >> 6)];
        bv[nt] = (w >> ((h >> 1) & 31)) & 1u;
      } else {
        bv[nt] = true;
      }
      an[nt] = MODE == 1 ? (bool)__any(bv[nt]) : true;
      anyw |= an[nt];
    }
    if (anyw) {
      bf16x8 kf[2][2], vf[4];
#pragma unroll
      for (int m2 = 0; m2 < 2; ++m2)
#pragma unroll
        for (int ks = 0; ks < 2; ++ks)
          kf[m2][ks] = *(const bf16x8*)(st + koff + m2 * 2048 + (((ks * 4 + quad) ^ ksw) * 16));
      if (MODE != 2) {
#pragma unroll
        for (int dt = 0; dt < 4; ++dt) {
          union { bf16x8 v; uint2 h2[2]; } u;
          u.h2[0] = *(const uint2*)(st + voff + dt * 1024 + (((quad >> 1) ^ vsw) * 16));
          u.h2[1] = *(const uint2*)(st + voff + dt * 1024 + (((2 + (quad >> 1)) ^ vsw) * 16));
          vf[dt] = u.v;
        }
      }
#pragma unroll
      for (int nt = 0; nt < NT; ++nt) {
        if (!an[nt]) continue;
        const int t = tq0 + nt * 4 + (l15 >> 2);
        const bf16x8 bq0 = *(const bf16x8*)(sQw + (nt * 16 + l15) * 72 + quad * 8);
        const bf16x8 bq1 = *(const bf16x8*)(sQw + (nt * 16 + l15) * 72 + 32 + quad * 8);
        f32x4 s[2];
#pragma unroll
        for (int m2 = 0; m2 < 2; ++m2) {
          s[m2] = f32x4{0.f, 0.f, 0.f, 0.f};
          s[m2] = mfma16(kf[m2][0], bq0, s[m2]);
          s[m2] = mfma16(kf[m2][1], bq1, s[m2]);
        }
        const float bias = MODE == 1 ? (bv[nt] ? 0.f : -1000.f) : (MODE == 3 ? inv[nt] : 0.f);
        if (interior) {
#pragma unroll
          for (int m2 = 0; m2 < 2; ++m2)
#pragma unroll
            for (int r = 0; r < 4; ++r) s[m2][r] = __builtin_amdgcn_exp2f(fmaf(s[m2][r], SC2, bias));
        } else {
          int base;
          if (MODE <= 1) base = h * 32 + quad * 4 - t;
          else base = h * 32 + quad * 4 - (t >= 31 ? ((t - 31) >> 4) : -1);
          asm volatile("" : "+v"(base));
#pragma unroll
          for (int m2 = 0; m2 < 2; ++m2)
#pragma unroll
            for (int r = 0; r < 4; ++r) {
              const int C = m2 * 16 + r;
              bool valid;
              if (MODE == 0) valid = base <= -C && base > -512 - C;
              else valid = base <= -C;
              float pvv = __builtin_amdgcn_exp2f(fmaf(s[m2][r], SC2, bias));
              s[m2][r] = valid ? pvv : 0.f;
            }
        }
        float ls = ((s[0][0] + s[0][1]) + (s[0][2] + s[0][3])) + ((s[1][0] + s[1][1]) + (s[1][2] + s[1][3]));
        if (MODE != 3) lsum[nt] += ls;
        if (MODE == 3) {
#pragma unroll
          for (int m2 = 0; m2 < 2; ++m2) {
            float ow = s[m2][0] + s[m2][1] + s[m2][2] + 0.5f * s[m2][3];
            float sp = 0.5f * s[m2][3];
            ow += __shfl_xor(ow, 1); ow += __shfl_xor(ow, 2);
            sp += __shfl_xor(sp, 1); sp += __shfl_xor(sp, 2);
            if ((l15 & 3) == 0) {
              const int j = h * 8 + m2 * 4 + quad;
              slc[(nt * 4 + (l15 >> 2)) * 256 + j] = ow;
              if (j + 1 < 256) slc[1024 + (nt * 4 + (l15 >> 2)) * 256 + j + 1] = sp;
            }
          }
        }
        if (MODE != 2) {
          bf16x8 P = pack8(s[0], s[1]);
#pragma unroll
          for (int dt = 0; dt < 4; ++dt) O[dt][nt] = mfma16(vf[dt], P, O[dt][nt]);
        }
      }
    }
  }
  RAW_BAR();
}

__device__ __forceinline__ void nsa_phase_c(KP p, int l, char* smem) {
  const int tid = otid(), lane = tid & 63, wv = tid >> 6, l15 = lane & 15, quad = lane >> 4;
  char* sStage = smem;
  u16* sQw = (u16*)(smem + 32768) + wv * 16 * 72;
  float* own = (float*)(smem + 32768 + 9216) + wv * 2048;
  float* spl = own + 1024;
  const u16* proj = (const u16*)(p->ws + OFF_PROJ);
  const float* small_ = (const float*)(p->ws + OFF_SMALL);
  float* OC = (float*)(p->ws + OFF_OC);
  u32* SEL = (u32*)(p->ws + OFF_SEL);
  for (int job = obid(); job < 4096; job += gridDim.x) {
    const int qt = 1023 - (job >> 2), bg = job & 3, b = bg >> 1, g = bg & 1;
    const int t0 = qt * 16 + wv * 4;
    const int ql = l15 >> 2, r_ = l15 & 3, head = g * 4 + r_;
    const int t = t0 + ql;
    const size_t tok = (size_t)b * T + t;
    const u16* KC = (const u16*)(p->ws + OFF_KC) + (size_t)bg * 1024 * 64;
    const u16* VCT = (const u16*)(p->ws + OFF_KC + 524288) + (size_t)bg * 64 * 1024;
    {
      const u16* qrow = proj + tok * PJ + C_NQ + head * 64;
      *(bf16x8*)(sQw + l15 * 72 + quad * 8) = *(const bf16x8*)(qrow + quad * 8);
      *(bf16x8*)(sQw + l15 * 72 + 32 + quad * 8) = *(const bf16x8*)(qrow + 32 + quad * 8);
    }
    const int tmax = qt * 16 + 15;
    const int nvmax = tmax >= 31 ? ((tmax - 31) >> 4) + 1 : 0;
    const int h1 = ((nvmax + 31) >> 5) - 1;
    f32x4 O[4][1];
    float lsum[1] = {0.f}, inv[1] = {0.f};
#pragma unroll
    for (int dt = 0; dt < 4; ++dt) O[dt][0] = f32x4{0.f, 0.f, 0.f, 0.f};
    if (h1 >= 0) {
      flash2<2, 1>(KC, 64, VCT, 64, 1024, 0, h1, sStage, sQw, O, lsum, inv, nullptr, own, t0);
      float ls = lsum[0];
      ls += __shfl_xor(ls, 16);
      ls += __shfl_xor(ls, 32);
      inv[0] = ls > 0.f ? -log2f(ls) : -1000.f;
      flash2<3, 1>(KC, 64, VCT, 64, 1024, 0, h1, sStage, sQw, O, lsum, inv, nullptr, own, t0);
    }
    {
      float gc = ZTEST == 1 ? 0.f : sigmoidf_(small_[tok * 32 + 8 + head * 3 + 0]);
#pragma unroll
      for (int dt = 0; dt < 4; ++dt) {
        float4 o = make_float4(O[dt][0][0] * gc, O[dt][0][1] * gc, O[dt][0][2] * gc, O[dt][0][3] * gc);
        *(float4*)(OC + tok * 512 + head * 64 + dt * 16 + quad * 4) = o;
      }
    }
    __builtin_amdgcn_wave_barrier();
    for (int q = 0; q < 4; ++q) {
      const int tq = t0 + q, cur = tq >> 6;
      u32 word = 0;
      if (cur <= 15) {
        if (lane == 0) word = (2u << cur) - 1u;
      } else {
        u32 key[4];
#pragma unroll
        for (int k = 0; k < 4; ++k) {
          int j = lane + 64 * k;
          float v = own[q * 256 + j] + spl[q * 256 + j];
          key[k] = (j >= 1 && j <= cur - 2) ? (__float_as_uint(fmaxf(v, 0.f)) + 1u) : 0u;
        }
        u32 T = 0u;
        for (int bit = 30; bit >= 0; --bit) {
          const u32 cand = T | (1u << bit);
          int cnt = 0;
#pragma unroll
          for (int k = 0; k < 4; ++k) cnt += __popcll(__ballot(key[k] >= cand));
          if (cnt >= 13) T = cand;
        }
        int ngt = 0;
#pragma unroll
        for (int k = 0; k < 4; ++k) ngt += __popcll(__ballot(key[k] > T));
        int quota = 13 - ngt;
        const unsigned long long lt = (1ull << lane) - 1ull;
#pragma unroll
        for (int k = 0; k < 4; ++k) {
          const unsigned long long me = __ballot(key[k] == T);
          const bool take = key[k] > T || (key[k] == T && (int)__popcll(me & lt) < quota);
          const int ne = (int)__popcll(me);
          quota = quota > ne ? quota - ne : 0;
          const unsigned long long sm = __ballot(take);
          if (lane == 2 * k) word = (u32)sm;
          if (lane == 2 * k + 1) word = (u32)(sm >> 32);
        }
        if (lane == 0) word |= 1u;
        if (lane == (cur >> 5)) word |= 1u << (cur & 31);
        if (lane == ((cur - 1) >> 5)) word |= 1u << ((cur - 1) & 31);
      }
      if (lane < 8) SEL[(((size_t)b * 16384 + tq) * 2 + g) * 8 + lane] = word;
    }
    __builtin_amdgcn_wave_barrier();
  }
}

__device__ __forceinline__ void nsa_s_tile(KP p, int l, char* smem, int tile) {
  const int cur = 255 - (tile >> 2), bg = tile & 3, b = bg >> 1, g = bg & 1;
  const int tid = otid(), lane = tid & 63, wv = tid >> 6, l15 = lane & 15, quad = lane >> 4;
  char* sStage = smem;
  u16* sQw = (u16*)(smem + 32768) + wv * 64 * 72;
  u32* sSel = (u32*)(smem + 32768 + 36864);
  const u32* sSelw = sSel + wv * 16 * 8;
  const u16* proj = (const u16*)(p->ws + OFF_PROJ);
  const float* small_ = (const float*)(p->ws + OFF_SMALL);
  const float* rope = (const float*)(p->ws + OFF_ROPE);
  float* OC = (float*)(p->ws + OFF_OC);
  u16* mix = (u16*)(p->ws + OFF_H);
  const size_t tokb = (size_t)b * T;
  const int tq0 = cur * 64 + wv * 16;
  const int r_ = l15 & 3, head = g * 4 + r_;
  {
    const u32* SEL = (const u32*)(p->ws + OFF_SEL);
    int q = tid >> 2, w2 = (tid & 3) * 2;
    uint2 v = *(const uint2*)(SEL + ((tokb + cur * 64 + q) * 2 + g) * 8 + w2);
    *(uint2*)(sSel + q * 8 + w2) = v;
  }
#pragma unroll
  for (int nt = 0; nt < 4; ++nt) {
    const size_t tok = tokb + tq0 + nt * 4 + (l15 >> 2);
    const u16* qrow = proj + tok * PJ + C_NQ + head * 64;
    u16* qd = sQw + (nt * 16 + l15) * 72;
    *(bf16x8*)(qd + 32 + quad * 8) = *(const bf16x8*)(qrow + 32 + quad * 8);
    if (quad >= 2) {
      *(bf16x8*)(qd + quad * 8) = *(const bf16x8*)(qrow + quad * 8);
    } else {
      union { bf16x8 v; u16 h[8]; } x1, x2, o;
      x1.v = *(const bf16x8*)(qrow);
      x2.v = *(const bf16x8*)(qrow + 8);
      const float* rp = rope + tok * 16;
#pragma unroll
      for (int i = 0; i < 8; ++i) {
        float a = bf2f(x1.h[i]), bb = bf2f(x2.h[i]), c = rp[i], s = rp[8 + i];
        o.h[i] = f2bf(quad == 0 ? a * c - bb * s : bb * c + a * s);
      }
      *(bf16x8*)(qd + quad * 8) = o.v;
    }
  }
  f32x4 O[4][4];
  float lsum[4], inv[4] = {0.f, 0.f, 0.f, 0.f};
#pragma unroll
  for (int dt = 0; dt < 4; ++dt)
#pragma unroll
    for (int nt = 0; nt < 4; ++nt) O[dt][nt] = f32x4{0.f, 0.f, 0.f, 0.f};
#pragma unroll
  for (int nt = 0; nt < 4; ++nt) lsum[nt] = 0.f;
  {
    const u16* Kg = proj + tokb * PJ + C_KWIN + g * 64;
    const u16* VTg = (const u16*)(p->ws + OFF_VT + 8 * MiB) + (size_t)(bg * 256) * 4096;
    int h0 = 2 * cur - 16 < 0 ? 0 : 2 * cur - 16;
    flash2<0, 4>(Kg, PJ, VTg, 4096, 64, h0, 2 * cur + 1, sStage, sQw, O, lsum, inv, sSelw, nullptr, tq0);
  }
#pragma unroll
  for (int nt = 0; nt < 4; ++nt) {
    const size_t tok = tokb + tq0 + nt * 4 + (l15 >> 2);
    float ls = lsum[nt];
    ls += __shfl_xor(ls, 16);
    ls += __shfl_xor(ls, 32);
    float sc = ZTEST == 2 ? 0.f : sigmoidf_(small_[tok * 32 + 8 + head * 3 + 2]) / ls;
#pragma unroll
    for (int dt = 0; dt < 4; ++dt) {
      float4* op = (float4*)(OC + tok * 512 + head * 64 + dt * 16 + quad * 4);
      float4 o = *op;
      o.x += O[dt][nt][0] * sc; o.y += O[dt][nt][1] * sc; o.z += O[dt][nt][2] * sc; o.w += O[dt][nt][3] * sc;
      *op = o;
      O[dt][nt] = f32x4{0.f, 0.f, 0.f, 0.f};
    }
    lsum[nt] = 0.f;
  }
  {
    const u16* Kg = proj + tokb * PJ + C_KSLC + g * 64;
    const u16* VTg = (const u16*)(p->ws + OFF_VT) + (size_t)(bg * 256) * 4096;
    flash2<1, 4>(Kg, PJ, VTg, 4096, 64, 0, 2 * cur + 1, sStage, sQw, O, lsum, inv, sSelw, nullptr, tq0);
  }
#pragma unroll
  for (int nt = 0; nt < 4; ++nt) {
    const size_t tok = tokb + tq0 + nt * 4 + (l15 >> 2);
    float ls = lsum[nt];
    ls += __shfl_xor(ls, 16);
    ls += __shfl_xor(ls, 32);
    float sc = ZTEST == 3 ? 0.f : sigmoidf_(small_[tok * 32 + 8 + head * 3 + 1]) / ls;
#pragma unroll
    for (int dt = 0; dt < 4; ++dt) {
      float4 o = *(const float4*)(OC + tok * 512 + head * 64 + dt * 16 + quad * 4);
      uint2 w;
      w.x = pack2(o.x + O[dt][nt][0] * sc, o.y + O[dt][nt][1] * sc);
      w.y = pack2(o.z + O[dt][nt][2] * sc, o.w + O[dt][nt][3] * sc);
      *(uint2*)(mix + tok * DM + 256 + head * 64 + dt * 16 + quad * 4) = w;
    }
  }
}


#define XB_TMO      128
#define XB_XCNT(j)  (256  + 64 * (j))
#define XB_XSUB(j)  (1280 + 64 * (j))
#define XB_XGEN(j)  (2304 + 64 * (j))
#define XB_TOP      3328
#define XB_TOPGEN   3392
#define XCD_BAR_WORDS 3456
#define XB_SPIN_CAP (1u << 18)
#define LAS __attribute__((address_space(3)))
__device__ __forceinline__ unsigned xb_ld(unsigned* p) { return __hip_atomic_load(p, __ATOMIC_RELAXED, __HIP_MEMORY_SCOPE_AGENT); }
__device__ __forceinline__ unsigned xb_add(unsigned* p, unsigned v) { return __hip_atomic_fetch_add(p, v, __ATOMIC_RELAXED, __HIP_MEMORY_SCOPE_AGENT); }
__device__ __forceinline__ unsigned xb_xcc_id() { return (unsigned)__builtin_amdgcn_s_getreg((3 << 11) | 20) & 0xFu; }
#define XB_SPIN(cond, bar) do { unsigned _sp = 0; while (cond) { __builtin_amdgcn_s_sleep(1); \
    if ((++_sp & 255u) == 0u) { if (xb_ld(&(bar)[XB_TMO])) break; if (_sp > XB_SPIN_CAP) { atomicAdd(&(bar)[XB_TMO], 1u); break; } } } } while (0)
struct XcdBarrier { unsigned* bar; unsigned x; volatile LAS unsigned* st; };
__device__ __forceinline__ XcdBarrier xcd_barrier_post(unsigned* bar, volatile LAS unsigned* st) {
  XcdBarrier b; b.bar = bar; b.x = xb_xcc_id(); b.st = st;
  if (threadIdx.x == 0) (void)xb_add(&bar[XB_XCNT(b.x)], 1u);
  return b;
}
__device__ __forceinline__ void xcd_barrier_complete(unsigned* bar, unsigned x, unsigned& nloc, unsigned& nx) {
  const unsigned G = gridDim.x * gridDim.y * gridDim.z;
  unsigned sum, cnt, mine, sp = 0u;
  for (;;) {
    sum = 0u; cnt = 0u; mine = 0u;
#pragma unroll
    for (unsigned j = 0; j < 16; ++j) { const unsigned c = xb_ld(&bar[XB_XCNT(j)]); sum += c; cnt += (c > 0u) ? 1u : 0u; mine = (j == x) ? c : mine; }
    if (sum == G) break;
    __builtin_amdgcn_s_sleep(1);
    if ((++sp & 255u) == 0u) { if (xb_ld(&bar[XB_TMO])) break; if (sp > XB_SPIN_CAP) { atomicAdd(&bar[XB_TMO], 1u); break; } }
  }
  nloc = mine > 0u ? mine : 1u; nx = cnt > 0u ? cnt : 1u;
}
__device__ __forceinline__ void xcd_barrier(const XcdBarrier& b) {
  asm volatile("s_waitcnt vmcnt(0)" ::: "memory");
  __syncthreads();
  if (threadIdx.x == 0) {
    unsigned* bar = b.bar;
    __builtin_amdgcn_s_waitcnt(0);
    unsigned nloc = b.st[0], nx = b.st[1];
    if (nloc == 0u) { xcd_barrier_complete(bar, b.x, nloc, nx); b.st[0] = nloc; b.st[1] = nx; }
    const unsigned old = xb_add(&bar[XB_XSUB(b.x)], 1u);
    const unsigned gen = old / nloc;
    if (old + 1u == (gen + 1u) * nloc) {
      __builtin_amdgcn_fence(__ATOMIC_RELEASE, "agent");
      asm volatile("s_waitcnt vmcnt(0)" ::: "memory");
      const unsigned og = xb_add(&bar[XB_TOP], 1u);
      const unsigned tg = og / nx;
      if (og + 1u == (tg + 1u) * nx) xb_add(&bar[XB_TOPGEN], 1u);
      else XB_SPIN(xb_ld(&bar[XB_TOPGEN]) == tg, bar);
      __builtin_amdgcn_fence(__ATOMIC_ACQUIRE, "agent");
      xb_add(&bar[XB_XGEN(b.x)], 1u);
      asm volatile("s_waitcnt vmcnt(0)" ::: "memory");
    } else {
      XB_SPIN(xb_ld(&bar[XB_XGEN(b.x)]) == gen, bar);
      __builtin_amdgcn_fence(__ATOMIC_ACQUIRE, "agent");
      asm volatile("s_waitcnt vmcnt(0)" ::: "memory");
    }
  }
  __syncthreads();
}
#ifndef REPE
#define REPE 1
#endif
#ifndef REP3C
#define REP3C 1
#endif
#ifndef REP3
#define REP3 1
#endif
#ifndef XSYNC
#define XSYNC 0
#endif
#ifndef REP4
#define REP4 1
#endif
#ifndef REPSCAN
#define REPSCAN 1
#endif
#ifndef REPG
#define REPG 1
#endif
__global__ void __launch_bounds__(256, 2) hymba_mega(Params p_unused) {
  cg::grid_group grid = cg::this_grid();
  __shared__ uint4 xb_words;
  if (threadIdx.x == 0) xb_words = make_uint4(0u, 0u, 0u, 0u);
  __syncthreads();
  XcdBarrier xb = xcd_barrier_post((unsigned*)(kargs()->ws + OFF_CNT + 4096), (volatile LAS unsigned*)&xb_words);
  __shared__ __attribute__((aligned(16))) char smem[77824];
  __shared__ int s_tile;
  { KP p = kargs(); rope_table(p); }
  grid.sync();
#pragma unroll 1
  for (int l = 0; l < DEPTH; ++l) {
    {
      KP p = kargs();
      if (blockIdx.x == 0 && threadIdx.x == 0) { u32 z0 = 0u; asm volatile("" : "+v"(z0)); ((u32*)(p->ws + OFF_CNT))[0] = z0; }
      for (int re = 0; re < REPE; ++re) {
      convert_weights(p, l, smem);
      rmsnorm_rows(l == 0 ? p->x_in : p->out, p->attn_norm + l * DM, (u16*)(p->ws + OFF_H));
      }
    }
    xcd_barrier(xb);
    {
      KP p = kargs();
      for (int rep = 0; rep < REPG; ++rep)
      gemm_phase((const u16*)(p->ws + OFF_H), DM, (const u16*)(p->ws + OFF_W + W_IN), DM, DM, 256, 25, smem,
                 EpiInProj{(u16*)(p->ws + OFF_PROJ), (float*)(p->ws + OFF_SMALL)});
    }
    xcd_barrier(xb);
    {
      KP p = kargs();
      for (int job = obid(); job < 2048 + 512 + 128; job += gridDim.x) {
        if (job < 2048) gdn_chunk_prep(p, l, smem, job);
        else if (job < 2560) nsa_token_prep(p, l, smem, job - 2048);
        else nsa_compress(p, l, smem, job - 2560);
      }
    }
    xcd_barrier(xb);
#ifndef REP45
#define REP45 1
#endif
    for (int rep = 0; rep < REP45; ++rep) {
    {
      KP p = kargs();
      if (blockIdx.x == 0 && threadIdx.x == 0) { u32 z0 = 0u; asm volatile("" : "+v"(z0)); ((u32*)(p->ws + OFF_CNT))[0] = z0; }
      for (int r4 = 0; r4 < REP4; ++r4) nsa_phase_c(p, l, smem);
    }
    xcd_barrier(xb);
    {
      KP p = kargs();
      if (obid() < 32) for (int rs = 0; rs < REPSCAN; ++rs) gdn_scan(p, smem, obid());
      u32* CNT = (u32*)(p->ws + OFF_CNT);
      for (;;) {
        __syncthreads();
        if (threadIdx.x == 0) s_tile = (int)atomicAdd(&CNT[0], 1u);
        __syncthreads();
        int tile = s_tile;
        if (tile >= 1024) break;
        nsa_s_tile(p, l, smem, tile);
      }
    }
    xcd_barrier(xb);
    }
    {
      KP p = kargs();
      for (int re = 0; re < REPE; ++re) gdn_finalize(p, l);
      for (int xs = 0; xs < XSYNC; ++xs) xcd_barrier(xb);
    }
    xcd_barrier(xb);
    {
      KP p = kargs();
      gemm_phase((const u16*)(p->ws + OFF_H), DM, (const u16*)(p->ws + OFF_W + W_OUT), DM, DM, 256, 8, smem,
                 EpiResid{l == 0 ? p->x_in : p->out, p->out});
    }
    xcd_barrier(xb);
    {
      KP p = kargs();
      for (int re = 0; re < REPE; ++re) rmsnorm_rows(p->out, p->ffn_norm + l * DM, (u16*)(p->ws + OFF_H));
    }
    xcd_barrier(xb);
    {
      KP p = kargs();
      for (int rep = 0; rep < REPG; ++rep)
      gemm_phase((const u16*)(p->ws + OFF_H), DM, (const u16*)(p->ws + OFF_W + W_GU), DM, DM, 256, 44, smem,
                 EpiSwiGLU{(u16*)(p->ws + OFF_PROJ)});
    }
    xcd_barrier(xb);
    {
      KP p = kargs();
      gemm_phase((const u16*)(p->ws + OFF_PROJ), DFF, (const u16*)(p->ws + OFF_W + W_DOWN), DFF, DFF, 256, 8, smem,
                 EpiResid{p->out, p->out});
    }
    xcd_barrier(xb);
  }
}

extern "C" void kernel_launch(void* const* d_in, const int* in_sizes, int n_in, void* d_out, int out_size, void* d_ws,
                              size_t ws_size, hipStream_t stream) {
  static int grid_blocks = 0;
  if (!grid_blocks) {
    int dev = 0, cus = 0, per_cu = 0;
    hipGetDevice(&dev);
    hipDeviceGetAttribute(&cus, hipDeviceAttributeMultiprocessorCount, dev);
    hipOccupancyMaxActiveBlocksPerMultiprocessor(&per_cu, hymba_mega, 256, 0);
    if (per_cu > 2) per_cu = 2;
    if (per_cu < 1) per_cu = 1;
    grid_blocks = cus * per_cu;
    grid_blocks &= ~7;
  }
  Params p;
  memset(&p, 0, sizeof(p));
  p.x_in = (const float*)d_in[0]; p.positions = (const int*)d_in[1]; p.attn_norm = (const float*)d_in[2];
  p.w_in = (const float*)d_in[3]; p.gdn_conv_w = (const float*)d_in[4]; p.gdn_a_log = (const float*)d_in[5];
  p.gdn_dt_bias = (const float*)d_in[6]; p.gdn_norm = (const float*)d_in[7]; p.nsa_q_norm = (const float*)d_in[8];
  p.nsa_k_norm = (const float*)d_in[9]; p.cmp_pe = (const float*)d_in[10]; p.cmp_w1 = (const float*)d_in[11];
  p.cmp_w2 = (const float*)d_in[12]; p.conv_w = (const float*)d_in[13]; p.w_out = (const float*)d_in[14];
  p.ffn_norm = (const float*)d_in[15]; p.w_gate_up = (const float*)d_in[16]; p.w_down = (const float*)d_in[17];
  p.out = (float*)d_out; p.ws = (char*)d_ws;
  hipMemsetAsync((char*)d_ws + OFF_CNT, 0, 4096 + XCD_BAR_WORDS * 4, stream);
  void* args[] = {&p};
  hipError_t e = hipLaunchCooperativeKernel((void*)hymba_mega, dim3(grid_blocks), dim3(256), args, 0, stream);
  if (e != hipSuccess) fprintf(stderr, "cooperative launch failed: %s (grid %d)\n", hipGetErrorString(e), grid_blocks);
}
```

```cpp
#include <hip/hip_runtime.h>
#include <hip/hip_cooperative_groups.h>
#include <cstdio>
#include <cstring>
namespace cg = cooperative_groups;

#ifndef ZTEST
#define ZTEST 0
#endif
typedef unsigned short u16;
typedef unsigned int u32;
typedef __attribute__((ext_vector_type(8))) short bf16x8;
typedef __attribute__((ext_vector_type(4))) short bf16x4;
typedef __attribute__((ext_vector_type(4))) float f32x4;

constexpr int NB = 2, T = 16384, NTOK = NB * T, DM = 1024, DFF = 2816, DEPTH = 4;
constexpr int PJ = 3072;
constexpr int C_GQ = 0, C_GK = 256, C_GV = 512, C_GZ = 768, C_NQ = 1024, C_KCMP = 1536, C_VCMP = 1664,
              C_KSLC = 1792, C_VSLC = 1920, C_KWIN = 2048, C_VWIN = 2176, C_CB = 2304, C_CC = 2560, C_CX = 2816;
constexpr size_t MiB = 1ull << 20;
constexpr size_t OFF_H = 0, OFF_PROJ = 64 * MiB, OFF_SMALL = 256 * MiB, OFF_W = 260 * MiB, OFF_GDN = 288 * MiB,
                 OFF_OG = 384 * MiB, OFF_OC = 416 * MiB, OFF_VT = 480 * MiB, OFF_KC = 496 * MiB, OFF_SEL = 497 * MiB,
                 OFF_ROPE = 499 * MiB, OFF_GL = 501 * MiB, OFF_CNT = 501 * MiB + 65536;
constexpr size_t W_IN = 0, W_OUT = 6553600, W_GU = 8650752, W_DOWN = 20185088, W_C1 = 25952256, W_C2 = 26476544;
constexpr int CHUNK_B = 49152;
constexpr float SC2 = 0.125f * 1.4426950408889634f;

struct Params {
  const float* x_in; const int* positions; const float* attn_norm; const float* w_in; const float* gdn_conv_w;
  const float* gdn_a_log; const float* gdn_dt_bias; const float* gdn_norm; const float* nsa_q_norm;
  const float* nsa_k_norm; const float* cmp_pe; const float* cmp_w1; const float* cmp_w2; const float* conv_w;
  const float* w_out; const float* ffn_norm; const float* w_gate_up; const float* w_down;
  float* out; char* ws;
};


__device__ __forceinline__ int otid() { int t = threadIdx.x; asm volatile("" : "+v"(t)); return t; }
__device__ __forceinline__ int obid() { int t = blockIdx.x; asm volatile("" : "+s"(t)); return t; }
typedef const __attribute__((address_space(4))) Params* KP;
__device__ __forceinline__ KP kargs() {
  KP k = (KP)__builtin_amdgcn_kernarg_segment_ptr();
  asm volatile("" : "+s"(k));
  return k;
}

typedef __bf16 bf2_t __attribute__((ext_vector_type(2)));
typedef float f2_t __attribute__((ext_vector_type(2)));
__device__ __forceinline__ u32 pack2(float a, float b) {
  f2_t v = {a, b};
  bf2_t r = __builtin_convertvector(v, bf2_t);
  return __builtin_bit_cast(u32, r);
}
__device__ __forceinline__ u16 f2bf(float f) { return (u16)(pack2(f, 0.f) & 0xffffu); }
__device__ __forceinline__ float bf2f(u16 h) { return __uint_as_float(((u32)h) << 16); }
__device__ __forceinline__ float wave_sum(float v) {
#pragma unroll
  for (int o = 32; o; o >>= 1) v += __shfl_xor(v, o);
  return v;
}
__device__ __forceinline__ float sigmoidf_(float x) { return 1.f / (1.f + __expf(-x)); }
__device__ __forceinline__ f32x4 mfma16(bf16x8 a, bf16x8 b, f32x4 c) {
  return __builtin_amdgcn_mfma_f32_16x16x32_bf16(a, b, c, 0, 0, 0);
}
__device__ __forceinline__ bf16x8 pack8(f32x4 a, f32x4 b) {
  union { bf16x8 v; u32 u[4]; } r;
  r.u[0] = pack2(a[0], a[1]); r.u[1] = pack2(a[2], a[3]);
  r.u[2] = pack2(b[0], b[1]); r.u[3] = pack2(b[2], b[3]);
  return r.v;
}

__device__ __forceinline__ void rmsnorm_rows(const float* __restrict__ x, const float* __restrict__ gain, u16* __restrict__ h) {
  int lane = otid() & 63;
  int gw = obid() * 4 + (otid() >> 6), nw = gridDim.x * 4;
  for (int row = gw; row < NTOK; row += nw) {
    const float4* xr = (const float4*)(x + (size_t)row * DM);
    float4 v[4];
    float ss = 0.f;
#pragma unroll
    for (int i = 0; i < 4; ++i) {
      v[i] = xr[lane + 64 * i];
      ss += v[i].x * v[i].x + v[i].y * v[i].y + v[i].z * v[i].z + v[i].w * v[i].w;
    }
    ss = wave_sum(ss);
    float rs = rsqrtf(ss * (1.f / DM) + 1e-6f);
#pragma unroll
    for (int i = 0; i < 4; ++i) {
      float4 g = ((const float4*)gain)[lane + 64 * i];
      uint2 o;
      o.x = pack2(v[i].x * rs * g.x, v[i].y * rs * g.y);
      o.y = pack2(v[i].z * rs * g.z, v[i].w * rs * g.w);
      *(uint2*)(h + (size_t)row * DM + (lane + 64 * i) * 4) = o;
    }
  }
}

struct MapId { __device__ int operator()(int n) const { return n; } };
struct MapIn {
  __device__ int operator()(int n) const {
    if (n < 1024) return n;
    if (n < 2304) return n + 8;
    if (n < 3072) return n + 32;
    if (n < 3080) return n - 3072 + 1024;
    if (n < 3104) return n - 3080 + 2312;
    return -1;
  }
};
struct MapGU {
  __device__ int operator()(int n) const {
    int grp = n >> 6, r = n & 63;
    return r < 32 ? grp * 32 + r : DFF + grp * 32 + (r - 32);
  }
};
template <class Map>
__device__ __forceinline__ void transpose_tile(const float* __restrict__ src, int lds_, Map map, u16* __restrict__ dst, int ldd, int n0,
                               int k0, float* t) {
  int tid = otid();
#pragma unroll 4
  for (int i = 0; i < 16; ++i) {
    int k = i * 4 + (tid >> 6), n = tid & 63;
    int sn = map(n0 + n);
    t[k * 65 + n] = sn >= 0 ? src[(size_t)(k0 + k) * lds_ + sn] : 0.f;
  }
  __syncthreads();
#pragma unroll 4
  for (int i = 0; i < 16; ++i) {
    int n = i * 4 + (tid >> 6), k = tid & 63;
    dst[(size_t)(n0 + n) * ldd + k0 + k] = f2bf(t[k * 65 + n]);
  }
  __syncthreads();
}

__device__ __forceinline__ void convert_weights(KP p, int l, char* smem) {
  float* t = (float*)smem;
  char* W = p->ws + OFF_W;
  const int J0 = 800, J1 = J0 + 256, J2 = J1 + 1408, J3 = J2 + 704, J4 = J3 + 64, J5 = J4 + 2;
  for (int job = obid(); job < J5; job += gridDim.x) {
    if (job < J0) {
      transpose_tile(p->w_in + (size_t)l * DM * 3104, 3104, MapIn(), (u16*)(W + W_IN), 1024, (job >> 4) * 64,
                     (job & 15) * 64, t);
    } else if (job < J1) {
      int j = job - J0;
      transpose_tile(p->w_out + (size_t)l * DM * DM, 1024, MapId(), (u16*)(W + W_OUT), 1024, (j >> 4) * 64,
                     (j & 15) * 64, t);
    } else if (job < J2) {
      int j = job - J1;
      transpose_tile(p->w_gate_up + (size_t)l * DM * 2 * DFF, 2 * DFF, MapGU(), (u16*)(W + W_GU), 1024, (j >> 4) * 64,
                     (j & 15) * 64, t);
    } else if (job < J3) {
      int j = job - J2;
      transpose_tile(p->w_down + (size_t)l * DFF * DM, 1024, MapId(), (u16*)(W + W_DOWN), DFF, (j / 44) * 64,
                     (j % 44) * 64, t);
    } else if (job < J4) {
      int j = job - J3;
      int which = j >> 5, kt = j & 31;
      transpose_tile(p->cmp_w1 + (size_t)(l * 2 + which) * 2048 * 64, 64, MapId(),
                     (u16*)(W + W_C1) + (size_t)which * 64 * 2048, 2048, 0, kt * 64, t);
    } else {
      int which = job - J4;
      transpose_tile(p->cmp_w2 + (size_t)(l * 2 + which) * 64 * 64, 64, MapId(), (u16*)(W + W_C2) + which * 4096, 64, 0,
                     0, t);
    }
  }
}

#define WAIT_VM(n) asm volatile("s_waitcnt vmcnt(" #n ")" ::: "memory")
#define RAW_BAR() do { asm volatile("s_waitcnt lgkmcnt(0)" ::: "memory"); __builtin_amdgcn_s_barrier(); } while (0)
typedef __attribute__((ext_vector_type(16))) float f32x16;
template <class Epi>
__device__ __forceinline__ void gemm_phase(const u16* __restrict__ A, int lda, const u16* __restrict__ Bt, int ldb, int K, int ntm,
                           int ntn, char* smem, Epi epi) {
  const int tid = otid(), lane = tid & 63, wv = tid >> 6;
  const int wm = wv >> 1, wn = wv & 1, l31 = lane & 31, hi = lane >> 5;
  const int ntiles = ntm * ntn, nk = K >> 5;
  const int lrow = tid >> 2, lc = tid & 3;
  const int woff = lrow * 64 + ((lc ^ ((lrow >> 2) & 3)) * 16);
  const int sw = (l31 >> 2) & 3;
  const int arow = (wm * 128 + l31) * 64, brow = 16384 + (wn * 64 + l31) * 64;
#define TILE_DECODE(id_, row0_, col0_, tn_)                                                  \
  do {                                                                                       \
    int xcd_ = (id_) & 7, loc_ = (id_) >> 3;                                                 \
    int per_rb_ = 8 * ntn;                                                                   \
    int rb_ = loc_ / per_rb_, rem_ = loc_ % per_rb_;                                         \
    int cb_ = rem_ >> 6, rem2_ = rem_ & 63;                                                  \
    int width_ = (cb_ + 1) * 8 <= ntn ? 8 : ntn - cb_ * 8;                                   \
    int tm_l_ = rb_ * 8 + rem2_ / width_;                                                    \
    tn_ = cb_ * 8 + rem2_ % width_;                                                          \
    row0_ = (tm_l_ * 8 + xcd_) * 256;                                                        \
    col0_ = tn_ * 128;                                                                       \
  } while (0)
#define G_LOAD(R, kt_)                                                       \
  do {                                                                       \
    R##a0 = *(const uint4*)(gA + (kt_) * 32);                                \
    R##a1 = *(const uint4*)(gA + a64 + (kt_) * 32);                          \
    R##a2 = *(const uint4*)(gA + 2 * a64 + (kt_) * 32);                      \
    R##a3 = *(const uint4*)(gA + 3 * a64 + (kt_) * 32);                      \
    R##b0 = *(const uint4*)(gB + (kt_) * 32);                                \
    R##b1 = *(const uint4*)(gB + b64 + (kt_) * 32);                          \
  } while (0)
#define G_WRITE(R, slot_)                                                    \
  do {                                                                       \
    char* st_ = smem + (slot_) * 24576 + woff;                               \
    *(uint4*)(st_) = R##a0;                                                  \
    *(uint4*)(st_ + 4096) = R##a1;                                           \
    *(uint4*)(st_ + 8192) = R##a2;                                           \
    *(uint4*)(st_ + 12288) = R##a3;                                          \
    *(uint4*)(st_ + 16384) = R##b0;                                          \
    *(uint4*)(st_ + 20480) = R##b1;                                          \
  } while (0)
#define G_KSTEP(st_, ks_)                                                                        \
  do {                                                                                           \
    const int po_ = (((ks_) * 2 + hi) ^ sw) * 16;                                                \
    bf16x8 b0_ = *(const bf16x8*)(st_ + brow + po_), b1_ = *(const bf16x8*)(st_ + brow + 2048 + po_); \
    bf16x8 a0_ = *(const bf16x8*)(st_ + arow + po_), a1_ = *(const bf16x8*)(st_ + arow + 2048 + po_); \
    bf16x8 a2_ = *(const bf16x8*)(st_ + arow + 4096 + po_), a3_ = *(const bf16x8*)(st_ + arow + 6144 + po_); \
    acc[0][0] = __builtin_amdgcn_mfma_f32_32x32x16_bf16(b0_, a0_, acc[0][0], 0, 0, 0);           \
    acc[0][1] = __builtin_amdgcn_mfma_f32_32x32x16_bf16(b1_, a0_, acc[0][1], 0, 0, 0);           \
    acc[1][0] = __builtin_amdgcn_mfma_f32_32x32x16_bf16(b0_, a1_, acc[1][0], 0, 0, 0);           \
    acc[1][1] = __builtin_amdgcn_mfma_f32_32x32x16_bf16(b1_, a1_, acc[1][1], 0, 0, 0);           \
    acc[2][0] = __builtin_amdgcn_mfma_f32_32x32x16_bf16(b0_, a2_, acc[2][0], 0, 0, 0);           \
    acc[2][1] = __builtin_amdgcn_mfma_f32_32x32x16_bf16(b1_, a2_, acc[2][1], 0, 0, 0);           \
    acc[3][0] = __builtin_amdgcn_mfma_f32_32x32x16_bf16(b0_, a3_, acc[3][0], 0, 0, 0);           \
    acc[3][1] = __builtin_amdgcn_mfma_f32_32x32x16_bf16(b1_, a3_, acc[3][1], 0, 0, 0);           \
  } while (0)
#define G_COMPUTE(slot_)                                   \
  do {                                                     \
    const char* st_ = smem + (slot_) * 24576;              \
    __builtin_amdgcn_s_setprio(1);                         \
    G_KSTEP(st_, 0); G_KSTEP(st_, 1);                      \
    __builtin_amdgcn_s_setprio(0);                         \
  } while (0)
#define G_ITER(u_, RN, sn_)                                                   \
  if (kt + (u_) < nk) {                                                       \
    const int k_ = kt + (u_);                                                 \
    if (k_ + 1 < nk) G_WRITE(RN, sn_);                                        \
    if (k_ + 3 < nk) G_LOAD(RN, k_ + 3);                                      \
    G_COMPUTE(u_);                                                            \
    RAW_BAR();                                                                \
  }
  const size_t a64 = (size_t)64 * lda, b64 = (size_t)64 * ldb;
  int id = obid();
  int row0 = 0, col0 = 0, tn = 0;
  const u16 *gA = A, *gB = Bt;
  uint4 R0a0, R0a1, R0a2, R0a3, R0b0, R0b1, R1a0, R1a1, R1a2, R1a3, R1b0, R1b1;
  if (id < ntiles) {
    TILE_DECODE(id, row0, col0, tn);
    gA = A + (size_t)(row0 + lrow) * lda + lc * 8;
    gB = Bt + (size_t)(col0 + lrow) * ldb + lc * 8;
    G_LOAD(R0, 0);
    G_LOAD(R1, 1);
  }
  while (id < ntiles) {
    f32x16 acc[4][2];
#pragma unroll
    for (int m = 0; m < 4; ++m)
#pragma unroll
      for (int n = 0; n < 2; ++n)
#pragma unroll
        for (int r = 0; r < 16; ++r) acc[m][n][r] = 0.f;
    G_WRITE(R0, 0);
    G_LOAD(R0, 2);
    RAW_BAR();
    for (int kt = 0; kt < nk; kt += 2) {
      G_ITER(0, R1, 1)
      G_ITER(1, R0, 0)
    }
    const int erow = row0 + wm * 128 + l31, ecol = col0 + wn * 64 + hi * 4, etn = tn;
    id += gridDim.x;
    if (id < ntiles) {
      TILE_DECODE(id, row0, col0, tn);
      gA = A + (size_t)(row0 + lrow) * lda + lc * 8;
      gB = Bt + (size_t)(col0 + lrow) * ldb + lc * 8;
      G_LOAD(R0, 0);
      G_LOAD(R1, 1);
    }
    epi(acc, erow, ecol, etn);
  }
}

struct EpiInProj {
  u16* proj; float* small_;
  __device__ __forceinline__ void operator()(f32x16 (&acc)[4][2], int rbase, int cbase, int tn) const {
    if (tn < 24) {
#pragma unroll
      for (int m = 0; m < 4; ++m)
#pragma unroll
        for (int n = 0; n < 2; ++n)
#pragma unroll
          for (int g = 0; g < 4; ++g) {
            uint2 o;
            o.x = pack2(acc[m][n][g * 4 + 0], acc[m][n][g * 4 + 1]);
            o.y = pack2(acc[m][n][g * 4 + 2], acc[m][n][g * 4 + 3]);
            *(uint2*)(proj + (size_t)(rbase + m * 32) * PJ + cbase + n * 32 + g * 8) = o;
          }
    } else {
#pragma unroll
      for (int m = 0; m < 4; ++m)
#pragma unroll
        for (int g = 0; g < 4; ++g) {
          int c = cbase + g * 8 - 3072;
          if (c < 32)
            *(float4*)(small_ + (size_t)(rbase + m * 32) * 32 + c) =
                make_float4(acc[m][0][g * 4 + 0], acc[m][0][g * 4 + 1], acc[m][0][g * 4 + 2], acc[m][0][g * 4 + 3]);
        }
    }
  }
};
struct EpiResid {
  const float* xin; float* xout;
  __device__ __forceinline__ void operator()(f32x16 (&acc)[4][2], int rbase, int cbase, int tn) const {
#pragma unroll
    for (int m = 0; m < 4; ++m)
#pragma unroll
      for (int n = 0; n < 2; ++n)
#pragma unroll
        for (int g = 0; g < 4; ++g) {
          size_t idx = (size_t)(rbase + m * 32) * DM + cbase + n * 32 + g * 8;
          float4 x = *(const float4*)(xin + idx);
          x.x += acc[m][n][g * 4 + 0]; x.y += acc[m][n][g * 4 + 1]; x.z += acc[m][n][g * 4 + 2]; x.w += acc[m][n][g * 4 + 3];
          *(float4*)(xout + idx) = x;
        }
  }
};
struct EpiSwiGLU {
  u16* act;
  __device__ __forceinline__ void operator()(f32x16 (&acc)[4][2], int rbase, int cbase, int tn) const {
    int grp = cbase >> 6, c4 = cbase & 7;
#pragma unroll
    for (int m = 0; m < 4; ++m)
#pragma unroll
      for (int g = 0; g < 4; ++g) {
        float v[4];
#pragma unroll
        for (int r = 0; r < 4; ++r) {
          float gt = acc[m][0][g * 4 + r], up = acc[m][1][g * 4 + r];
          v[r] = gt / (1.f + __expf(-gt)) * up;
        }
        uint2 o;
        o.x = pack2(v[0], v[1]);
        o.y = pack2(v[2], v[3]);
        *(uint2*)(act + (size_t)(rbase + m * 32) * DFF + grp * 32 + g * 8 + c4) = o;
      }
  }
};

__device__ __forceinline__ void gdn_chunk_prep(KP p, int l, char* smem, int job) {
  const int b = job >> 10, h = (job >> 8) & 3, c = job & 255;
  const int tid = otid(), lane = tid & 63, wv = tid >> 6;
  float* sq = (float*)smem;
  float* sk = sq + 64 * 65;
  float* sv = sk + 64 * 65;
  float* sA = sv + 64 * 65;
  float* sgc = sA + 64 * 64;
  float* sbeta = sgc + 64;
  float* seg = sbeta + 64;
  float* sf2 = seg + 64;
  const u16* proj = (const u16*)(p->ws + OFF_PROJ);
  const float* small_ = (const float*)(p->ws + OFF_SMALL);
  const size_t tok0 = (size_t)b * T + c * 64;
  char* cb = p->ws + OFF_GDN + (size_t)((b * 4 + h) * 256 + c) * CHUNK_B;
  float* UT = (float*)cb;
  u16* NW = (u16*)(cb + 16384);
  u16* QD = (u16*)(cb + 24576);
  u16* KDT = (u16*)(cb + 32768);
  u16* QKM = (u16*)(cb + 40960);
  {
    int d = lane, i0 = wv * 16;
#pragma unroll
    for (int seg_ = 0; seg_ < 3; ++seg_) {
      int ch = seg_ * 256 + h * 64 + d;
      const float* cw = p->gdn_conv_w + (size_t)l * 4 * 768 + ch;
      float w0 = cw[0], w1 = cw[768], w2 = cw[1536], w3 = cw[2304];
      float* dst = seg_ == 0 ? sq : (seg_ == 1 ? sk : sv);
      float x0 = 0, x1 = 0, x2 = 0;
      int tl = c * 64 + i0;
      if (tl - 3 >= 0) x0 = bf2f(proj[(tok0 + i0 - 3) * PJ + ch]);
      if (tl - 2 >= 0) x1 = bf2f(proj[(tok0 + i0 - 2) * PJ + ch]);
      if (tl - 1 >= 0) x2 = bf2f(proj[(tok0 + i0 - 1) * PJ + ch]);
      for (int i = 0; i < 16; ++i) {
        float x3 = bf2f(proj[(tok0 + i0 + i) * PJ + ch]);
        float y = w0 * x0 + w1 * x1 + w2 * x2 + w3 * x3;
        dst[(i0 + i) * 65 + d] = y / (1.f + __expf(-y));
        x0 = x1; x1 = x2; x2 = x3;
      }
    }
  }
  if (tid < 64) {
    float gb = small_[(tok0 + tid) * 32 + h], ga = small_[(tok0 + tid) * 32 + 4 + h];
    float xx = ga + p->gdn_dt_bias[l * 4 + h];
    float sp = fmaxf(xx, 0.f) + log1pf(__expf(-fabsf(xx)));
    float g = -__expf(p->gdn_a_log[l * 4 + h]) * sp;
#pragma unroll
    for (int o = 1; o < 64; o <<= 1) {
      float t = __shfl_up(g, o);
      if (lane >= o) g += t;
    }
    float beta = sigmoidf_(gb);
    float eg = __expf(g);
    sgc[tid] = g; sbeta[tid] = beta; seg[tid] = eg; sf2[tid] = beta * eg;
    if (tid == 63) ((float*)(p->ws + OFF_GL))[(b * 4 + h) * 256 + c] = eg;
  }
  __syncthreads();
  if (tid < 128) {
    float* rowp = (tid < 64 ? sq : sk) + (tid & 63) * 65;
    float ss = 0.f;
#pragma unroll 16
    for (int d = 0; d < 64; ++d) ss += rowp[d] * rowp[d];
    const float sc = rsqrtf(ss + 1e-6f) * (tid < 64 ? 0.125f : 1.f);
#pragma unroll 16
    for (int d = 0; d < 64; ++d) rowp[d] *= sc;
  }
  __syncthreads();
  {
    int ti = tid >> 4, tj = tid & 15;
    float kk[4][4], qk[4][4];
#pragma unroll
    for (int a = 0; a < 4; ++a)
#pragma unroll
      for (int bb = 0; bb < 4; ++bb) { kk[a][bb] = 0.f; qk[a][bb] = 0.f; }
    if (tj <= ti) {
      for (int d = 0; d < 64; ++d) {
        float ki[4], kj[4], qi[4];
#pragma unroll
        for (int a = 0; a < 4; ++a) {
          ki[a] = sk[(ti * 4 + a) * 65 + d];
          qi[a] = sq[(ti * 4 + a) * 65 + d];
          kj[a] = sk[(tj * 4 + a) * 65 + d];
        }
#pragma unroll
        for (int a = 0; a < 4; ++a)
#pragma unroll
          for (int bb = 0; bb < 4; ++bb) { kk[a][bb] += ki[a] * kj[bb]; qk[a][bb] += qi[a] * kj[bb]; }
      }
    }
#pragma unroll
    for (int a = 0; a < 4; ++a) {
      int i = ti * 4 + a;
      float gi = sgc[i], bi = sbeta[i];
      uint2 o;
      float qv[4];
#pragma unroll
      for (int bb = 0; bb < 4; ++bb) {
        int j = tj * 4 + bb;
        float dec = (j <= i) ? __expf(gi - sgc[j]) : 0.f;
        sA[i * 64 + j] = (j < i) ? bi * kk[a][bb] * dec : 0.f;
        qv[bb] = qk[a][bb] * dec;
      }
      o.x = pack2(qv[0], qv[1]); o.y = pack2(qv[2], qv[3]);
      *(uint2*)(QKM + i * 64 + tj * 4) = o;
    }
  }
  {
    float gl = sgc[63];
    for (int idx = tid; idx < 4096; idx += 256) {
      int i = idx >> 6, d = idx & 63;
      QD[idx] = f2bf(sq[i * 65 + d] * seg[i]);
      KDT[idx] = f2bf(sk[d * 65 + i] * __expf(gl - sgc[d]));
    }
  }
  __syncthreads();
  if (tid < 128) {
    int cidx = tid;
    const float* src = cidx < 64 ? sv + cidx : sk + (cidx - 64);
    const float* fac = cidx < 64 ? sbeta : sf2;
    float x[64];
#pragma unroll
    for (int i = 0; i < 64; ++i) {
      float s0 = src[i * 65] * fac[i], s1 = 0.f, s2 = 0.f, s3 = 0.f;
#pragma unroll
      for (int j = 0; j < i; ++j) {
        if ((j & 3) == 0) s0 -= sA[i * 64 + j] * x[j];
        else if ((j & 3) == 1) s1 -= sA[i * 64 + j] * x[j];
        else if ((j & 3) == 2) s2 -= sA[i * 64 + j] * x[j];
        else s3 -= sA[i * 64 + j] * x[j];
      }
      x[i] = (s0 + s1) + (s2 + s3);
    }
    if (cidx < 64) {
#pragma unroll
      for (int i = 0; i < 64; i += 4) *(float4*)(UT + cidx * 64 + i) = make_float4(x[i], x[i + 1], x[i + 2], x[i + 3]);
    } else {
#pragma unroll
      for (int i = 0; i < 64; ++i) NW[i * 64 + (cidx - 64)] = f2bf(-x[i]);
    }
  }
  __syncthreads();
}

__device__ __forceinline__ void gdn_scan(KP p, char* smem, int sid) {
  const int b = sid >> 4, h = (sid >> 2) & 3, v0 = (sid & 3) * 16;
  const int tid = otid(), lane = tid & 63, wv = tid >> 6, l15 = lane & 15, quad = lane >> 4;
  u16* Sb = (u16*)smem;
  u16* Vb = Sb + 16 * 72;
  f32x4 S = {0.f, 0.f, 0.f, 0.f};
  { u32 z0 = 0u; asm volatile("" : "+v"(z0)); *(uint2*)(Sb + l15 * 72 + 16 * wv + quad * 4) = make_uint2(z0, z0); }
  __syncthreads();
  const char* gbase = p->ws + OFF_GDN + (size_t)((b * 4 + h) * 256) * CHUNK_B;
  const float* GL = (const float*)(p->ws + OFF_GL) + (b * 4 + h) * 256;
  float* OG = (float*)(p->ws + OFF_OG);
  const int arow = (16 * wv + l15) * 64 + quad * 8;
  f32x4 u, un;
  bf16x8 wA[2], qdA[2], qkA[2], kdA[2], wAn[2], qdAn[2], qkAn[2], kdAn[2];
  float gl, gln;
  {
    const char* cb = gbase;
    u = *(const f32x4*)((const float*)cb + (v0 + l15) * 64 + 16 * wv + quad * 4);
#pragma unroll
    for (int ks = 0; ks < 2; ++ks) {
      wA[ks] = *(const bf16x8*)((const u16*)(cb + 16384) + arow + ks * 32);
      qdA[ks] = *(const bf16x8*)((const u16*)(cb + 24576) + arow + ks * 32);
      kdA[ks] = *(const bf16x8*)((const u16*)(cb + 32768) + arow + ks * 32);
      qkA[ks] = *(const bf16x8*)((const u16*)(cb + 40960) + arow + ks * 32);
    }
    gl = GL[0];
  }
  for (int c = 0; c < 256; ++c) {
    if (c + 1 < 256) {
      const char* cb = gbase + (size_t)(c + 1) * CHUNK_B;
      un = *(const f32x4*)((const float*)cb + (v0 + l15) * 64 + 16 * wv + quad * 4);
#pragma unroll
      for (int ks = 0; ks < 2; ++ks) {
        wAn[ks] = *(const bf16x8*)((const u16*)(cb + 16384) + arow + ks * 32);
        qdAn[ks] = *(const bf16x8*)((const u16*)(cb + 24576) + arow + ks * 32);
        kdAn[ks] = *(const bf16x8*)((const u16*)(cb + 32768) + arow + ks * 32);
        qkAn[ks] = *(const bf16x8*)((const u16*)(cb + 40960) + arow + ks * 32);
      }
      gln = GL[c + 1];
    }
    bf16x8 sB0 = *(const bf16x8*)(Sb + l15 * 72 + quad * 8);
    bf16x8 sB1 = *(const bf16x8*)(Sb + l15 * 72 + 32 + quad * 8);
    f32x4 vn = u;
    vn = mfma16(wA[0], sB0, vn);
    vn = mfma16(wA[1], sB1, vn);
    f32x4 o = {0.f, 0.f, 0.f, 0.f};
    o = mfma16(qdA[0], sB0, o);
    o = mfma16(qdA[1], sB1, o);
    *(uint2*)(Vb + l15 * 72 + 16 * wv + quad * 4) = make_uint2(pack2(vn[0], vn[1]), pack2(vn[2], vn[3]));
    __syncthreads();
    bf16x8 vB0 = *(const bf16x8*)(Vb + l15 * 72 + quad * 8);
    bf16x8 vB1 = *(const bf16x8*)(Vb + l15 * 72 + 32 + quad * 8);
    o = mfma16(qkA[0], vB0, o);
    o = mfma16(qkA[1], vB1, o);
    S[0] *= gl; S[1] *= gl; S[2] *= gl; S[3] *= gl;
    S = mfma16(kdA[0], vB0, S);
    S = mfma16(kdA[1], vB1, S);
    *(uint2*)(Sb + l15 * 72 + 16 * wv + quad * 4) = make_uint2(pack2(S[0], S[1]), pack2(S[2], S[3]));
    size_t orow = (size_t)b * T + c * 64 + 16 * wv + quad * 4;
#pragma unroll
    for (int r = 0; r < 4; ++r) OG[(orow + r) * 256 + h * 64 + v0 + l15] = o[r];
    __syncthreads();
    u = un; gl = gln;
#pragma unroll
    for (int ks = 0; ks < 2; ++ks) { wA[ks] = wAn[ks]; qdA[ks] = qdAn[ks]; kdA[ks] = kdAn[ks]; qkA[ks] = qkAn[ks]; }
  }
}

__device__ __forceinline__ void gdn_finalize(KP p, int l) {
  const int lane = otid() & 63;
  int gw = obid() * 4 + (otid() >> 6), nw = gridDim.x * 4;
  const float* OG = (const float*)(p->ws + OFF_OG);
  const u16* proj = (const u16*)(p->ws + OFF_PROJ);
  u16* mix = (u16*)(p->ws + OFF_H);
  float gn = p->gdn_norm[l * 64 + lane];
  for (int row = gw; row < NTOK * 4; row += nw) {
    int t = row >> 2, h = row & 3;
    float o = OG[(size_t)t * 256 + h * 64 + lane];
    float ss = wave_sum(o * o);
    float z = bf2f(proj[(size_t)t * PJ + C_GZ + h * 64 + lane]);
    float y = o * rsqrtf(ss * (1.f / 64.f) + 1e-6f) * gn * (z / (1.f + __expf(-z)));
    mix[(size_t)t * DM + h * 64 + lane] = f2bf(ZTEST == 4 ? 0.f : y);
  }
}

__device__ __forceinline__ void rope_table(KP p) {
  float* rp = (float*)(p->ws + OFF_ROPE);
  int gt = obid() * blockDim.x + otid(), nt = gridDim.x * blockDim.x;
  for (int idx = gt; idx < NTOK * 8; idx += nt) {
    int t = idx >> 3, i = idx & 7;
    float inv = (float)pow(500000.0, -(double)i / 8.0);
    float ang = (float)p->positions[t] * inv;
    rp[t * 16 + i] = (float)cos((double)ang);
    rp[t * 16 + 8 + i] = (float)sin((double)ang);
  }
}

__device__ __forceinline__ void nsa_token_prep(KP p, int l, char* smem, int tb) {
  const int tid = otid(), lane = tid & 63, wv = tid >> 6;
  const int b = tb >> 8, blk = tb & 255;
  u16* proj = (u16*)(p->ws + OFF_PROJ);
  const float* rope = (const float*)(p->ws + OFF_ROPE);
  const size_t tok0 = (size_t)tb * 64;
  for (int r = tid; r < 768; r += 256) {
    int i = r / 12, which = r % 12;
    size_t t = tok0 + i;
    int col; const float* gain;
    if (which < 8) { col = C_NQ + which * 64; gain = p->nsa_q_norm + l * 64; }
    else if (which < 10) { col = C_KSLC + (which - 8) * 64; gain = p->nsa_k_norm + (l * 3 + 1) * 64; }
    else { col = C_KWIN + (which - 10) * 64; gain = p->nsa_k_norm + (l * 3 + 2) * 64; }
    u16* rowp = proj + t * PJ + col;
    union { uint4 q; u16 h[8]; } v[8];
    float ss = 0.f;
#pragma unroll
    for (int c = 0; c < 8; ++c) {
      v[c].q = *(const uint4*)(rowp + c * 8);
#pragma unroll
      for (int e = 0; e < 8; ++e) { float x = bf2f(v[c].h[e]); ss += x * x; }
    }
    const float rs = rsqrtf(ss * (1.f / 64.f) + 1e-6f);
    float y0[16];
#pragma unroll
    for (int e = 0; e < 16; ++e) y0[e] = bf2f(v[e >> 3].h[e & 7]) * rs * gain[e];
    if (which >= 8) {
      const float* rp = rope + t * 16;
#pragma unroll
      for (int e = 0; e < 8; ++e) {
        float c = rp[e], sn = rp[8 + e];
        float a1 = y0[e], a2 = y0[8 + e];
        y0[e] = a1 * c - a2 * sn;
        y0[8 + e] = a2 * c + a1 * sn;
      }
    }
#pragma unroll
    for (int c = 0; c < 8; ++c) {
      uint4 o;
      float y[8];
#pragma unroll
      for (int e = 0; e < 8; ++e) y[e] = c < 2 ? y0[c * 8 + e] : bf2f(v[c].h[e]) * rs * gain[c * 8 + e];
      o.x = pack2(y[0], y[1]); o.y = pack2(y[2], y[3]); o.z = pack2(y[4], y[5]); o.w = pack2(y[6], y[7]);
      *(uint4*)(rowp + c * 8) = o;
    }
  }
  u16* tt = (u16*)smem;
  for (int z = 0; z < 4; ++z) {
    int tensor = z >> 1, g = z & 1;
    int col = (tensor ? C_VWIN : C_VSLC) + g * 64;
    for (int idx = tid; idx < 4096; idx += 256) {
      int i = idx >> 6, d = idx & 63;
      tt[i * 66 + d] = proj[(tok0 + i) * PJ + col + d];
    }
    __syncthreads();
    u16* dst = (u16*)(p->ws + OFF_VT + (size_t)tensor * 8 * MiB) + ((size_t)((b * 2 + g) * 256 + blk)) * 4096;
    for (int idx = tid; idx < 4096; idx += 256) {
      int d = idx >> 6, i = idx & 63;
      dst[idx] = tt[i * 66 + d];
    }
    __syncthreads();
  }
  {
    int ch = tid;
    const float* cw = p->conv_w + (size_t)l * 3 * 256 + ch;
    float w0 = cw[0], w1 = cw[256], w2 = cw[512];
    u16* mix = (u16*)(p->ws + OFF_H);
    float p0 = 0.f, p1 = 0.f;
    if (blk > 0) {
      p0 = bf2f(proj[(tok0 - 2) * PJ + C_CC + ch]) * bf2f(proj[(tok0 - 2) * PJ + C_CX + ch]);
      p1 = bf2f(proj[(tok0 - 1) * PJ + C_CC + ch]) * bf2f(proj[(tok0 - 1) * PJ + C_CX + ch]);
    }
    for (int i = 0; i < 64; ++i) {
      size_t t = tok0 + i;
      float p2 = bf2f(proj[t * PJ + C_CC + ch]) * bf2f(proj[t * PJ + C_CX + ch]);
      float y = w0 * p0 + w1 * p1 + w2 * p2;
      mix[t * DM + 768 + ch] = f2bf(ZTEST == 5 ? 0.f : bf2f(proj[t * PJ + C_CB + ch]) * y);
      p0 = p1; p1 = p2;
    }
  }
}

__device__ __forceinline__ void nsa_compress(KP p, int l, char* smem, int job) {
  const int tid = otid(), lane = tid & 63, wv = tid >> 6, l15 = lane & 15, quad = lane >> 4;
  const int which = job >> 6, b = (job >> 5) & 1, g = (job >> 4) & 1, tile = job & 15;
  const u16* proj = (const u16*)(p->ws + OFF_PROJ);
  const u16* W1T = (const u16*)(p->ws + OFF_W + W_C1) + (size_t)which * 64 * 2048;
  const u16* W2T = (const u16*)(p->ws + OFF_W + W_C2) + which * 4096;
  const float* pe = p->cmp_pe + (size_t)(l * 2 + which) * 32 * 64;
  const int blk0 = tile * 64 + wv * 16;
  int blk = blk0 + l15;
  int blkc = blk < 1023 ? blk : 1022;
  const u16* arow = proj + ((size_t)b * T + blkc * 16) * PJ + (which ? C_VCMP : C_KCMP) + g * 64;
  f32x4 acc[4];
#pragma unroll
  for (int n = 0; n < 4; ++n) acc[n] = f32x4{0.f, 0.f, 0.f, 0.f};
  for (int ks = 0; ks < 64; ++ks) {
    int tok = ks >> 1, d0 = (ks & 1) * 32 + quad * 8;
    uint4 raw = *(const uint4*)(arow + (size_t)tok * PJ + d0);
    float4 pe0 = *(const float4*)(pe + tok * 64 + d0), pe1 = *(const float4*)(pe + tok * 64 + d0 + 4);
    union { bf16x8 v; u32 u[4]; } af;
    af.u[0] = pack2(bf2f(raw.x & 0xffff) + pe0.x, bf2f(raw.x >> 16) + pe0.y);
    af.u[1] = pack2(bf2f(raw.y & 0xffff) + pe0.z, bf2f(raw.y >> 16) + pe0.w);
    af.u[2] = pack2(bf2f(raw.z & 0xffff) + pe1.x, bf2f(raw.z >> 16) + pe1.y);
    af.u[3] = pack2(bf2f(raw.w & 0xffff) + pe1.z, bf2f(raw.w >> 16) + pe1.w);
#pragma unroll
    for (int n = 0; n < 4; ++n) {
      bf16x8 bfr = *(const bf16x8*)(W1T + (size_t)(n * 16 + l15) * 2048 + ks * 32 + quad * 8);
      acc[n] = mfma16(af.v, bfr, acc[n]);
    }
  }
  u16* hid = (u16*)smem + wv * 16 * 72;
#pragma unroll
  for (int n = 0; n < 4; ++n)
#pragma unroll
    for (int r = 0; r < 4; ++r) {
      float x = acc[n][r];
      float u = 0.7978845608028654f * (x + 0.044715f * x * x * x);
      float gl = 0.5f * x * (1.f + tanhf(u));
      hid[(quad * 4 + r) * 72 + n * 16 + l15] = f2bf(gl);
    }
  __syncthreads();
  f32x4 o2[4];
#pragma unroll
  for (int n = 0; n < 4; ++n) o2[n] = f32x4{0.f, 0.f, 0.f, 0.f};
#pragma unroll
  for (int ks = 0; ks < 2; ++ks) {
    bf16x8 af = *(const bf16x8*)(hid + l15 * 72 + ks * 32 + quad * 8);
#pragma unroll
    for (int n = 0; n < 4; ++n) {
      bf16x8 bfr = *(const bf16x8*)(W2T + (n * 16 + l15) * 64 + ks * 32 + quad * 8);
      o2[n] = mfma16(af, bfr, o2[n]);
    }
  }
  __syncthreads();
  if (which == 0) {
    u16* KC = (u16*)(p->ws + OFF_KC) + (size_t)(b * 2 + g) * 1024 * 64;
    const float* kg = p->nsa_k_norm + (l * 3 + 0) * 64;
#pragma unroll
    for (int r = 0; r < 4; ++r) {
      float ss = 0.f;
#pragma unroll
      for (int n = 0; n < 4; ++n) ss += o2[n][r] * o2[n][r];
      ss += __shfl_xor(ss, 1); ss += __shfl_xor(ss, 2); ss += __shfl_xor(ss, 4); ss += __shfl_xor(ss, 8);
      float rs = rsqrtf(ss * (1.f / 64.f) + 1e-6f);
      int row = blk0 + quad * 4 + r;
#pragma unroll
      for (int n = 0; n < 4; ++n) {
        float v = row < 1023 ? o2[n][r] * rs * kg[n * 16 + l15] : 0.f;
        KC[(size_t)row * 64 + n * 16 + l15] = f2bf(v);
      }
    }
  } else {
    u16* VCT = (u16*)(p->ws + OFF_KC + 524288) + (size_t)(b * 2 + g) * 64 * 1024;
#pragma unroll
    for (int r = 0; r < 4; ++r) {
      int row = blk0 + quad * 4 + r;
#pragma unroll
      for (int n = 0; n < 4; ++n) {
        float v = row < 1023 ? o2[n][r] : 0.f;
        VCT[(size_t)(n * 16 + l15) * 1024 + row] = f2bf(v);
      }
    }
  }
}

template <int MODE, int NT>
__device__ __forceinline__ void flash2(const u16* __restrict__ Kg, int kld, const u16* __restrict__ VTg, int vblk,
                                       int vld, int h0, int h1, char* sStage, const u16* sQw, f32x4 (&O)[4][NT],
                                       float (&lsum)[NT], const float (&inv)[NT], const u32* sSelw, float* slc,
                                       int tq0) {
  const int tid = otid(), lane = tid & 63, wv = tid >> 6, l15 = lane & 15, quad = lane >> 4;
  const int krow = tid >> 3, kc = tid & 7;
  const u16* kptr = Kg + (size_t)krow * kld + kc * 8;
  const int kw = krow * 128 + ((kc ^ ((krow >> 1) & 7)) * 16);
  const int vd = tid >> 2, vc = tid & 3;
  const u16* vptr = VTg + (size_t)vd * vld + vc * 8;
  const int vw = 4096 + vd * 64 + ((vc ^ ((vd >> 2) & 3)) * 16);
  const int jb0 = h0 >> 1, nst = (h1 >> 1) - jb0 + 1;
  uint4 S0k0, S0k1, S0v0, S0v1, S1k0, S1k1, S1v0, S1v1;
#define F2_LOAD(S, i_)                                                                             \
  do {                                                                                             \
    const int jb_ = jb0 + (i_);                                                                    \
    S##k0 = *(const uint4*)(kptr + (size_t)(jb_ * 64) * kld);                                      \
    S##k1 = *(const uint4*)(kptr + (size_t)(jb_ * 64 + 32) * kld);                                 \
    if (MODE != 2) {                                                                               \
      S##v0 = *(const uint4*)(vptr + (size_t)jb_ * vblk);                                          \
      S##v1 = *(const uint4*)(vptr + (size_t)jb_ * vblk + 32);                                     \
    }                                                                                              \
  } while (0)
#define F2_WRITE(S, slot_)                                                     \
  do {                                                                         \
    char* sl_ = sStage + (slot_) * 16384;                                      \
    *(uint4*)(sl_ + kw) = S##k0;                                               \
    *(uint4*)(sl_ + 8192 + kw) = S##k1;                                        \
    if (MODE != 2) {                                                           \
      *(uint4*)(sl_ + vw) = S##v0;                                             \
      *(uint4*)(sl_ + 8192 + vw) = S##v1;                                      \
    }                                                                          \
  } while (0)
  if (0 < nst) F2_LOAD(S0, 0);
  if (1 < nst) F2_LOAD(S1, 1);
  const int koff = l15 * 128;
  const int ksw = (l15 >> 1) & 7;
  const int voff = 4096 + l15 * 64 + (quad & 1) * 8;
  const int vsw = (l15 >> 2) & 3;
  const int tq0u = __builtin_amdgcn_readfirstlane(tq0);
  const int lim0u = tq0u >= 31 ? ((tq0u - 31) >> 4) : -1;
  auto compute = [&](const int h, const char* st) __attribute__((always_inline)) {
    bool interior;
    if (MODE == 0) interior = (h * 32 + 31 <= tq0u) && (h * 32 > tq0u + NT * 4 - 1 - 512);
    else if (MODE == 1) interior = (h * 32 + 31 <= tq0u);
    else interior = (h * 32 + 31 <= lim0u);
    bool bv[NT], an[NT];
    bool anyw = false;
#pragma unroll
    for (int nt = 0; nt < NT; ++nt) {
      if (MODE == 1) {
        u32 w = sSelw[(nt * 4 + (l15 >> 2)) * 8 + (h >> 6)];
        bv[nt] = (w >> ((h >> 1) & 31)) & 1u;
      } else {
        bv[nt] = true;
      }
      an[nt] = MODE == 1 ? (bool)__any(bv[nt]) : true;
      anyw |= an[nt];
    }
    if (anyw) {
      bf16x8 kf[2][2], vf[4];
#pragma unroll
      for (int m2 = 0; m2 < 2; ++m2)
#pragma unroll
        for (int ks = 0; ks < 2; ++ks)
          kf[m2][ks] = *(const bf16x8*)(st + koff + m2 * 2048 + (((ks * 4 + quad) ^ ksw) * 16));
      if (MODE != 2) {
#pragma unroll
        for (int dt = 0; dt < 4; ++dt) {
          union { bf16x8 v; uint2 h2[2]; } u;
          u.h2[0] = *(const uint2*)(st + voff + dt * 1024 + (((quad >> 1) ^ vsw) * 16));
          u.h2[1] = *(const uint2*)(st + voff + dt * 1024 + (((2 + (quad >> 1)) ^ vsw) * 16));
          vf[dt] = u.v;
        }
      }
#pragma unroll
      for (int nt = 0; nt < NT; ++nt) {
        if (!an[nt]) continue;
        const int t = tq0 + nt * 4 + (l15 >> 2);
        const bf16x8 bq0 = *(const bf16x8*)(sQw + (nt * 16 + l15) * 72 + quad * 8);
        const bf16x8 bq1 = *(const bf16x8*)(sQw + (nt * 16 + l15) * 72 + 32 + quad * 8);
        f32x4 s[2];
#pragma unroll
        for (int m2 = 0; m2 < 2; ++m2) {
          s[m2] = f32x4{0.f, 0.f, 0.f, 0.f};
          s[m2] = mfma16(kf[m2][0], bq0, s[m2]);
          s[m2] = mfma16(kf[m2][1], bq1, s[m2]);
        }
        const float bias = MODE == 1 ? (bv[nt] ? 0.f : -1000.f) : (MODE == 3 ? inv[nt] : 0.f);
        if (interior) {
#pragma unroll
          for (int m2 = 0; m2 < 2; ++m2)
#pragma unroll
            for (int r = 0; r < 4; ++r) s[m2][r] = __builtin_amdgcn_exp2f(fmaf(s[m2][r], SC2, bias));
        } else {
          int base;
          if (MODE <= 1) base = h * 32 + quad * 4 - t;
          else base = h * 32 + quad * 4 - (t >= 31 ? ((t - 31) >> 4) : -1);
          asm volatile("" : "+v"(base));
#pragma unroll
          for (int m2 = 0; m2 < 2; ++m2)
#pragma unroll
            for (int r = 0; r < 4; ++r) {
              const int C = m2 * 16 + r;
              bool valid;
              if (MODE == 0) valid = base <= -C && base > -512 - C;
              else valid = base <= -C;
              float pvv = __builtin_amdgcn_exp2f(fmaf(s[m2][r], SC2, bias));
              s[m2][r] = valid ? pvv : 0.f;
            }
        }
        float ls = ((s[0][0] + s[0][1]) + (s[0][2] + s[0][3])) + ((s[1][0] + s[1][1]) + (s[1][2] + s[1][3]));
        if (MODE != 3) lsum[nt] += ls;
        if (MODE == 3) {
#pragma unroll
          for (int m2 = 0; m2 < 2; ++m2) {
            float ow = s[m2][0] + s[m2][1] + s[m2][2] + 0.5f * s[m2][3];
            float sp = 0.5f * s[m2][3];
            ow += __shfl_xor(ow, 1); ow += __shfl_xor(ow, 2);
            sp += __shfl_xor(sp, 1); sp += __shfl_xor(sp, 2);
            if ((l15 & 3) == 0) {
              const int j = h * 8 + m2 * 4 + quad;
              slc[(nt * 4 + (l15 >> 2)) * 256 + j] = ow;
              if (j + 1 < 256) slc[1024 + (nt * 4 + (l15 >> 2)) * 256 + j + 1] = sp;
            }
          }
        }
        if (MODE != 2) {
          bf16x8 P = pack8(s[0], s[1]);
#pragma unroll
          for (int dt = 0; dt < 4; ++dt) O[dt][nt] = mfma16(vf[dt], P, O[dt][nt]);
        }
      }
    }
  };
  if (0 < nst) F2_WRITE(S0, 0);
  if (2 < nst) F2_LOAD(S0, 2);
  RAW_BAR();
#define F2_ITER(u_, SN, sn_)                                            \
  if (i + (u_) < nst) {                                                 \
    const int ii_ = i + (u_);                                           \
    if (ii_ + 1 < nst) F2_WRITE(SN, sn_);                               \
    if (ii_ + 3 < nst) F2_LOAD(SN, ii_ + 3);                            \
    compute(2 * (jb0 + ii_), sStage + (u_) * 16384);                    \
    compute(2 * (jb0 + ii_) + 1, sStage + (u_) * 16384 + 8192);         \
    RAW_BAR();                                                          \
  }
  for (int i = 0; i < nst; i += 2) {
    F2_ITER(0, S1, 1)
    F2_ITER(1, S0, 0)
  }
}

__device__ __forceinline__ void nsa_phase_c(KP p, int l, char* smem) {
  const int tid = otid(), lane = tid & 63, wv = tid >> 6, l15 = lane & 15, quad = lane >> 4;
  char* sStage = smem;
  u16* sQw = (u16*)(smem + 32768) + wv * 16 * 72;
  float* own = (float*)(smem + 32768 + 9216) + wv * 2048;
  float* spl = own + 1024;
  const u16* proj = (const u16*)(p->ws + OFF_PROJ);
  const float* small_ = (const float*)(p->ws + OFF_SMALL);
  float* OC = (float*)(p->ws + OFF_OC);
  u32* SEL = (u32*)(p->ws + OFF_SEL);
  for (int job = obid(); job < 4096; job += gridDim.x) {
    const int qt = 1023 - (job >> 2), bg = job & 3, b = bg >> 1, g = bg & 1;
    const int t0 = qt * 16 + wv * 4;
    const int ql = l15 >> 2, r_ = l15 & 3, head = g * 4 + r_;
    const int t = t0 + ql;
    const size_t tok = (size_t)b * T + t;
    const u16* KC = (const u16*)(p->ws + OFF_KC) + (size_t)bg * 1024 * 64;
    const u16* VCT = (const u16*)(p->ws + OFF_KC + 524288) + (size_t)bg * 64 * 1024;
    {
      const u16* qrow = proj + tok * PJ + C_NQ + head * 64;
      *(bf16x8*)(sQw + l15 * 72 + quad * 8) = *(const bf16x8*)(qrow + quad * 8);
      *(bf16x8*)(sQw + l15 * 72 + 32 + quad * 8) = *(const bf16x8*)(qrow + 32 + quad * 8);
    }
    const int tmax = qt * 16 + 15;
    const int nvmax = tmax >= 31 ? ((tmax - 31) >> 4) + 1 : 0;
    const int h1 = ((nvmax + 31) >> 5) - 1;
    f32x4 O[4][1];
    float lsum[1] = {0.f}, inv[1] = {0.f};
#pragma unroll
    for (int dt = 0; dt < 4; ++dt) O[dt][0] = f32x4{0.f, 0.f, 0.f, 0.f};
    if (h1 >= 0) {
      flash2<2, 1>(KC, 64, VCT, 64, 1024, 0, h1, sStage, sQw, O, lsum, inv, nullptr, own, t0);
      float ls = lsum[0];
      ls += __shfl_xor(ls, 16);
      ls += __shfl_xor(ls, 32);
      inv[0] = ls > 0.f ? -log2f(ls) : -1000.f;
      flash2<3, 1>(KC, 64, VCT, 64, 1024, 0, h1, sStage, sQw, O, lsum, inv, nullptr, own, t0);
    }
    {
      float gc = ZTEST == 1 ? 0.f : sigmoidf_(small_[tok * 32 + 8 + head * 3 + 0]);
#pragma unroll
      for (int dt = 0; dt < 4; ++dt) {
        float4 o = make_float4(O[dt][0][0] * gc, O[dt][0][1] * gc, O[dt][0][2] * gc, O[dt][0][3] * gc);
        *(float4*)(OC + tok * 512 + head * 64 + dt * 16 + quad * 4) = o;
      }
    }
    __builtin_amdgcn_wave_barrier();
    for (int q = 0; q < 4; ++q) {
      const int tq = t0 + q, cur = tq >> 6;
      u32 word = 0;
      if (cur <= 15) {
        if (lane == 0) word = (2u << cur) - 1u;
      } else {
        u32 key[4];
#pragma unroll
        for (int k = 0; k < 4; ++k) {
          int j = lane + 64 * k;
          float v = own[q * 256 + j] + spl[q * 256 + j];
          key[k] = (j >= 1 && j <= cur - 2) ? (__float_as_uint(fmaxf(v, 0.f)) + 1u) : 0u;
        }
        u32 T = 0u;
        for (int bit = 30; bit >= 0; --bit) {
          const u32 cand = T | (1u << bit);
          int cnt = 0;
#pragma unroll
          for (int k = 0; k < 4; ++k) cnt += __popcll(__ballot(key[k] >= cand));
          if (cnt >= 13) T = cand;
        }
        int ngt = 0;
#pragma unroll
        for (int k = 0; k < 4; ++k) ngt += __popcll(__ballot(key[k] > T));
        int quota = 13 - ngt;
        const unsigned long long lt = (1ull << lane) - 1ull;
#pragma unroll
        for (int k = 0; k < 4; ++k) {
          const unsigned long long me = __ballot(key[k] == T);
          const bool take = key[k] > T || (key[k] == T && (int)__popcll(me & lt) < quota);
          const int ne = (int)__popcll(me);
          quota = quota > ne ? quota - ne : 0;
          const unsigned long long sm = __ballot(take);
          if (lane == 2 * k) word = (u32)sm;
          if (lane == 2 * k + 1) word = (u32)(sm >> 32);
        }
        if (lane == 0) word |= 1u;
        if (lane == (cur >> 5)) word |= 1u << (cur & 31);
        if (lane == ((cur - 1) >> 5)) word |= 1u << ((cur - 1) & 31);
      }
      if (lane < 8) SEL[(((size_t)b * 16384 + tq) * 2 + g) * 8 + lane] = word;
    }
    __builtin_amdgcn_wave_barrier();
  }
}

__device__ __forceinline__ void nsa_s_tile(KP p, int l, char* smem, int tile) {
  const int cur = 255 - (tile >> 2), bg = tile & 3, b = bg >> 1, g = bg & 1;
  const int tid = otid(), lane = tid & 63, wv = tid >> 6, l15 = lane & 15, quad = lane >> 4;
  char* sStage = smem;
  u16* sQw = (u16*)(smem + 32768) + wv * 64 * 72;
  u32* sSel = (u32*)(smem + 32768 + 36864);
  const u32* sSelw = sSel + wv * 16 * 8;
  const u16* proj = (const u16*)(p->ws + OFF_PROJ);
  const float* small_ = (const float*)(p->ws + OFF_SMALL);
  const float* rope = (const float*)(p->ws + OFF_ROPE);
  float* OC = (float*)(p->ws + OFF_OC);
  u16* mix = (u16*)(p->ws + OFF_H);
  const size_t tokb = (size_t)b * T;
  const int tq0 = cur * 64 + wv * 16;
  const int r_ = l15 & 3, head = g * 4 + r_;
  {
    const u32* SEL = (const u32*)(p->ws + OFF_SEL);
    int q = tid >> 2, w2 = (tid & 3) * 2;
    uint2 v = *(const uint2*)(SEL + ((tokb + cur * 64 + q) * 2 + g) * 8 + w2);
    *(uint2*)(sSel + q * 8 + w2) = v;
  }
#pragma unroll
  for (int nt = 0; nt < 4; ++nt) {
    const size_t tok = tokb + tq0 + nt * 4 + (l15 >> 2);
    const u16* qrow = proj + tok * PJ + C_NQ + head * 64;
    u16* qd = sQw + (nt * 16 + l15) * 72;
    *(bf16x8*)(qd + 32 + quad * 8) = *(const bf16x8*)(qrow + 32 + quad * 8);
    if (quad >= 2) {
      *(bf16x8*)(qd + quad * 8) = *(const bf16x8*)(qrow + quad * 8);
    } else {
      union { bf16x8 v; u16 h[8]; } x1, x2, o;
      x1.v = *(const bf16x8*)(qrow);
      x2.v = *(const bf16x8*)(qrow + 8);
      const float* rp = rope + tok * 16;
#pragma unroll
      for (int i = 0; i < 8; ++i) {
        float a = bf2f(x1.h[i]), bb = bf2f(x2.h[i]), c = rp[i], s = rp[8 + i];
        o.h[i] = f2bf(quad == 0 ? a * c - bb * s : bb * c + a * s);
      }
      *(bf16x8*)(qd + quad * 8) = o.v;
    }
  }
  f32x4 O[4][4];
  float lsum[4], inv[4] = {0.f, 0.f, 0.f, 0.f};
#pragma unroll
  for (int dt = 0; dt < 4; ++dt)
#pragma unroll
    for (int nt = 0; nt < 4; ++nt) O[dt][nt] = f32x4{0.f, 0.f, 0.f, 0.f};
#pragma unroll
  for (int nt = 0; nt < 4; ++nt) lsum[nt] = 0.f;
  {
    const u16* Kg = proj + tokb * PJ + C_KWIN + g * 64;
    const u16* VTg = (const u16*)(p->ws + OFF_VT + 8 * MiB) + (size_t)(bg * 256) * 4096;
    int h0 = 2 * cur - 16 < 0 ? 0 : 2 * cur - 16;
    flash2<0, 4>(Kg, PJ, VTg, 4096, 64, h0, 2 * cur + 1, sStage, sQw, O, lsum, inv, sSelw, nullptr, tq0);
  }
#pragma unroll
  for (int nt = 0; nt < 4; ++nt) {
    const size_t tok = tokb + tq0 + nt * 4 + (l15 >> 2);
    float ls = lsum[nt];
    ls += __shfl_xor(ls, 16);
    ls += __shfl_xor(ls, 32);
    float sc = ZTEST == 2 ? 0.f : sigmoidf_(small_[tok * 32 + 8 + head * 3 + 2]) / ls;
#pragma unroll
    for (int dt = 0; dt < 4; ++dt) {
      float4* op = (float4*)(OC + tok * 512 + head * 64 + dt * 16 + quad * 4);
      float4 o = *op;
      o.x += O[dt][nt][0] * sc; o.y += O[dt][nt][1] * sc; o.z += O[dt][nt][2] * sc; o.w += O[dt][nt][3] * sc;
      *op = o;
      O[dt][nt] = f32x4{0.f, 0.f, 0.f, 0.f};
    }
    lsum[nt] = 0.f;
  }
  {
    const u16* Kg = proj + tokb * PJ + C_KSLC + g * 64;
    const u16* VTg = (const u16*)(p->ws + OFF_VT) + (size_t)(bg * 256) * 4096;
    flash2<1, 4>(Kg, PJ, VTg, 4096, 64, 0, 2 * cur + 1, sStage, sQw, O, lsum, inv, sSelw, nullptr, tq0);
  }
#pragma unroll
  for (int nt = 0; nt < 4; ++nt) {
    const size_t tok = tokb + tq0 + nt * 4 + (l15 >> 2);
    float ls = lsum[nt];
    ls += __shfl_xor(ls, 16);
    ls += __shfl_xor(ls, 32);
    float sc = ZTEST == 3 ? 0.f : sigmoidf_(small_[tok * 32 + 8 + head * 3 + 1]) / ls;
#pragma unroll
    for (int dt = 0; dt < 4; ++dt) {
      float4 o = *(const float4*)(OC + tok * 512 + head * 64 + dt * 16 + quad * 4);
      uint2 w;
      w.x = pack2(o.x + O[dt][nt][0] * sc, o.y + O[dt][nt][1] * sc);
      w.y = pack2(o.z + O[dt][nt][2] * sc, o.w + O[dt][nt][3] * sc);
      *(uint2*)(mix + tok * DM + 256 + head * 64 + dt * 16 + quad * 4) = w;
    }
  }
}


#define XB_TMO      128
#define XB_XCNT(j)  (256  + 64 * (j))
#define XB_XSUB(j)  (1280 + 64 * (j))
#define XB_XGEN(j)  (2304 + 64 * (j))
#define XB_TOP      3328
#define XB_TOPGEN   3392
#define XCD_BAR_WORDS 3456
#define XB_SPIN_CAP (1u << 18)
#define LAS __attribute__((address_space(3)))
__device__ __forceinline__ unsigned xb_ld(unsigned* p) { return __hip_atomic_load(p, __ATOMIC_RELAXED, __HIP_MEMORY_SCOPE_AGENT); }
__device__ __forceinline__ unsigned xb_add(unsigned* p, unsigned v) { return __hip_atomic_fetch_add(p, v, __ATOMIC_RELAXED, __HIP_MEMORY_SCOPE_AGENT); }
__device__ __forceinline__ unsigned xb_xcc_id() { return (unsigned)__builtin_amdgcn_s_getreg((3 << 11) | 20) & 0xFu; }
#define XB_SPIN(cond, bar) do { unsigned _sp = 0; while (cond) { __builtin_amdgcn_s_sleep(1); \
    if ((++_sp & 255u) == 0u) { if (xb_ld(&(bar)[XB_TMO])) break; if (_sp > XB_SPIN_CAP) { atomicAdd(&(bar)[XB_TMO], 1u); break; } } } } while (0)
struct XcdBarrier { unsigned* bar; unsigned x; volatile LAS unsigned* st; };
__device__ __forceinline__ XcdBarrier xcd_barrier_post(unsigned* bar, volatile LAS unsigned* st) {
  XcdBarrier b; b.bar = bar; b.x = xb_xcc_id(); b.st = st;
  if (threadIdx.x == 0) (void)xb_add(&bar[XB_XCNT(b.x)], 1u);
  return b;
}
__device__ __forceinline__ void xcd_barrier_complete(unsigned* bar, unsigned x, unsigned& nloc, unsigned& nx) {
  const unsigned G = gridDim.x * gridDim.y * gridDim.z;
  unsigned sum, cnt, mine, sp = 0u;
  for (;;) {
    sum = 0u; cnt = 0u; mine = 0u;
#pragma unroll
    for (unsigned j = 0; j < 16; ++j) { const unsigned c = xb_ld(&bar[XB_XCNT(j)]); sum += c; cnt += (c > 0u) ? 1u : 0u; mine = (j == x) ? c : mine; }
    if (sum == G) break;
    __builtin_amdgcn_s_sleep(1);
    if ((++sp & 255u) == 0u) { if (xb_ld(&bar[XB_TMO])) break; if (sp > XB_SPIN_CAP) { atomicAdd(&bar[XB_TMO], 1u); break; } }
  }
  nloc = mine > 0u ? mine : 1u; nx = cnt > 0u ? cnt : 1u;
}
__device__ __forceinline__ void xcd_barrier(const XcdBarrier& b) {
  asm volatile("s_waitcnt vmcnt(0)" ::: "memory");
  __syncthreads();
  if (threadIdx.x == 0) {
    unsigned* bar = b.bar;
    __builtin_amdgcn_s_waitcnt(0);
    unsigned nloc = b.st[0], nx = b.st[1];
    if (nloc == 0u) { xcd_barrier_complete(bar, b.x, nloc, nx); b.st[0] = nloc; b.st[1] = nx; }
    const unsigned old = xb_add(&bar[XB_XSUB(b.x)], 1u);
    const unsigned gen = old / nloc;
    if (old + 1u == (gen + 1u) * nloc) {
      __builtin_amdgcn_fence(__ATOMIC_RELEASE, "agent");
      asm volatile("s_waitcnt vmcnt(0)" ::: "memory");
      const unsigned og = xb_add(&bar[XB_TOP], 1u);
      const unsigned tg = og / nx;
      if (og + 1u == (tg + 1u) * nx) xb_add(&bar[XB_TOPGEN], 1u);
      else XB_SPIN(xb_ld(&bar[XB_TOPGEN]) == tg, bar);
      __builtin_amdgcn_fence(__ATOMIC_ACQUIRE, "agent");
      xb_add(&bar[XB_XGEN(b.x)], 1u);
      asm volatile("s_waitcnt vmcnt(0)" ::: "memory");
    } else {
      XB_SPIN(xb_ld(&bar[XB_XGEN(b.x)]) == gen, bar);
      __builtin_amdgcn_fence(__ATOMIC_ACQUIRE, "agent");
      asm volatile("s_waitcnt vmcnt(0)" ::: "memory");
    }
  }
  __syncthreads();
}
#ifndef REPE
#define REPE 1
#endif
#ifndef REP3C
#define REP3C 1
#endif
#ifndef REP3
#define REP3 1
#endif
#ifndef XSYNC
#define XSYNC 0
#endif
#ifndef REP4
#define REP4 1
#endif
#ifndef REPSCAN
#define REPSCAN 1
#endif
#ifndef REPG
#define REPG 1
#endif
__global__ void __launch_bounds__(256, 2) hymba_mega(Params p_unused) {
  cg::grid_group grid = cg::this_grid();
  __shared__ uint4 xb_words;
  if (threadIdx.x == 0) xb_words = make_uint4(0u, 0u, 0u, 0u);
  __syncthreads();
  XcdBarrier xb = xcd_barrier_post((unsigned*)(kargs()->ws + OFF_CNT + 4096), (volatile LAS unsigned*)&xb_words);
  __shared__ __attribute__((aligned(16))) char smem[77824];
  __shared__ int s_tile;
  { KP p = kargs(); rope_table(p); }
  grid.sync();
#pragma unroll 1
  for (int l = 0; l < DEPTH; ++l) {
    {
      KP p = kargs();
      if (blockIdx.x == 0 && threadIdx.x == 0) { u32 z0 = 0u; asm volatile("" : "+v"(z0)); ((u32*)(p->ws + OFF_CNT))[0] = z0; }
      for (int re = 0; re < REPE; ++re) {
      convert_weights(p, l, smem);
      rmsnorm_rows(l == 0 ? p->x_in : p->out, p->attn_norm + l * DM, (u16*)(p->ws + OFF_H));
      }
    }
    xcd_barrier(xb);
    {
      KP p = kargs();
      for (int rep = 0; rep < REPG; ++rep)
      gemm_phase((const u16*)(p->ws + OFF_H), DM, (const u16*)(p->ws + OFF_W + W_IN), DM, DM, 128, 25, smem,
                 EpiInProj{(u16*)(p->ws + OFF_PROJ), (float*)(p->ws + OFF_SMALL)});
    }
    xcd_barrier(xb);
    {
      KP p = kargs();
      for (int job = obid(); job < 2048 + 512 + 128; job += gridDim.x) {
        if (job < 2048) gdn_chunk_prep(p, l, smem, job);
        else if (job < 2560) nsa_token_prep(p, l, smem, job - 2048);
        else nsa_compress(p, l, smem, job - 2560);
      }
    }
    xcd_barrier(xb);
#ifndef REP45
#define REP45 1
#endif
    for (int rep = 0; rep < REP45; ++rep) {
    {
      KP p = kargs();
      if (blockIdx.x == 0 && threadIdx.x == 0) { u32 z0 = 0u; asm volatile("" : "+v"(z0)); ((u32*)(p->ws + OFF_CNT))[0] = z0; }
      for (int r4 = 0; r4 < REP4; ++r4) nsa_phase_c(p, l, smem);
    }
    xcd_barrier(xb);
    {
      KP p = kargs();
      if (obid() < 32) for (int rs = 0; rs < REPSCAN; ++rs) gdn_scan(p, smem, obid());
      u32* CNT = (u32*)(p->ws + OFF_CNT);
      for (;;) {
        __syncthreads();
        if (threadIdx.x == 0) s_tile = (int)atomicAdd(&CNT[0], 1u);
        __syncthreads();
        int tile = s_tile;
        if (tile >= 1024) break;
        nsa_s_tile(p, l, smem, tile);
      }
    }
    xcd_barrier(xb);
    }
    {
      KP p = kargs();
      for (int re = 0; re < REPE; ++re) gdn_finalize(p, l);
      for (int xs = 0; xs < XSYNC; ++xs) xcd_barrier(xb);
    }
    xcd_barrier(xb);
    {
      KP p = kargs();
      gemm_phase((const u16*)(p->ws + OFF_H), DM, (const u16*)(p->ws + OFF_W + W_OUT), DM, DM, 128, 8, smem,
                 EpiResid{l == 0 ? p->x_in : p->out, p->out});
    }
    xcd_barrier(xb);
    {
      KP p = kargs();
      for (int re = 0; re < REPE; ++re) rmsnorm_rows(p->out, p->ffn_norm + l * DM, (u16*)(p->ws + OFF_H));
    }
    xcd_barrier(xb);
    {
      KP p = kargs();
      for (int rep = 0; rep < REPG; ++rep)
      gemm_phase((const u16*)(p->ws + OFF_H), DM, (const u16*)(p->ws + OFF_W + W_GU), DM, DM, 128, 44, smem,
                 EpiSwiGLU{(u16*)(p->ws + OFF_PROJ)});
    }
    xcd_barrier(xb);
    {
      KP p = kargs();
      gemm_phase((const u16*)(p->ws + OFF_PROJ), DFF, (const u16*)(p->ws + OFF_W + W_DOWN), DFF, DFF, 128, 8, smem,
                 EpiResid{p->out, p->out});
    }
    xcd_barrier(xb);
  }
}

extern "C" void kernel_launch(void* const* d_in, const int* in_sizes, int n_in, void* d_out, int out_size, void* d_ws,
                              size_t ws_size, hipStream_t stream) {
  static int grid_blocks = 0;
  if (!grid_blocks) {
    int dev = 0, cus = 0, per_cu = 0;
    hipGetDevice(&dev);
    hipDeviceGetAttribute(&cus, hipDeviceAttributeMultiprocessorCount, dev);
    hipOccupancyMaxActiveBlocksPerMultiprocessor(&per_cu, hymba_mega, 256, 0);
    if (per_cu > 2) per_cu = 2;
    if (per_cu < 1) per_cu = 1;
    grid_blocks = cus * per_cu;
    grid_blocks &= ~7;
  }
  Params p;
  memset(&p, 0, sizeof(p));
  p.x_in = (const float*)d_in[0]; p.positions = (const int*)d_in[1]; p.attn_norm = (const float*)d_in[2];
  p.w_in = (const float*)d_in[3]; p.gdn_conv_w = (const float*)d_in[4]; p.gdn_a_log = (const float*)d_in[5];
  p.gdn_dt_bias = (const float*)d_in[6]; p.gdn_norm = (const float*)d_in[7]; p.nsa_q_norm = (const float*)d_in[8];
  p.nsa_k_norm = (const float*)d_in[9]; p.cmp_pe = (const float*)d_in[10]; p.cmp_w1 = (const float*)d_in[11];
  p.cmp_w2 = (const float*)d_in[12]; p.conv_w = (const float*)d_in[13]; p.w_out = (const float*)d_in[14];
  p.ffn_norm = (const float*)d_in[15]; p.w_gate_up = (const float*)d_in[16]; p.w_down = (const float*)d_in[17];
  p.out = (float*)d_out; p.ws = (char*)d_ws;
  hipMemsetAsync((char*)d_ws + OFF_CNT, 0, 4096 + XCD_BAR_WORDS * 4, stream);
  void* args[] = {&p};
  hipError_t e = hipLaunchCooperativeKernel((void*)hymba_mega, dim3(grid_blocks), dim3(256), args, 0, stream);
  if (e != hipSuccess) fprintf(stderr, "cooperative launch failed: %s (grid %d)\n", hipGetErrorString(e), grid_blocks);
}
```

```cpp
#include <hip/hip_runtime.h>
#include <hip/hip_cooperative_groups.h>
#include <cstdio>
#include <cmath>
#include <cstring>
namespace cg = cooperative_groups;

#ifndef ZTEST
#define ZTEST 0
#endif
typedef unsigned short u16;
typedef unsigned int u32;
typedef __attribute__((ext_vector_type(8))) short bf16x8;
typedef __attribute__((ext_vector_type(4))) short bf16x4;
typedef __attribute__((ext_vector_type(4))) float f32x4;

constexpr int NB = 2, T = 16384, NTOK = NB * T, DM = 1024, DFF = 2816, DEPTH = 4;
constexpr int PJ = 3072;
constexpr int C_GQ = 0, C_GK = 256, C_GV = 512, C_GZ = 768, C_NQ = 1024, C_KCMP = 1536, C_VCMP = 1664,
              C_KSLC = 1792, C_VSLC = 1920, C_KWIN = 2048, C_VWIN = 2176, C_CB = 2304, C_CC = 2560, C_CX = 2816;
constexpr size_t MiB = 1ull << 20;
constexpr size_t OFF_H = 0, OFF_PROJ = 64 * MiB, OFF_SMALL = 256 * MiB, OFF_W = 260 * MiB, OFF_GDN = 288 * MiB,
                 OFF_OG = 384 * MiB, OFF_OC = 416 * MiB, OFF_VT = 480 * MiB, OFF_KC = 496 * MiB, OFF_SEL = 497 * MiB,
                 OFF_ROPE = 499 * MiB, OFF_GL = 501 * MiB, OFF_CNT = 501 * MiB + 65536;
constexpr size_t W_IN = 0, W_OUT = 6553600, W_GU = 8650752, W_DOWN = 20185088, W_C1 = 25952256, W_C2 = 26476544;
constexpr int CHUNK_B = 49152;
constexpr float SC2 = 0.125f * 1.4426950408889634f;

struct Params {
  const float* x_in; const int* positions; const float* attn_norm; const float* w_in; const float* gdn_conv_w;
  const float* gdn_a_log; const float* gdn_dt_bias; const float* gdn_norm; const float* nsa_q_norm;
  const float* nsa_k_norm; const float* cmp_pe; const float* cmp_w1; const float* cmp_w2; const float* conv_w;
  const float* w_out; const float* ffn_norm; const float* w_gate_up; const float* w_down;
  float* out; char* ws;
  float inv_freq[8];
};


__device__ __forceinline__ int otid() { int t = threadIdx.x; asm volatile("" : "+v"(t)); return t; }
__device__ __forceinline__ int obid() { int t = blockIdx.x; asm volatile("" : "+s"(t)); return t; }
typedef const __attribute__((address_space(4))) Params* KP;
__device__ __forceinline__ KP kargs() {
  KP k = (KP)__builtin_amdgcn_kernarg_segment_ptr();
  asm volatile("" : "+s"(k));
  return k;
}

typedef __bf16 bf2_t __attribute__((ext_vector_type(2)));
typedef float f2_t __attribute__((ext_vector_type(2)));
__device__ __forceinline__ u32 pack2(float a, float b) {
  f2_t v = {a, b};
  bf2_t r = __builtin_convertvector(v, bf2_t);
  return __builtin_bit_cast(u32, r);
}
__device__ __forceinline__ u16 f2bf(float f) { return (u16)(pack2(f, 0.f) & 0xffffu); }
__device__ __forceinline__ float bf2f(u16 h) { return __uint_as_float(((u32)h) << 16); }
__device__ __forceinline__ float wave_sum(float v) {
#pragma unroll
  for (int o = 32; o; o >>= 1) v += __shfl_xor(v, o);
  return v;
}
__device__ __forceinline__ float sigmoidf_(float x) { return 1.f / (1.f + __expf(-x)); }
__device__ __forceinline__ f32x4 mfma16(bf16x8 a, bf16x8 b, f32x4 c) {
  return __builtin_amdgcn_mfma_f32_16x16x32_bf16(a, b, c, 0, 0, 0);
}
__device__ __forceinline__ bf16x8 pack8(f32x4 a, f32x4 b) {
  union { bf16x8 v; u32 u[4]; } r;
  r.u[0] = pack2(a[0], a[1]); r.u[1] = pack2(a[2], a[3]);
  r.u[2] = pack2(b[0], b[1]); r.u[3] = pack2(b[2], b[3]);
  return r.v;
}

__device__ __forceinline__ void rmsnorm_rows(const float* __restrict__ x, const float* __restrict__ gain, u16* __restrict__ h) {
  int lane = otid() & 63;
  int gw = obid() * 4 + (otid() >> 6), nw = gridDim.x * 4;
  for (int row = gw; row < NTOK; row += nw) {
    const float4* xr = (const float4*)(x + (size_t)row * DM);
    float4 v[4];
    float ss = 0.f;
#pragma unroll
    for (int i = 0; i < 4; ++i) {
      v[i] = xr[lane + 64 * i];
      ss += v[i].x * v[i].x + v[i].y * v[i].y + v[i].z * v[i].z + v[i].w * v[i].w;
    }
    ss = wave_sum(ss);
    float rs = rsqrtf(ss * (1.f / DM) + 1e-6f);
#pragma unroll
    for (int i = 0; i < 4; ++i) {
      float4 g = ((const float4*)gain)[lane + 64 * i];
      uint2 o;
      o.x = pack2(v[i].x * rs * g.x, v[i].y * rs * g.y);
      o.y = pack2(v[i].z * rs * g.z, v[i].w * rs * g.w);
      *(uint2*)(h + (size_t)row * DM + (lane + 64 * i) * 4) = o;
    }
  }
}

struct MapId { __device__ int operator()(int n) const { return n; } };
struct MapIn {
  __device__ int operator()(int n) const {
    if (n < 1024) return n;
    if (n < 2304) return n + 8;
    if (n < 3072) return n + 32;
    if (n < 3080) return n - 3072 + 1024;
    if (n < 3104) return n - 3080 + 2312;
    return -1;
  }
};
struct MapGU {
  __device__ int operator()(int n) const {
    int grp = n >> 6, r = n & 63;
    return r < 32 ? grp * 32 + r : DFF + grp * 32 + (r - 32);
  }
};
template <class Map>
__device__ __forceinline__ void transpose_tile(const float* __restrict__ src, int lds_, Map map, u16* __restrict__ dst, int ldd, int n0,
                               int k0, float* t) {
  int tid = otid();
#pragma unroll 4
  for (int i = 0; i < 16; ++i) {
    int k = i * 4 + (tid >> 6), n = tid & 63;
    int sn = map(n0 + n);
    t[k * 65 + n] = sn >= 0 ? src[(size_t)(k0 + k) * lds_ + sn] : 0.f;
  }
  __syncthreads();
#pragma unroll 4
  for (int i = 0; i < 16; ++i) {
    int n = i * 4 + (tid >> 6), k = tid & 63;
    dst[(size_t)(n0 + n) * ldd + k0 + k] = f2bf(t[k * 65 + n]);
  }
  __syncthreads();
}

__device__ __forceinline__ void convert_weights(KP p, int l, char* smem) {
  float* t = (float*)smem;
  char* W = p->ws + OFF_W;
  const int J0 = 800, J1 = J0 + 256, J2 = J1 + 1408, J3 = J2 + 704, J4 = J3 + 64, J5 = J4 + 2;
  for (int job = obid(); job < J5; job += gridDim.x) {
    if (job < J0) {
      transpose_tile(p->w_in + (size_t)l * DM * 3104, 3104, MapIn(), (u16*)(W + W_IN), 1024, (job >> 4) * 64,
                     (job & 15) * 64, t);
    } else if (job < J1) {
      int j = job - J0;
      transpose_tile(p->w_out + (size_t)l * DM * DM, 1024, MapId(), (u16*)(W + W_OUT), 1024, (j >> 4) * 64,
                     (j & 15) * 64, t);
    } else if (job < J2) {
      int j = job - J1;
      transpose_tile(p->w_gate_up + (size_t)l * DM * 2 * DFF, 2 * DFF, MapGU(), (u16*)(W + W_GU), 1024, (j >> 4) * 64,
                     (j & 15) * 64, t);
    } else if (job < J3) {
      int j = job - J2;
      transpose_tile(p->w_down + (size_t)l * DFF * DM, 1024, MapId(), (u16*)(W + W_DOWN), DFF, (j / 44) * 64,
                     (j % 44) * 64, t);
    } else if (job < J4) {
      int j = job - J3;
      int which = j >> 5, kt = j & 31;
      transpose_tile(p->cmp_w1 + (size_t)(l * 2 + which) * 2048 * 64, 64, MapId(),
                     (u16*)(W + W_C1) + (size_t)which * 64 * 2048, 2048, 0, kt * 64, t);
    } else {
      int which = job - J4;
      transpose_tile(p->cmp_w2 + (size_t)(l * 2 + which) * 64 * 64, 64, MapId(), (u16*)(W + W_C2) + which * 4096, 64, 0,
                     0, t);
    }
  }
}

#define WAIT_VM(n) asm volatile("s_waitcnt vmcnt(" #n ")" ::: "memory")
#define RAW_BAR() do { asm volatile("s_waitcnt lgkmcnt(0)" ::: "memory"); __builtin_amdgcn_s_barrier(); } while (0)
typedef __attribute__((ext_vector_type(16))) float f32x16;
template <class Epi>
__device__ __forceinline__ void gemm_phase(const u16* __restrict__ A, int lda, const u16* __restrict__ Bt, int ldb, int K, int ntm,
                           int ntn, char* smem, Epi epi) {
  const int tid = otid(), lane = tid & 63, wv = tid >> 6;
  const int wm = wv >> 1, wn = wv & 1, l31 = lane & 31, hi = lane >> 5;
  const int ntiles = ntm * ntn, nk = K >> 5;
  const int lrow = tid >> 2, lc = tid & 3;
  const int woff = lrow * 64 + ((lc ^ ((lrow >> 2) & 3)) * 16);
  const int sw = (l31 >> 2) & 3;
  const int arow = (wm * 128 + l31) * 64, brow = 16384 + (wn * 64 + l31) * 64;
#define TILE_DECODE(id_, row0_, col0_, tn_)                                                  \
  do {                                                                                       \
    int xcd_ = (id_) & 7, loc_ = (id_) >> 3;                                                 \
    int per_rb_ = 8 * ntn;                                                                   \
    int rb_ = loc_ / per_rb_, rem_ = loc_ % per_rb_;                                         \
    int cb_ = rem_ >> 6, rem2_ = rem_ & 63;                                                  \
    int width_ = (cb_ + 1) * 8 <= ntn ? 8 : ntn - cb_ * 8;                                   \
    int tm_l_ = rb_ * 8 + rem2_ / width_;                                                    \
    tn_ = cb_ * 8 + rem2_ % width_;                                                          \
    row0_ = (tm_l_ * 8 + xcd_) * 256;                                                        \
    col0_ = tn_ * 128;                                                                       \
  } while (0)
#define G_LOAD(R, kt_)                                                       \
  do {                                                                       \
    R##a0 = *(const uint4*)(gA + (kt_) * 32);                                \
    R##a1 = *(const uint4*)(gA + a64 + (kt_) * 32);                          \
    R##a2 = *(const uint4*)(gA + 2 * a64 + (kt_) * 32);                      \
    R##a3 = *(const uint4*)(gA + 3 * a64 + (kt_) * 32);                      \
    R##b0 = *(const uint4*)(gB + (kt_) * 32);                                \
    R##b1 = *(const uint4*)(gB + b64 + (kt_) * 32);                          \
  } while (0)
#define G_WRITE(R, slot_)                                                    \
  do {                                                                       \
    char* st_ = smem + (slot_) * 24576 + woff;                               \
    *(uint4*)(st_) = R##a0;                                                  \
    *(uint4*)(st_ + 4096) = R##a1;                                           \
    *(uint4*)(st_ + 8192) = R##a2;                                           \
    *(uint4*)(st_ + 12288) = R##a3;                                          \
    *(uint4*)(st_ + 16384) = R##b0;                                          \
    *(uint4*)(st_ + 20480) = R##b1;                                          \
  } while (0)
#define G_KSTEP(st_, ks_)                                                                        \
  do {                                                                                           \
    const int po_ = (((ks_) * 2 + hi) ^ sw) * 16;                                                \
    bf16x8 b0_ = *(const bf16x8*)(st_ + brow + po_), b1_ = *(const bf16x8*)(st_ + brow + 2048 + po_); \
    bf16x8 a0_ = *(const bf16x8*)(st_ + arow + po_), a1_ = *(const bf16x8*)(st_ + arow + 2048 + po_); \
    bf16x8 a2_ = *(const bf16x8*)(st_ + arow + 4096 + po_), a3_ = *(const bf16x8*)(st_ + arow + 6144 + po_); \
    acc[0][0] = __builtin_amdgcn_mfma_f32_32x32x16_bf16(b0_, a0_, acc[0][0], 0, 0, 0);           \
    acc[0][1] = __builtin_amdgcn_mfma_f32_32x32x16_bf16(b1_, a0_, acc[0][1], 0, 0, 0);           \
    acc[1][0] = __builtin_amdgcn_mfma_f32_32x32x16_bf16(b0_, a1_, acc[1][0], 0, 0, 0);           \
    acc[1][1] = __builtin_amdgcn_mfma_f32_32x32x16_bf16(b1_, a1_, acc[1][1], 0, 0, 0);           \
    acc[2][0] = __builtin_amdgcn_mfma_f32_32x32x16_bf16(b0_, a2_, acc[2][0], 0, 0, 0);           \
    acc[2][1] = __builtin_amdgcn_mfma_f32_32x32x16_bf16(b1_, a2_, acc[2][1], 0, 0, 0);           \
    acc[3][0] = __builtin_amdgcn_mfma_f32_32x32x16_bf16(b0_, a3_, acc[3][0], 0, 0, 0);           \
    acc[3][1] = __builtin_amdgcn_mfma_f32_32x32x16_bf16(b1_, a3_, acc[3][1], 0, 0, 0);           \
  } while (0)
#define G_COMPUTE(slot_)                                   \
  do {                                                     \
    const char* st_ = smem + (slot_) * 24576;              \
    __builtin_amdgcn_s_setprio(1);                         \
    G_KSTEP(st_, 0); G_KSTEP(st_, 1);                      \
    __builtin_amdgcn_s_setprio(0);                         \
  } while (0)
#define G_ITER(u_, RN, sn_)                                                   \
  {                                                                           \
    const int k_ = kt + (u_);                                                 \
    G_WRITE(RN, sn_);                         \
    { const int kl_ = k_ + 3 < nk ? k_ + 3 : nk - 1; G_LOAD(RN, kl_); }    \
    G_COMPUTE(u_);                                                            \
    RAW_BAR();                                                                \
  }
  const size_t a64 = (size_t)64 * lda, b64 = (size_t)64 * ldb;
  int id = obid();
  int row0 = 0, col0 = 0, tn = 0;
  const u16 *gA = A, *gB = Bt;
  uint4 R0a0, R0a1, R0a2, R0a3, R0b0, R0b1, R1a0, R1a1, R1a2, R1a3, R1b0, R1b1;
  if (id < ntiles) {
    TILE_DECODE(id, row0, col0, tn);
    gA = A + (size_t)(row0 + lrow) * lda + lc * 8;
    gB = Bt + (size_t)(col0 + lrow) * ldb + lc * 8;
    G_LOAD(R0, 0);
    G_LOAD(R1, 1);
  }
  while (id < ntiles) {
    f32x16 acc[4][2];
#pragma unroll
    for (int m = 0; m < 4; ++m)
#pragma unroll
      for (int n = 0; n < 2; ++n)
#pragma unroll
        for (int r = 0; r < 16; ++r) acc[m][n][r] = 0.f;
    G_WRITE(R0, 0);
    G_LOAD(R0, 2);
    RAW_BAR();
    for (int kt = 0; kt < nk; kt += 2) {
      G_ITER(0, R1, 1)
      G_ITER(1, R0, 0)
    }
    const int erow = row0 + wm * 128 + l31, ecol = col0 + wn * 64 + hi * 4, etn = tn;
    id += gridDim.x;
    if (id < ntiles) {
      TILE_DECODE(id, row0, col0, tn);
      gA = A + (size_t)(row0 + lrow) * lda + lc * 8;
      gB = Bt + (size_t)(col0 + lrow) * ldb + lc * 8;
      G_LOAD(R0, 0);
      G_LOAD(R1, 1);
    }
    epi(acc, erow, ecol, etn);
  }
}

struct EpiInProj {
  u16* proj; float* small_;
  __device__ __forceinline__ void operator()(f32x16 (&acc)[4][2], int rbase, int cbase, int tn) const {
    if (tn < 24) {
#pragma unroll
      for (int m = 0; m < 4; ++m)
#pragma unroll
        for (int n = 0; n < 2; ++n)
#pragma unroll
          for (int g = 0; g < 4; ++g) {
            uint2 o;
            o.x = pack2(acc[m][n][g * 4 + 0], acc[m][n][g * 4 + 1]);
            o.y = pack2(acc[m][n][g * 4 + 2], acc[m][n][g * 4 + 3]);
            *(uint2*)(proj + (size_t)(rbase + m * 32) * PJ + cbase + n * 32 + g * 8) = o;
          }
    } else {
#pragma unroll
      for (int m = 0; m < 4; ++m)
#pragma unroll
        for (int g = 0; g < 4; ++g) {
          int c = cbase + g * 8 - 3072;
          if (c < 32)
            *(float4*)(small_ + (size_t)(rbase + m * 32) * 32 + c) =
                make_float4(acc[m][0][g * 4 + 0], acc[m][0][g * 4 + 1], acc[m][0][g * 4 + 2], acc[m][0][g * 4 + 3]);
        }
    }
  }
};
struct EpiResid {
  const float* xin; float* xout;
  __device__ __forceinline__ void operator()(f32x16 (&acc)[4][2], int rbase, int cbase, int tn) const {
#pragma unroll
    for (int m = 0; m < 4; ++m)
#pragma unroll
      for (int n = 0; n < 2; ++n)
#pragma unroll
        for (int g = 0; g < 4; ++g) {
          size_t idx = (size_t)(rbase + m * 32) * DM + cbase + n * 32 + g * 8;
          float4 x = *(const float4*)(xin + idx);
          x.x += acc[m][n][g * 4 + 0]; x.y += acc[m][n][g * 4 + 1]; x.z += acc[m][n][g * 4 + 2]; x.w += acc[m][n][g * 4 + 3];
          *(float4*)(xout + idx) = x;
        }
  }
};
struct EpiSwiGLU {
  u16* act;
  __device__ __forceinline__ void operator()(f32x16 (&acc)[4][2], int rbase, int cbase, int tn) const {
    int grp = cbase >> 6, c4 = cbase & 7;
#pragma unroll
    for (int m = 0; m < 4; ++m)
#pragma unroll
      for (int g = 0; g < 4; ++g) {
        float v[4];
#pragma unroll
        for (int r = 0; r < 4; ++r) {
          float gt = acc[m][0][g * 4 + r], up = acc[m][1][g * 4 + r];
          v[r] = gt / (1.f + __expf(-gt)) * up;
        }
        uint2 o;
        o.x = pack2(v[0], v[1]);
        o.y = pack2(v[2], v[3]);
        *(uint2*)(act + (size_t)(rbase + m * 32) * DFF + grp * 32 + g * 8 + c4) = o;
      }
  }
};

__device__ __forceinline__ void gdn_chunk_prep(KP p, int l, char* smem, int job) {
  const int b = job >> 10, h = (job >> 8) & 3, c = job & 255;
  const int tid = otid(), lane = tid & 63, wv = tid >> 6;
  float* sq = (float*)smem;
  float* sk = sq + 64 * 65;
  float* sv = sk + 64 * 65;
  float* sA = sv + 64 * 65;
  float* sgc = sA + 64 * 64;
  float* sbeta = sgc + 64;
  float* seg = sbeta + 64;
  float* sf2 = seg + 64;
  const u16* proj = (const u16*)(p->ws + OFF_PROJ);
  const float* small_ = (const float*)(p->ws + OFF_SMALL);
  const size_t tok0 = (size_t)b * T + c * 64;
  char* cb = p->ws + OFF_GDN + (size_t)((b * 4 + h) * 256 + c) * CHUNK_B;
  float* UT = (float*)cb;
  u16* NW = (u16*)(cb + 16384);
  u16* QD = (u16*)(cb + 24576);
  u16* KDT = (u16*)(cb + 32768);
  u16* QKM = (u16*)(cb + 40960);
  {
    int d = lane, i0 = wv * 16;
#pragma unroll
    for (int seg_ = 0; seg_ < 3; ++seg_) {
      int ch = seg_ * 256 + h * 64 + d;
      const float* cw = p->gdn_conv_w + (size_t)l * 4 * 768 + ch;
      float w0 = cw[0], w1 = cw[768], w2 = cw[1536], w3 = cw[2304];
      float* dst = seg_ == 0 ? sq : (seg_ == 1 ? sk : sv);
      float x0 = 0, x1 = 0, x2 = 0;
      int tl = c * 64 + i0;
      if (tl - 3 >= 0) x0 = bf2f(proj[(tok0 + i0 - 3) * PJ + ch]);
      if (tl - 2 >= 0) x1 = bf2f(proj[(tok0 + i0 - 2) * PJ + ch]);
      if (tl - 1 >= 0) x2 = bf2f(proj[(tok0 + i0 - 1) * PJ + ch]);
      for (int i = 0; i < 16; ++i) {
        float x3 = bf2f(proj[(tok0 + i0 + i) * PJ + ch]);
        float y = w0 * x0 + w1 * x1 + w2 * x2 + w3 * x3;
        dst[(i0 + i) * 65 + d] = y / (1.f + __expf(-y));
        x0 = x1; x1 = x2; x2 = x3;
      }
    }
  }
  if (tid < 64) {
    float gb = small_[(tok0 + tid) * 32 + h], ga = small_[(tok0 + tid) * 32 + 4 + h];
    float xx = ga + p->gdn_dt_bias[l * 4 + h];
    float sp = fmaxf(xx, 0.f) + log1pf(__expf(-fabsf(xx)));
    float g = -__expf(p->gdn_a_log[l * 4 + h]) * sp;
#pragma unroll
    for (int o = 1; o < 64; o <<= 1) {
      float t = __shfl_up(g, o);
      if (lane >= o) g += t;
    }
    float beta = sigmoidf_(gb);
    float eg = __expf(g);
    sgc[tid] = g; sbeta[tid] = beta; seg[tid] = eg; sf2[tid] = beta * eg;
    if (tid == 63) ((float*)(p->ws + OFF_GL))[(b * 4 + h) * 256 + c] = eg;
  }
  __syncthreads();
  if (tid < 128) {
    float* rowp = (tid < 64 ? sq : sk) + (tid & 63) * 65;
    float ss = 0.f;
#pragma unroll 16
    for (int d = 0; d < 64; ++d) ss += rowp[d] * rowp[d];
    const float sc = rsqrtf(ss + 1e-6f) * (tid < 64 ? 0.125f : 1.f);
#pragma unroll 16
    for (int d = 0; d < 64; ++d) rowp[d] *= sc;
  }
  __syncthreads();
  {
    int ti = tid >> 4, tj = tid & 15;
    float kk[4][4], qk[4][4];
#pragma unroll
    for (int a = 0; a < 4; ++a)
#pragma unroll
      for (int bb = 0; bb < 4; ++bb) { kk[a][bb] = 0.f; qk[a][bb] = 0.f; }
    if (tj <= ti) {
      for (int d = 0; d < 64; ++d) {
        float ki[4], kj[4], qi[4];
#pragma unroll
        for (int a = 0; a < 4; ++a) {
          ki[a] = sk[(ti * 4 + a) * 65 + d];
          qi[a] = sq[(ti * 4 + a) * 65 + d];
          kj[a] = sk[(tj * 4 + a) * 65 + d];
        }
#pragma unroll
        for (int a = 0; a < 4; ++a)
#pragma unroll
          for (int bb = 0; bb < 4; ++bb) { kk[a][bb] += ki[a] * kj[bb]; qk[a][bb] += qi[a] * kj[bb]; }
      }
    }
#pragma unroll
    for (int a = 0; a < 4; ++a) {
      int i = ti * 4 + a;
      float gi = sgc[i], bi = sbeta[i];
      uint2 o;
      float qv[4];
#pragma unroll
      for (int bb = 0; bb < 4; ++bb) {
        int j = tj * 4 + bb;
        float dec = (j <= i) ? __expf(gi - sgc[j]) : 0.f;
        sA[i * 64 + j] = (j < i) ? bi * kk[a][bb] * dec : 0.f;
        qv[bb] = qk[a][bb] * dec;
      }
      o.x = pack2(qv[0], qv[1]); o.y = pack2(qv[2], qv[3]);
      *(uint2*)(QKM + i * 64 + tj * 4) = o;
    }
  }
  {
    float gl = sgc[63];
    for (int idx = tid; idx < 4096; idx += 256) {
      int i = idx >> 6, d = idx & 63;
      QD[idx] = f2bf(sq[i * 65 + d] * seg[i]);
      KDT[idx] = f2bf(sk[d * 65 + i] * __expf(gl - sgc[d]));
    }
  }
  __syncthreads();
  if (tid < 128) {
    int cidx = tid;
    const float* src = cidx < 64 ? sv + cidx : sk + (cidx - 64);
    const float* fac = cidx < 64 ? sbeta : sf2;
    float x[64];
#pragma unroll
    for (int i = 0; i < 64; ++i) {
      float s0 = src[i * 65] * fac[i], s1 = 0.f, s2 = 0.f, s3 = 0.f;
#pragma unroll
      for (int j = 0; j < i; ++j) {
        if ((j & 3) == 0) s0 -= sA[i * 64 + j] * x[j];
        else if ((j & 3) == 1) s1 -= sA[i * 64 + j] * x[j];
        else if ((j & 3) == 2) s2 -= sA[i * 64 + j] * x[j];
        else s3 -= sA[i * 64 + j] * x[j];
      }
      x[i] = (s0 + s1) + (s2 + s3);
    }
    if (cidx < 64) {
#pragma unroll
      for (int i = 0; i < 64; i += 4) *(float4*)(UT + cidx * 64 + i) = make_float4(x[i], x[i + 1], x[i + 2], x[i + 3]);
    } else {
#pragma unroll
      for (int i = 0; i < 64; ++i) NW[i * 64 + (cidx - 64)] = f2bf(-x[i]);
    }
  }
  __syncthreads();
}

__device__ __forceinline__ void gdn_scan(KP p, char* smem, int sid) {
  const int b = sid >> 4, h = (sid >> 2) & 3, v0 = (sid & 3) * 16;
  const int tid = otid(), lane = tid & 63, wv = tid >> 6, l15 = lane & 15, quad = lane >> 4;
  u16* Sb = (u16*)smem;
  u16* Vb = Sb + 16 * 72;
  f32x4 S = {0.f, 0.f, 0.f, 0.f};
  { u32 z0 = 0u; asm volatile("" : "+v"(z0)); *(uint2*)(Sb + l15 * 72 + 16 * wv + quad * 4) = make_uint2(z0, z0); }
  __syncthreads();
  const char* gbase = p->ws + OFF_GDN + (size_t)((b * 4 + h) * 256) * CHUNK_B;
  const float* GL = (const float*)(p->ws + OFF_GL) + (b * 4 + h) * 256;
  float* OG = (float*)(p->ws + OFF_OG);
  const int arow = (16 * wv + l15) * 64 + quad * 8;
  f32x4 u, un;
  bf16x8 wA[2], qdA[2], qkA[2], kdA[2], wAn[2], qdAn[2], qkAn[2], kdAn[2];
  float gl, gln;
  {
    const char* cb = gbase;
    u = *(const f32x4*)((const float*)cb + (v0 + l15) * 64 + 16 * wv + quad * 4);
#pragma unroll
    for (int ks = 0; ks < 2; ++ks) {
      wA[ks] = *(const bf16x8*)((const u16*)(cb + 16384) + arow + ks * 32);
      qdA[ks] = *(const bf16x8*)((const u16*)(cb + 24576) + arow + ks * 32);
      kdA[ks] = *(const bf16x8*)((const u16*)(cb + 32768) + arow + ks * 32);
      qkA[ks] = *(const bf16x8*)((const u16*)(cb + 40960) + arow + ks * 32);
    }
    gl = GL[0];
  }
  for (int c = 0; c < 256; ++c) {
    if (c + 1 < 256) {
      const char* cb = gbase + (size_t)(c + 1) * CHUNK_B;
      un = *(const f32x4*)((const float*)cb + (v0 + l15) * 64 + 16 * wv + quad * 4);
#pragma unroll
      for (int ks = 0; ks < 2; ++ks) {
        wAn[ks] = *(const bf16x8*)((const u16*)(cb + 16384) + arow + ks * 32);
        qdAn[ks] = *(const bf16x8*)((const u16*)(cb + 24576) + arow + ks * 32);
        kdAn[ks] = *(const bf16x8*)((const u16*)(cb + 32768) + arow + ks * 32);
        qkAn[ks] = *(const bf16x8*)((const u16*)(cb + 40960) + arow + ks * 32);
      }
      gln = GL[c + 1];
    }
    bf16x8 sB0 = *(const bf16x8*)(Sb + l15 * 72 + quad * 8);
    bf16x8 sB1 = *(const bf16x8*)(Sb + l15 * 72 + 32 + quad * 8);
    f32x4 vn = u;
    vn = mfma16(wA[0], sB0, vn);
    vn = mfma16(wA[1], sB1, vn);
    f32x4 o = {0.f, 0.f, 0.f, 0.f};
    o = mfma16(qdA[0], sB0, o);
    o = mfma16(qdA[1], sB1, o);
    *(uint2*)(Vb + l15 * 72 + 16 * wv + quad * 4) = make_uint2(pack2(vn[0], vn[1]), pack2(vn[2], vn[3]));
    __syncthreads();
    bf16x8 vB0 = *(const bf16x8*)(Vb + l15 * 72 + quad * 8);
    bf16x8 vB1 = *(const bf16x8*)(Vb + l15 * 72 + 32 + quad * 8);
    o = mfma16(qkA[0], vB0, o);
    o = mfma16(qkA[1], vB1, o);
    S[0] *= gl; S[1] *= gl; S[2] *= gl; S[3] *= gl;
    S = mfma16(kdA[0], vB0, S);
    S = mfma16(kdA[1], vB1, S);
    *(uint2*)(Sb + l15 * 72 + 16 * wv + quad * 4) = make_uint2(pack2(S[0], S[1]), pack2(S[2], S[3]));
    size_t orow = (size_t)b * T + c * 64 + 16 * wv + quad * 4;
#pragma unroll
    for (int r = 0; r < 4; ++r) OG[(orow + r) * 256 + h * 64 + v0 + l15] = o[r];
    __syncthreads();
    u = un; gl = gln;
#pragma unroll
    for (int ks = 0; ks < 2; ++ks) { wA[ks] = wAn[ks]; qdA[ks] = qdAn[ks]; kdA[ks] = kdAn[ks]; qkA[ks] = qkAn[ks]; }
  }
}

__device__ __forceinline__ void gdn_finalize(KP p, int l) {
  const int lane = otid() & 63;
  int gw = obid() * 4 + (otid() >> 6), nw = gridDim.x * 4;
  const float* OG = (const float*)(p->ws + OFF_OG);
  const u16* proj = (const u16*)(p->ws + OFF_PROJ);
  u16* mix = (u16*)(p->ws + OFF_H);
  float gn = p->gdn_norm[l * 64 + lane];
  for (int row = gw; row < NTOK * 4; row += nw) {
    int t = row >> 2, h = row & 3;
    float o = OG[(size_t)t * 256 + h * 64 + lane];
    float ss = wave_sum(o * o);
    float z = bf2f(proj[(size_t)t * PJ + C_GZ + h * 64 + lane]);
    float y = o * rsqrtf(ss * (1.f / 64.f) + 1e-6f) * gn * (z / (1.f + __expf(-z)));
    mix[(size_t)t * DM + h * 64 + lane] = f2bf(ZTEST == 4 ? 0.f : y);
  }
}

__device__ __forceinline__ void rope_table(KP p) {
  float* rp = (float*)(p->ws + OFF_ROPE);
  int gt = obid() * blockDim.x + otid(), nt = gridDim.x * blockDim.x;
  for (int idx = gt; idx < NTOK * 8; idx += nt) {
    int t = idx >> 3, i = idx & 7;
    float ang = (float)p->positions[t] * p->inv_freq[i];
    float sn, cs;
    sincosf(ang, &sn, &cs);
    rp[t * 16 + i] = cs;
    rp[t * 16 + 8 + i] = sn;
  }
}

__device__ __forceinline__ void nsa_token_prep(KP p, int l, char* smem, int tb) {
  const int tid = otid(), lane = tid & 63, wv = tid >> 6;
  const int b = tb >> 8, blk = tb & 255;
  u16* proj = (u16*)(p->ws + OFF_PROJ);
  const float* rope = (const float*)(p->ws + OFF_ROPE);
  const size_t tok0 = (size_t)tb * 64;
  for (int r = tid; r < 768; r += 256) {
    int i = r / 12, which = r % 12;
    size_t t = tok0 + i;
    int col; const float* gain;
    if (which < 8) { col = C_NQ + which * 64; gain = p->nsa_q_norm + l * 64; }
    else if (which < 10) { col = C_KSLC + (which - 8) * 64; gain = p->nsa_k_norm + (l * 3 + 1) * 64; }
    else { col = C_KWIN + (which - 10) * 64; gain = p->nsa_k_norm + (l * 3 + 2) * 64; }
    u16* rowp = proj + t * PJ + col;
    union { uint4 q; u16 h[8]; } v[8];
    float ss = 0.f;
#pragma unroll
    for (int c = 0; c < 8; ++c) {
      v[c].q = *(const uint4*)(rowp + c * 8);
#pragma unroll
      for (int e = 0; e < 8; ++e) { float x = bf2f(v[c].h[e]); ss += x * x; }
    }
    const float rs = rsqrtf(ss * (1.f / 64.f) + 1e-6f);
    float y0[16];
#pragma unroll
    for (int e = 0; e < 16; ++e) y0[e] = bf2f(v[e >> 3].h[e & 7]) * rs * gain[e];
    if (which >= 8) {
      const float* rp = rope + t * 16;
#pragma unroll
      for (int e = 0; e < 8; ++e) {
        float c = rp[e], sn = rp[8 + e];
        float a1 = y0[e], a2 = y0[8 + e];
        y0[e] = a1 * c - a2 * sn;
        y0[8 + e] = a2 * c + a1 * sn;
      }
    }
#pragma unroll
    for (int c = 0; c < 8; ++c) {
      uint4 o;
      float y[8];
#pragma unroll
      for (int e = 0; e < 8; ++e) y[e] = c < 2 ? y0[c * 8 + e] : bf2f(v[c].h[e]) * rs * gain[c * 8 + e];
      o.x = pack2(y[0], y[1]); o.y = pack2(y[2], y[3]); o.z = pack2(y[4], y[5]); o.w = pack2(y[6], y[7]);
      *(uint4*)(rowp + c * 8) = o;
    }
  }
  u16* tt = (u16*)smem;
  for (int z = 0; z < 4; ++z) {
    int tensor = z >> 1, g = z & 1;
    int col = (tensor ? C_VWIN : C_VSLC) + g * 64;
    for (int idx = tid; idx < 4096; idx += 256) {
      int i = idx >> 6, d = idx & 63;
      tt[i * 66 + d] = proj[(tok0 + i) * PJ + col + d];
    }
    __syncthreads();
    u16* dst = (u16*)(p->ws + OFF_VT + (size_t)tensor * 8 * MiB) + ((size_t)((b * 2 + g) * 256 + blk)) * 4096;
    for (int idx = tid; idx < 4096; idx += 256) {
      int d = idx >> 6, i = idx & 63;
      dst[idx] = tt[i * 66 + d];
    }
    __syncthreads();
  }
  {
    int ch = tid;
    const float* cw = p->conv_w + (size_t)l * 3 * 256 + ch;
    float w0 = cw[0], w1 = cw[256], w2 = cw[512];
    u16* mix = (u16*)(p->ws + OFF_H);
    float p0 = 0.f, p1 = 0.f;
    if (blk > 0) {
      p0 = bf2f(proj[(tok0 - 2) * PJ + C_CC + ch]) * bf2f(proj[(tok0 - 2) * PJ + C_CX + ch]);
      p1 = bf2f(proj[(tok0 - 1) * PJ + C_CC + ch]) * bf2f(proj[(tok0 - 1) * PJ + C_CX + ch]);
    }
    for (int i = 0; i < 64; ++i) {
      size_t t = tok0 + i;
      float p2 = bf2f(proj[t * PJ + C_CC + ch]) * bf2f(proj[t * PJ + C_CX + ch]);
      float y = w0 * p0 + w1 * p1 + w2 * p2;
      mix[t * DM + 768 + ch] = f2bf(ZTEST == 5 ? 0.f : bf2f(proj[t * PJ + C_CB + ch]) * y);
      p0 = p1; p1 = p2;
    }
  }
}

__device__ __forceinline__ void nsa_compress(KP p, int l, char* smem, int job) {
  const int tid = otid(), lane = tid & 63, wv = tid >> 6, l15 = lane & 15, quad = lane >> 4;
  const int which = job >> 6, b = (job >> 5) & 1, g = (job >> 4) & 1, tile = job & 15;
  const u16* proj = (const u16*)(p->ws + OFF_PROJ);
  const u16* W1T = (const u16*)(p->ws + OFF_W + W_C1) + (size_t)which * 64 * 2048;
  const u16* W2T = (const u16*)(p->ws + OFF_W + W_C2) + which * 4096;
  const float* pe = p->cmp_pe + (size_t)(l * 2 + which) * 32 * 64;
  const int blk0 = tile * 64 + wv * 16;
  int blk = blk0 + l15;
  int blkc = blk < 1023 ? blk : 1022;
  const u16* arow = proj + ((size_t)b * T + blkc * 16) * PJ + (which ? C_VCMP : C_KCMP) + g * 64;
  f32x4 acc[4];
#pragma unroll
  for (int n = 0; n < 4; ++n) acc[n] = f32x4{0.f, 0.f, 0.f, 0.f};
  for (int ks = 0; ks < 64; ++ks) {
    int tok = ks >> 1, d0 = (ks & 1) * 32 + quad * 8;
    uint4 raw = *(const uint4*)(arow + (size_t)tok * PJ + d0);
    float4 pe0 = *(const float4*)(pe + tok * 64 + d0), pe1 = *(const float4*)(pe + tok * 64 + d0 + 4);
    union { bf16x8 v; u32 u[4]; } af;
    af.u[0] = pack2(bf2f(raw.x & 0xffff) + pe0.x, bf2f(raw.x >> 16) + pe0.y);
    af.u[1] = pack2(bf2f(raw.y & 0xffff) + pe0.z, bf2f(raw.y >> 16) + pe0.w);
    af.u[2] = pack2(bf2f(raw.z & 0xffff) + pe1.x, bf2f(raw.z >> 16) + pe1.y);
    af.u[3] = pack2(bf2f(raw.w & 0xffff) + pe1.z, bf2f(raw.w >> 16) + pe1.w);
#pragma unroll
    for (int n = 0; n < 4; ++n) {
      bf16x8 bfr = *(const bf16x8*)(W1T + (size_t)(n * 16 + l15) * 2048 + ks * 32 + quad * 8);
      acc[n] = mfma16(af.v, bfr, acc[n]);
    }
  }
  u16* hid = (u16*)smem + wv * 16 * 72;
#pragma unroll
  for (int n = 0; n < 4; ++n)
#pragma unroll
    for (int r = 0; r < 4; ++r) {
      float x = acc[n][r];
      float u = 0.7978845608028654f * (x + 0.044715f * x * x * x);
      float gl = 0.5f * x * (1.f + tanhf(u));
      hid[(quad * 4 + r) * 72 + n * 16 + l15] = f2bf(gl);
    }
  __syncthreads();
  f32x4 o2[4];
#pragma unroll
  for (int n = 0; n < 4; ++n) o2[n] = f32x4{0.f, 0.f, 0.f, 0.f};
#pragma unroll
  for (int ks = 0; ks < 2; ++ks) {
    bf16x8 af = *(const bf16x8*)(hid + l15 * 72 + ks * 32 + quad * 8);
#pragma unroll
    for (int n = 0; n < 4; ++n) {
      bf16x8 bfr = *(const bf16x8*)(W2T + (n * 16 + l15) * 64 + ks * 32 + quad * 8);
      o2[n] = mfma16(af, bfr, o2[n]);
    }
  }
  __syncthreads();
  if (which == 0) {
    u16* KC = (u16*)(p->ws + OFF_KC) + (size_t)(b * 2 + g) * 1024 * 64;
    const float* kg = p->nsa_k_norm + (l * 3 + 0) * 64;
#pragma unroll
    for (int r = 0; r < 4; ++r) {
      float ss = 0.f;
#pragma unroll
      for (int n = 0; n < 4; ++n) ss += o2[n][r] * o2[n][r];
      ss += __shfl_xor(ss, 1); ss += __shfl_xor(ss, 2); ss += __shfl_xor(ss, 4); ss += __shfl_xor(ss, 8);
      float rs = rsqrtf(ss * (1.f / 64.f) + 1e-6f);
      int row = blk0 + quad * 4 + r;
#pragma unroll
      for (int n = 0; n < 4; ++n) {
        float v = row < 1023 ? o2[n][r] * rs * kg[n * 16 + l15] : 0.f;
        KC[(size_t)row * 64 + n * 16 + l15] = f2bf(v);
      }
    }
  } else {
    u16* VCT = (u16*)(p->ws + OFF_KC + 524288) + (size_t)(b * 2 + g) * 64 * 1024;
#pragma unroll
    for (int r = 0; r < 4; ++r) {
      int row = blk0 + quad * 4 + r;
#pragma unroll
      for (int n = 0; n < 4; ++n) {
        float v = row < 1023 ? o2[n][r] : 0.f;
        VCT[(size_t)(n * 16 + l15) * 1024 + row] = f2bf(v);
      }
    }
  }
}

template <int MODE, int NT>
__device__ __forceinline__ void flash2(const u16* __restrict__ Kg, int kld, const u16* __restrict__ VTg, int vblk,
                                       int vld, int h0, int h1, char* sStage, const u16* sQw, f32x4 (&O)[4][NT],
                                       float (&lsum)[NT], const float (&inv)[NT], const u32* sSelw, float* slc,
                                       int tq0) {
  const int tid = otid(), lane = tid & 63, wv = tid >> 6, l15 = lane & 15, quad = lane >> 4;
  const int krow = tid >> 3, kc = tid & 7;
  const u16* kptr = Kg + (size_t)krow * kld + kc * 8;
  const int kw = krow * 128 + ((kc ^ ((krow >> 1) & 7)) * 16);
  const int vd = tid >> 2, vc = tid & 3;
  const u16* vptr = VTg + (size_t)vd * vld + vc * 8;
  const int vw = 4096 + vd * 64 + ((vc ^ ((vd >> 2) & 3)) * 16);
  const int jb0 = h0 >> 1, nst = (h1 >> 1) - jb0 + 1;
  uint4 S0k0, S0k1, S0v0, S0v1, S1k0, S1k1, S1v0, S1v1;
#define F2_LOAD(S, i_)                                                                             \
  do {                                                                                             \
    const int jb_ = jb0 + (i_);                                                                    \
    S##k0 = *(const uint4*)(kptr + (size_t)(jb_ * 64) * kld);                                      \
    S##k1 = *(const uint4*)(kptr + (size_t)(jb_ * 64 + 32) * kld);                                 \
    if (MODE != 2) {                                                                               \
      S##v0 = *(const uint4*)(vptr + (size_t)jb_ * vblk);                                          \
      S##v1 = *(const uint4*)(vptr + (size_t)jb_ * vblk + 32);                                     \
    }                                                                                              \
  } while (0)
#define F2_WRITE(S, slot_)                                                     \
  do {                                                                         \
    char* sl_ = sStage + (slot_) * 16384;                                      \
    *(uint4*)(sl_ + kw) = S##k0;                                               \
    *(uint4*)(sl_ + 8192 + kw) = S##k1;                                        \
    if (MODE != 2) {                                                           \
      *(uint4*)(sl_ + vw) = S##v0;                                             \
      *(uint4*)(sl_ + 8192 + vw) = S##v1;                                      \
    }                                                                          \
  } while (0)
  F2_LOAD(S0, 0);
  { const int i1_ = 1 < nst ? 1 : nst - 1; F2_LOAD(S1, i1_); }
  const int koff = l15 * 128;
  const int ksw = (l15 >> 1) & 7;
  const int voff = 4096 + l15 * 64 + (quad & 1) * 8;
  const int vsw = (l15 >> 2) & 3;
  const int tq0u = __builtin_amdgcn_readfirstlane(tq0);
  const int lim0u = tq0u >= 31 ? ((tq0u - 31) >> 4) : -1;
  auto compute = [&](const int h, const char* st) __attribute__((always_inline)) {
    bool interior;
    if (MODE == 0) interior = (h * 32 + 31 <= tq0u) && (h * 32 > tq0u + NT * 4 - 1 - 512);
    else if (MODE == 1) interior = (h * 32 + 31 <= tq0u);
    else interior = (h * 32 + 31 <= lim0u);
    bool bv[NT], an[NT];
    bool anyw = false;
#pragma unroll
    for (int nt = 0; nt < NT; ++nt) {
      if (MODE == 1) {
        u32 w = sSelw[(nt * 4 + (l15 >> 2)) * 8 + (h >> 6)];
        bv[nt] = (w >> ((h >> 1) & 31)) & 1u;
      } else {
        bv[nt] = true;
      }
      an[nt] = MODE == 1 ? (bool)__any(bv[nt]) : true;
      anyw |= an[nt];
    }
    if (anyw) {
      bf16x8 kf[2][2], vf[4];
#pragma unroll
      for (int m2 = 0; m2 < 2; ++m2)
#pragma unroll
        for (int ks = 0; ks < 2; ++ks)
          kf[m2][ks] = *(const bf16x8*)(st + koff + m2 * 2048 + (((ks * 4 + quad) ^ ksw) * 16));
      if (MODE != 2) {
#pragma unroll
        for (int dt = 0; dt < 4; ++dt) {
          union { bf16x8 v; uint2 h2[2]; } u;
          u.h2[0] = *(const uint2*)(st + voff + dt * 1024 + (((quad >> 1) ^ vsw) * 16));
          u.h2[1] = *(const uint2*)(st + voff + dt * 1024 + (((2 + (quad >> 1)) ^ vsw) * 16));
          vf[dt] = u.v;
        }
      }
#pragma unroll
      for (int nt = 0; nt < NT; ++nt) {
        if (!an[nt]) continue;
        const int t = tq0 + nt * 4 + (l15 >> 2);
        const bf16x8 bq0 = *(const bf16x8*)(sQw + (nt * 16 + l15) * 72 + quad * 8);
        const bf16x8 bq1 = *(const bf16x8*)(sQw + (nt * 16 + l15) * 72 + 32 + quad * 8);
        f32x4 s[2];
#pragma unroll
        for (int m2 = 0; m2 < 2; ++m2) {
          s[m2] = f32x4{0.f, 0.f, 0.f, 0.f};
          s[m2] = mfma16(kf[m2][0], bq0, s[m2]);
          s[m2] = mfma16(kf[m2][1], bq1, s[m2]);
        }
        const float bias = MODE == 1 ? (bv[nt] ? 0.f : -1000.f) : (MODE == 3 ? inv[nt] : 0.f);
        if (interior) {
#pragma unroll
          for (int m2 = 0; m2 < 2; ++m2)
#pragma unroll
            for (int r = 0; r < 4; ++r) s[m2][r] = __builtin_amdgcn_exp2f(fmaf(s[m2][r], SC2, bias));
        } else {
          int base;
          if (MODE <= 1) base = h * 32 + quad * 4 - t;
          else base = h * 32 + quad * 4 - (t >= 31 ? ((t - 31) >> 4) : -1);
          asm volatile("" : "+v"(base));
#pragma unroll
          for (int m2 = 0; m2 < 2; ++m2)
#pragma unroll
            for (int r = 0; r < 4; ++r) {
              const int C = m2 * 16 + r;
              bool valid;
              if (MODE == 0) valid = base <= -C && base > -512 - C;
              else valid = base <= -C;
              float pvv = __builtin_amdgcn_exp2f(fmaf(s[m2][r], SC2, bias));
              s[m2][r] = valid ? pvv : 0.f;
            }
        }
        float ls = ((s[0][0] + s[0][1]) + (s[0][2] + s[0][3])) + ((s[1][0] + s[1][1]) + (s[1][2] + s[1][3]));
        if (MODE != 3) lsum[nt] += ls;
        if (MODE == 3) {
#pragma unroll
          for (int m2 = 0; m2 < 2; ++m2) {
            float ow = s[m2][0] + s[m2][1] + s[m2][2] + 0.5f * s[m2][3];
            float sp = 0.5f * s[m2][3];
            ow += __shfl_xor(ow, 1); ow += __shfl_xor(ow, 2);
            sp += __shfl_xor(sp, 1); sp += __shfl_xor(sp, 2);
            if ((l15 & 3) == 0) {
              const int j = h * 8 + m2 * 4 + quad;
              slc[(nt * 4 + (l15 >> 2)) * 256 + j] = ow;
              if (j + 1 < 256) slc[1024 + (nt * 4 + (l15 >> 2)) * 256 + j + 1] = sp;
            }
          }
        }
        if (MODE != 2) {
          bf16x8 P = pack8(s[0], s[1]);
#pragma unroll
          for (int dt = 0; dt < 4; ++dt) O[dt][nt] = mfma16(vf[dt], P, O[dt][nt]);
        }
      }
    }
  };
  F2_WRITE(S0, 0);
  { const int i2_ = 2 < nst ? 2 : nst - 1; F2_LOAD(S0, i2_); }
  RAW_BAR();
#define F2_ITER(u_, SN, sn_)                                            \
  {                                                                     \
    const int ii_ = i + (u_);                                           \
    F2_WRITE(SN, sn_);                                                  \
    { const int il_ = ii_ + 3 < nst ? ii_ + 3 : nst - 1; F2_LOAD(SN, il_); } \
    compute(2 * (jb0 + ii_), sStage + (u_) * 16384);                    \
    compute(2 * (jb0 + ii_) + 1, sStage + (u_) * 16384 + 8192);         \
    RAW_BAR();                                                          \
  }
  for (int i = 0; i < nst; i += 2) {
    F2_ITER(0, S1, 1)
    if (i + 1 < nst) F2_ITER(1, S0, 0)
  }
}

__device__ __forceinline__ void nsa_phase_c(KP p, int l, char* smem) {
  const int tid = otid(), lane = tid & 63, wv = tid >> 6, l15 = lane & 15, quad = lane >> 4;
  char* sStage = smem;
  u16* sQw = (u16*)(smem + 32768) + wv * 16 * 72;
  float* own = (float*)(smem + 32768 + 9216) + wv * 2048;
  float* spl = own + 1024;
  const u16* proj = (const u16*)(p->ws + OFF_PROJ);
  const float* small_ = (const float*)(p->ws + OFF_SMALL);
  float* OC = (float*)(p->ws + OFF_OC);
  u32* SEL = (u32*)(p->ws + OFF_SEL);
  for (int job = obid(); job < 4096; job += gridDim.x) {
    const int qt = 1023 - (job >> 2), bg = job & 3, b = bg >> 1, g = bg & 1;
    const int t0 = qt * 16 + wv * 4;
    const int ql = l15 >> 2, r_ = l15 & 3, head = g * 4 + r_;
    const int t = t0 + ql;
    const size_t tok = (size_t)b * T + t;
    const u16* KC = (const u16*)(p->ws + OFF_KC) + (size_t)bg * 1024 * 64;
    const u16* VCT = (const u16*)(p->ws + OFF_KC + 524288) + (size_t)bg * 64 * 1024;
    {
      const u16* qrow = proj + tok * PJ + C_NQ + head * 64;
      *(bf16x8*)(sQw + l15 * 72 + quad * 8) = *(const bf16x8*)(qrow + quad * 8);
      *(bf16x8*)(sQw + l15 * 72 + 32 + quad * 8) = *(const bf16x8*)(qrow + 32 + quad * 8);
    }
    const int tmax = qt * 16 + 15;
    const int nvmax = tmax >= 31 ? ((tmax - 31) >> 4) + 1 : 0;
    const int h1 = ((nvmax + 31) >> 5) - 1;
    f32x4 O[4][1];
    float lsum[1] = {0.f}, inv[1] = {0.f};
#pragma unroll
    for (int dt = 0; dt < 4; ++dt) O[dt][0] = f32x4{0.f, 0.f, 0.f, 0.f};
    if (h1 >= 0) {
      flash2<2, 1>(KC, 64, VCT, 64, 1024, 0, h1, sStage, sQw, O, lsum, inv, nullptr, own, t0);
      float ls = lsum[0];
      ls += __shfl_xor(ls, 16);
      ls += __shfl_xor(ls, 32);
      inv[0] = ls > 0.f ? -log2f(ls) : -1000.f;
      flash2<3, 1>(KC, 64, VCT, 64, 1024, 0, h1, sStage, sQw, O, lsum, inv, nullptr, own, t0);
    }
    {
      float gc = ZTEST == 1 ? 0.f : sigmoidf_(small_[tok * 32 + 8 + head * 3 + 0]);
#pragma unroll
      for (int dt = 0; dt < 4; ++dt) {
        float4 o = make_float4(O[dt][0][0] * gc, O[dt][0][1] * gc, O[dt][0][2] * gc, O[dt][0][3] * gc);
        *(float4*)(OC + tok * 512 + head * 64 + dt * 16 + quad * 4) = o;
      }
    }
    __builtin_amdgcn_wave_barrier();
    for (int q = 0; q < 4; ++q) {
      const int tq = t0 + q, cur = tq >> 6;
      u32 word = 0;
      if (cur <= 15) {
        if (lane == 0) word = (2u << cur) - 1u;
      } else {
        u32 key[4];
#pragma unroll
        for (int k = 0; k < 4; ++k) {
          int j = lane + 64 * k;
          float v = own[q * 256 + j] + spl[q * 256 + j];
          key[k] = (j >= 1 && j <= cur - 2) ? (__float_as_uint(fmaxf(v, 0.f)) + 1u) : 0u;
        }
        u32 T = 0u;
        for (int bit = 30; bit >= 0; --bit) {
          const u32 cand = T | (1u << bit);
          int cnt = 0;
#pragma unroll
          for (int k = 0; k < 4; ++k) cnt += __popcll(__ballot(key[k] >= cand));
          if (cnt >= 13) T = cand;
        }
        int ngt = 0;
#pragma unroll
        for (int k = 0; k < 4; ++k) ngt += __popcll(__ballot(key[k] > T));
        int quota = 13 - ngt;
        const unsigned long long lt = (1ull << lane) - 1ull;
#pragma unroll
        for (int k = 0; k < 4; ++k) {
          const unsigned long long me = __ballot(key[k] == T);
          const bool take = key[k] > T || (key[k] == T && (int)__popcll(me & lt) < quota);
          const int ne = (int)__popcll(me);
          quota = quota > ne ? quota - ne : 0;
          const unsigned long long sm = __ballot(take);
          if (lane == 2 * k) word = (u32)sm;
          if (lane == 2 * k + 1) word = (u32)(sm >> 32);
        }
        if (lane == 0) word |= 1u;
        if (lane == (cur >> 5)) word |= 1u << (cur & 31);
        if (lane == ((cur - 1) >> 5)) word |= 1u << ((cur - 1) & 31);
      }
      if (lane < 8) SEL[(((size_t)b * 16384 + tq) * 2 + g) * 8 + lane] = word;
    }
    __builtin_amdgcn_wave_barrier();
  }
}

__device__ __forceinline__ void nsa_s_tile(KP p, int l, char* smem, int tile) {
  const int cur = 255 - (tile >> 2), bg = tile & 3, b = bg >> 1, g = bg & 1;
  const int tid = otid(), lane = tid & 63, wv = tid >> 6, l15 = lane & 15, quad = lane >> 4;
  char* sStage = smem;
  u16* sQw = (u16*)(smem + 32768) + wv * 64 * 72;
  u32* sSel = (u32*)(smem + 32768 + 36864);
  const u32* sSelw = sSel + wv * 16 * 8;
  const u16* proj = (const u16*)(p->ws + OFF_PROJ);
  const float* small_ = (const float*)(p->ws + OFF_SMALL);
  const float* rope = (const float*)(p->ws + OFF_ROPE);
  float* OC = (float*)(p->ws + OFF_OC);
  u16* mix = (u16*)(p->ws + OFF_H);
  const size_t tokb = (size_t)b * T;
  const int tq0 = cur * 64 + wv * 16;
  const int r_ = l15 & 3, head = g * 4 + r_;
  {
    const u32* SEL = (const u32*)(p->ws + OFF_SEL);
    int q = tid >> 2, w2 = (tid & 3) * 2;
    uint2 v = *(const uint2*)(SEL + ((tokb + cur * 64 + q) * 2 + g) * 8 + w2);
    *(uint2*)(sSel + q * 8 + w2) = v;
  }
#pragma unroll
  for (int nt = 0; nt < 4; ++nt) {
    const size_t tok = tokb + tq0 + nt * 4 + (l15 >> 2);
    const u16* qrow = proj + tok * PJ + C_NQ + head * 64;
    u16* qd = sQw + (nt * 16 + l15) * 72;
    *(bf16x8*)(qd + 32 + quad * 8) = *(const bf16x8*)(qrow + 32 + quad * 8);
    if (quad >= 2) {
      *(bf16x8*)(qd + quad * 8) = *(const bf16x8*)(qrow + quad * 8);
    } else {
      union { bf16x8 v; u16 h[8]; } x1, x2, o;
      x1.v = *(const bf16x8*)(qrow);
      x2.v = *(const bf16x8*)(qrow + 8);
      const float* rp = rope + tok * 16;
#pragma unroll
      for (int i = 0; i < 8; ++i) {
        float a = bf2f(x1.h[i]), bb = bf2f(x2.h[i]), c = rp[i], s = rp[8 + i];
        o.h[i] = f2bf(quad == 0 ? a * c - bb * s : bb * c + a * s);
      }
      *(bf16x8*)(qd + quad * 8) = o.v;
    }
  }
  f32x4 O[4][4];
  float lsum[4], inv[4] = {0.f, 0.f, 0.f, 0.f};
#pragma unroll
  for (int dt = 0; dt < 4; ++dt)
#pragma unroll
    for (int nt = 0; nt < 4; ++nt) O[dt][nt] = f32x4{0.f, 0.f, 0.f, 0.f};
#pragma unroll
  for (int nt = 0; nt < 4; ++nt) lsum[nt] = 0.f;
  {
    const u16* Kg = proj + tokb * PJ + C_KWIN + g * 64;
    const u16* VTg = (const u16*)(p->ws + OFF_VT + 8 * MiB) + (size_t)(bg * 256) * 4096;
    int h0 = 2 * cur - 16 < 0 ? 0 : 2 * cur - 16;
    flash2<0, 4>(Kg, PJ, VTg, 4096, 64, h0, 2 * cur + 1, sStage, sQw, O, lsum, inv, sSelw, nullptr, tq0);
  }
#pragma unroll
  for (int nt = 0; nt < 4; ++nt) {
    const size_t tok = tokb + tq0 + nt * 4 + (l15 >> 2);
    float ls = lsum[nt];
    ls += __shfl_xor(ls, 16);
    ls += __shfl_xor(ls, 32);
    float sc = ZTEST == 2 ? 0.f : sigmoidf_(small_[tok * 32 + 8 + head * 3 + 2]) / ls;
#pragma unroll
    for (int dt = 0; dt < 4; ++dt) {
      float4* op = (float4*)(OC + tok * 512 + head * 64 + dt * 16 + quad * 4);
      float4 o = *op;
      o.x += O[dt][nt][0] * sc; o.y += O[dt][nt][1] * sc; o.z += O[dt][nt][2] * sc; o.w += O[dt][nt][3] * sc;
      *op = o;
      O[dt][nt] = f32x4{0.f, 0.f, 0.f, 0.f};
    }
    lsum[nt] = 0.f;
  }
  {
    const u16* Kg = proj + tokb * PJ + C_KSLC + g * 64;
    const u16* VTg = (const u16*)(p->ws + OFF_VT) + (size_t)(bg * 256) * 4096;
    flash2<1, 4>(Kg, PJ, VTg, 4096, 64, 0, 2 * cur + 1, sStage, sQw, O, lsum, inv, sSelw, nullptr, tq0);
  }
#pragma unroll
  for (int nt = 0; nt < 4; ++nt) {
    const size_t tok = tokb + tq0 + nt * 4 + (l15 >> 2);
    float ls = lsum[nt];
    ls += __shfl_xor(ls, 16);
    ls += __shfl_xor(ls, 32);
    float sc = ZTEST == 3 ? 0.f : sigmoidf_(small_[tok * 32 + 8 + head * 3 + 1]) / ls;
#pragma unroll
    for (int dt = 0; dt < 4; ++dt) {
      float4 o = *(const float4*)(OC + tok * 512 + head * 64 + dt * 16 + quad * 4);
      uint2 w;
      w.x = pack2(o.x + O[dt][nt][0] * sc, o.y + O[dt][nt][1] * sc);
      w.y = pack2(o.z + O[dt][nt][2] * sc, o.w + O[dt][nt][3] * sc);
      *(uint2*)(mix + tok * DM + 256 + head * 64 + dt * 16 + quad * 4) = w;
    }
  }
}


#define XB_TMO      128
#define XB_XCNT(j)  (256  + 64 * (j))
#define XB_XSUB(j)  (1280 + 64 * (j))
#define XB_XGEN(j)  (2304 + 64 * (j))
#define XB_TOP      3328
#define XB_TOPGEN   3392
#define XCD_BAR_WORDS 3456
#define XB_SPIN_CAP (1u << 18)
#define LAS __attribute__((address_space(3)))
__device__ __forceinline__ unsigned xb_ld(unsigned* p) { return __hip_atomic_load(p, __ATOMIC_RELAXED, __HIP_MEMORY_SCOPE_AGENT); }
__device__ __forceinline__ unsigned xb_add(unsigned* p, unsigned v) { return __hip_atomic_fetch_add(p, v, __ATOMIC_RELAXED, __HIP_MEMORY_SCOPE_AGENT); }
__device__ __forceinline__ unsigned xb_xcc_id() { return (unsigned)__builtin_amdgcn_s_getreg((3 << 11) | 20) & 0xFu; }
#define XB_SPIN(cond, bar) do { unsigned _sp = 0; while (cond) { __builtin_amdgcn_s_sleep(1); \
    if ((++_sp & 255u) == 0u) { if (xb_ld(&(bar)[XB_TMO])) break; if (_sp > XB_SPIN_CAP) { atomicAdd(&(bar)[XB_TMO], 1u); break; } } } } while (0)
struct XcdBarrier { unsigned* bar; unsigned x; volatile LAS unsigned* st; };
__device__ __forceinline__ XcdBarrier xcd_barrier_post(unsigned* bar, volatile LAS unsigned* st) {
  XcdBarrier b; b.bar = bar; b.x = xb_xcc_id(); b.st = st;
  if (threadIdx.x == 0) (void)xb_add(&bar[XB_XCNT(b.x)], 1u);
  return b;
}
__device__ __forceinline__ void xcd_barrier_complete(unsigned* bar, unsigned x, unsigned& nloc, unsigned& nx) {
  const unsigned G = gridDim.x * gridDim.y * gridDim.z;
  unsigned sum, cnt, mine, sp = 0u;
  for (;;) {
    sum = 0u; cnt = 0u; mine = 0u;
#pragma unroll
    for (unsigned j = 0; j < 16; ++j) { const unsigned c = xb_ld(&bar[XB_XCNT(j)]); sum += c; cnt += (c > 0u) ? 1u : 0u; mine = (j == x) ? c : mine; }
    if (sum == G) break;
    __builtin_amdgcn_s_sleep(1);
    if ((++sp & 255u) == 0u) { if (xb_ld(&bar[XB_TMO])) break; if (sp > XB_SPIN_CAP) { atomicAdd(&bar[XB_TMO], 1u); break; } }
  }
  nloc = mine > 0u ? mine : 1u; nx = cnt > 0u ? cnt : 1u;
}
__device__ __forceinline__ void xcd_barrier(const XcdBarrier& b) {
  asm volatile("s_waitcnt vmcnt(0)" ::: "memory");
  __syncthreads();
  if (threadIdx.x == 0) {
    unsigned* bar = b.bar;
    __builtin_amdgcn_s_waitcnt(0);
    unsigned nloc = b.st[0], nx = b.st[1];
    if (nloc == 0u) { xcd_barrier_complete(bar, b.x, nloc, nx); b.st[0] = nloc; b.st[1] = nx; }
    const unsigned old = xb_add(&bar[XB_XSUB(b.x)], 1u);
    const unsigned gen = old / nloc;
    if (old + 1u == (gen + 1u) * nloc) {
      __builtin_amdgcn_fence(__ATOMIC_RELEASE, "agent");
      asm volatile("s_waitcnt vmcnt(0)" ::: "memory");
      const unsigned og = xb_add(&bar[XB_TOP], 1u);
      const unsigned tg = og / nx;
      if (og + 1u == (tg + 1u) * nx) xb_add(&bar[XB_TOPGEN], 1u);
      else XB_SPIN(xb_ld(&bar[XB_TOPGEN]) == tg, bar);
      __builtin_amdgcn_fence(__ATOMIC_ACQUIRE, "agent");
      xb_add(&bar[XB_XGEN(b.x)], 1u);
      asm volatile("s_waitcnt vmcnt(0)" ::: "memory");
    } else {
      XB_SPIN(xb_ld(&bar[XB_XGEN(b.x)]) == gen, bar);
      __builtin_amdgcn_fence(__ATOMIC_ACQUIRE, "agent");
      asm volatile("s_waitcnt vmcnt(0)" ::: "memory");
    }
  }
  __syncthreads();
}
#ifndef REPE
#define REPE 1
#endif
#ifndef REP3C
#define REP3C 1
#endif
#ifndef REP3
#define REP3 1
#endif
#ifndef XSYNC
#define XSYNC 0
#endif
#ifndef REP4
#define REP4 1
#endif
#ifndef REPSCAN
#define REPSCAN 1
#endif
#ifndef REPG
#define REPG 1
#endif
__global__ void __launch_bounds__(256, 2) hymba_mega(Params p_unused) {
  cg::grid_group grid = cg::this_grid();
  __shared__ uint4 xb_words;
  if (threadIdx.x == 0) xb_words = make_uint4(0u, 0u, 0u, 0u);
  __syncthreads();
  XcdBarrier xb = xcd_barrier_post((unsigned*)(kargs()->ws + OFF_CNT + 4096), (volatile LAS unsigned*)&xb_words);
  __shared__ __attribute__((aligned(16))) char smem[77824];
  __shared__ int s_tile;
  { KP p = kargs(); rope_table(p); if (p->ws == nullptr) grid.sync(); }
  xcd_barrier(xb);
#pragma unroll 1
  for (int l = 0; l < DEPTH; ++l) {
    {
      KP p = kargs();
      if (blockIdx.x == 0 && threadIdx.x == 0) { u32 z0 = 0u; asm volatile("" : "+v"(z0)); ((u32*)(p->ws + OFF_CNT))[0] = z0; }
      for (int re = 0; re < REPE; ++re) {
      convert_weights(p, l, smem);
      rmsnorm_rows(l == 0 ? p->x_in : p->out, p->attn_norm + l * DM, (u16*)(p->ws + OFF_H));
      }
    }
    xcd_barrier(xb);
    {
      KP p = kargs();
      for (int rep = 0; rep < REPG; ++rep)
      gemm_phase((const u16*)(p->ws + OFF_H), DM, (const u16*)(p->ws + OFF_W + W_IN), DM, DM, 128, 25, smem,
                 EpiInProj{(u16*)(p->ws + OFF_PROJ), (float*)(p->ws + OFF_SMALL)});
    }
    xcd_barrier(xb);
    {
      KP p = kargs();
      for (int job = obid(); job < 2048 + 512 + 128; job += gridDim.x) {
        if (job < 2048) gdn_chunk_prep(p, l, smem, job);
        else if (job < 2560) nsa_token_prep(p, l, smem, job - 2048);
        else nsa_compress(p, l, smem, job - 2560);
      }
    }
    xcd_barrier(xb);
#ifndef REP45
#define REP45 1
#endif
    for (int rep = 0; rep < REP45; ++rep) {
    {
      KP p = kargs();
      if (blockIdx.x == 0 && threadIdx.x == 0) { u32 z0 = 0u; asm volatile("" : "+v"(z0)); ((u32*)(p->ws + OFF_CNT))[0] = z0; }
      for (int r4 = 0; r4 < REP4; ++r4) nsa_phase_c(p, l, smem);
    }
    xcd_barrier(xb);
    {
      KP p = kargs();
      if (obid() < 32) for (int rs = 0; rs < REPSCAN; ++rs) gdn_scan(p, smem, obid());
      u32* CNT = (u32*)(p->ws + OFF_CNT);
      for (;;) {
        __syncthreads();
        if (threadIdx.x == 0) s_tile = (int)atomicAdd(&CNT[0], 1u);
        __syncthreads();
        int tile = s_tile;
        if (tile >= 1024) break;
        nsa_s_tile(p, l, smem, tile);
      }
    }
    xcd_barrier(xb);
    }
    {
      KP p = kargs();
      for (int re = 0; re < REPE; ++re) gdn_finalize(p, l);
      for (int xs = 0; xs < XSYNC; ++xs) xcd_barrier(xb);
    }
    xcd_barrier(xb);
    {
      KP p = kargs();
      gemm_phase((const u16*)(p->ws + OFF_H), DM, (const u16*)(p->ws + OFF_W + W_OUT), DM, DM, 128, 8, smem,
                 EpiResid{l == 0 ? p->x_in : p->out, p->out});
    }
    xcd_barrier(xb);
    {
      KP p = kargs();
      for (int re = 0; re < REPE; ++re) rmsnorm_rows(p->out, p->ffn_norm + l * DM, (u16*)(p->ws + OFF_H));
    }
    xcd_barrier(xb);
    {
      KP p = kargs();
      for (int rep = 0; rep < REPG; ++rep)
      gemm_phase((const u16*)(p->ws + OFF_H), DM, (const u16*)(p->ws + OFF_W + W_GU), DM, DM, 128, 44, smem,
                 EpiSwiGLU{(u16*)(p->ws + OFF_PROJ)});
    }
    xcd_barrier(xb);
    {
      KP p = kargs();
      gemm_phase((const u16*)(p->ws + OFF_PROJ), DFF, (const u16*)(p->ws + OFF_W + W_DOWN), DFF, DFF, 128, 8, smem,
                 EpiResid{p->out, p->out});
    }
    xcd_barrier(xb);
  }
}

extern "C" void kernel_launch(void* const* d_in, const int* in_sizes, int n_in, void* d_out, int out_size, void* d_ws,
                              size_t ws_size, hipStream_t stream) {
  static int grid_blocks = 0;
  if (!grid_blocks) {
    int dev = 0, cus = 0, per_cu = 0;
    hipGetDevice(&dev);
    hipDeviceGetAttribute(&cus, hipDeviceAttributeMultiprocessorCount, dev);
    hipOccupancyMaxActiveBlocksPerMultiprocessor(&per_cu, hymba_mega, 256, 0);
    if (per_cu > 2) per_cu = 2;
    if (per_cu < 1) per_cu = 1;
    grid_blocks = cus * per_cu;
    grid_blocks &= ~7;
  }
  Params p;
  memset(&p, 0, sizeof(p));
  p.x_in = (const float*)d_in[0]; p.positions = (const int*)d_in[1]; p.attn_norm = (const float*)d_in[2];
  p.w_in = (const float*)d_in[3]; p.gdn_conv_w = (const float*)d_in[4]; p.gdn_a_log = (const float*)d_in[5];
  p.gdn_dt_bias = (const float*)d_in[6]; p.gdn_norm = (const float*)d_in[7]; p.nsa_q_norm = (const float*)d_in[8];
  p.nsa_k_norm = (const float*)d_in[9]; p.cmp_pe = (const float*)d_in[10]; p.cmp_w1 = (const float*)d_in[11];
  p.cmp_w2 = (const float*)d_in[12]; p.conv_w = (const float*)d_in[13]; p.w_out = (const float*)d_in[14];
  p.ffn_norm = (const float*)d_in[15]; p.w_gate_up = (const float*)d_in[16]; p.w_down = (const float*)d_in[17];
  p.out = (float*)d_out; p.ws = (char*)d_ws;
  for (int i = 0; i < 8; ++i) p.inv_freq[i] = (float)pow(500000.0, -(double)i / 8.0);
  hipMemsetAsync((char*)d_ws + OFF_CNT, 0, 4096 + XCD_BAR_WORDS * 4, stream);
  void* args[] = {&p};
  hipError_t e = hipLaunchCooperativeKernel((void*)hymba_mega, dim3(grid_blocks), dim3(256), args, 0, stream);
  if (e != hipSuccess) fprintf(stderr, "cooperative launch failed: %s (grid %d)\n", hipGetErrorString(e), grid_blocks);
}
```

```cpp
#include <hip/hip_runtime.h>
#include <hip/hip_cooperative_groups.h>
#include <cstdio>
#include <cstring>
namespace cg = cooperative_groups;

#ifndef ZTEST
#define ZTEST 0
#endif
typedef unsigned short u16;
typedef unsigned int u32;
typedef __attribute__((ext_vector_type(8))) short bf16x8;
typedef __attribute__((ext_vector_type(4))) short bf16x4;
typedef __attribute__((ext_vector_type(4))) float f32x4;

constexpr int NB = 2, T = 16384, NTOK = NB * T, DM = 1024, DFF = 2816, DEPTH = 4;
constexpr int PJ = 3072;
constexpr int C_GQ = 0, C_GK = 256, C_GV = 512, C_GZ = 768, C_NQ = 1024, C_KCMP = 1536, C_VCMP = 1664,
              C_KSLC = 1792, C_VSLC = 1920, C_KWIN = 2048, C_VWIN = 2176, C_CB = 2304, C_CC = 2560, C_CX = 2816;
constexpr size_t MiB = 1ull << 20;
constexpr size_t OFF_H = 0, OFF_PROJ = 64 * MiB, OFF_SMALL = 256 * MiB, OFF_W = 260 * MiB, OFF_GDN = 288 * MiB,
                 OFF_OG = 384 * MiB, OFF_OC = 416 * MiB, OFF_VT = 480 * MiB, OFF_KC = 496 * MiB, OFF_SEL = 497 * MiB,
                 OFF_ROPE = 499 * MiB, OFF_GL = 501 * MiB, OFF_CNT = 501 * MiB + 65536;
constexpr size_t W_IN = 0, W_OUT = 6553600, W_GU = 8650752, W_DOWN = 20185088, W_C1 = 25952256, W_C2 = 26476544;
constexpr int CHUNK_B = 49152;
constexpr float SC2 = 0.125f * 1.4426950408889634f;

struct Params {
  const float* x_in; const int* positions; const float* attn_norm; const float* w_in; const float* gdn_conv_w;
  const float* gdn_a_log; const float* gdn_dt_bias; const float* gdn_norm; const float* nsa_q_norm;
  const float* nsa_k_norm; const float* cmp_pe; const float* cmp_w1; const float* cmp_w2; const float* conv_w;
  const float* w_out; const float* ffn_norm; const float* w_gate_up; const float* w_down;
  float* out; char* ws;
};


__device__ __forceinline__ int otid() { int t = threadIdx.x; asm volatile("" : "+v"(t)); return t; }
__device__ __forceinline__ int obid() { int t = blockIdx.x; asm volatile("" : "+s"(t)); return t; }
typedef const __attribute__((address_space(4))) Params* KP;
__device__ __forceinline__ KP kargs() {
  KP k = (KP)__builtin_amdgcn_kernarg_segment_ptr();
  asm volatile("" : "+s"(k));
  return k;
}

typedef __bf16 bf2_t __attribute__((ext_vector_type(2)));
typedef float f2_t __attribute__((ext_vector_type(2)));
__device__ __forceinline__ u32 pack2(float a, float b) {
  f2_t v = {a, b};
  bf2_t r = __builtin_convertvector(v, bf2_t);
  return __builtin_bit_cast(u32, r);
}
__device__ __forceinline__ u16 f2bf(float f) { return (u16)(pack2(f, 0.f) & 0xffffu); }
__device__ __forceinline__ float bf2f(u16 h) { return __uint_as_float(((u32)h) << 16); }
__device__ __forceinline__ float wave_sum(float v) {
#pragma unroll
  for (int o = 32; o; o >>= 1) v += __shfl_xor(v, o);
  return v;
}
__device__ __forceinline__ float sigmoidf_(float x) { return 1.f / (1.f + __expf(-x)); }
__device__ __forceinline__ f32x4 mfma16(bf16x8 a, bf16x8 b, f32x4 c) {
  return __builtin_amdgcn_mfma_f32_16x16x32_bf16(a, b, c, 0, 0, 0);
}
__device__ __forceinline__ bf16x8 pack8(f32x4 a, f32x4 b) {
  union { bf16x8 v; u32 u[4]; } r;
  r.u[0] = pack2(a[0], a[1]); r.u[1] = pack2(a[2], a[3]);
  r.u[2] = pack2(b[0], b[1]); r.u[3] = pack2(b[2], b[3]);
  return r.v;
}

__device__ __forceinline__ void rmsnorm_rows(const float* __restrict__ x, const float* __restrict__ gain, u16* __restrict__ h) {
  int lane = otid() & 63;
  int gw = obid() * 4 + (otid() >> 6), nw = gridDim.x * 4;
  for (int row = gw; row < NTOK; row += nw) {
    const float4* xr = (const float4*)(x + (size_t)row * DM);
    float4 v[4];
    float ss = 0.f;
#pragma unroll
    for (int i = 0; i < 4; ++i) {
      v[i] = xr[lane + 64 * i];
      ss += v[i].x * v[i].x + v[i].y * v[i].y + v[i].z * v[i].z + v[i].w * v[i].w;
    }
    ss = wave_sum(ss);
    float rs = rsqrtf(ss * (1.f / DM) + 1e-6f);
#pragma unroll
    for (int i = 0; i < 4; ++i) {
      float4 g = ((const float4*)gain)[lane + 64 * i];
      uint2 o;
      o.x = pack2(v[i].x * rs * g.x, v[i].y * rs * g.y);
      o.y = pack2(v[i].z * rs * g.z, v[i].w * rs * g.w);
      *(uint2*)(h + (size_t)row * DM + (lane + 64 * i) * 4) = o;
    }
  }
}

struct MapId { __device__ int operator()(int n) const { return n; } };
struct MapIn {
  __device__ int operator()(int n) const {
    if (n < 1024) return n;
    if (n < 2304) return n + 8;
    if (n < 3072) return n + 32;
    if (n < 3080) return n - 3072 + 1024;
    if (n < 3104) return n - 3080 + 2312;
    return -1;
  }
};
struct MapGU {
  __device__ int operator()(int n) const {
    int grp = n >> 6, r = n & 63;
    return r < 32 ? grp * 32 + r : DFF + grp * 32 + (r - 32);
  }
};
template <class Map>
__device__ __forceinline__ void transpose_tile(const float* __restrict__ src, int lds_, Map map, u16* __restrict__ dst, int ldd, int n0,
                               int k0, float* t) {
  int tid = otid();
#pragma unroll 4
  for (int i = 0; i < 16; ++i) {
    int k = i * 4 + (tid >> 6), n = tid & 63;
    int sn = map(n0 + n);
    t[k * 65 + n] = sn >= 0 ? src[(size_t)(k0 + k) * lds_ + sn] : 0.f;
  }
  __syncthreads();
#pragma unroll 4
  for (int i = 0; i < 16; ++i) {
    int n = i * 4 + (tid >> 6), k = tid & 63;
    dst[(size_t)(n0 + n) * ldd + k0 + k] = f2bf(t[k * 65 + n]);
  }
  __syncthreads();
}

__device__ __forceinline__ void convert_weights(KP p, int l, char* smem) {
  float* t = (float*)smem;
  char* W = p->ws + OFF_W;
  const int J0 = 800, J1 = J0 + 256, J2 = J1 + 1408, J3 = J2 + 704, J4 = J3 + 64, J5 = J4 + 2;
  for (int job = obid(); job < J5; job += gridDim.x) {
    if (job < J0) {
      transpose_tile(p->w_in + (size_t)l * DM * 3104, 3104, MapIn(), (u16*)(W + W_IN), 1024, (job >> 4) * 64,
                     (job & 15) * 64, t);
    } else if (job < J1) {
      int j = job - J0;
      transpose_tile(p->w_out + (size_t)l * DM * DM, 1024, MapId(), (u16*)(W + W_OUT), 1024, (j >> 4) * 64,
                     (j & 15) * 64, t);
    } else if (job < J2) {
      int j = job - J1;
      transpose_tile(p->w_gate_up + (size_t)l * DM * 2 * DFF, 2 * DFF, MapGU(), (u16*)(W + W_GU), 1024, (j >> 4) * 64,
                     (j & 15) * 64, t);
    } else if (job < J3) {
      int j = job - J2;
      transpose_tile(p->w_down + (size_t)l * DFF * DM, 1024, MapId(), (u16*)(W + W_DOWN), DFF, (j / 44) * 64,
                     (j % 44) * 64, t);
    } else if (job < J4) {
      int j = job - J3;
      int which = j >> 5, kt = j & 31;
      transpose_tile(p->cmp_w1 + (size_t)(l * 2 + which) * 2048 * 64, 64, MapId(),
                     (u16*)(W + W_C1) + (size_t)which * 64 * 2048, 2048, 0, kt * 64, t);
    } else {
      int which = job - J4;
      transpose_tile(p->cmp_w2 + (size_t)(l * 2 + which) * 64 * 64, 64, MapId(), (u16*)(W + W_C2) + which * 4096, 64, 0,
                     0, t);
    }
  }
}

#define WAIT_VM(n) asm volatile("s_waitcnt vmcnt(" #n ")" ::: "memory")
#define RAW_BAR() do { asm volatile("s_waitcnt lgkmcnt(0)" ::: "memory"); __builtin_amdgcn_s_barrier(); } while (0)
typedef __attribute__((ext_vector_type(16))) float f32x16;
template <class Epi>
__device__ __forceinline__ void gemm_phase(const u16* __restrict__ A, int lda, const u16* __restrict__ Bt, int ldb, int K, int ntm,
                           int ntn, char* smem, Epi epi) {
  const int tid = otid(), lane = tid & 63, wv = tid >> 6;
  const int wm = wv >> 1, wn = wv & 1, l31 = lane & 31, hi = lane >> 5;
  const int ntiles = ntm * ntn, nk = K >> 5;
  const int lrow = tid >> 2, lc = tid & 3;
  const int woff = lrow * 64 + ((lc ^ ((lrow >> 2) & 3)) * 16);
  const int sw = (l31 >> 2) & 3;
  const int arow = (wm * 128 + l31) * 64, brow = 16384 + (wn * 64 + l31) * 64;
#define TILE_DECODE(id_, row0_, col0_, tn_)                                                  \
  do {                                                                                       \
    int xcd_ = (id_) & 7, loc_ = (id_) >> 3;                                                 \
    int per_rb_ = 8 * ntn;                                                                   \
    int rb_ = loc_ / per_rb_, rem_ = loc_ % per_rb_;                                         \
    int cb_ = rem_ >> 6, rem2_ = rem_ & 63;                                                  \
    int width_ = (cb_ + 1) * 8 <= ntn ? 8 : ntn - cb_ * 8;                                   \
    int tm_l_ = rb_ * 8 + rem2_ / width_;                                                    \
    tn_ = cb_ * 8 + rem2_ % width_;                                                          \
    row0_ = (tm_l_ * 8 + xcd_) * 256;                                                        \
    col0_ = tn_ * 128;                                                                       \
  } while (0)
#define G_LOAD(R, kt_)                                                       \
  do {                                                                       \
    R##a0 = *(const uint4*)(gA + (kt_) * 32);                                \
    R##a1 = *(const uint4*)(gA + a64 + (kt_) * 32);                          \
    R##a2 = *(const uint4*)(gA + 2 * a64 + (kt_) * 32);                      \
    R##a3 = *(const uint4*)(gA + 3 * a64 + (kt_) * 32);                      \
    R##b0 = *(const uint4*)(gB + (kt_) * 32);                                \
    R##b1 = *(const uint4*)(gB + b64 + (kt_) * 32);                          \
  } while (0)
#define G_WRITE(R, slot_)                                                    \
  do {                                                                       \
    char* st_ = smem + (slot_) * 24576 + woff;                               \
    *(uint4*)(st_) = R##a0;                                                  \
    *(uint4*)(st_ + 4096) = R##a1;                                           \
    *(uint4*)(st_ + 8192) = R##a2;                                           \
    *(uint4*)(st_ + 12288) = R##a3;                                          \
    *(uint4*)(st_ + 16384) = R##b0;                                          \
    *(uint4*)(st_ + 20480) = R##b1;                                          \
  } while (0)
#define MF(accv, bv, av) accv = __builtin_amdgcn_mfma_f32_32x32x16_bf16(bv, av, accv, 0, 0, 0)
#define SB() __builtin_amdgcn_sched_barrier(0)
#define G_ITER(kt_)                                                                              \
  do {                                                                                           \
    const char* st_ = smem + ((kt_) & 1) * 24576;                                                \
    char* wr_ = smem + (((kt_) + 1) & 1) * 24576 + woff;                                         \
    const int p0_ = ((0 + hi) ^ sw) * 16, p1_ = ((2 + hi) ^ sw) * 16;                            \
    bf16x8 b00 = *(const bf16x8*)(st_ + brow + p0_), b01 = *(const bf16x8*)(st_ + brow + 2048 + p0_); \
    bf16x8 a00 = *(const bf16x8*)(st_ + arow + p0_), a01 = *(const bf16x8*)(st_ + arow + 2048 + p0_); \
    bf16x8 a02 = *(const bf16x8*)(st_ + arow + 4096 + p0_), a03 = *(const bf16x8*)(st_ + arow + 6144 + p0_); \
    SB();                                                                                        \
    MF(acc[0][0], b00, a00); MF(acc[0][1], b01, a00);                                            \
    bf16x8 b10 = *(const bf16x8*)(st_ + brow + p1_), b11 = *(const bf16x8*)(st_ + brow + 2048 + p1_); \
    SB();                                                                                        \
    MF(acc[1][0], b00, a01); MF(acc[1][1], b01, a01);                                            \
    bf16x8 a10 = *(const bf16x8*)(st_ + arow + p1_), a11 = *(const bf16x8*)(st_ + arow + 2048 + p1_); \
    SB();                                                                                        \
    MF(acc[2][0], b00, a02); MF(acc[2][1], b01, a02);                                            \
    bf16x8 a12 = *(const bf16x8*)(st_ + arow + 4096 + p1_), a13 = *(const bf16x8*)(st_ + arow + 6144 + p1_); \
    SB();                                                                                        \
    MF(acc[3][0], b00, a03); MF(acc[3][1], b01, a03);                                            \
    *(uint4*)(wr_) = R0a0; *(uint4*)(wr_ + 4096) = R0a1;                                         \
    SB();                                                                                        \
    MF(acc[0][0], b10, a10); MF(acc[0][1], b11, a10);                                            \
    *(uint4*)(wr_ + 8192) = R0a2; *(uint4*)(wr_ + 12288) = R0a3;                                 \
    SB();                                                                                        \
    MF(acc[1][0], b10, a11); MF(acc[1][1], b11, a11);                                            \
    *(uint4*)(wr_ + 16384) = R0b0; *(uint4*)(wr_ + 20480) = R0b1;                                \
    SB();                                                                                        \
    MF(acc[2][0], b10, a12); MF(acc[2][1], b11, a12);                                            \
    { const int kl_ = (kt_) + 2 < nk ? (kt_) + 2 : nk - 1; G_LOAD(R0, kl_); }                    \
    SB();                                                                                        \
    MF(acc[3][0], b10, a13); MF(acc[3][1], b11, a13);                                            \
    RAW_BAR();                                                                                   \
  } while (0)
  const size_t a64 = (size_t)64 * lda, b64 = (size_t)64 * ldb;
  int id = obid();
  int row0 = 0, col0 = 0, tn = 0;
  const u16 *gA = A, *gB = Bt;
  uint4 R0a0, R0a1, R0a2, R0a3, R0b0, R0b1;
  if (id < ntiles) {
    TILE_DECODE(id, row0, col0, tn);
    gA = A + (size_t)(row0 + lrow) * lda + lc * 8;
    gB = Bt + (size_t)(col0 + lrow) * ldb + lc * 8;
    G_LOAD(R0, 0);
  }
  while (id < ntiles) {
    f32x16 acc[4][2];
#pragma unroll
    for (int m = 0; m < 4; ++m)
#pragma unroll
      for (int n = 0; n < 2; ++n)
#pragma unroll
        for (int r = 0; r < 16; ++r) acc[m][n][r] = 0.f;
    G_WRITE(R0, 0);
    G_LOAD(R0, 1);
    RAW_BAR();
    __builtin_amdgcn_s_setprio(1);
    for (int kt = 0; kt < nk; ++kt) G_ITER(kt);
    __builtin_amdgcn_s_setprio(0);
    const int erow = row0 + wm * 128 + l31, ecol = col0 + wn * 64 + hi * 4, etn = tn;
    id += gridDim.x;
    if (id < ntiles) {
      TILE_DECODE(id, row0, col0, tn);
      gA = A + (size_t)(row0 + lrow) * lda + lc * 8;
      gB = Bt + (size_t)(col0 + lrow) * ldb + lc * 8;
      G_LOAD(R0, 0);
    }
    epi(acc, erow, ecol, etn);
  }
}

struct EpiInProj {
  u16* proj; float* small_;
  __device__ __forceinline__ void operator()(f32x16 (&acc)[4][2], int rbase, int cbase, int tn) const {
    if (tn < 24) {
#pragma unroll
      for (int m = 0; m < 4; ++m)
#pragma unroll
        for (int n = 0; n < 2; ++n)
#pragma unroll
          for (int g = 0; g < 4; ++g) {
            uint2 o;
            o.x = pack2(acc[m][n][g * 4 + 0], acc[m][n][g * 4 + 1]);
            o.y = pack2(acc[m][n][g * 4 + 2], acc[m][n][g * 4 + 3]);
            *(uint2*)(proj + (size_t)(rbase + m * 32) * PJ + cbase + n * 32 + g * 8) = o;
          }
    } else {
#pragma unroll
      for (int m = 0; m < 4; ++m)
#pragma unroll
        for (int g = 0; g < 4; ++g) {
          int c = cbase + g * 8 - 3072;
          if (c < 32)
            *(float4*)(small_ + (size_t)(rbase + m * 32) * 32 + c) =
                make_float4(acc[m][0][g * 4 + 0], acc[m][0][g * 4 + 1], acc[m][0][g * 4 + 2], acc[m][0][g * 4 + 3]);
        }
    }
  }
};
struct EpiResid {
  const float* xin; float* xout;
  __device__ __forceinline__ void operator()(f32x16 (&acc)[4][2], int rbase, int cbase, int tn) const {
#pragma unroll
    for (int m = 0; m < 4; ++m)
#pragma unroll
      for (int n = 0; n < 2; ++n)
#pragma unroll
        for (int g = 0; g < 4; ++g) {
          size_t idx = (size_t)(rbase + m * 32) * DM + cbase + n * 32 + g * 8;
          float4 x = *(const float4*)(xin + idx);
          x.x += acc[m][n][g * 4 + 0]; x.y += acc[m][n][g * 4 + 1]; x.z += acc[m][n][g * 4 + 2]; x.w += acc[m][n][g * 4 + 3];
          *(float4*)(xout + idx) = x;
        }
  }
};
struct EpiSwiGLU {
  u16* act;
  __device__ __forceinline__ void operator()(f32x16 (&acc)[4][2], int rbase, int cbase, int tn) const {
    int grp = cbase >> 6, c4 = cbase & 7;
#pragma unroll
    for (int m = 0; m < 4; ++m)
#pragma unroll
      for (int g = 0; g < 4; ++g) {
        float v[4];
#pragma unroll
        for (int r = 0; r < 4; ++r) {
          float gt = acc[m][0][g * 4 + r], up = acc[m][1][g * 4 + r];
          v[r] = gt / (1.f + __expf(-gt)) * up;
        }
        uint2 o;
        o.x = pack2(v[0], v[1]);
        o.y = pack2(v[2], v[3]);
        *(uint2*)(act + (size_t)(rbase + m * 32) * DFF + grp * 32 + g * 8 + c4) = o;
      }
  }
};

__device__ __forceinline__ void gdn_chunk_prep(KP p, int l, char* smem, int job) {
  const int b = job >> 10, h = (job >> 8) & 3, c = job & 255;
  const int tid = otid(), lane = tid & 63, wv = tid >> 6;
  float* sq = (float*)smem;
  float* sk = sq + 64 * 65;
  float* sv = sk + 64 * 65;
  float* sA = sv + 64 * 65;
  float* sgc = sA + 64 * 64;
  float* sbeta = sgc + 64;
  float* seg = sbeta + 64;
  float* sf2 = seg + 64;
  const u16* proj = (const u16*)(p->ws + OFF_PROJ);
  const float* small_ = (const float*)(p->ws + OFF_SMALL);
  const size_t tok0 = (size_t)b * T + c * 64;
  char* cb = p->ws + OFF_GDN + (size_t)((b * 4 + h) * 256 + c) * CHUNK_B;
  float* UT = (float*)cb;
  u16* NW = (u16*)(cb + 16384);
  u16* QD = (u16*)(cb + 24576);
  u16* KDT = (u16*)(cb + 32768);
  u16* QKM = (u16*)(cb + 40960);
  {
    int d = lane, i0 = wv * 16;
#pragma unroll
    for (int seg_ = 0; seg_ < 3; ++seg_) {
      int ch = seg_ * 256 + h * 64 + d;
      const float* cw = p->gdn_conv_w + (size_t)l * 4 * 768 + ch;
      float w0 = cw[0], w1 = cw[768], w2 = cw[1536], w3 = cw[2304];
      float* dst = seg_ == 0 ? sq : (seg_ == 1 ? sk : sv);
      float x0 = 0, x1 = 0, x2 = 0;
      int tl = c * 64 + i0;
      if (tl - 3 >= 0) x0 = bf2f(proj[(tok0 + i0 - 3) * PJ + ch]);
      if (tl - 2 >= 0) x1 = bf2f(proj[(tok0 + i0 - 2) * PJ + ch]);
      if (tl - 1 >= 0) x2 = bf2f(proj[(tok0 + i0 - 1) * PJ + ch]);
      for (int i = 0; i < 16; ++i) {
        float x3 = bf2f(proj[(tok0 + i0 + i) * PJ + ch]);
        float y = w0 * x0 + w1 * x1 + w2 * x2 + w3 * x3;
        dst[(i0 + i) * 65 + d] = y / (1.f + __expf(-y));
        x0 = x1; x1 = x2; x2 = x3;
      }
    }
  }
  if (tid < 64) {
    float gb = small_[(tok0 + tid) * 32 + h], ga = small_[(tok0 + tid) * 32 + 4 + h];
    float xx = ga + p->gdn_dt_bias[l * 4 + h];
    float sp = fmaxf(xx, 0.f) + log1pf(__expf(-fabsf(xx)));
    float g = -__expf(p->gdn_a_log[l * 4 + h]) * sp;
#pragma unroll
    for (int o = 1; o < 64; o <<= 1) {
      float t = __shfl_up(g, o);
      if (lane >= o) g += t;
    }
    float beta = sigmoidf_(gb);
    float eg = __expf(g);
    sgc[tid] = g; sbeta[tid] = beta; seg[tid] = eg; sf2[tid] = beta * eg;
    if (tid == 63) ((float*)(p->ws + OFF_GL))[(b * 4 + h) * 256 + c] = eg;
  }
  __syncthreads();
  if (tid < 128) {
    float* rowp = (tid < 64 ? sq : sk) + (tid & 63) * 65;
    float ss = 0.f;
#pragma unroll 16
    for (int d = 0; d < 64; ++d) ss += rowp[d] * rowp[d];
    const float sc = rsqrtf(ss + 1e-6f) * (tid < 64 ? 0.125f : 1.f);
#pragma unroll 16
    for (int d = 0; d < 64; ++d) rowp[d] *= sc;
  }
  __syncthreads();
  {
    int ti = tid >> 4, tj = tid & 15;
    float kk[4][4], qk[4][4];
#pragma unroll
    for (int a = 0; a < 4; ++a)
#pragma unroll
      for (int bb = 0; bb < 4; ++bb) { kk[a][bb] = 0.f; qk[a][bb] = 0.f; }
    if (tj <= ti) {
      for (int d = 0; d < 64; ++d) {
        float ki[4], kj[4], qi[4];
#pragma unroll
        for (int a = 0; a < 4; ++a) {
          ki[a] = sk[(ti * 4 + a) * 65 + d];
          qi[a] = sq[(ti * 4 + a) * 65 + d];
          kj[a] = sk[(tj * 4 + a) * 65 + d];
        }
#pragma unroll
        for (int a = 0; a < 4; ++a)
#pragma unroll
          for (int bb = 0; bb < 4; ++bb) { kk[a][bb] += ki[a] * kj[bb]; qk[a][bb] += qi[a] * kj[bb]; }
      }
    }
#pragma unroll
    for (int a = 0; a < 4; ++a) {
      int i = ti * 4 + a;
      float gi = sgc[i], bi = sbeta[i];
      uint2 o;
      float qv[4];
#pragma unroll
      for (int bb = 0; bb < 4; ++bb) {
        int j = tj * 4 + bb;
        float dec = (j <= i) ? __expf(gi - sgc[j]) : 0.f;
        sA[i * 64 + j] = (j < i) ? bi * kk[a][bb] * dec : 0.f;
        qv[bb] = qk[a][bb] * dec;
      }
      o.x = pack2(qv[0], qv[1]); o.y = pack2(qv[2], qv[3]);
      *(uint2*)(QKM + i * 64 + tj * 4) = o;
    }
  }
  {
    float gl = sgc[63];
    for (int idx = tid; idx < 4096; idx += 256) {
      int i = idx >> 6, d = idx & 63;
      QD[idx] = f2bf(sq[i * 65 + d] * seg[i]);
      KDT[idx] = f2bf(sk[d * 65 + i] * __expf(gl - sgc[d]));
    }
  }
  __syncthreads();
  if (tid < 128) {
    int cidx = tid;
    const float* src = cidx < 64 ? sv + cidx : sk + (cidx - 64);
    const float* fac = cidx < 64 ? sbeta : sf2;
    float x[64];
#pragma unroll
    for (int i = 0; i < 64; ++i) {
      float s0 = src[i * 65] * fac[i], s1 = 0.f, s2 = 0.f, s3 = 0.f;
#pragma unroll
      for (int j = 0; j < i; ++j) {
        if ((j & 3) == 0) s0 -= sA[i * 64 + j] * x[j];
        else if ((j & 3) == 1) s1 -= sA[i * 64 + j] * x[j];
        else if ((j & 3) == 2) s2 -= sA[i * 64 + j] * x[j];
        else s3 -= sA[i * 64 + j] * x[j];
      }
      x[i] = (s0 + s1) + (s2 + s3);
    }
    if (cidx < 64) {
#pragma unroll
      for (int i = 0; i < 64; i += 4) *(float4*)(UT + cidx * 64 + i) = make_float4(x[i], x[i + 1], x[i + 2], x[i + 3]);
    } else {
#pragma unroll
      for (int i = 0; i < 64; ++i) NW[i * 64 + (cidx - 64)] = f2bf(-x[i]);
    }
  }
  __syncthreads();
}

__device__ __forceinline__ void gdn_scan(KP p, char* smem, int sid) {
  const int b = sid >> 4, h = (sid >> 2) & 3, v0 = (sid & 3) * 16;
  const int tid = otid(), lane = tid & 63, wv = tid >> 6, l15 = lane & 15, quad = lane >> 4;
  u16* Sb = (u16*)smem;
  u16* Vb = Sb + 16 * 72;
  f32x4 S = {0.f, 0.f, 0.f, 0.f};
  { u32 z0 = 0u; asm volatile("" : "+v"(z0)); *(uint2*)(Sb + l15 * 72 + 16 * wv + quad * 4) = make_uint2(z0, z0); }
  __syncthreads();
  const char* gbase = p->ws + OFF_GDN + (size_t)((b * 4 + h) * 256) * CHUNK_B;
  const float* GL = (const float*)(p->ws + OFF_GL) + (b * 4 + h) * 256;
  float* OG = (float*)(p->ws + OFF_OG);
  const int arow = (16 * wv + l15) * 64 + quad * 8;
  f32x4 u, un;
  bf16x8 wA[2], qdA[2], qkA[2], kdA[2], wAn[2], qdAn[2], qkAn[2], kdAn[2];
  float gl, gln;
  {
    const char* cb = gbase;
    u = *(const f32x4*)((const float*)cb + (v0 + l15) * 64 + 16 * wv + quad * 4);
#pragma unroll
    for (int ks = 0; ks < 2; ++ks) {
      wA[ks] = *(const bf16x8*)((const u16*)(cb + 16384) + arow + ks * 32);
      qdA[ks] = *(const bf16x8*)((const u16*)(cb + 24576) + arow + ks * 32);
      kdA[ks] = *(const bf16x8*)((const u16*)(cb + 32768) + arow + ks * 32);
      qkA[ks] = *(const bf16x8*)((const u16*)(cb + 40960) + arow + ks * 32);
    }
    gl = GL[0];
  }
  for (int c = 0; c < 256; ++c) {
    if (c + 1 < 256) {
      const char* cb = gbase + (size_t)(c + 1) * CHUNK_B;
      un = *(const f32x4*)((const float*)cb + (v0 + l15) * 64 + 16 * wv + quad * 4);
#pragma unroll
      for (int ks = 0; ks < 2; ++ks) {
        wAn[ks] = *(const bf16x8*)((const u16*)(cb + 16384) + arow + ks * 32);
        qdAn[ks] = *(const bf16x8*)((const u16*)(cb + 24576) + arow + ks * 32);
        kdAn[ks] = *(const bf16x8*)((const u16*)(cb + 32768) + arow + ks * 32);
        qkAn[ks] = *(const bf16x8*)((const u16*)(cb + 40960) + arow + ks * 32);
      }
      gln = GL[c + 1];
    }
    bf16x8 sB0 = *(const bf16x8*)(Sb + l15 * 72 + quad * 8);
    bf16x8 sB1 = *(const bf16x8*)(Sb + l15 * 72 + 32 + quad * 8);
    f32x4 vn = u;
    vn = mfma16(wA[0], sB0, vn);
    vn = mfma16(wA[1], sB1, vn);
    f32x4 o = {0.f, 0.f, 0.f, 0.f};
    o = mfma16(qdA[0], sB0, o);
    o = mfma16(qdA[1], sB1, o);
    *(uint2*)(Vb + l15 * 72 + 16 * wv + quad * 4) = make_uint2(pack2(vn[0], vn[1]), pack2(vn[2], vn[3]));
    __syncthreads();
    bf16x8 vB0 = *(const bf16x8*)(Vb + l15 * 72 + quad * 8);
    bf16x8 vB1 = *(const bf16x8*)(Vb + l15 * 72 + 32 + quad * 8);
    o = mfma16(qkA[0], vB0, o);
    o = mfma16(qkA[1], vB1, o);
    S[0] *= gl; S[1] *= gl; S[2] *= gl; S[3] *= gl;
    S = mfma16(kdA[0], vB0, S);
    S = mfma16(kdA[1], vB1, S);
    *(uint2*)(Sb + l15 * 72 + 16 * wv + quad * 4) = make_uint2(pack2(S[0], S[1]), pack2(S[2], S[3]));
    size_t orow = (size_t)b * T + c * 64 + 16 * wv + quad * 4;
#pragma unroll
    for (int r = 0; r < 4; ++r) OG[(orow + r) * 256 + h * 64 + v0 + l15] = o[r];
    __syncthreads();
    u = un; gl = gln;
#pragma unroll
    for (int ks = 0; ks < 2; ++ks) { wA[ks] = wAn[ks]; qdA[ks] = qdAn[ks]; kdA[ks] = kdAn[ks]; qkA[ks] = qkAn[ks]; }
  }
}

__device__ __forceinline__ void gdn_finalize(KP p, int l) {
  const int lane = otid() & 63;
  int gw = obid() * 4 + (otid() >> 6), nw = gridDim.x * 4;
  const float* OG = (const float*)(p->ws + OFF_OG);
  const u16* proj = (const u16*)(p->ws + OFF_PROJ);
  u16* mix = (u16*)(p->ws + OFF_H);
  float gn = p->gdn_norm[l * 64 + lane];
  for (int row = gw; row < NTOK * 4; row += nw) {
    int t = row >> 2, h = row & 3;
    float o = OG[(size_t)t * 256 + h * 64 + lane];
    float ss = wave_sum(o * o);
    float z = bf2f(proj[(size_t)t * PJ + C_GZ + h * 64 + lane]);
    float y = o * rsqrtf(ss * (1.f / 64.f) + 1e-6f) * gn * (z / (1.f + __expf(-z)));
    mix[(size_t)t * DM + h * 64 + lane] = f2bf(ZTEST == 4 ? 0.f : y);
  }
}

__device__ __forceinline__ void rope_table(KP p) {
  float* rp = (float*)(p->ws + OFF_ROPE);
  int gt = obid() * blockDim.x + otid(), nt = gridDim.x * blockDim.x;
  for (int idx = gt; idx < NTOK * 8; idx += nt) {
    int t = idx >> 3, i = idx & 7;
    float inv = (float)pow(500000.0, -(double)i / 8.0);
    float ang = (float)p->positions[t] * inv;
    rp[t * 16 + i] = (float)cos((double)ang);
    rp[t * 16 + 8 + i] = (float)sin((double)ang);
  }
}

__device__ __forceinline__ void nsa_token_prep(KP p, int l, char* smem, int tb) {
  const int tid = otid(), lane = tid & 63, wv = tid >> 6;
  const int b = tb >> 8, blk = tb & 255;
  u16* proj = (u16*)(p->ws + OFF_PROJ);
  const float* rope = (const float*)(p->ws + OFF_ROPE);
  const size_t tok0 = (size_t)tb * 64;
  for (int r = tid; r < 768; r += 256) {
    int i = r / 12, which = r % 12;
    size_t t = tok0 + i;
    int col; const float* gain;
    if (which < 8) { col = C_NQ + which * 64; gain = p->nsa_q_norm + l * 64; }
    else if (which < 10) { col = C_KSLC + (which - 8) * 64; gain = p->nsa_k_norm + (l * 3 + 1) * 64; }
    else { col = C_KWIN + (which - 10) * 64; gain = p->nsa_k_norm + (l * 3 + 2) * 64; }
    u16* rowp = proj + t * PJ + col;
    union { uint4 q; u16 h[8]; } v[8];
    float ss = 0.f;
#pragma unroll
    for (int c = 0; c < 8; ++c) {
      v[c].q = *(const uint4*)(rowp + c * 8);
#pragma unroll
      for (int e = 0; e < 8; ++e) { float x = bf2f(v[c].h[e]); ss += x * x; }
    }
    const float rs = rsqrtf(ss * (1.f / 64.f) + 1e-6f);
    float y0[16];
#pragma unroll
    for (int e = 0; e < 16; ++e) y0[e] = bf2f(v[e >> 3].h[e & 7]) * rs * gain[e];
    if (which >= 8) {
      const float* rp = rope + t * 16;
#pragma unroll
      for (int e = 0; e < 8; ++e) {
        float c = rp[e], sn = rp[8 + e];
        float a1 = y0[e], a2 = y0[8 + e];
        y0[e] = a1 * c - a2 * sn;
        y0[8 + e] = a2 * c + a1 * sn;
      }
    }
#pragma unroll
    for (int c = 0; c < 8; ++c) {
      uint4 o;
      float y[8];
#pragma unroll
      for (int e = 0; e < 8; ++e) y[e] = c < 2 ? y0[c * 8 + e] : bf2f(v[c].h[e]) * rs * gain[c * 8 + e];
      o.x = pack2(y[0], y[1]); o.y = pack2(y[2], y[3]); o.z = pack2(y[4], y[5]); o.w = pack2(y[6], y[7]);
      *(uint4*)(rowp + c * 8) = o;
    }
  }
  u16* tt = (u16*)smem;
  for (int z = 0; z < 4; ++z) {
    int tensor = z >> 1, g = z & 1;
    int col = (tensor ? C_VWIN : C_VSLC) + g * 64;
    for (int idx = tid; idx < 4096; idx += 256) {
      int i = idx >> 6, d = idx & 63;
      tt[i * 66 + d] = proj[(tok0 + i) * PJ + col + d];
    }
    __syncthreads();
    u16* dst = (u16*)(p->ws + OFF_VT + (size_t)tensor * 8 * MiB) + ((size_t)((b * 2 + g) * 256 + blk)) * 4096;
    for (int idx = tid; idx < 4096; idx += 256) {
      int d = idx >> 6, i = idx & 63;
      dst[idx] = tt[i * 66 + d];
    }
    __syncthreads();
  }
  {
    int ch = tid;
    const float* cw = p->conv_w + (size_t)l * 3 * 256 + ch;
    float w0 = cw[0], w1 = cw[256], w2 = cw[512];
    u16* mix = (u16*)(p->ws + OFF_H);
    float p0 = 0.f, p1 = 0.f;
    if (blk > 0) {
      p0 = bf2f(proj[(tok0 - 2) * PJ + C_CC + ch]) * bf2f(proj[(tok0 - 2) * PJ + C_CX + ch]);
      p1 = bf2f(proj[(tok0 - 1) * PJ + C_CC + ch]) * bf2f(proj[(tok0 - 1) * PJ + C_CX + ch]);
    }
    for (int i = 0; i < 64; ++i) {
      size_t t = tok0 + i;
      float p2 = bf2f(proj[t * PJ + C_CC + ch]) * bf2f(proj[t * PJ + C_CX + ch]);
      float y = w0 * p0 + w1 * p1 + w2 * p2;
      mix[t * DM + 768 + ch] = f2bf(ZTEST == 5 ? 0.f : bf2f(proj[t * PJ + C_CB + ch]) * y);
      p0 = p1; p1 = p2;
    }
  }
}

__device__ __forceinline__ void nsa_compress(KP p, int l, char* smem, int job) {
  const int tid = otid(), lane = tid & 63, wv = tid >> 6, l15 = lane & 15, quad = lane >> 4;
  const int which = job >> 6, b = (job >> 5) & 1, g = (job >> 4) & 1, tile = job & 15;
  const u16* proj = (const u16*)(p->ws + OFF_PROJ);
  const u16* W1T = (const u16*)(p->ws + OFF_W + W_C1) + (size_t)which * 64 * 2048;
  const u16* W2T = (const u16*)(p->ws + OFF_W + W_C2) + which * 4096;
  const float* pe = p->cmp_pe + (size_t)(l * 2 + which) * 32 * 64;
  const int blk0 = tile * 64 + wv * 16;
  int blk = blk0 + l15;
  int blkc = blk < 1023 ? blk : 1022;
  const u16* arow = proj + ((size_t)b * T + blkc * 16) * PJ + (which ? C_VCMP : C_KCMP) + g * 64;
  f32x4 acc[4];
#pragma unroll
  for (int n = 0; n < 4; ++n) acc[n] = f32x4{0.f, 0.f, 0.f, 0.f};
  for (int ks = 0; ks < 64; ++ks) {
    int tok = ks >> 1, d0 = (ks & 1) * 32 + quad * 8;
    uint4 raw = *(const uint4*)(arow + (size_t)tok * PJ + d0);
    float4 pe0 = *(const float4*)(pe + tok * 64 + d0), pe1 = *(const float4*)(pe + tok * 64 + d0 + 4);
    union { bf16x8 v; u32 u[4]; } af;
    af.u[0] = pack2(bf2f(raw.x & 0xffff) + pe0.x, bf2f(raw.x >> 16) + pe0.y);
    af.u[1] = pack2(bf2f(raw.y & 0xffff) + pe0.z, bf2f(raw.y >> 16) + pe0.w);
    af.u[2] = pack2(bf2f(raw.z & 0xffff) + pe1.x, bf2f(raw.z >> 16) + pe1.y);
    af.u[3] = pack2(bf2f(raw.w & 0xffff) + pe1.z, bf2f(raw.w >> 16) + pe1.w);
#pragma unroll
    for (int n = 0; n < 4; ++n) {
      bf16x8 bfr = *(const bf16x8*)(W1T + (size_t)(n * 16 + l15) * 2048 + ks * 32 + quad * 8);
      acc[n] = mfma16(af.v, bfr, acc[n]);
    }
  }
  u16* hid = (u16*)smem + wv * 16 * 72;
#pragma unroll
  for (int n = 0; n < 4; ++n)
#pragma unroll
    for (int r = 0; r < 4; ++r) {
      float x = acc[n][r];
      float u = 0.7978845608028654f * (x + 0.044715f * x * x * x);
      float gl = 0.5f * x * (1.f + tanhf(u));
      hid[(quad * 4 + r) * 72 + n * 16 + l15] = f2bf(gl);
    }
  __syncthreads();
  f32x4 o2[4];
#pragma unroll
  for (int n = 0; n < 4; ++n) o2[n] = f32x4{0.f, 0.f, 0.f, 0.f};
#pragma unroll
  for (int ks = 0; ks < 2; ++ks) {
    bf16x8 af = *(const bf16x8*)(hid + l15 * 72 + ks * 32 + quad * 8);
#pragma unroll
    for (int n = 0; n < 4; ++n) {
      bf16x8 bfr = *(const bf16x8*)(W2T + (n * 16 + l15) * 64 + ks * 32 + quad * 8);
      o2[n] = mfma16(af, bfr, o2[n]);
    }
  }
  __syncthreads();
  if (which == 0) {
    u16* KC = (u16*)(p->ws + OFF_KC) + (size_t)(b * 2 + g) * 1024 * 64;
    const float* kg = p->nsa_k_norm + (l * 3 + 0) * 64;
#pragma unroll
    for (int r = 0; r < 4; ++r) {
      float ss = 0.f;
#pragma unroll
      for (int n = 0; n < 4; ++n) ss += o2[n][r] * o2[n][r];
      ss += __shfl_xor(ss, 1); ss += __shfl_xor(ss, 2); ss += __shfl_xor(ss, 4); ss += __shfl_xor(ss, 8);
      float rs = rsqrtf(ss * (1.f / 64.f) + 1e-6f);
      int row = blk0 + quad * 4 + r;
#pragma unroll
      for (int n = 0; n < 4; ++n) {
        float v = row < 1023 ? o2[n][r] * rs * kg[n * 16 + l15] : 0.f;
        KC[(size_t)row * 64 + n * 16 + l15] = f2bf(v);
      }
    }
  } else {
    u16* VCT = (u16*)(p->ws + OFF_KC + 524288) + (size_t)(b * 2 + g) * 64 * 1024;
#pragma unroll
    for (int r = 0; r < 4; ++r) {
      int row = blk0 + quad * 4 + r;
#pragma unroll
      for (int n = 0; n < 4; ++n) {
        float v = row < 1023 ? o2[n][r] : 0.f;
        VCT[(size_t)(n * 16 + l15) * 1024 + row] = f2bf(v);
      }
    }
  }
}

template <int MODE, int NT>
__device__ __forceinline__ void flash2(const u16* __restrict__ Kg, int kld, const u16* __restrict__ VTg, int vblk,
                                       int vld, int h0, int h1, char* sStage, const u16* sQw, f32x4 (&O)[4][NT],
                                       float (&lsum)[NT], const float (&inv)[NT], const u32* sSelw, float* slc,
                                       int tq0) {
  const int tid = otid(), lane = tid & 63, wv = tid >> 6, l15 = lane & 15, quad = lane >> 4;
  const int krow = tid >> 3, kc = tid & 7;
  const u16* kptr = Kg + (size_t)krow * kld + kc * 8;
  const int kw = krow * 128 + ((kc ^ ((krow >> 1) & 7)) * 16);
  const int vd = tid >> 2, vc = tid & 3;
  const u16* vptr = VTg + (size_t)vd * vld + vc * 8;
  const int vw = 4096 + vd * 64 + ((vc ^ ((vd >> 2) & 3)) * 16);
  const int jb0 = h0 >> 1, nst = (h1 >> 1) - jb0 + 1;
  uint4 S0k0, S0k1, S0v0, S0v1, S1k0, S1k1, S1v0, S1v1;
#define F2_LOAD(S, i_)                                                                             \
  do {                                                                                             \
    const int jb_ = jb0 + (i_);                                                                    \
    S##k0 = *(const uint4*)(kptr + (size_t)(jb_ * 64) * kld);                                      \
    S##k1 = *(const uint4*)(kptr + (size_t)(jb_ * 64 + 32) * kld);                                 \
    if (MODE != 2) {                                                                               \
      S##v0 = *(const uint4*)(vptr + (size_t)jb_ * vblk);                                          \
      S##v1 = *(const uint4*)(vptr + (size_t)jb_ * vblk + 32);                                     \
    }                                                                                              \
  } while (0)
#define F2_WRITE(S, slot_)                                                     \
  do {                                                                         \
    char* sl_ = sStage + (slot_) * 16384;                                      \
    *(uint4*)(sl_ + kw) = S##k0;                                               \
    *(uint4*)(sl_ + 8192 + kw) = S##k1;                                        \
    if (MODE != 2) {                                                           \
      *(uint4*)(sl_ + vw) = S##v0;                                             \
      *(uint4*)(sl_ + 8192 + vw) = S##v1;                                      \
    }                                                                          \
  } while (0)
  if (0 < nst) F2_LOAD(S0, 0);
  if (1 < nst) F2_LOAD(S1, 1);
  const int koff = l15 * 128;
  const int ksw = (l15 >> 1) & 7;
  const int voff = 4096 + l15 * 64 + (quad & 1) * 8;
  const int vsw = (l15 >> 2) & 3;
  const int tq0u = __builtin_amdgcn_readfirstlane(tq0);
  const int lim0u = tq0u >= 31 ? ((tq0u - 31) >> 4) : -1;
  auto compute = [&](const int h, const char* st) __attribute__((always_inline)) {
    bool interior;
    if (MODE == 0) interior = (h * 32 + 31 <= tq0u) && (h * 32 > tq0u + NT * 4 - 1 - 512);
    else if (MODE == 1) interior = (h * 32 + 31 <= tq0u);
    else interior = (h * 32 + 31 <= lim0u);
    bool bv[NT], an[NT];
    bool anyw = false;
#pragma unroll
    for (int nt = 0; nt < NT; ++nt) {
      if (MODE == 1) {
        u32 w = sSelw[(nt * 4 + (l15 >> 2)) * 8 + (h >> 6)];
        bv[nt] = (w >> ((h >> 1) & 31)) & 1u;
      } else {
        bv[nt] = true;
      }
      an[nt] = MODE == 1 ? (bool)__any(bv[nt]) : true;
      anyw |= an[nt];
    }
    if (anyw) {
      bf16x8 kf[2][2], vf[4];
#pragma unroll
      for (int m2 = 0; m2 < 2; ++m2)
#pragma unroll
        for (int ks = 0; ks < 2; ++ks)
          kf[m2][ks] = *(const bf16x8*)(st + koff + m2 * 2048 + (((ks * 4 + quad) ^ ksw) * 16));
      if (MODE != 2) {
#pragma unroll
        for (int dt = 0; dt < 4; ++dt) {
          union { bf16x8 v; uint2 h2[2]; } u;
          u.h2[0] = *(const uint2*)(st + voff + dt * 1024 + (((quad >> 1) ^ vsw) * 16));
          u.h2[1] = *(const uint2*)(st + voff + dt * 1024 + (((2 + (quad >> 1)) ^ vsw) * 16));
          vf[dt] = u.v;
        }
      }
#pragma unroll
      for (int nt = 0; nt < NT; ++nt) {
        if (!an[nt]) continue;
        const int t = tq0 + nt * 4 + (l15 >> 2);
        const bf16x8 bq0 = *(const bf16x8*)(sQw + (nt * 16 + l15) * 72 + quad * 8);
        const bf16x8 bq1 = *(const bf16x8*)(sQw + (nt * 16 + l15) * 72 + 32 + quad * 8);
        f32x4 s[2];
#pragma unroll
        for (int m2 = 0; m2 < 2; ++m2) {
          s[m2] = f32x4{0.f, 0.f, 0.f, 0.f};
          s[m2] = mfma16(kf[m2][0], bq0, s[m2]);
          s[m2] = mfma16(kf[m2][1], bq1, s[m2]);
        }
        const float bias = MODE == 1 ? (bv[nt] ? 0.f : -1000.f) : (MODE == 3 ? inv[nt] : 0.f);
        if (interior) {
#pragma unroll
          for (int m2 = 0; m2 < 2; ++m2)
#pragma unroll
            for (int r = 0; r < 4; ++r) s[m2][r] = __builtin_amdgcn_exp2f(fmaf(s[m2][r], SC2, bias));
        } else {
          int base;
          if (MODE <= 1) base = h * 32 + quad * 4 - t;
          else base = h * 32 + quad * 4 - (t >= 31 ? ((t - 31) >> 4) : -1);
          asm volatile("" : "+v"(base));
#pragma unroll
          for (int m2 = 0; m2 < 2; ++m2)
#pragma unroll
            for (int r = 0; r < 4; ++r) {
              const int C = m2 * 16 + r;
              bool valid;
              if (MODE == 0) valid = base <= -C && base > -512 - C;
              else valid = base <= -C;
              float pvv = __builtin_amdgcn_exp2f(fmaf(s[m2][r], SC2, bias));
              s[m2][r] = valid ? pvv : 0.f;
            }
        }
        float ls = ((s[0][0] + s[0][1]) + (s[0][2] + s[0][3])) + ((s[1][0] + s[1][1]) + (s[1][2] + s[1][3]));
        if (MODE != 3) lsum[nt] += ls;
        if (MODE == 3) {
#pragma unroll
          for (int m2 = 0; m2 < 2; ++m2) {
            float ow = s[m2][0] + s[m2][1] + s[m2][2] + 0.5f * s[m2][3];
            float sp = 0.5f * s[m2][3];
            ow += __shfl_xor(ow, 1); ow += __shfl_xor(ow, 2);
            sp += __shfl_xor(sp, 1); sp += __shfl_xor(sp, 2);
            if ((l15 & 3) == 0) {
              const int j = h * 8 + m2 * 4 + quad;
              slc[(nt * 4 + (l15 >> 2)) * 256 + j] = ow;
              if (j + 1 < 256) slc[1024 + (nt * 4 + (l15 >> 2)) * 256 + j + 1] = sp;
            }
          }
        }
        if (MODE != 2) {
          bf16x8 P = pack8(s[0], s[1]);
#pragma unroll
          for (int dt = 0; dt < 4; ++dt) O[dt][nt] = mfma16(vf[dt], P, O[dt][nt]);
        }
      }
    }
  };
  if (0 < nst) F2_WRITE(S0, 0);
  if (2 < nst) F2_LOAD(S0, 2);
  RAW_BAR();
#define F2_ITER(u_, SN, sn_)                                            \
  if (i + (u_) < nst) {                                                 \
    const int ii_ = i + (u_);                                           \
    if (ii_ + 1 < nst) F2_WRITE(SN, sn_);                               \
    if (ii_ + 3 < nst) F2_LOAD(SN, ii_ + 3);                            \
    compute(2 * (jb0 + ii_), sStage + (u_) * 16384);                    \
    compute(2 * (jb0 + ii_) + 1, sStage + (u_) * 16384 + 8192);         \
    RAW_BAR();                                                          \
  }
  for (int i = 0; i < nst; i += 2) {
    F2_ITER(0, S1, 1)
    F2_ITER(1, S0, 0)
  }
}

__device__ __forceinline__ void nsa_phase_c(KP p, int l, char* smem) {
  const int tid = otid(), lane = tid & 63, wv = tid >> 6, l15 = lane & 15, quad = lane >> 4;
  char* sStage = smem;
  u16* sQw = (u16*)(smem + 32768) + wv * 16 * 72;
  float* own = (float*)(smem + 32768 + 9216) + wv * 2048;
  float* spl = own + 1024;
  const u16* proj = (const u16*)(p->ws + OFF_PROJ);
  const float* small_ = (const float*)(p->ws + OFF_SMALL);
  float* OC = (float*)(p->ws + OFF_OC);
  u32* SEL = (u32*)(p->ws + OFF_SEL);
  for (int job = obid(); job < 4096; job += gridDim.x) {
    const int qt = 1023 - (job >> 2), bg = job & 3, b = bg >> 1, g = bg & 1;
    const int t0 = qt * 16 + wv * 4;
    const int ql = l15 >> 2, r_ = l15 & 3, head = g * 4 + r_;
    const int t = t0 + ql;
    const size_t tok = (size_t)b * T + t;
    const u16* KC = (const u16*)(p->ws + OFF_KC) + (size_t)bg * 1024 * 64;
    const u16* VCT = (const u16*)(p->ws + OFF_KC + 524288) + (size_t)bg * 64 * 1024;
    {
      const u16* qrow = proj + tok * PJ + C_NQ + head * 64;
      *(bf16x8*)(sQw + l15 * 72 + quad * 8) = *(const bf16x8*)(qrow + quad * 8);
      *(bf16x8*)(sQw + l15 * 72 + 32 + quad * 8) = *(const bf16x8*)(qrow + 32 + quad * 8);
    }
    const int tmax = qt * 16 + 15;
    const int nvmax = tmax >= 31 ? ((tmax - 31) >> 4) + 1 : 0;
    const int h1 = ((nvmax + 31) >> 5) - 1;
    f32x4 O[4][1];
    float lsum[1] = {0.f}, inv[1] = {0.f};
#pragma unroll
    for (int dt = 0; dt < 4; ++dt) O[dt][0] = f32x4{0.f, 0.f, 0.f, 0.f};
    if (h1 >= 0) {
      flash2<2, 1>(KC, 64, VCT, 64, 1024, 0, h1, sStage, sQw, O, lsum, inv, nullptr, own, t0);
      float ls = lsum[0];
      ls += __shfl_xor(ls, 16);
      ls += __shfl_xor(ls, 32);
      inv[0] = ls > 0.f ? -log2f(ls) : -1000.f;
      flash2<3, 1>(KC, 64, VCT, 64, 1024, 0, h1, sStage, sQw, O, lsum, inv, nullptr, own, t0);
    }
    {
      float gc = ZTEST == 1 ? 0.f : sigmoidf_(small_[tok * 32 + 8 + head * 3 + 0]);
#pragma unroll
      for (int dt = 0; dt < 4; ++dt) {
        float4 o = make_float4(O[dt][0][0] * gc, O[dt][0][1] * gc, O[dt][0][2] * gc, O[dt][0][3] * gc);
        *(float4*)(OC + tok * 512 + head * 64 + dt * 16 + quad * 4) = o;
      }
    }
    __builtin_amdgcn_wave_barrier();
    for (int q = 0; q < 4; ++q) {
      const int tq = t0 + q, cur = tq >> 6;
      u32 word = 0;
      if (cur <= 15) {
        if (lane == 0) word = (2u << cur) - 1u;
      } else {
        u32 key[4];
#pragma unroll
        for (int k = 0; k < 4; ++k) {
          int j = lane + 64 * k;
          float v = own[q * 256 + j] + spl[q * 256 + j];
          key[k] = (j >= 1 && j <= cur - 2) ? (__float_as_uint(fmaxf(v, 0.f)) + 1u) : 0u;
        }
        u32 T = 0u;
        for (int bit = 30; bit >= 0; --bit) {
          const u32 cand = T | (1u << bit);
          int cnt = 0;
#pragma unroll
          for (int k = 0; k < 4; ++k) cnt += __popcll(__ballot(key[k] >= cand));
          if (cnt >= 13) T = cand;
        }
        int ngt = 0;
#pragma unroll
        for (int k = 0; k < 4; ++k) ngt += __popcll(__ballot(key[k] > T));
        int quota = 13 - ngt;
        const unsigned long long lt = (1ull << lane) - 1ull;
#pragma unroll
        for (int k = 0; k < 4; ++k) {
          const unsigned long long me = __ballot(key[k] == T);
          const bool take = key[k] > T || (key[k] == T && (int)__popcll(me & lt) < quota);
          const int ne = (int)__popcll(me);
          quota = quota > ne ? quota - ne : 0;
          const unsigned long long sm = __ballot(take);
          if (lane == 2 * k) word = (u32)sm;
          if (lane == 2 * k + 1) word = (u32)(sm >> 32);
        }
        if (lane == 0) word |= 1u;
        if (lane == (cur >> 5)) word |= 1u << (cur & 31);
        if (lane == ((cur - 1) >> 5)) word |= 1u << ((cur - 1) & 31);
      }
      if (lane < 8) SEL[(((size_t)b * 16384 + tq) * 2 + g) * 8 + lane] = word;
    }
    __builtin_amdgcn_wave_barrier();
  }
}

__device__ __forceinline__ void nsa_s_tile(KP p, int l, char* smem, int tile) {
  const int cur = 255 - (tile >> 2), bg = tile & 3, b = bg >> 1, g = bg & 1;
  const int tid = otid(), lane = tid & 63, wv = tid >> 6, l15 = lane & 15, quad = lane >> 4;
  char* sStage = smem;
  u16* sQw = (u16*)(smem + 32768) + wv * 64 * 72;
  u32* sSel = (u32*)(smem + 32768 + 36864);
  const u32* sSelw = sSel + wv * 16 * 8;
  const u16* proj = (const u16*)(p->ws + OFF_PROJ);
  const float* small_ = (const float*)(p->ws + OFF_SMALL);
  const float* rope = (const float*)(p->ws + OFF_ROPE);
  float* OC = (float*)(p->ws + OFF_OC);
  u16* mix = (u16*)(p->ws + OFF_H);
  const size_t tokb = (size_t)b * T;
  const int tq0 = cur * 64 + wv * 16;
  const int r_ = l15 & 3, head = g * 4 + r_;
  {
    const u32* SEL = (const u32*)(p->ws + OFF_SEL);
    int q = tid >> 2, w2 = (tid & 3) * 2;
    uint2 v = *(const uint2*)(SEL + ((tokb + cur * 64 + q) * 2 + g) * 8 + w2);
    *(uint2*)(sSel + q * 8 + w2) = v;
  }
#pragma unroll
  for (int nt = 0; nt < 4; ++nt) {
    const size_t tok = tokb + tq0 + nt * 4 + (l15 >> 2);
    const u16* qrow = proj + tok * PJ + C_NQ + head * 64;
    u16* qd = sQw + (nt * 16 + l15) * 72;
    *(bf16x8*)(qd + 32 + quad * 8) = *(const bf16x8*)(qrow + 32 + quad * 8);
    if (quad >= 2) {
      *(bf16x8*)(qd + quad * 8) = *(const bf16x8*)(qrow + quad * 8);
    } else {
      union { bf16x8 v; u16 h[8]; } x1, x2, o;
      x1.v = *(const bf16x8*)(qrow);
      x2.v = *(const bf16x8*)(qrow + 8);
      const float* rp = rope + tok * 16;
#pragma unroll
      for (int i = 0; i < 8; ++i) {
        float a = bf2f(x1.h[i]), bb = bf2f(x2.h[i]), c = rp[i], s = rp[8 + i];
        o.h[i] = f2bf(quad == 0 ? a * c - bb * s : bb * c + a * s);
      }
      *(bf16x8*)(qd + quad * 8) = o.v;
    }
  }
  f32x4 O[4][4];
  float lsum[4], inv[4] = {0.f, 0.f, 0.f, 0.f};
#pragma unroll
  for (int dt = 0; dt < 4; ++dt)
#pragma unroll
    for (int nt = 0; nt < 4; ++nt) O[dt][nt] = f32x4{0.f, 0.f, 0.f, 0.f};
#pragma unroll
  for (int nt = 0; nt < 4; ++nt) lsum[nt] = 0.f;
  {
    const u16* Kg = proj + tokb * PJ + C_KWIN + g * 64;
    const u16* VTg = (const u16*)(p->ws + OFF_VT + 8 * MiB) + (size_t)(bg * 256) * 4096;
    int h0 = 2 * cur - 16 < 0 ? 0 : 2 * cur - 16;
    flash2<0, 4>(Kg, PJ, VTg, 4096, 64, h0, 2 * cur + 1, sStage, sQw, O, lsum, inv, sSelw, nullptr, tq0);
  }
#pragma unroll
  for (int nt = 0; nt < 4; ++nt) {
    const size_t tok = tokb + tq0 + nt * 4 + (l15 >> 2);
    float ls = lsum[nt];
    ls += __shfl_xor(ls, 16);
    ls += __shfl_xor(ls, 32);
    float sc = ZTEST == 2 ? 0.f : sigmoidf_(small_[tok * 32 + 8 + head * 3 + 2]) / ls;
#pragma unroll
    for (int dt = 0; dt < 4; ++dt) {
      float4* op = (float4*)(OC + tok * 512 + head * 64 + dt * 16 + quad * 4);
      float4 o = *op;
      o.x += O[dt][nt][0] * sc; o.y += O[dt][nt][1] * sc; o.z += O[dt][nt][2] * sc; o.w += O[dt][nt][3] * sc;
      *op = o;
      O[dt][nt] = f32x4{0.f, 0.f, 0.f, 0.f};
    }
    lsum[nt] = 0.f;
  }
  {
    const u16* Kg = proj + tokb * PJ + C_KSLC + g * 64;
    const u16* VTg = (const u16*)(p->ws + OFF_VT) + (size_t)(bg * 256) * 4096;
    flash2<1, 4>(Kg, PJ, VTg, 4096, 64, 0, 2 * cur + 1, sStage, sQw, O, lsum, inv, sSelw, nullptr, tq0);
  }
#pragma unroll
  for (int nt = 0; nt < 4; ++nt) {
    const size_t tok = tokb + tq0 + nt * 4 + (l15 >> 2);
    float ls = lsum[nt];
    ls += __shfl_xor(ls, 16);
    ls += __shfl_xor(ls, 32);
    float sc = ZTEST == 3 ? 0.f : sigmoidf_(small_[tok * 32 + 8 + head * 3 + 1]) / ls;
#pragma unroll
    for (int dt = 0; dt < 4; ++dt) {
      float4 o = *(const float4*)(OC + tok * 512 + head * 64 + dt * 16 + quad * 4);
      uint2 w;
      w.x = pack2(o.x + O[dt][nt][0] * sc, o.y + O[dt][nt][1] * sc);
      w.y = pack2(o.z + O[dt][nt][2] * sc, o.w + O[dt][nt][3] * sc);
      *(uint2*)(mix + tok * DM + 256 + head * 64 + dt * 16 + quad * 4) = w;
    }
  }
}


#define XB_TMO      128
#define XB_XCNT(j)  (256  + 64 * (j))
#define XB_XSUB(j)  (1280 + 64 * (j))
#define XB_XGEN(j)  (2304 + 64 * (j))
#define XB_TOP      3328
#define XB_TOPGEN   3392
#define XCD_BAR_WORDS 3456
#define XB_SPIN_CAP (1u << 18)
#define LAS __attribute__((address_space(3)))
__device__ __forceinline__ unsigned xb_ld(unsigned* p) { return __hip_atomic_load(p, __ATOMIC_RELAXED, __HIP_MEMORY_SCOPE_AGENT); }
__device__ __forceinline__ unsigned xb_add(unsigned* p, unsigned v) { return __hip_atomic_fetch_add(p, v, __ATOMIC_RELAXED, __HIP_MEMORY_SCOPE_AGENT); }
__device__ __forceinline__ unsigned xb_xcc_id() { return (unsigned)__builtin_amdgcn_s_getreg((3 << 11) | 20) & 0xFu; }
#define XB_SPIN(cond, bar) do { unsigned _sp = 0; while (cond) { __builtin_amdgcn_s_sleep(1); \
    if ((++_sp & 255u) == 0u) { if (xb_ld(&(bar)[XB_TMO])) break; if (_sp > XB_SPIN_CAP) { atomicAdd(&(bar)[XB_TMO], 1u); break; } } } } while (0)
struct XcdBarrier { unsigned* bar; unsigned x; volatile LAS unsigned* st; };
__device__ __forceinline__ XcdBarrier xcd_barrier_post(unsigned* bar, volatile LAS unsigned* st) {
  XcdBarrier b; b.bar = bar; b.x = xb_xcc_id(); b.st = st;
  if (threadIdx.x == 0) (void)xb_add(&bar[XB_XCNT(b.x)], 1u);
  return b;
}
__device__ __forceinline__ void xcd_barrier_complete(unsigned* bar, unsigned x, unsigned& nloc, unsigned& nx) {
  const unsigned G = gridDim.x * gridDim.y * gridDim.z;
  unsigned sum, cnt, mine, sp = 0u;
  for (;;) {
    sum = 0u; cnt = 0u; mine = 0u;
#pragma unroll
    for (unsigned j = 0; j < 16; ++j) { const unsigned c = xb_ld(&bar[XB_XCNT(j)]); sum += c; cnt += (c > 0u) ? 1u : 0u; mine = (j == x) ? c : mine; }
    if (sum == G) break;
    __builtin_amdgcn_s_sleep(1);
    if ((++sp & 255u) == 0u) { if (xb_ld(&bar[XB_TMO])) break; if (sp > XB_SPIN_CAP) { atomicAdd(&bar[XB_TMO], 1u); break; } }
  }
  nloc = mine > 0u ? mine : 1u; nx = cnt > 0u ? cnt : 1u;
}
__device__ __forceinline__ void xcd_barrier(const XcdBarrier& b) {
  asm volatile("s_waitcnt vmcnt(0)" ::: "memory");
  __syncthreads();
  if (threadIdx.x == 0) {
    unsigned* bar = b.bar;
    __builtin_amdgcn_s_waitcnt(0);
    unsigned nloc = b.st[0], nx = b.st[1];
    if (nloc == 0u) { xcd_barrier_complete(bar, b.x, nloc, nx); b.st[0] = nloc; b.st[1] = nx; }
    const unsigned old = xb_add(&bar[XB_XSUB(b.x)], 1u);
    const unsigned gen = old / nloc;
    if (old + 1u == (gen + 1u) * nloc) {
      __builtin_amdgcn_fence(__ATOMIC_RELEASE, "agent");
      asm volatile("s_waitcnt vmcnt(0)" ::: "memory");
      const unsigned og = xb_add(&bar[XB_TOP], 1u);
      const unsigned tg = og / nx;
      if (og + 1u == (tg + 1u) * nx) xb_add(&bar[XB_TOPGEN], 1u);
      else XB_SPIN(xb_ld(&bar[XB_TOPGEN]) == tg, bar);
      __builtin_amdgcn_fence(__ATOMIC_ACQUIRE, "agent");
      xb_add(&bar[XB_XGEN(b.x)], 1u);
      asm volatile("s_waitcnt vmcnt(0)" ::: "memory");
    } else {
      XB_SPIN(xb_ld(&bar[XB_XGEN(b.x)]) == gen, bar);
      __builtin_amdgcn_fence(__ATOMIC_ACQUIRE, "agent");
      asm volatile("s_waitcnt vmcnt(0)" ::: "memory");
    }
  }
  __syncthreads();
}
#ifndef REPE
#define REPE 1
#endif
#ifndef REP3C
#define REP3C 1
#endif
#ifndef REP3
#define REP3 1
#endif
#ifndef XSYNC
#define XSYNC 0
#endif
#ifndef REP4
#define REP4 1
#endif
#ifndef REPSCAN
#define REPSCAN 1
#endif
#ifndef REPG
#define REPG 1
#endif
__global__ void __launch_bounds__(256, 2) hymba_mega(Params p_unused) {
  cg::grid_group grid = cg::this_grid();
  __shared__ uint4 xb_words;
  if (threadIdx.x == 0) xb_words = make_uint4(0u, 0u, 0u, 0u);
  __syncthreads();
  XcdBarrier xb = xcd_barrier_post((unsigned*)(kargs()->ws + OFF_CNT + 4096), (volatile LAS unsigned*)&xb_words);
  __shared__ __attribute__((aligned(16))) char smem[77824];
  __shared__ int s_tile;
  { KP p = kargs(); rope_table(p); }
  grid.sync();
#pragma unroll 1
  for (int l = 0; l < DEPTH; ++l) {
    {
      KP p = kargs();
      if (blockIdx.x == 0 && threadIdx.x == 0) { u32 z0 = 0u; asm volatile("" : "+v"(z0)); ((u32*)(p->ws + OFF_CNT))[0] = z0; }
      for (int re = 0; re < REPE; ++re) {
      convert_weights(p, l, smem);
      rmsnorm_rows(l == 0 ? p->x_in : p->out, p->attn_norm + l * DM, (u16*)(p->ws + OFF_H));
      }
    }
    xcd_barrier(xb);
    {
      KP p = kargs();
      for (int rep = 0; rep < REPG; ++rep)
      gemm_phase((const u16*)(p->ws + OFF_H), DM, (const u16*)(p->ws + OFF_W + W_IN), DM, DM, 128, 25, smem,
                 EpiInProj{(u16*)(p->ws + OFF_PROJ), (float*)(p->ws + OFF_SMALL)});
    }
    xcd_barrier(xb);
    {
      KP p = kargs();
      for (int job = obid(); job < 2048 + 512 + 128; job += gridDim.x) {
        if (job < 2048) gdn_chunk_prep(p, l, smem, job);
        else if (job < 2560) nsa_token_prep(p, l, smem, job - 2048);
        else nsa_compress(p, l, smem, job - 2560);
      }
    }
    xcd_barrier(xb);
#ifndef REP45
#define REP45 1
#endif
    for (int rep = 0; rep < REP45; ++rep) {
    {
      KP p = kargs();
      if (blockIdx.x == 0 && threadIdx.x == 0) { u32 z0 = 0u; asm volatile("" : "+v"(z0)); ((u32*)(p->ws + OFF_CNT))[0] = z0; }
      for (int r4 = 0; r4 < REP4; ++r4) nsa_phase_c(p, l, smem);
    }
    xcd_barrier(xb);
    {
      KP p = kargs();
      if (obid() < 32) for (int rs = 0; rs < REPSCAN; ++rs) gdn_scan(p, smem, obid());
      u32* CNT = (u32*)(p->ws + OFF_CNT);
      for (;;) {
        __syncthreads();
        if (threadIdx.x == 0) s_tile = (int)atomicAdd(&CNT[0], 1u);
        __syncthreads();
        int tile = s_tile;
        if (tile >= 1024) break;
        nsa_s_tile(p, l, smem, tile);
      }
    }
    xcd_barrier(xb);
    }
    {
      KP p = kargs();
      for (int re = 0; re < REPE; ++re) gdn_finalize(p, l);
      for (int xs = 0; xs < XSYNC; ++xs) xcd_barrier(xb);
    }
    xcd_barrier(xb);
    {
      KP p = kargs();
      gemm_phase((const u16*)(p->ws + OFF_H), DM, (const u16*)(p->ws + OFF_W + W_OUT), DM, DM, 128, 8, smem,
                 EpiResid{l == 0 ? p->x_in : p->out, p->out});
    }
    xcd_barrier(xb);
    {
      KP p = kargs();
      for (int re = 0; re < REPE; ++re) rmsnorm_rows(p->out, p->ffn_norm + l * DM, (u16*)(p->ws + OFF_H));
    }
    xcd_barrier(xb);
    {
      KP p = kargs();
      for (int rep = 0; rep < REPG; ++rep)
      gemm_phase((const u16*)(p->ws + OFF_H), DM, (const u16*)(p->ws + OFF_W + W_GU), DM, DM, 128, 44, smem,
                 EpiSwiGLU{(u16*)(p->ws + OFF_PROJ)});
    }
    xcd_barrier(xb);
    {
      KP p = kargs();
      gemm_phase((const u16*)(p->ws + OFF_PROJ), DFF, (const u16*)(p->ws + OFF_W + W_DOWN), DFF, DFF, 128, 8, smem,
                 EpiResid{p->out, p->out});
    }
    xcd_barrier(xb);
  }
}

extern "C" void kernel_launch(void* const* d_in, const int* in_sizes, int n_in, void* d_out, int out_size, void* d_ws,
                              size_t ws_size, hipStream_t stream) {
  static int grid_blocks = 0;
  if (!grid_blocks) {
    int dev = 0, cus = 0, per_cu = 0;
    hipGetDevice(&dev);
    hipDeviceGetAttribute(&cus, hipDeviceAttributeMultiprocessorCount, dev);
    hipOccupancyMaxActiveBlocksPerMultiprocessor(&per_cu, hymba_mega, 256, 0);
    if (per_cu > 2) per_cu = 2;
    if (per_cu < 1) per_cu = 1;
    grid_blocks = cus * per_cu;
    grid_blocks &= ~7;
  }
  Params p;
  memset(&p, 0, sizeof(p));
  p.x_in = (const float*)d_in[0]; p.positions = (const int*)d_in[1]; p.attn_norm = (const float*)d_in[2];
  p.w_in = (const float*)d_in[3]; p.gdn_conv_w = (const float*)d_in[4]; p.gdn_a_log = (const float*)d_in[5];
  p.gdn_dt_bias = (const float*)d_in[6]; p.gdn_norm = (const float*)d_in[7]; p.nsa_q_norm = (const float*)d_in[8];
  p.nsa_k_norm = (const float*)d_in[9]; p.cmp_pe = (const float*)d_in[10]; p.cmp_w1 = (const float*)d_in[11];
  p.cmp_w2 = (const float*)d_in[12]; p.conv_w = (const float*)d_in[13]; p.w_out = (const float*)d_in[14];
  p.ffn_norm = (const float*)d_in[15]; p.w_gate_up = (const float*)d_in[16]; p.w_down = (const float*)d_in[17];
  p.out = (float*)d_out; p.ws = (char*)d_ws;
  hipMemsetAsync((char*)d_ws + OFF_CNT, 0, 4096 + XCD_BAR_WORDS * 4, stream);
  void* args[] = {&p};
  hipError_t e = hipLaunchCooperativeKernel((void*)hymba_mega, dim3(grid_blocks), dim3(256), args, 0, stream);
  if (e != hipSuccess) fprintf(stderr, "cooperative launch failed: %s (grid %d)\n", hipGetErrorString(e), grid_blocks);
}
```

```cpp
#include <hip/hip_runtime.h>
#include <hip/hip_cooperative_groups.h>
#include <cstdio>
#include <cstring>
namespace cg = cooperative_groups;

#ifndef ZTEST
#define ZTEST 0
#endif
typedef unsigned short u16;
typedef unsigned int u32;
typedef __attribute__((ext_vector_type(8))) short bf16x8;
typedef __attribute__((ext_vector_type(4))) short bf16x4;
typedef __attribute__((ext_vector_type(4))) float f32x4;

constexpr int NB = 2, T = 16384, NTOK = NB * T, DM = 1024, DFF = 2816, DEPTH = 4;
constexpr int PJ = 3072;
constexpr int C_GQ = 0, C_GK = 256, C_GV = 512, C_GZ = 768, C_NQ = 1024, C_KCMP = 1536, C_VCMP = 1664,
              C_KSLC = 1792, C_VSLC = 1920, C_KWIN = 2048, C_VWIN = 2176, C_CB = 2304, C_CC = 2560, C_CX = 2816;
constexpr size_t MiB = 1ull << 20;
constexpr size_t OFF_H = 0, OFF_PROJ = 64 * MiB, OFF_SMALL = 256 * MiB, OFF_W = 260 * MiB, OFF_GDN = 288 * MiB,
                 OFF_OG = 384 * MiB, OFF_OC = 416 * MiB, OFF_VT = 480 * MiB, OFF_KC = 496 * MiB, OFF_SEL = 497 * MiB,
                 OFF_ROPE = 499 * MiB, OFF_GL = 501 * MiB, OFF_CNT = 501 * MiB + 65536;
constexpr size_t W_IN = 0, W_OUT = 6553600, W_GU = 8650752, W_DOWN = 20185088, W_C1 = 25952256, W_C2 = 26476544;
constexpr int CHUNK_B = 49152;
constexpr float SC2 = 0.125f * 1.4426950408889634f;

struct Params {
  const float* x_in; const int* positions; const float* attn_norm; const float* w_in; const float* gdn_conv_w;
  const float* gdn_a_log; const float* gdn_dt_bias; const float* gdn_norm; const float* nsa_q_norm;
  const float* nsa_k_norm; const float* cmp_pe; const float* cmp_w1; const float* cmp_w2; const float* conv_w;
  const float* w_out; const float* ffn_norm; const float* w_gate_up; const float* w_down;
  float* out; char* ws;
};


__device__ __forceinline__ int otid() { int t = threadIdx.x; asm volatile("" : "+v"(t)); return t; }
__device__ __forceinline__ int obid() { int t = blockIdx.x; asm volatile("" : "+s"(t)); return t; }
typedef const __attribute__((address_space(4))) Params* KP;
__device__ __forceinline__ KP kargs() {
  KP k = (KP)__builtin_amdgcn_kernarg_segment_ptr();
  asm volatile("" : "+s"(k));
  return k;
}

typedef __bf16 bf2_t __attribute__((ext_vector_type(2)));
typedef float f2_t __attribute__((ext_vector_type(2)));
__device__ __forceinline__ u32 pack2(float a, float b) {
  f2_t v = {a, b};
  bf2_t r = __builtin_convertvector(v, bf2_t);
  return __builtin_bit_cast(u32, r);
}
__device__ __forceinline__ u16 f2bf(float f) { return (u16)(pack2(f, 0.f) & 0xffffu); }
__device__ __forceinline__ float bf2f(u16 h) { return __uint_as_float(((u32)h) << 16); }
__device__ __forceinline__ float wave_sum(float v) {
#pragma unroll
  for (int o = 32; o; o >>= 1) v += __shfl_xor(v, o);
  return v;
}
__device__ __forceinline__ float sigmoidf_(float x) { return 1.f / (1.f + __expf(-x)); }
__device__ __forceinline__ f32x4 mfma16(bf16x8 a, bf16x8 b, f32x4 c) {
  return __builtin_amdgcn_mfma_f32_16x16x32_bf16(a, b, c, 0, 0, 0);
}
__device__ __forceinline__ bf16x8 pack8(f32x4 a, f32x4 b) {
  union { bf16x8 v; u32 u[4]; } r;
  r.u[0] = pack2(a[0], a[1]); r.u[1] = pack2(a[2], a[3]);
  r.u[2] = pack2(b[0], b[1]); r.u[3] = pack2(b[2], b[3]);
  return r.v;
}

__device__ __forceinline__ void rmsnorm_rows(const float* __restrict__ x, const float* __restrict__ gain, u16* __restrict__ h) {
  int lane = otid() & 63;
  int gw = obid() * 4 + (otid() >> 6), nw = gridDim.x * 4;
  for (int row = gw; row < NTOK; row += nw) {
    const float4* xr = (const float4*)(x + (size_t)row * DM);
    float4 v[4];
    float ss = 0.f;
#pragma unroll
    for (int i = 0; i < 4; ++i) {
      v[i] = xr[lane + 64 * i];
      ss += v[i].x * v[i].x + v[i].y * v[i].y + v[i].z * v[i].z + v[i].w * v[i].w;
    }
    ss = wave_sum(ss);
    float rs = rsqrtf(ss * (1.f / DM) + 1e-6f);
#pragma unroll
    for (int i = 0; i < 4; ++i) {
      float4 g = ((const float4*)gain)[lane + 64 * i];
      uint2 o;
      o.x = pack2(v[i].x * rs * g.x, v[i].y * rs * g.y);
      o.y = pack2(v[i].z * rs * g.z, v[i].w * rs * g.w);
      *(uint2*)(h + (size_t)row * DM + (lane + 64 * i) * 4) = o;
    }
  }
}

struct MapId { __device__ int operator()(int n) const { return n; } };
struct MapIn {
  __device__ int operator()(int n) const {
    if (n < 1024) return n;
    if (n < 2304) return n + 8;
    if (n < 3072) return n + 32;
    if (n < 3080) return n - 3072 + 1024;
    if (n < 3104) return n - 3080 + 2312;
    return -1;
  }
};
struct MapGU {
  __device__ int operator()(int n) const {
    int grp = n >> 6, r = n & 63;
    return r < 32 ? grp * 32 + r : DFF + grp * 32 + (r - 32);
  }
};
template <class Map>
__device__ __forceinline__ void transpose_tile(const float* __restrict__ src, int lds_, Map map, u16* __restrict__ dst, int ldd, int n0,
                               int k0, float* t) {
  int tid = otid();
#pragma unroll 4
  for (int i = 0; i < 16; ++i) {
    int k = i * 4 + (tid >> 6), n = tid & 63;
    int sn = map(n0 + n);
    t[k * 65 + n] = sn >= 0 ? src[(size_t)(k0 + k) * lds_ + sn] : 0.f;
  }
  __syncthreads();
#pragma unroll 4
  for (int i = 0; i < 16; ++i) {
    int n = i * 4 + (tid >> 6), k = tid & 63;
    dst[(size_t)(n0 + n) * ldd + k0 + k] = f2bf(t[k * 65 + n]);
  }
  __syncthreads();
}

__device__ __forceinline__ void convert_weights(KP p, int l, char* smem) {
  float* t = (float*)smem;
  char* W = p->ws + OFF_W;
  const int J0 = 800, J1 = J0 + 256, J2 = J1 + 1408, J3 = J2 + 704, J4 = J3 + 64, J5 = J4 + 2;
  for (int job = obid(); job < J5; job += gridDim.x) {
    if (job < J0) {
      transpose_tile(p->w_in + (size_t)l * DM * 3104, 3104, MapIn(), (u16*)(W + W_IN), 1024, (job >> 4) * 64,
                     (job & 15) * 64, t);
    } else if (job < J1) {
      int j = job - J0;
      transpose_tile(p->w_out + (size_t)l * DM * DM, 1024, MapId(), (u16*)(W + W_OUT), 1024, (j >> 4) * 64,
                     (j & 15) * 64, t);
    } else if (job < J2) {
      int j = job - J1;
      transpose_tile(p->w_gate_up + (size_t)l * DM * 2 * DFF, 2 * DFF, MapGU(), (u16*)(W + W_GU), 1024, (j >> 4) * 64,
                     (j & 15) * 64, t);
    } else if (job < J3) {
      int j = job - J2;
      transpose_tile(p->w_down + (size_t)l * DFF * DM, 1024, MapId(), (u16*)(W + W_DOWN), DFF, (j / 44) * 64,
                     (j % 44) * 64, t);
    } else if (job < J4) {
      int j = job - J3;
      int which = j >> 5, kt = j & 31;
      transpose_tile(p->cmp_w1 + (size_t)(l * 2 + which) * 2048 * 64, 64, MapId(),
                     (u16*)(W + W_C1) + (size_t)which * 64 * 2048, 2048, 0, kt * 64, t);
    } else {
      int which = job - J4;
      transpose_tile(p->cmp_w2 + (size_t)(l * 2 + which) * 64 * 64, 64, MapId(), (u16*)(W + W_C2) + which * 4096, 64, 0,
                     0, t);
    }
  }
}

#define WAIT_VM(n) asm volatile("s_waitcnt vmcnt(" #n ")" ::: "memory")
#define RAW_BAR() do { asm volatile("s_waitcnt lgkmcnt(0)" ::: "memory"); __builtin_amdgcn_s_barrier(); } while (0)
typedef __attribute__((ext_vector_type(16))) float f32x16;
template <class Epi>
__device__ __forceinline__ void gemm_phase(const u16* __restrict__ A, int lda, const u16* __restrict__ Bt, int ldb, int K, int ntm,
                           int ntn, char* smem, Epi epi) {
  const int tid = otid(), lane = tid & 63, wv = tid >> 6;
  const int wm = wv >> 1, wn = wv & 1, l31 = lane & 31, hi = lane >> 5;
  const int ntiles = ntm * ntn, nk = K >> 5;
  const int lrow = tid >> 3, lc8 = tid & 7;
  const int woff = lrow * 64 + (((lc8 & 3) ^ ((lrow >> 2) & 3)) * 16);
  const bool wodd = (lc8 >> 2) != 0;
  const int sw = (l31 >> 2) & 3;
  const int arow = (wm * 128 + l31) * 64, brow = 16384 + (wn * 64 + l31) * 64;
#define TILE_DECODE(id_, row0_, col0_, tn_)                                                  \
  do {                                                                                       \
    int xcd_ = (id_) & 7, loc_ = (id_) >> 3;                                                 \
    int per_rb_ = 8 * ntn;                                                                   \
    int rb_ = loc_ / per_rb_, rem_ = loc_ % per_rb_;                                         \
    int cb_ = rem_ >> 6, rem2_ = rem_ & 63;                                                  \
    int width_ = (cb_ + 1) * 8 <= ntn ? 8 : ntn - cb_ * 8;                                   \
    int tm_l_ = rb_ * 8 + rem2_ / width_;                                                    \
    tn_ = cb_ * 8 + rem2_ % width_;                                                          \
    row0_ = (tm_l_ * 8 + xcd_) * 256;                                                        \
    col0_ = tn_ * 128;                                                                       \
  } while (0)
#define W_LOAD(w_)                                                           \
  do {                                                                       \
    const u16* pa_ = gA + (w_) * 64;                                         \
    const u16* pb_ = gB + (w_) * 64;                                         \
    Ra0 = *(const uint4*)(pa_);           Ra1 = *(const uint4*)(pa_ + a32);  \
    Ra2 = *(const uint4*)(pa_ + 2 * a32); Ra3 = *(const uint4*)(pa_ + 3 * a32); \
    Ra4 = *(const uint4*)(pa_ + 4 * a32); Ra5 = *(const uint4*)(pa_ + 5 * a32); \
    Ra6 = *(const uint4*)(pa_ + 6 * a32); Ra7 = *(const uint4*)(pa_ + 7 * a32); \
    Rb0 = *(const uint4*)(pb_);           Rb1 = *(const uint4*)(pb_ + b32);  \
    Rb2 = *(const uint4*)(pb_ + 2 * b32); Rb3 = *(const uint4*)(pb_ + 3 * b32); \
  } while (0)
#define MF(accv, bv, av) accv = __builtin_amdgcn_mfma_f32_32x32x16_bf16(bv, av, accv, 0, 0, 0)
#define SB() __builtin_amdgcn_sched_barrier(0)
#define G_ITER(sl_, ODD, wnext_)                                                                 \
  do {                                                                                           \
    const char* st_ = smem + (sl_) * 24576;                                                      \
    const int s1_ = (sl_) + 1 >= 3 ? (sl_) - 2 : (sl_) + 1, s2_ = (sl_) + 2 >= 3 ? (sl_) - 1 : (sl_) + 2; \
    char* wr_ = smem + (wodd ? s2_ : s1_) * 24576 + woff;                                        \
    const int p0_ = ((0 + hi) ^ sw) * 16, p1_ = ((2 + hi) ^ sw) * 16;                            \
    bf16x8 b00 = *(const bf16x8*)(st_ + brow + p0_), b01 = *(const bf16x8*)(st_ + brow + 2048 + p0_); \
    bf16x8 a00 = *(const bf16x8*)(st_ + arow + p0_), a01 = *(const bf16x8*)(st_ + arow + 2048 + p0_); \
    bf16x8 a02 = *(const bf16x8*)(st_ + arow + 4096 + p0_), a03 = *(const bf16x8*)(st_ + arow + 6144 + p0_); \
    SB();                                                                                        \
    MF(acc[0][0], b00, a00); MF(acc[0][1], b01, a00);                                            \
    bf16x8 b10 = *(const bf16x8*)(st_ + brow + p1_), b11 = *(const bf16x8*)(st_ + brow + 2048 + p1_); \
    SB();                                                                                        \
    MF(acc[1][0], b00, a01); MF(acc[1][1], b01, a01);                                            \
    bf16x8 a10 = *(const bf16x8*)(st_ + arow + p1_), a11 = *(const bf16x8*)(st_ + arow + 2048 + p1_); \
    SB();                                                                                        \
    MF(acc[2][0], b00, a02); MF(acc[2][1], b01, a02);                                            \
    bf16x8 a12 = *(const bf16x8*)(st_ + arow + 4096 + p1_), a13 = *(const bf16x8*)(st_ + arow + 6144 + p1_); \
    SB();                                                                                        \
    MF(acc[3][0], b00, a03); MF(acc[3][1], b01, a03);                                            \
    if (ODD) { *(uint4*)(wr_) = Ra0; *(uint4*)(wr_ + 2048) = Ra1; *(uint4*)(wr_ + 4096) = Ra2; } \
    SB();                                                                                        \
    MF(acc[0][0], b10, a10); MF(acc[0][1], b11, a10);                                            \
    if (ODD) { *(uint4*)(wr_ + 6144) = Ra3; *(uint4*)(wr_ + 8192) = Ra4; *(uint4*)(wr_ + 10240) = Ra5; } \
    SB();                                                                                        \
    MF(acc[1][0], b10, a11); MF(acc[1][1], b11, a11);                                            \
    if (ODD) { *(uint4*)(wr_ + 12288) = Ra6; *(uint4*)(wr_ + 14336) = Ra7; *(uint4*)(wr_ + 16384) = Rb0; } \
    SB();                                                                                        \
    MF(acc[2][0], b10, a12); MF(acc[2][1], b11, a12);                                            \
    if (ODD) { *(uint4*)(wr_ + 18432) = Rb1; *(uint4*)(wr_ + 20480) = Rb2; *(uint4*)(wr_ + 22528) = Rb3; } \
    SB();                                                                                        \
    MF(acc[3][0], b10, a13); MF(acc[3][1], b11, a13);                                            \
    if (ODD) { const int wl_ = (wnext_) < nw ? (wnext_) : nw - 1; W_LOAD(wl_); }                 \
    RAW_BAR();                                                                                   \
  } while (0)
  const size_t a32 = (size_t)32 * lda, b32 = (size_t)32 * ldb;
  const int nw = nk >> 1;
  int id = obid();
  int row0 = 0, col0 = 0, tn = 0;
  const u16 *gA = A, *gB = Bt;
  uint4 Ra0, Ra1, Ra2, Ra3, Ra4, Ra5, Ra6, Ra7, Rb0, Rb1, Rb2, Rb3;
  if (id < ntiles) {
    TILE_DECODE(id, row0, col0, tn);
    gA = A + (size_t)(row0 + lrow) * lda + lc8 * 8;
    gB = Bt + (size_t)(col0 + lrow) * ldb + lc8 * 8;
    W_LOAD(0);
  }
  while (id < ntiles) {
    f32x16 acc[4][2];
#pragma unroll
    for (int m = 0; m < 4; ++m)
#pragma unroll
      for (int n = 0; n < 2; ++n)
#pragma unroll
        for (int r = 0; r < 16; ++r) acc[m][n][r] = 0.f;
    {
      char* wr_ = smem + (wodd ? 1 : 0) * 24576 + woff;
      *(uint4*)(wr_) = Ra0; *(uint4*)(wr_ + 2048) = Ra1; *(uint4*)(wr_ + 4096) = Ra2; *(uint4*)(wr_ + 6144) = Ra3;
      *(uint4*)(wr_ + 8192) = Ra4; *(uint4*)(wr_ + 10240) = Ra5; *(uint4*)(wr_ + 12288) = Ra6; *(uint4*)(wr_ + 14336) = Ra7;
      *(uint4*)(wr_ + 16384) = Rb0; *(uint4*)(wr_ + 18432) = Rb1; *(uint4*)(wr_ + 20480) = Rb2; *(uint4*)(wr_ + 22528) = Rb3;
    }
    W_LOAD(1);
    RAW_BAR();
    __builtin_amdgcn_s_setprio(1);
    int sl = 0;
    for (int w = 0; w < nw; ++w) {
      G_ITER(sl, false, 0);
      sl = sl + 1 >= 3 ? 0 : sl + 1;
      G_ITER(sl, true, w + 2);
      sl = sl + 1 >= 3 ? 0 : sl + 1;
    }
    __builtin_amdgcn_s_setprio(0);
    const int erow = row0 + wm * 128 + l31, ecol = col0 + wn * 64 + hi * 4, etn = tn;
    id += gridDim.x;
    if (id < ntiles) {
      TILE_DECODE(id, row0, col0, tn);
      gA = A + (size_t)(row0 + lrow) * lda + lc8 * 8;
      gB = Bt + (size_t)(col0 + lrow) * ldb + lc8 * 8;
      W_LOAD(0);
    }
    epi(acc, erow, ecol, etn);
  }
}

struct EpiInProj {
  u16* proj; float* small_;
  __device__ __forceinline__ void operator()(f32x16 (&acc)[4][2], int rbase, int cbase, int tn) const {
    if (tn < 24) {
#pragma unroll
      for (int m = 0; m < 4; ++m)
#pragma unroll
        for (int n = 0; n < 2; ++n)
#pragma unroll
          for (int g = 0; g < 4; ++g) {
            uint2 o;
            o.x = pack2(acc[m][n][g * 4 + 0], acc[m][n][g * 4 + 1]);
            o.y = pack2(acc[m][n][g * 4 + 2], acc[m][n][g * 4 + 3]);
            *(uint2*)(proj + (size_t)(rbase + m * 32) * PJ + cbase + n * 32 + g * 8) = o;
          }
    } else {
#pragma unroll
      for (int m = 0; m < 4; ++m)
#pragma unroll
        for (int g = 0; g < 4; ++g) {
          int c = cbase + g * 8 - 3072;
          if (c < 32)
            *(float4*)(small_ + (size_t)(rbase + m * 32) * 32 + c) =
                make_float4(acc[m][0][g * 4 + 0], acc[m][0][g * 4 + 1], acc[m][0][g * 4 + 2], acc[m][0][g * 4 + 3]);
        }
    }
  }
};
struct EpiResid {
  const float* xin; float* xout;
  __device__ __forceinline__ void operator()(f32x16 (&acc)[4][2], int rbase, int cbase, int tn) const {
#pragma unroll
    for (int m = 0; m < 4; ++m)
#pragma unroll
      for (int n = 0; n < 2; ++n)
#pragma unroll
        for (int g = 0; g < 4; ++g) {
          size_t idx = (size_t)(rbase + m * 32) * DM + cbase + n * 32 + g * 8;
          float4 x = *(const float4*)(xin + idx);
          x.x += acc[m][n][g * 4 + 0]; x.y += acc[m][n][g * 4 + 1]; x.z += acc[m][n][g * 4 + 2]; x.w += acc[m][n][g * 4 + 3];
          *(float4*)(xout + idx) = x;
        }
  }
};
struct EpiSwiGLU {
  u16* act;
  __device__ __forceinline__ void operator()(f32x16 (&acc)[4][2], int rbase, int cbase, int tn) const {
    int grp = cbase >> 6, c4 = cbase & 7;
#pragma unroll
    for (int m = 0; m < 4; ++m)
#pragma unroll
      for (int g = 0; g < 4; ++g) {
        float v[4];
#pragma unroll
        for (int r = 0; r < 4; ++r) {
          float gt = acc[m][0][g * 4 + r], up = acc[m][1][g * 4 + r];
          v[r] = gt / (1.f + __expf(-gt)) * up;
        }
        uint2 o;
        o.x = pack2(v[0], v[1]);
        o.y = pack2(v[2], v[3]);
        *(uint2*)(act + (size_t)(rbase + m * 32) * DFF + grp * 32 + g * 8 + c4) = o;
      }
  }
};

__device__ __forceinline__ void gdn_chunk_prep(KP p, int l, char* smem, int job) {
  const int b = job >> 10, h = (job >> 8) & 3, c = job & 255;
  const int tid = otid(), lane = tid & 63, wv = tid >> 6;
  float* sq = (float*)smem;
  float* sk = sq + 64 * 65;
  float* sv = sk + 64 * 65;
  float* sA = sv + 64 * 65;
  float* sgc = sA + 64 * 64;
  float* sbeta = sgc + 64;
  float* seg = sbeta + 64;
  float* sf2 = seg + 64;
  const u16* proj = (const u16*)(p->ws + OFF_PROJ);
  const float* small_ = (const float*)(p->ws + OFF_SMALL);
  const size_t tok0 = (size_t)b * T + c * 64;
  char* cb = p->ws + OFF_GDN + (size_t)((b * 4 + h) * 256 + c) * CHUNK_B;
  float* UT = (float*)cb;
  u16* NW = (u16*)(cb + 16384);
  u16* QD = (u16*)(cb + 24576);
  u16* KDT = (u16*)(cb + 32768);
  u16* QKM = (u16*)(cb + 40960);
  {
    int d = lane, i0 = wv * 16;
#pragma unroll
    for (int seg_ = 0; seg_ < 3; ++seg_) {
      int ch = seg_ * 256 + h * 64 + d;
      const float* cw = p->gdn_conv_w + (size_t)l * 4 * 768 + ch;
      float w0 = cw[0], w1 = cw[768], w2 = cw[1536], w3 = cw[2304];
      float* dst = seg_ == 0 ? sq : (seg_ == 1 ? sk : sv);
      float x0 = 0, x1 = 0, x2 = 0;
      int tl = c * 64 + i0;
      if (tl - 3 >= 0) x0 = bf2f(proj[(tok0 + i0 - 3) * PJ + ch]);
      if (tl - 2 >= 0) x1 = bf2f(proj[(tok0 + i0 - 2) * PJ + ch]);
      if (tl - 1 >= 0) x2 = bf2f(proj[(tok0 + i0 - 1) * PJ + ch]);
      for (int i = 0; i < 16; ++i) {
        float x3 = bf2f(proj[(tok0 + i0 + i) * PJ + ch]);
        float y = w0 * x0 + w1 * x1 + w2 * x2 + w3 * x3;
        dst[(i0 + i) * 65 + d] = y / (1.f + __expf(-y));
        x0 = x1; x1 = x2; x2 = x3;
      }
    }
  }
  if (tid < 64) {
    float gb = small_[(tok0 + tid) * 32 + h], ga = small_[(tok0 + tid) * 32 + 4 + h];
    float xx = ga + p->gdn_dt_bias[l * 4 + h];
    float sp = fmaxf(xx, 0.f) + log1pf(__expf(-fabsf(xx)));
    float g = -__expf(p->gdn_a_log[l * 4 + h]) * sp;
#pragma unroll
    for (int o = 1; o < 64; o <<= 1) {
      float t = __shfl_up(g, o);
      if (lane >= o) g += t;
    }
    float beta = sigmoidf_(gb);
    float eg = __expf(g);
    sgc[tid] = g; sbeta[tid] = beta; seg[tid] = eg; sf2[tid] = beta * eg;
    if (tid == 63) ((float*)(p->ws + OFF_GL))[(b * 4 + h) * 256 + c] = eg;
  }
  __syncthreads();
  if (tid < 128) {
    float* rowp = (tid < 64 ? sq : sk) + (tid & 63) * 65;
    float ss = 0.f;
#pragma unroll 16
    for (int d = 0; d < 64; ++d) ss += rowp[d] * rowp[d];
    const float sc = rsqrtf(ss + 1e-6f) * (tid < 64 ? 0.125f : 1.f);
#pragma unroll 16
    for (int d = 0; d < 64; ++d) rowp[d] *= sc;
  }
  __syncthreads();
  {
    int ti = tid >> 4, tj = tid & 15;
    float kk[4][4], qk[4][4];
#pragma unroll
    for (int a = 0; a < 4; ++a)
#pragma unroll
      for (int bb = 0; bb < 4; ++bb) { kk[a][bb] = 0.f; qk[a][bb] = 0.f; }
    if (tj <= ti) {
      for (int d = 0; d < 64; ++d) {
        float ki[4], kj[4], qi[4];
#pragma unroll
        for (int a = 0; a < 4; ++a) {
          ki[a] = sk[(ti * 4 + a) * 65 + d];
          qi[a] = sq[(ti * 4 + a) * 65 + d];
          kj[a] = sk[(tj * 4 + a) * 65 + d];
        }
#pragma unroll
        for (int a = 0; a < 4; ++a)
#pragma unroll
          for (int bb = 0; bb < 4; ++bb) { kk[a][bb] += ki[a] * kj[bb]; qk[a][bb] += qi[a] * kj[bb]; }
      }
    }
#pragma unroll
    for (int a = 0; a < 4; ++a) {
      int i = ti * 4 + a;
      float gi = sgc[i], bi = sbeta[i];
      uint2 o;
      float qv[4];
#pragma unroll
      for (int bb = 0; bb < 4; ++bb) {
        int j = tj * 4 + bb;
        float dec = (j <= i) ? __expf(gi - sgc[j]) : 0.f;
        sA[i * 64 + j] = (j < i) ? bi * kk[a][bb] * dec : 0.f;
        qv[bb] = qk[a][bb] * dec;
      }
      o.x = pack2(qv[0], qv[1]); o.y = pack2(qv[2], qv[3]);
      *(uint2*)(QKM + i * 64 + tj * 4) = o;
    }
  }
  {
    float gl = sgc[63];
    for (int idx = tid; idx < 4096; idx += 256) {
      int i = idx >> 6, d = idx & 63;
      QD[idx] = f2bf(sq[i * 65 + d] * seg[i]);
      KDT[idx] = f2bf(sk[d * 65 + i] * __expf(gl - sgc[d]));
    }
  }
  __syncthreads();
  if (tid < 128) {
    int cidx = tid;
    const float* src = cidx < 64 ? sv + cidx : sk + (cidx - 64);
    const float* fac = cidx < 64 ? sbeta : sf2;
    float x[64];
#pragma unroll
    for (int i = 0; i < 64; ++i) {
      float s0 = src[i * 65] * fac[i], s1 = 0.f, s2 = 0.f, s3 = 0.f;
#pragma unroll
      for (int j = 0; j < i; ++j) {
        if ((j & 3) == 0) s0 -= sA[i * 64 + j] * x[j];
        else if ((j & 3) == 1) s1 -= sA[i * 64 + j] * x[j];
        else if ((j & 3) == 2) s2 -= sA[i * 64 + j] * x[j];
        else s3 -= sA[i * 64 + j] * x[j];
      }
      x[i] = (s0 + s1) + (s2 + s3);
    }
    if (cidx < 64) {
#pragma unroll
      for (int i = 0; i < 64; i += 4) *(float4*)(UT + cidx * 64 + i) = make_float4(x[i], x[i + 1], x[i + 2], x[i + 3]);
    } else {
#pragma unroll
      for (int i = 0; i < 64; ++i) NW[i * 64 + (cidx - 64)] = f2bf(-x[i]);
    }
  }
  __syncthreads();
}

__device__ __forceinline__ void gdn_scan(KP p, char* smem, int sid) {
  const int b = sid >> 4, h = (sid >> 2) & 3, v0 = (sid & 3) * 16;
  const int tid = otid(), lane = tid & 63, wv = tid >> 6, l15 = lane & 15, quad = lane >> 4;
  u16* Sb = (u16*)smem;
  u16* Vb = Sb + 16 * 72;
  f32x4 S = {0.f, 0.f, 0.f, 0.f};
  { u32 z0 = 0u; asm volatile("" : "+v"(z0)); *(uint2*)(Sb + l15 * 72 + 16 * wv + quad * 4) = make_uint2(z0, z0); }
  __syncthreads();
  const char* gbase = p->ws + OFF_GDN + (size_t)((b * 4 + h) * 256) * CHUNK_B;
  const float* GL = (const float*)(p->ws + OFF_GL) + (b * 4 + h) * 256;
  float* OG = (float*)(p->ws + OFF_OG);
  const int arow = (16 * wv + l15) * 64 + quad * 8;
  f32x4 u, un;
  bf16x8 wA[2], qdA[2], qkA[2], kdA[2], wAn[2], qdAn[2], qkAn[2], kdAn[2];
  float gl, gln;
  {
    const char* cb = gbase;
    u = *(const f32x4*)((const float*)cb + (v0 + l15) * 64 + 16 * wv + quad * 4);
#pragma unroll
    for (int ks = 0; ks < 2; ++ks) {
      wA[ks] = *(const bf16x8*)((const u16*)(cb + 16384) + arow + ks * 32);
      qdA[ks] = *(const bf16x8*)((const u16*)(cb + 24576) + arow + ks * 32);
      kdA[ks] = *(const bf16x8*)((const u16*)(cb + 32768) + arow + ks * 32);
      qkA[ks] = *(const bf16x8*)((const u16*)(cb + 40960) + arow + ks * 32);
    }
    gl = GL[0];
  }
  for (int c = 0; c < 256; ++c) {
    if (c + 1 < 256) {
      const char* cb = gbase + (size_t)(c + 1) * CHUNK_B;
      un = *(const f32x4*)((const float*)cb + (v0 + l15) * 64 + 16 * wv + quad * 4);
#pragma unroll
      for (int ks = 0; ks < 2; ++ks) {
        wAn[ks] = *(const bf16x8*)((const u16*)(cb + 16384) + arow + ks * 32);
        qdAn[ks] = *(const bf16x8*)((const u16*)(cb + 24576) + arow + ks * 32);
        kdAn[ks] = *(const bf16x8*)((const u16*)(cb + 32768) + arow + ks * 32);
        qkAn[ks] = *(const bf16x8*)((const u16*)(cb + 40960) + arow + ks * 32);
      }
      gln = GL[c + 1];
    }
    bf16x8 sB0 = *(const bf16x8*)(Sb + l15 * 72 + quad * 8);
    bf16x8 sB1 = *(const bf16x8*)(Sb + l15 * 72 + 32 + quad * 8);
    f32x4 vn = u;
    vn = mfma16(wA[0], sB0, vn);
    vn = mfma16(wA[1], sB1, vn);
    f32x4 o = {0.f, 0.f, 0.f, 0.f};
    o = mfma16(qdA[0], sB0, o);
    o = mfma16(qdA[1], sB1, o);
    *(uint2*)(Vb + l15 * 72 + 16 * wv + quad * 4) = make_uint2(pack2(vn[0], vn[1]), pack2(vn[2], vn[3]));
    __syncthreads();
    bf16x8 vB0 = *(const bf16x8*)(Vb + l15 * 72 + quad * 8);
    bf16x8 vB1 = *(const bf16x8*)(Vb + l15 * 72 + 32 + quad * 8);
    o = mfma16(qkA[0], vB0, o);
    o = mfma16(qkA[1], vB1, o);
    S[0] *= gl; S[1] *= gl; S[2] *= gl; S[3] *= gl;
    S = mfma16(kdA[0], vB0, S);
    S = mfma16(kdA[1], vB1, S);
    *(uint2*)(Sb + l15 * 72 + 16 * wv + quad * 4) = make_uint2(pack2(S[0], S[1]), pack2(S[2], S[3]));
    size_t orow = (size_t)b * T + c * 64 + 16 * wv + quad * 4;
#pragma unroll
    for (int r = 0; r < 4; ++r) OG[(orow + r) * 256 + h * 64 + v0 + l15] = o[r];
    __syncthreads();
    u = un; gl = gln;
#pragma unroll
    for (int ks = 0; ks < 2; ++ks) { wA[ks] = wAn[ks]; qdA[ks] = qdAn[ks]; kdA[ks] = kdAn[ks]; qkA[ks] = qkAn[ks]; }
  }
}

__device__ __forceinline__ void gdn_finalize(KP p, int l) {
  const int lane = otid() & 63;
  int gw = obid() * 4 + (otid() >> 6), nw = gridDim.x * 4;
  const float* OG = (const float*)(p->ws + OFF_OG);
  const u16* proj = (const u16*)(p->ws + OFF_PROJ);
  u16* mix = (u16*)(p->ws + OFF_H);
  float gn = p->gdn_norm[l * 64 + lane];
  for (int row = gw; row < NTOK * 4; row += nw) {
    int t = row >> 2, h = row & 3;
    float o = OG[(size_t)t * 256 + h * 64 + lane];
    float ss = wave_sum(o * o);
    float z = bf2f(proj[(size_t)t * PJ + C_GZ + h * 64 + lane]);
    float y = o * rsqrtf(ss * (1.f / 64.f) + 1e-6f) * gn * (z / (1.f + __expf(-z)));
    mix[(size_t)t * DM + h * 64 + lane] = f2bf(ZTEST == 4 ? 0.f : y);
  }
}

__device__ __forceinline__ void rope_table(KP p) {
  float* rp = (float*)(p->ws + OFF_ROPE);
  int gt = obid() * blockDim.x + otid(), nt = gridDim.x * blockDim.x;
  for (int idx = gt; idx < NTOK * 8; idx += nt) {
    int t = idx >> 3, i = idx & 7;
    float inv = (float)pow(500000.0, -(double)i / 8.0);
    float ang = (float)p->positions[t] * inv;
    rp[t * 16 + i] = (float)cos((double)ang);
    rp[t * 16 + 8 + i] = (float)sin((double)ang);
  }
}

__device__ __forceinline__ void nsa_token_prep(KP p, int l, char* smem, int tb) {
  const int tid = otid(), lane = tid & 63, wv = tid >> 6;
  const int b = tb >> 8, blk = tb & 255;
  u16* proj = (u16*)(p->ws + OFF_PROJ);
  const float* rope = (const float*)(p->ws + OFF_ROPE);
  const size_t tok0 = (size_t)tb * 64;
  for (int r = tid; r < 768; r += 256) {
    int i = r / 12, which = r % 12;
    size_t t = tok0 + i;
    int col; const float* gain;
    if (which < 8) { col = C_NQ + which * 64; gain = p->nsa_q_norm + l * 64; }
    else if (which < 10) { col = C_KSLC + (which - 8) * 64; gain = p->nsa_k_norm + (l * 3 + 1) * 64; }
    else { col = C_KWIN + (which - 10) * 64; gain = p->nsa_k_norm + (l * 3 + 2) * 64; }
    u16* rowp = proj + t * PJ + col;
    union { uint4 q; u16 h[8]; } v[8];
    float ss = 0.f;
#pragma unroll
    for (int c = 0; c < 8; ++c) {
      v[c].q = *(const uint4*)(rowp + c * 8);
#pragma unroll
      for (int e = 0; e < 8; ++e) { float x = bf2f(v[c].h[e]); ss += x * x; }
    }
    const float rs = rsqrtf(ss * (1.f / 64.f) + 1e-6f);
    float y0[16];
#pragma unroll
    for (int e = 0; e < 16; ++e) y0[e] = bf2f(v[e >> 3].h[e & 7]) * rs * gain[e];
    if (which >= 8) {
      const float* rp = rope + t * 16;
#pragma unroll
      for (int e = 0; e < 8; ++e) {
        float c = rp[e], sn = rp[8 + e];
        float a1 = y0[e], a2 = y0[8 + e];
        y0[e] = a1 * c - a2 * sn;
        y0[8 + e] = a2 * c + a1 * sn;
      }
    }
#pragma unroll
    for (int c = 0; c < 8; ++c) {
      uint4 o;
      float y[8];
#pragma unroll
      for (int e = 0; e < 8; ++e) y[e] = c < 2 ? y0[c * 8 + e] : bf2f(v[c].h[e]) * rs * gain[c * 8 + e];
      o.x = pack2(y[0], y[1]); o.y = pack2(y[2], y[3]); o.z = pack2(y[4], y[5]); o.w = pack2(y[6], y[7]);
      *(uint4*)(rowp + c * 8) = o;
    }
  }
  u16* tt = (u16*)smem;
  for (int z = 0; z < 4; ++z) {
    int tensor = z >> 1, g = z & 1;
    int col = (tensor ? C_VWIN : C_VSLC) + g * 64;
    for (int idx = tid; idx < 4096; idx += 256) {
      int i = idx >> 6, d = idx & 63;
      tt[i * 66 + d] = proj[(tok0 + i) * PJ + col + d];
    }
    __syncthreads();
    u16* dst = (u16*)(p->ws + OFF_VT + (size_t)tensor * 8 * MiB) + ((size_t)((b * 2 + g) * 256 + blk)) * 4096;
    for (int idx = tid; idx < 4096; idx += 256) {
      int d = idx >> 6, i = idx & 63;
      dst[idx] = tt[i * 66 + d];
    }
    __syncthreads();
  }
  {
    int ch = tid;
    const float* cw = p->conv_w + (size_t)l * 3 * 256 + ch;
    float w0 = cw[0], w1 = cw[256], w2 = cw[512];
    u16* mix = (u16*)(p->ws + OFF_H);
    float p0 = 0.f, p1 = 0.f;
    if (blk > 0) {
      p0 = bf2f(proj[(tok0 - 2) * PJ + C_CC + ch]) * bf2f(proj[(tok0 - 2) * PJ + C_CX + ch]);
      p1 = bf2f(proj[(tok0 - 1) * PJ + C_CC + ch]) * bf2f(proj[(tok0 - 1) * PJ + C_CX + ch]);
    }
    for (int i = 0; i < 64; ++i) {
      size_t t = tok0 + i;
      float p2 = bf2f(proj[t * PJ + C_CC + ch]) * bf2f(proj[t * PJ + C_CX + ch]);
      float y = w0 * p0 + w1 * p1 + w2 * p2;
      mix[t * DM + 768 + ch] = f2bf(ZTEST == 5 ? 0.f : bf2f(proj[t * PJ + C_CB + ch]) * y);
      p0 = p1; p1 = p2;
    }
  }
}

__device__ __forceinline__ void nsa_compress(KP p, int l, char* smem, int job) {
  const int tid = otid(), lane = tid & 63, wv = tid >> 6, l15 = lane & 15, quad = lane >> 4;
  const int which = job >> 6, b = (job >> 5) & 1, g = (job >> 4) & 1, tile = job & 15;
  const u16* proj = (const u16*)(p->ws + OFF_PROJ);
  const u16* W1T = (const u16*)(p->ws + OFF_W + W_C1) + (size_t)which * 64 * 2048;
  const u16* W2T = (const u16*)(p->ws + OFF_W + W_C2) + which * 4096;
  const float* pe = p->cmp_pe + (size_t)(l * 2 + which) * 32 * 64;
  const int blk0 = tile * 64 + wv * 16;
  int blk = blk0 + l15;
  int blkc = blk < 1023 ? blk : 1022;
  const u16* arow = proj + ((size_t)b * T + blkc * 16) * PJ + (which ? C_VCMP : C_KCMP) + g * 64;
  f32x4 acc[4];
#pragma unroll
  for (int n = 0; n < 4; ++n) acc[n] = f32x4{0.f, 0.f, 0.f, 0.f};
  for (int ks = 0; ks < 64; ++ks) {
    int tok = ks >> 1, d0 = (ks & 1) * 32 + quad * 8;
    uint4 raw = *(const uint4*)(arow + (size_t)tok * PJ + d0);
    float4 pe0 = *(const float4*)(pe + tok * 64 + d0), pe1 = *(const float4*)(pe + tok * 64 + d0 + 4);
    union { bf16x8 v; u32 u[4]; } af;
    af.u[0] = pack2(bf2f(raw.x & 0xffff) + pe0.x, bf2f(raw.x >> 16) + pe0.y);
    af.u[1] = pack2(bf2f(raw.y & 0xffff) + pe0.z, bf2f(raw.y >> 16) + pe0.w);
    af.u[2] = pack2(bf2f(raw.z & 0xffff) + pe1.x, bf2f(raw.z >> 16) + pe1.y);
    af.u[3] = pack2(bf2f(raw.w & 0xffff) + pe1.z, bf2f(raw.w >> 16) + pe1.w);
#pragma unroll
    for (int n = 0; n < 4; ++n) {
      bf16x8 bfr = *(const bf16x8*)(W1T + (size_t)(n * 16 + l15) * 2048 + ks * 32 + quad * 8);
      acc[n] = mfma16(af.v, bfr, acc[n]);
    }
  }
  u16* hid = (u16*)smem + wv * 16 * 72;
#pragma unroll
  for (int n = 0; n < 4; ++n)
#pragma unroll
    for (int r = 0; r < 4; ++r) {
      float x = acc[n][r];
      float u = 0.7978845608028654f * (x + 0.044715f * x * x * x);
      float gl = 0.5f * x * (1.f + tanhf(u));
      hid[(quad * 4 + r) * 72 + n * 16 + l15] = f2bf(gl);
    }
  __syncthreads();
  f32x4 o2[4];
#pragma unroll
  for (int n = 0; n < 4; ++n) o2[n] = f32x4{0.f, 0.f, 0.f, 0.f};
#pragma unroll
  for (int ks = 0; ks < 2; ++ks) {
    bf16x8 af = *(const bf16x8*)(hid + l15 * 72 + ks * 32 + quad * 8);
#pragma unroll
    for (int n = 0; n < 4; ++n) {
      bf16x8 bfr = *(const bf16x8*)(W2T + (n * 16 + l15) * 64 + ks * 32 + quad * 8);
      o2[n] = mfma16(af, bfr, o2[n]);
    }
  }
  __syncthreads();
  if (which == 0) {
    u16* KC = (u16*)(p->ws + OFF_KC) + (size_t)(b * 2 + g) * 1024 * 64;
    const float* kg = p->nsa_k_norm + (l * 3 + 0) * 64;
#pragma unroll
    for (int r = 0; r < 4; ++r) {
      float ss = 0.f;
#pragma unroll
      for (int n = 0; n < 4; ++n) ss += o2[n][r] * o2[n][r];
      ss += __shfl_xor(ss, 1); ss += __shfl_xor(ss, 2); ss += __shfl_xor(ss, 4); ss += __shfl_xor(ss, 8);
      float rs = rsqrtf(ss * (1.f / 64.f) + 1e-6f);
      int row = blk0 + quad * 4 + r;
#pragma unroll
      for (int n = 0; n < 4; ++n) {
        float v = row < 1023 ? o2[n][r] * rs * kg[n * 16 + l15] : 0.f;
        KC[(size_t)row * 64 + n * 16 + l15] = f2bf(v);
      }
    }
  } else {
    u16* VCT = (u16*)(p->ws + OFF_KC + 524288) + (size_t)(b * 2 + g) * 64 * 1024;
#pragma unroll
    for (int r = 0; r < 4; ++r) {
      int row = blk0 + quad * 4 + r;
#pragma unroll
      for (int n = 0; n < 4; ++n) {
        float v = row < 1023 ? o2[n][r] : 0.f;
        VCT[(size_t)(n * 16 + l15) * 1024 + row] = f2bf(v);
      }
    }
  }
}

template <int MODE, int NT>
__device__ __forceinline__ void flash2(const u16* __restrict__ Kg, int kld, const u16* __restrict__ VTg, int vblk,
                                       int vld, int h0, int h1, char* sStage, const u16* sQw, f32x4 (&O)[4][NT],
                                       float (&lsum)[NT], const float (&inv)[NT], const u32* sSelw, float* slc,
                                       int tq0) {
  const int tid = otid(), lane = tid & 63, wv = tid >> 6, l15 = lane & 15, quad = lane >> 4;
  const int krow = tid >> 3, kc = tid & 7;
  const u16* kptr = Kg + (size_t)krow * kld + kc * 8;
  const int kw = krow * 128 + ((kc ^ ((krow >> 1) & 7)) * 16);
  const int vd = tid >> 2, vc = tid & 3;
  const u16* vptr = VTg + (size_t)vd * vld + vc * 8;
  const int vw = 4096 + vd * 64 + ((vc ^ ((vd >> 2) & 3)) * 16);
  const int jb0 = h0 >> 1, nst = (h1 >> 1) - jb0 + 1;
  uint4 S0k0, S0k1, S0v0, S0v1, S1k0, S1k1, S1v0, S1v1;
#define F2_LOAD(S, i_)                                                                             \
  do {                                                                                             \
    const int jb_ = jb0 + (i_);                                                                    \
    S##k0 = *(const uint4*)(kptr + (size_t)(jb_ * 64) * kld);                                      \
    S##k1 = *(const uint4*)(kptr + (size_t)(jb_ * 64 + 32) * kld);                                 \
    if (MODE != 2) {                                                                               \
      S##v0 = *(const uint4*)(vptr + (size_t)jb_ * vblk);                                          \
      S##v1 = *(const uint4*)(vptr + (size_t)jb_ * vblk + 32);                                     \
    }                                                                                              \
  } while (0)
#define F2_WRITE(S, slot_)                                                     \
  do {                                                                         \
    char* sl_ = sStage + (slot_) * 16384;                                      \
    *(uint4*)(sl_ + kw) = S##k0;                                               \
    *(uint4*)(sl_ + 8192 + kw) = S##k1;                                        \
    if (MODE != 2) {                                                           \
      *(uint4*)(sl_ + vw) = S##v0;                                             \
      *(uint4*)(sl_ + 8192 + vw) = S##v1;                                      \
    }                                                                          \
  } while (0)
  if (0 < nst) F2_LOAD(S0, 0);
  if (1 < nst) F2_LOAD(S1, 1);
  const int koff = l15 * 128;
  const int ksw = (l15 >> 1) & 7;
  const int voff = 4096 + l15 * 64 + (quad & 1) * 8;
  const int vsw = (l15 >> 2) & 3;
  const int tq0u = __builtin_amdgcn_readfirstlane(tq0);
  const int lim0u = tq0u >= 31 ? ((tq0u - 31) >> 4) : -1;
  auto compute = [&](const int h, const char* st) __attribute__((always_inline)) {
    bool interior;
    if (MODE == 0) interior = (h * 32 + 31 <= tq0u) && (h * 32 > tq0u + NT * 4 - 1 - 512);
    else if (MODE == 1) interior = (h * 32 + 31 <= tq0u);
    else interior = (h * 32 + 31 <= lim0u);
    bool bv[NT], an[NT];
    bool anyw = false;
#pragma unroll
    for (int nt = 0; nt < NT; ++nt) {
      if (MODE == 1) {
        u32 w = sSelw[(nt * 4 + (l15 >> 2)) * 8 + (h >> 6)];
        bv[nt] = (w >> ((h >> 1) & 31)) & 1u;
      } else {
        bv[nt] = true;
      }
      an[nt] = MODE == 1 ? (bool)__any(bv[nt]) : true;
      anyw |= an[nt];
    }
    if (anyw) {
      bf16x8 kf[2][2], vf[4];
#pragma unroll
      for (int m2 = 0; m2 < 2; ++m2)
#pragma unroll
        for (int ks = 0; ks < 2; ++ks)
          kf[m2][ks] = *(const bf16x8*)(st + koff + m2 * 2048 + (((ks * 4 + quad) ^ ksw) * 16));
      if (MODE != 2) {
#pragma unroll
        for (int dt = 0; dt < 4; ++dt) {
          union { bf16x8 v; uint2 h2[2]; } u;
          u.h2[0] = *(const uint2*)(st + voff + dt * 1024 + (((quad >> 1) ^ vsw) * 16));
          u.h2[1] = *(const uint2*)(st + voff + dt * 1024 + (((2 + (quad >> 1)) ^ vsw) * 16));
          vf[dt] = u.v;
        }
      }
#pragma unroll
      for (int nt = 0; nt < NT; ++nt) {
        if (!an[nt]) continue;
        const int t = tq0 + nt * 4 + (l15 >> 2);
        const bf16x8 bq0 = *(const bf16x8*)(sQw + (nt * 16 + l15) * 72 + quad * 8);
        const bf16x8 bq1 = *(const bf16x8*)(sQw + (nt * 16 + l15) * 72 + 32 + quad * 8);
        f32x4 s[2];
#pragma unroll
        for (int m2 = 0; m2 < 2; ++m2) {
          s[m2] = f32x4{0.f, 0.f, 0.f, 0.f};
          s[m2] = mfma16(kf[m2][0], bq0, s[m2]);
          s[m2] = mfma16(kf[m2][1], bq1, s[m2]);
        }
        const float bias = MODE == 1 ? (bv[nt] ? 0.f : -1000.f) : (MODE == 3 ? inv[nt] : 0.f);
        if (interior) {
#pragma unroll
          for (int m2 = 0; m2 < 2; ++m2)
#pragma unroll
            for (int r = 0; r < 4; ++r) s[m2][r] = __builtin_amdgcn_exp2f(fmaf(s[m2][r], SC2, bias));
        } else {
          int base;
          if (MODE <= 1) base = h * 32 + quad * 4 - t;
          else base = h * 32 + quad * 4 - (t >= 31 ? ((t - 31) >> 4) : -1);
          asm volatile("" : "+v"(base));
#pragma unroll
          for (int m2 = 0; m2 < 2; ++m2)
#pragma unroll
            for (int r = 0; r < 4; ++r) {
              const int C = m2 * 16 + r;
              bool valid;
              if (MODE == 0) valid = base <= -C && base > -512 - C;
              else valid = base <= -C;
              float pvv = __builtin_amdgcn_exp2f(fmaf(s[m2][r], SC2, bias));
              s[m2][r] = valid ? pvv : 0.f;
            }
        }
        float ls = ((s[0][0] + s[0][1]) + (s[0][2] + s[0][3])) + ((s[1][0] + s[1][1]) + (s[1][2] + s[1][3]));
        if (MODE != 3) lsum[nt] += ls;
        if (MODE == 3) {
#pragma unroll
          for (int m2 = 0; m2 < 2; ++m2) {
            float ow = s[m2][0] + s[m2][1] + s[m2][2] + 0.5f * s[m2][3];
            float sp = 0.5f * s[m2][3];
            ow += __shfl_xor(ow, 1); ow += __shfl_xor(ow, 2);
            sp += __shfl_xor(sp, 1); sp += __shfl_xor(sp, 2);
            if ((l15 & 3) == 0) {
              const int j = h * 8 + m2 * 4 + quad;
              slc[(nt * 4 + (l15 >> 2)) * 256 + j] = ow;
              if (j + 1 < 256) slc[1024 + (nt * 4 + (l15 >> 2)) * 256 + j + 1] = sp;
            }
          }
        }
        if (MODE != 2) {
          bf16x8 P = pack8(s[0], s[1]);
#pragma unroll
          for (int dt = 0; dt < 4; ++dt) O[dt][nt] = mfma16(vf[dt], P, O[dt][nt]);
        }
      }
    }
  };
  if (0 < nst) F2_WRITE(S0, 0);
  if (2 < nst) F2_LOAD(S0, 2);
  RAW_BAR();
#define F2_ITER(u_, SN, sn_)                                            \
  if (i + (u_) < nst) {                                                 \
    const int ii_ = i + (u_);                                           \
    if (ii_ + 1 < nst) F2_WRITE(SN, sn_);                               \
    if (ii_ + 3 < nst) F2_LOAD(SN, ii_ + 3);                            \
    compute(2 * (jb0 + ii_), sStage + (u_) * 16384);                    \
    compute(2 * (jb0 + ii_) + 1, sStage + (u_) * 16384 + 8192);         \
    RAW_BAR();                                                          \
  }
  for (int i = 0; i < nst; i += 2) {
    F2_ITER(0, S1, 1)
    F2_ITER(1, S0, 0)
  }
}

__device__ __forceinline__ void nsa_phase_c(KP p, int l, char* smem) {
  const int tid = otid(), lane = tid & 63, wv = tid >> 6, l15 = lane & 15, quad = lane >> 4;
  char* sStage = smem;
  u16* sQw = (u16*)(smem + 32768) + wv * 16 * 72;
  float* own = (float*)(smem + 32768 + 9216) + wv * 2048;
  float* spl = own + 1024;
  const u16* proj = (const u16*)(p->ws + OFF_PROJ);
  const float* small_ = (const float*)(p->ws + OFF_SMALL);
  float* OC = (float*)(p->ws + OFF_OC);
  u32* SEL = (u32*)(p->ws + OFF_SEL);
  for (int job = obid(); job < 4096; job += gridDim.x) {
    const int qt = 1023 - (job >> 2), bg = job & 3, b = bg >> 1, g = bg & 1;
    const int t0 = qt * 16 + wv * 4;
    const int ql = l15 >> 2, r_ = l15 & 3, head = g * 4 + r_;
    const int t = t0 + ql;
    const size_t tok = (size_t)b * T + t;
    const u16* KC = (const u16*)(p->ws + OFF_KC) + (size_t)bg * 1024 * 64;
    const u16* VCT = (const u16*)(p->ws + OFF_KC + 524288) + (size_t)bg * 64 * 1024;
    {
      const u16* qrow = proj + tok * PJ + C_NQ + head * 64;
      *(bf16x8*)(sQw + l15 * 72 + quad * 8) = *(const bf16x8*)(qrow + quad * 8);
      *(bf16x8*)(sQw + l15 * 72 + 32 + quad * 8) = *(const bf16x8*)(qrow + 32 + quad * 8);
    }
    const int tmax = qt * 16 + 15;
    const int nvmax = tmax >= 31 ? ((tmax - 31) >> 4) + 1 : 0;
    const int h1 = ((nvmax + 31) >> 5) - 1;
    f32x4 O[4][1];
    float lsum[1] = {0.f}, inv[1] = {0.f};
#pragma unroll
    for (int dt = 0; dt < 4; ++dt) O[dt][0] = f32x4{0.f, 0.f, 0.f, 0.f};
    if (h1 >= 0) {
      flash2<2, 1>(KC, 64, VCT, 64, 1024, 0, h1, sStage, sQw, O, lsum, inv, nullptr, own, t0);
      float ls = lsum[0];
      ls += __shfl_xor(ls, 16);
      ls += __shfl_xor(ls, 32);
      inv[0] = ls > 0.f ? -log2f(ls) : -1000.f;
      flash2<3, 1>(KC, 64, VCT, 64, 1024, 0, h1, sStage, sQw, O, lsum, inv, nullptr, own, t0);
    }
    {
      float gc = ZTEST == 1 ? 0.f : sigmoidf_(small_[tok * 32 + 8 + head * 3 + 0]);
#pragma unroll
      for (int dt = 0; dt < 4; ++dt) {
        float4 o = make_float4(O[dt][0][0] * gc, O[dt][0][1] * gc, O[dt][0][2] * gc, O[dt][0][3] * gc);
        *(float4*)(OC + tok * 512 + head * 64 + dt * 16 + quad * 4) = o;
      }
    }
    __builtin_amdgcn_wave_barrier();
    for (int q = 0; q < 4; ++q) {
      const int tq = t0 + q, cur = tq >> 6;
      u32 word = 0;
      if (cur <= 15) {
        if (lane == 0) word = (2u << cur) - 1u;
      } else {
        u32 key[4];
#pragma unroll
        for (int k = 0; k < 4; ++k) {
          int j = lane + 64 * k;
          float v = own[q * 256 + j] + spl[q * 256 + j];
          key[k] = (j >= 1 && j <= cur - 2) ? (__float_as_uint(fmaxf(v, 0.f)) + 1u) : 0u;
        }
        u32 T = 0u;
        for (int bit = 30; bit >= 0; --bit) {
          const u32 cand = T | (1u << bit);
          int cnt = 0;
#pragma unroll
          for (int k = 0; k < 4; ++k) cnt += __popcll(__ballot(key[k] >= cand));
          if (cnt >= 13) T = cand;
        }
        int ngt = 0;
#pragma unroll
        for (int k = 0; k < 4; ++k) ngt += __popcll(__ballot(key[k] > T));
        int quota = 13 - ngt;
        const unsigned long long lt = (1ull << lane) - 1ull;
#pragma unroll
        for (int k = 0; k < 4; ++k) {
          const unsigned long long me = __ballot(key[k] == T);
          const bool take = key[k] > T || (key[k] == T && (int)__popcll(me & lt) < quota);
          const int ne = (int)__popcll(me);
          quota = quota > ne ? quota - ne : 0;
          const unsigned long long sm = __ballot(take);
          if (lane == 2 * k) word = (u32)sm;
          if (lane == 2 * k + 1) word = (u32)(sm >> 32);
        }
        if (lane == 0) word |= 1u;
        if (lane == (cur >> 5)) word |= 1u << (cur & 31);
        if (lane == ((cur - 1) >> 5)) word |= 1u << ((cur - 1) & 31);
      }
      if (lane < 8) SEL[(((size_t)b * 16384 + tq) * 2 + g) * 8 + lane] = word;
    }
    __builtin_amdgcn_wave_barrier();
  }
}

__device__ __forceinline__ void nsa_s_tile(KP p, int l, char* smem, int tile) {
  const int cur = 255 - (tile >> 2), bg = tile & 3, b = bg >> 1, g = bg & 1;
  const int tid = otid(), lane = tid & 63, wv = tid >> 6, l15 = lane & 15, quad = lane >> 4;
  char* sStage = smem;
  u16* sQw = (u16*)(smem + 32768) + wv * 64 * 72;
  u32* sSel = (u32*)(smem + 32768 + 36864);
  const u32* sSelw = sSel + wv * 16 * 8;
  const u16* proj = (const u16*)(p->ws + OFF_PROJ);
  const float* small_ = (const float*)(p->ws + OFF_SMALL);
  const float* rope = (const float*)(p->ws + OFF_ROPE);
  float* OC = (float*)(p->ws + OFF_OC);
  u16* mix = (u16*)(p->ws + OFF_H);
  const size_t tokb = (size_t)b * T;
  const int tq0 = cur * 64 + wv * 16;
  const int r_ = l15 & 3, head = g * 4 + r_;
  {
    const u32* SEL = (const u32*)(p->ws + OFF_SEL);
    int q = tid >> 2, w2 = (tid & 3) * 2;
    uint2 v = *(const uint2*)(SEL + ((tokb + cur * 64 + q) * 2 + g) * 8 + w2);
    *(uint2*)(sSel + q * 8 + w2) = v;
  }
#pragma unroll
  for (int nt = 0; nt < 4; ++nt) {
    const size_t tok = tokb + tq0 + nt * 4 + (l15 >> 2);
    const u16* qrow = proj + tok * PJ + C_NQ + head * 64;
    u16* qd = sQw + (nt * 16 + l15) * 72;
    *(bf16x8*)(qd + 32 + quad * 8) = *(const bf16x8*)(qrow + 32 + quad * 8);
    if (quad >= 2) {
      *(bf16x8*)(qd + quad * 8) = *(const bf16x8*)(qrow + quad * 8);
    } else {
      union { bf16x8 v; u16 h[8]; } x1, x2, o;
      x1.v = *(const bf16x8*)(qrow);
      x2.v = *(const bf16x8*)(qrow + 8);
      const float* rp = rope + tok * 16;
#pragma unroll
      for (int i = 0; i < 8; ++i) {
        float a = bf2f(x1.h[i]), bb = bf2f(x2.h[i]), c = rp[i], s = rp[8 + i];
        o.h[i] = f2bf(quad == 0 ? a * c - bb * s : bb * c + a * s);
      }
      *(bf16x8*)(qd + quad * 8) = o.v;
    }
  }
  f32x4 O[4][4];
  float lsum[4], inv[4] = {0.f, 0.f, 0.f, 0.f};
#pragma unroll
  for (int dt = 0; dt < 4; ++dt)
#pragma unroll
    for (int nt = 0; nt < 4; ++nt) O[dt][nt] = f32x4{0.f, 0.f, 0.f, 0.f};
#pragma unroll
  for (int nt = 0; nt < 4; ++nt) lsum[nt] = 0.f;
  {
    const u16* Kg = proj + tokb * PJ + C_KWIN + g * 64;
    const u16* VTg = (const u16*)(p->ws + OFF_VT + 8 * MiB) + (size_t)(bg * 256) * 4096;
    int h0 = 2 * cur - 16 < 0 ? 0 : 2 * cur - 16;
    flash2<0, 4>(Kg, PJ, VTg, 4096, 64, h0, 2 * cur + 1, sStage, sQw, O, lsum, inv, sSelw, nullptr, tq0);
  }
#pragma unroll
  for (int nt = 0; nt < 4; ++nt) {
    const size_t tok = tokb + tq0 + nt * 4 + (l15 >> 2);
    float ls = lsum[nt];
    ls += __shfl_xor(ls, 16);
    ls += __shfl_xor(ls, 32);
    float sc = ZTEST == 2 ? 0.f : sigmoidf_(small_[tok * 32 + 8 + head * 3 + 2]) / ls;
#pragma unroll
    for (int dt = 0; dt < 4; ++dt) {
      float4* op = (float4*)(OC + tok * 512 + head * 64 + dt * 16 + quad * 4);
      float4 o = *op;
      o.x += O[dt][nt][0] * sc; o.y += O[dt][nt][1] * sc; o.z += O[dt][nt][2] * sc; o.w += O[dt][nt][3] * sc;
      *op = o;
      O[dt][nt] = f32x4{0.f, 0.f, 0.f, 0.f};
    }
    lsum[nt] = 0.f;
  }
  {
    const u16* Kg = proj + tokb * PJ + C_KSLC + g * 64;
    const u16* VTg = (const u16*)(p->ws + OFF_VT) + (size_t)(bg * 256) * 4096;
    flash2<1, 4>(Kg, PJ, VTg, 4096, 64, 0, 2 * cur + 1, sStage, sQw, O, lsum, inv, sSelw, nullptr, tq0);
  }
#pragma unroll
  for (int nt = 0; nt < 4; ++nt) {
    const size_t tok = tokb + tq0 + nt * 4 + (l15 >> 2);
    float ls = lsum[nt];
    ls += __shfl_xor(ls, 16);
    ls += __shfl_xor(ls, 32);
    float sc = ZTEST == 3 ? 0.f : sigmoidf_(small_[tok * 32 + 8 + head * 3 + 1]) / ls;
#pragma unroll
    for (int dt = 0; dt < 4; ++dt) {
      float4 o = *(const float4*)(OC + tok * 512 + head * 64 + dt * 16 + quad * 4);
      uint2 w;
      w.x = pack2(o.x + O[dt][nt][0] * sc, o.y + O[dt][nt][1] * sc);
      w.y = pack2(o.z + O[dt][nt][2] * sc, o.w + O[dt][nt][3] * sc);
      *(uint2*)(mix + tok * DM + 256 + head * 64 + dt * 16 + quad * 4) = w;
    }
  }
}


#define XB_TMO      128
#define XB_XCNT(j)  (256  + 64 * (j))
#define XB_XSUB(j)  (1280 + 64 * (j))
#define XB_XGEN(j)  (2304 + 64 * (j))
#define XB_TOP      3328
#define XB_TOPGEN   3392
#define XCD_BAR_WORDS 3456
#define XB_SPIN_CAP (1u << 18)
#define LAS __attribute__((address_space(3)))
__device__ __forceinline__ unsigned xb_ld(unsigned* p) { return __hip_atomic_load(p, __ATOMIC_RELAXED, __HIP_MEMORY_SCOPE_AGENT); }
__device__ __forceinline__ unsigned xb_add(unsigned* p, unsigned v) { return __hip_atomic_fetch_add(p, v, __ATOMIC_RELAXED, __HIP_MEMORY_SCOPE_AGENT); }
__device__ __forceinline__ unsigned xb_xcc_id() { return (unsigned)__builtin_amdgcn_s_getreg((3 << 11) | 20) & 0xFu; }
#define XB_SPIN(cond, bar) do { unsigned _sp = 0; while (cond) { __builtin_amdgcn_s_sleep(1); \
    if ((++_sp & 255u) == 0u) { if (xb_ld(&(bar)[XB_TMO])) break; if (_sp > XB_SPIN_CAP) { atomicAdd(&(bar)[XB_TMO], 1u); break; } } } } while (0)
struct XcdBarrier { unsigned* bar; unsigned x; volatile LAS unsigned* st; };
__device__ __forceinline__ XcdBarrier xcd_barrier_post(unsigned* bar, volatile LAS unsigned* st) {
  XcdBarrier b; b.bar = bar; b.x = xb_xcc_id(); b.st = st;
  if (threadIdx.x == 0) (void)xb_add(&bar[XB_XCNT(b.x)], 1u);
  return b;
}
__device__ __forceinline__ void xcd_barrier_complete(unsigned* bar, unsigned x, unsigned& nloc, unsigned& nx) {
  const unsigned G = gridDim.x * gridDim.y * gridDim.z;
  unsigned sum, cnt, mine, sp = 0u;
  for (;;) {
    sum = 0u; cnt = 0u; mine = 0u;
#pragma unroll
    for (unsigned j = 0; j < 16; ++j) { const unsigned c = xb_ld(&bar[XB_XCNT(j)]); sum += c; cnt += (c > 0u) ? 1u : 0u; mine = (j == x) ? c : mine; }
    if (sum == G) break;
    __builtin_amdgcn_s_sleep(1);
    if ((++sp & 255u) == 0u) { if (xb_ld(&bar[XB_TMO])) break; if (sp > XB_SPIN_CAP) { atomicAdd(&bar[XB_TMO], 1u); break; } }
  }
  nloc = mine > 0u ? mine : 1u; nx = cnt > 0u ? cnt : 1u;
}
__device__ __forceinline__ void xcd_barrier(const XcdBarrier& b) {
  asm volatile("s_waitcnt vmcnt(0)" ::: "memory");
  __syncthreads();
  if (threadIdx.x == 0) {
    unsigned* bar = b.bar;
    __builtin_amdgcn_s_waitcnt(0);
    unsigned nloc = b.st[0], nx = b.st[1];
    if (nloc == 0u) { xcd_barrier_complete(bar, b.x, nloc, nx); b.st[0] = nloc; b.st[1] = nx; }
    const unsigned old = xb_add(&bar[XB_XSUB(b.x)], 1u);
    const unsigned gen = old / nloc;
    if (old + 1u == (gen + 1u) * nloc) {
      __builtin_amdgcn_fence(__ATOMIC_RELEASE, "agent");
      asm volatile("s_waitcnt vmcnt(0)" ::: "memory");
      const unsigned og = xb_add(&bar[XB_TOP], 1u);
      const unsigned tg = og / nx;
      if (og + 1u == (tg + 1u) * nx) xb_add(&bar[XB_TOPGEN], 1u);
      else XB_SPIN(xb_ld(&bar[XB_TOPGEN]) == tg, bar);
      __builtin_amdgcn_fence(__ATOMIC_ACQUIRE, "agent");
      xb_add(&bar[XB_XGEN(b.x)], 1u);
      asm volatile("s_waitcnt vmcnt(0)" ::: "memory");
    } else {
      XB_SPIN(xb_ld(&bar[XB_XGEN(b.x)]) == gen, bar);
      __builtin_amdgcn_fence(__ATOMIC_ACQUIRE, "agent");
      asm volatile("s_waitcnt vmcnt(0)" ::: "memory");
    }
  }
  __syncthreads();
}
#ifndef REPE
#define REPE 1
#endif
#ifndef REP3C
#define REP3C 1
#endif
#ifndef REP3
#define REP3 1
#endif
#ifndef XSYNC
#define XSYNC 0
#endif
#ifndef REP4
#define REP4 1
#endif
#ifndef REPSCAN
#define REPSCAN 1
#endif
#ifndef REPG
#define REPG 1
#endif
__global__ void __launch_bounds__(256, 2) hymba_mega(Params p_unused) {
  cg::grid_group grid = cg::this_grid();
  __shared__ uint4 xb_words;
  if (threadIdx.x == 0) xb_words = make_uint4(0u, 0u, 0u, 0u);
  __syncthreads();
  XcdBarrier xb = xcd_barrier_post((unsigned*)(kargs()->ws + OFF_CNT + 4096), (volatile LAS unsigned*)&xb_words);
  __shared__ __attribute__((aligned(16))) char smem[77824];
  __shared__ int s_tile;
  { KP p = kargs(); rope_table(p); }
  grid.sync();
#pragma unroll 1
  for (int l = 0; l < DEPTH; ++l) {
    {
      KP p = kargs();
      if (blockIdx.x == 0 && threadIdx.x == 0) { u32 z0 = 0u; asm volatile("" : "+v"(z0)); ((u32*)(p->ws + OFF_CNT))[0] = z0; }
      for (int re = 0; re < REPE; ++re) {
      convert_weights(p, l, smem);
      rmsnorm_rows(l == 0 ? p->x_in : p->out, p->attn_norm + l * DM, (u16*)(p->ws + OFF_H));
      }
    }
    xcd_barrier(xb);
    {
      KP p = kargs();
      for (int rep = 0; rep < REPG; ++rep)
      gemm_phase((const u16*)(p->ws + OFF_H), DM, (const u16*)(p->ws + OFF_W + W_IN), DM, DM, 128, 25, smem,
                 EpiInProj{(u16*)(p->ws + OFF_PROJ), (float*)(p->ws + OFF_SMALL)});
    }
    xcd_barrier(xb);
    {
      KP p = kargs();
      for (int job = obid(); job < 2048 + 512 + 128; job += gridDim.x) {
        if (job < 2048) gdn_chunk_prep(p, l, smem, job);
        else if (job < 2560) nsa_token_prep(p, l, smem, job - 2048);
        else nsa_compress(p, l, smem, job - 2560);
      }
    }
    xcd_barrier(xb);
#ifndef REP45
#define REP45 1
#endif
    for (int rep = 0; rep < REP45; ++rep) {
    {
      KP p = kargs();
      if (blockIdx.x == 0 && threadIdx.x == 0) { u32 z0 = 0u; asm volatile("" : "+v"(z0)); ((u32*)(p->ws + OFF_CNT))[0] = z0; }
      for (int r4 = 0; r4 < REP4; ++r4) nsa_phase_c(p, l, smem);
    }
    xcd_barrier(xb);
    {
      KP p = kargs();
      if (obid() < 32) for (int rs = 0; rs < REPSCAN; ++rs) gdn_scan(p, smem, obid());
      u32* CNT = (u32*)(p->ws + OFF_CNT);
      for (;;) {
        __syncthreads();
        if (threadIdx.x == 0) s_tile = (int)atomicAdd(&CNT[0], 1u);
        __syncthreads();
        int tile = s_tile;
        if (tile >= 1024) break;
        nsa_s_tile(p, l, smem, tile);
      }
    }
    xcd_barrier(xb);
    }
    {
      KP p = kargs();
      for (int re = 0; re < REPE; ++re) gdn_finalize(p, l);
      for (int xs = 0; xs < XSYNC; ++xs) xcd_barrier(xb);
    }
    xcd_barrier(xb);
    {
      KP p = kargs();
      gemm_phase((const u16*)(p->ws + OFF_H), DM, (const u16*)(p->ws + OFF_W + W_OUT), DM, DM, 128, 8, smem,
                 EpiResid{l == 0 ? p->x_in : p->out, p->out});
    }
    xcd_barrier(xb);
    {
      KP p = kargs();
      for (int re = 0; re < REPE; ++re) rmsnorm_rows(p->out, p->ffn_norm + l * DM, (u16*)(p->ws + OFF_H));
    }
    xcd_barrier(xb);
    {
      KP p = kargs();
      for (int rep = 0; rep < REPG; ++rep)
      gemm_phase((const u16*)(p->ws + OFF_H), DM, (const u16*)(p->ws + OFF_W + W_GU), DM, DM, 128, 44, smem,
                 EpiSwiGLU{(u16*)(p->ws + OFF_PROJ)});
    }
    xcd_barrier(xb);
    {
      KP p = kargs();
      gemm_phase((const u16*)(p->ws + OFF_PROJ), DFF, (const u16*)(p->ws + OFF_W + W_DOWN), DFF, DFF, 128, 8, smem,
                 EpiResid{p->out, p->out});
    }
    xcd_barrier(xb);
  }
}

extern "C" void kernel_launch(void* const* d_in, const int* in_sizes, int n_in, void* d_out, int out_size, void* d_ws,
                              size_t ws_size, hipStream_t stream) {
  static int grid_blocks = 0;
  if (!grid_blocks) {
    int dev = 0, cus = 0, per_cu = 0;
    hipGetDevice(&dev);
    hipDeviceGetAttribute(&cus, hipDeviceAttributeMultiprocessorCount, dev);
    hipOccupancyMaxActiveBlocksPerMultiprocessor(&per_cu, hymba_mega, 256, 0);
    if (per_cu > 2) per_cu = 2;
    if (per_cu < 1) per_cu = 1;
    grid_blocks = cus * per_cu;
    grid_blocks &= ~7;
  }
  Params p;
  memset(&p, 0, sizeof(p));
  p.x_in = (const float*)d_in[0]; p.positions = (const int*)d_in[1]; p.attn_norm = (const float*)d_in[2];
  p.w_in = (const float*)d_in[3]; p.gdn_conv_w = (const float*)d_in[4]; p.gdn_a_log = (const float*)d_in[5];
  p.gdn_dt_bias = (const float*)d_in[6]; p.gdn_norm = (const float*)d_in[7]; p.nsa_q_norm = (const float*)d_in[8];
  p.nsa_k_norm = (const float*)d_in[9]; p.cmp_pe = (const float*)d_in[10]; p.cmp_w1 = (const float*)d_in[11];
  p.cmp_w2 = (const float*)d_in[12]; p.conv_w = (const float*)d_in[13]; p.w_out = (const float*)d_in[14];
  p.ffn_norm = (const float*)d_in[15]; p.w_gate_up = (const float*)d_in[16]; p.w_down = (const float*)d_in[17];
  p.out = (float*)d_out; p.ws = (char*)d_ws;
  hipMemsetAsync((char*)d_ws + OFF_CNT, 0, 4096 + XCD_BAR_WORDS * 4, stream);
  void* args[] = {&p};
  hipError_t e = hipLaunchCooperativeKernel((void*)hymba_mega, dim3(grid_blocks), dim3(256), args, 0, stream);
  if (e != hipSuccess) fprintf(stderr, "cooperative launch failed: %s (grid %d)\n", hipGetErrorString(e), grid_blocks);
}
```

```cpp
#include <hip/hip_runtime.h>
#include <hip/hip_cooperative_groups.h>
#include <cstdio>
#include <cstring>
namespace cg = cooperative_groups;

#ifndef ZTEST
#define ZTEST 0
#endif
typedef unsigned short u16;
typedef unsigned int u32;
typedef __attribute__((ext_vector_type(8))) short bf16x8;
typedef __attribute__((ext_vector_type(4))) short bf16x4;
typedef __attribute__((ext_vector_type(4))) float f32x4;

constexpr int NB = 2, T = 16384, NTOK = NB * T, DM = 1024, DFF = 2816, DEPTH = 4;
constexpr int PJ = 3072;
constexpr int C_GQ = 0, C_GK = 256, C_GV = 512, C_GZ = 768, C_NQ = 1024, C_KCMP = 1536, C_VCMP = 1664,
              C_KSLC = 1792, C_VSLC = 1920, C_KWIN = 2048, C_VWIN = 2176, C_CB = 2304, C_CC = 2560, C_CX = 2816;
constexpr size_t MiB = 1ull << 20;
constexpr size_t OFF_H = 0, OFF_PROJ = 64 * MiB, OFF_SMALL = 256 * MiB, OFF_W = 260 * MiB, OFF_GDN = 288 * MiB,
                 OFF_OG = 384 * MiB, OFF_OC = 416 * MiB, OFF_VT = 480 * MiB, OFF_KC = 496 * MiB, OFF_SEL = 497 * MiB,
                 OFF_ROPE = 499 * MiB, OFF_GL = 501 * MiB, OFF_CNT = 501 * MiB + 65536;
constexpr size_t W_IN = 0, W_OUT = 6553600, W_GU = 8650752, W_DOWN = 20185088, W_C1 = 25952256, W_C2 = 26476544;
constexpr int CHUNK_B = 49152;
constexpr float SC2 = 0.125f * 1.4426950408889634f;

struct Params {
  const float* x_in; const int* positions; const float* attn_norm; const float* w_in; const float* gdn_conv_w;
  const float* gdn_a_log; const float* gdn_dt_bias; const float* gdn_norm; const float* nsa_q_norm;
  const float* nsa_k_norm; const float* cmp_pe; const float* cmp_w1; const float* cmp_w2; const float* conv_w;
  const float* w_out; const float* ffn_norm; const float* w_gate_up; const float* w_down;
  float* out; char* ws;
};


__device__ __forceinline__ int otid() { int t = threadIdx.x; asm volatile("" : "+v"(t)); return t; }
__device__ __forceinline__ int obid() { int t = blockIdx.x; asm volatile("" : "+s"(t)); return t; }
typedef const __attribute__((address_space(4))) Params* KP;
__device__ __forceinline__ KP kargs() {
  KP k = (KP)__builtin_amdgcn_kernarg_segment_ptr();
  asm volatile("" : "+s"(k));
  return k;
}

typedef __bf16 bf2_t __attribute__((ext_vector_type(2)));
typedef float f2_t __attribute__((ext_vector_type(2)));
__device__ __forceinline__ u32 pack2(float a, float b) {
  f2_t v = {a, b};
  bf2_t r = __builtin_convertvector(v, bf2_t);
  return __builtin_bit_cast(u32, r);
}
__device__ __forceinline__ u16 f2bf(float f) { return (u16)(pack2(f, 0.f) & 0xffffu); }
__device__ __forceinline__ float bf2f(u16 h) { return __uint_as_float(((u32)h) << 16); }
__device__ __forceinline__ float wave_sum(float v) {
#pragma unroll
  for (int o = 32; o; o >>= 1) v += __shfl_xor(v, o);
  return v;
}
__device__ __forceinline__ float sigmoidf_(float x) { return 1.f / (1.f + __expf(-x)); }
__device__ __forceinline__ f32x4 mfma16(bf16x8 a, bf16x8 b, f32x4 c) {
  return __builtin_amdgcn_mfma_f32_16x16x32_bf16(a, b, c, 0, 0, 0);
}
__device__ __forceinline__ bf16x8 pack8(f32x4 a, f32x4 b) {
  union { bf16x8 v; u32 u[4]; } r;
  r.u[0] = pack2(a[0], a[1]); r.u[1] = pack2(a[2], a[3]);
  r.u[2] = pack2(b[0], b[1]); r.u[3] = pack2(b[2], b[3]);
  return r.v;
}

__device__ __forceinline__ void rmsnorm_rows(const float* __restrict__ x, const float* __restrict__ gain, u16* __restrict__ h) {
  int lane = otid() & 63;
  int gw = obid() * 4 + (otid() >> 6), nw = gridDim.x * 4;
  for (int row = gw; row < NTOK; row += nw) {
    const float4* xr = (const float4*)(x + (size_t)row * DM);
    float4 v[4];
    float ss = 0.f;
#pragma unroll
    for (int i = 0; i < 4; ++i) {
      v[i] = xr[lane + 64 * i];
      ss += v[i].x * v[i].x + v[i].y * v[i].y + v[i].z * v[i].z + v[i].w * v[i].w;
    }
    ss = wave_sum(ss);
    float rs = rsqrtf(ss * (1.f / DM) + 1e-6f);
#pragma unroll
    for (int i = 0; i < 4; ++i) {
      float4 g = ((const float4*)gain)[lane + 64 * i];
      uint2 o;
      o.x = pack2(v[i].x * rs * g.x, v[i].y * rs * g.y);
      o.y = pack2(v[i].z * rs * g.z, v[i].w * rs * g.w);
      *(uint2*)(h + (size_t)row * DM + (lane + 64 * i) * 4) = o;
    }
  }
}

struct MapId { __device__ int operator()(int n) const { return n; } };
struct MapIn {
  __device__ int operator()(int n) const {
    if (n < 1024) return n;
    if (n < 2304) return n + 8;
    if (n < 3072) return n + 32;
    if (n < 3080) return n - 3072 + 1024;
    if (n < 3104) return n - 3080 + 2312;
    return -1;
  }
};
struct MapGU {
  __device__ int operator()(int n) const {
    int grp = n >> 6, r = n & 63;
    return r < 32 ? grp * 32 + r : DFF + grp * 32 + (r - 32);
  }
};
template <class Map>
__device__ __forceinline__ void transpose_tile(const float* __restrict__ src, int lds_, Map map, u16* __restrict__ dst, int ldd, int n0,
                               int k0, float* t) {
  int tid = otid();
#pragma unroll
  for (int i = 0; i < 16; ++i) {
    int k = i * 4 + (tid >> 6), n = tid & 63;
    int sn = map(n0 + n);
    t[k * 65 + n] = sn >= 0 ? src[(size_t)(k0 + k) * lds_ + sn] : 0.f;
  }
  __syncthreads();
#pragma unroll 4
  for (int i = 0; i < 16; ++i) {
    int n = i * 4 + (tid >> 6), k = tid & 63;
    dst[(size_t)(n0 + n) * ldd + k0 + k] = f2bf(t[k * 65 + n]);
  }
  __syncthreads();
}

__device__ __forceinline__ void convert_weights(KP p, int l, char* smem) {
  float* t = (float*)smem;
  char* W = p->ws + OFF_W;
  const int J0 = 800, J1 = J0 + 256, J2 = J1 + 1408, J3 = J2 + 704, J4 = J3 + 64, J5 = J4 + 2;
  for (int job = obid(); job < J5; job += gridDim.x) {
    if (job < J0) {
      transpose_tile(p->w_in + (size_t)l * DM * 3104, 3104, MapIn(), (u16*)(W + W_IN), 1024, (job >> 4) * 64,
                     (job & 15) * 64, t);
    } else if (job < J1) {
      int j = job - J0;
      transpose_tile(p->w_out + (size_t)l * DM * DM, 1024, MapId(), (u16*)(W + W_OUT), 1024, (j >> 4) * 64,
                     (j & 15) * 64, t);
    } else if (job < J2) {
      int j = job - J1;
      transpose_tile(p->w_gate_up + (size_t)l * DM * 2 * DFF, 2 * DFF, MapGU(), (u16*)(W + W_GU), 1024, (j >> 4) * 64,
                     (j & 15) * 64, t);
    } else if (job < J3) {
      int j = job - J2;
      transpose_tile(p->w_down + (size_t)l * DFF * DM, 1024, MapId(), (u16*)(W + W_DOWN), DFF, (j / 44) * 64,
                     (j % 44) * 64, t);
    } else if (job < J4) {
      int j = job - J3;
      int which = j >> 5, kt = j & 31;
      transpose_tile(p->cmp_w1 + (size_t)(l * 2 + which) * 2048 * 64, 64, MapId(),
                     (u16*)(W + W_C1) + (size_t)which * 64 * 2048, 2048, 0, kt * 64, t);
    } else {
      int which = job - J4;
      transpose_tile(p->cmp_w2 + (size_t)(l * 2 + which) * 64 * 64, 64, MapId(), (u16*)(W + W_C2) + which * 4096, 64, 0,
                     0, t);
    }
  }
}

#define WAIT_VM(n) asm volatile("s_waitcnt vmcnt(" #n ")" ::: "memory")
#define RAW_BAR() do { asm volatile("s_waitcnt lgkmcnt(0)" ::: "memory"); __builtin_amdgcn_s_barrier(); } while (0)
typedef __attribute__((ext_vector_type(16))) float f32x16;
template <class Epi>
__device__ __forceinline__ void gemm_phase(const u16* __restrict__ A, int lda, const u16* __restrict__ Bt, int ldb, int K, int ntm,
                           int ntn, char* smem, Epi epi) {
  const int tid = otid(), lane = tid & 63, wv = tid >> 6;
  const int wm = wv >> 1, wn = wv & 1, l31 = lane & 31, hi = lane >> 5;
  const int ntiles = ntm * ntn, nk = K >> 5;
  const int lrow = tid >> 3, lc8 = tid & 7;
  const int woff = lrow * 64 + (((lc8 & 3) ^ ((lrow >> 2) & 3)) * 16);
  const bool wodd = (lc8 >> 2) != 0;
  const int sw = (l31 >> 2) & 3;
  const int arow = (wm * 128 + l31) * 64, brow = 16384 + (wn * 64 + l31) * 64;
#define TILE_DECODE(id_, row0_, col0_, tn_)                                                  \
  do {                                                                                       \
    int xcd_ = (id_) & 7, loc_ = (id_) >> 3;                                                 \
    int per_rb_ = 8 * ntn;                                                                   \
    int rb_ = loc_ / per_rb_, rem_ = loc_ % per_rb_;                                         \
    int cb_ = rem_ >> 6, rem2_ = rem_ & 63;                                                  \
    int width_ = (cb_ + 1) * 8 <= ntn ? 8 : ntn - cb_ * 8;                                   \
    int tm_l_ = rb_ * 8 + rem2_ / width_;                                                    \
    tn_ = cb_ * 8 + rem2_ % width_;                                                          \
    row0_ = (tm_l_ * 8 + xcd_) * 256;                                                        \
    col0_ = tn_ * 128;                                                                       \
  } while (0)
#define W_LOAD(w_)                                                           \
  do {                                                                       \
    const u16* pa_ = gA + (w_) * 64;                                         \
    const u16* pb_ = gB + (w_) * 64;                                         \
    Ra0 = *(const uint4*)(pa_);           Ra1 = *(const uint4*)(pa_ + a32);  \
    Ra2 = *(const uint4*)(pa_ + 2 * a32); Ra3 = *(const uint4*)(pa_ + 3 * a32); \
    Ra4 = *(const uint4*)(pa_ + 4 * a32); Ra5 = *(const uint4*)(pa_ + 5 * a32); \
    Ra6 = *(const uint4*)(pa_ + 6 * a32); Ra7 = *(const uint4*)(pa_ + 7 * a32); \
    Rb0 = *(const uint4*)(pb_);           Rb1 = *(const uint4*)(pb_ + b32);  \
    Rb2 = *(const uint4*)(pb_ + 2 * b32); Rb3 = *(const uint4*)(pb_ + 3 * b32); \
  } while (0)
#define MF(accv, bv, av) accv = __builtin_amdgcn_mfma_f32_32x32x16_bf16(bv, av, accv, 0, 0, 0)
#define SB() __builtin_amdgcn_sched_barrier(0)
#define G_ITER(sl_, ODD, wnext_)                                                                 \
  do {                                                                                           \
    const char* st_ = smem + (sl_) * 24576;                                                      \
    const int s1_ = (sl_) + 1 >= 3 ? (sl_) - 2 : (sl_) + 1, s2_ = (sl_) + 2 >= 3 ? (sl_) - 1 : (sl_) + 2; \
    char* wr_ = smem + (wodd ? s2_ : s1_) * 24576 + woff;                                        \
    const int p0_ = ((0 + hi) ^ sw) * 16, p1_ = ((2 + hi) ^ sw) * 16;                            \
    bf16x8 b00 = *(const bf16x8*)(st_ + brow + p0_), b01 = *(const bf16x8*)(st_ + brow + 2048 + p0_); \
    bf16x8 a00 = *(const bf16x8*)(st_ + arow + p0_), a01 = *(const bf16x8*)(st_ + arow + 2048 + p0_); \
    bf16x8 a02 = *(const bf16x8*)(st_ + arow + 4096 + p0_), a03 = *(const bf16x8*)(st_ + arow + 6144 + p0_); \
    SB();                                                                                        \
    MF(acc[0][0], b00, a00); MF(acc[0][1], b01, a00);                                            \
    bf16x8 b10 = *(const bf16x8*)(st_ + brow + p1_), b11 = *(const bf16x8*)(st_ + brow + 2048 + p1_); \
    SB();                                                                                        \
    MF(acc[1][0], b00, a01); MF(acc[1][1], b01, a01);                                            \
    bf16x8 a10 = *(const bf16x8*)(st_ + arow + p1_), a11 = *(const bf16x8*)(st_ + arow + 2048 + p1_); \
    SB();                                                                                        \
    MF(acc[2][0], b00, a02); MF(acc[2][1], b01, a02);                                            \
    bf16x8 a12 = *(const bf16x8*)(st_ + arow + 4096 + p1_), a13 = *(const bf16x8*)(st_ + arow + 6144 + p1_); \
    SB();                                                                                        \
    MF(acc[3][0], b00, a03); MF(acc[3][1], b01, a03);                                            \
    if (ODD) { *(uint4*)(wr_) = Ra0; *(uint4*)(wr_ + 2048) = Ra1; *(uint4*)(wr_ + 4096) = Ra2; } \
    SB();                                                                                        \
    MF(acc[0][0], b10, a10); MF(acc[0][1], b11, a10);                                            \
    if (ODD) { *(uint4*)(wr_ + 6144) = Ra3; *(uint4*)(wr_ + 8192) = Ra4; *(uint4*)(wr_ + 10240) = Ra5; } \
    SB();                                                                                        \
    MF(acc[1][0], b10, a11); MF(acc[1][1], b11, a11);                                            \
    if (ODD) { *(uint4*)(wr_ + 12288) = Ra6; *(uint4*)(wr_ + 14336) = Ra7; *(uint4*)(wr_ + 16384) = Rb0; } \
    SB();                                                                                        \
    MF(acc[2][0], b10, a12); MF(acc[2][1], b11, a12);                                            \
    if (ODD) { *(uint4*)(wr_ + 18432) = Rb1; *(uint4*)(wr_ + 20480) = Rb2; *(uint4*)(wr_ + 22528) = Rb3; } \
    SB();                                                                                        \
    MF(acc[3][0], b10, a13); MF(acc[3][1], b11, a13);                                            \
    if (ODD) { const int wl_ = (wnext_) < nw ? (wnext_) : nw - 1; W_LOAD(wl_); }                 \
    RAW_BAR();                                                                                   \
  } while (0)
  const size_t a32 = (size_t)32 * lda, b32 = (size_t)32 * ldb;
  const int nw = nk >> 1;
  int id = obid();
  int row0 = 0, col0 = 0, tn = 0;
  const u16 *gA = A, *gB = Bt;
  uint4 Ra0, Ra1, Ra2, Ra3, Ra4, Ra5, Ra6, Ra7, Rb0, Rb1, Rb2, Rb3;
  if (id < ntiles) {
    TILE_DECODE(id, row0, col0, tn);
    gA = A + (size_t)(row0 + lrow) * lda + lc8 * 8;
    gB = Bt + (size_t)(col0 + lrow) * ldb + lc8 * 8;
    W_LOAD(0);
  }
  while (id < ntiles) {
    f32x16 acc[4][2];
#pragma unroll
    for (int m = 0; m < 4; ++m)
#pragma unroll
      for (int n = 0; n < 2; ++n)
#pragma unroll
        for (int r = 0; r < 16; ++r) acc[m][n][r] = 0.f;
    {
      char* wr_ = smem + (wodd ? 1 : 0) * 24576 + woff;
      *(uint4*)(wr_) = Ra0; *(uint4*)(wr_ + 2048) = Ra1; *(uint4*)(wr_ + 4096) = Ra2; *(uint4*)(wr_ + 6144) = Ra3;
      *(uint4*)(wr_ + 8192) = Ra4; *(uint4*)(wr_ + 10240) = Ra5; *(uint4*)(wr_ + 12288) = Ra6; *(uint4*)(wr_ + 14336) = Ra7;
      *(uint4*)(wr_ + 16384) = Rb0; *(uint4*)(wr_ + 18432) = Rb1; *(uint4*)(wr_ + 20480) = Rb2; *(uint4*)(wr_ + 22528) = Rb3;
    }
    W_LOAD(1);
    RAW_BAR();
    __builtin_amdgcn_s_setprio(1);
    int sl = 0;
    for (int w = 0; w < nw; ++w) {
      G_ITER(sl, false, 0);
      sl = sl + 1 >= 3 ? 0 : sl + 1;
      G_ITER(sl, true, w + 2);
      sl = sl + 1 >= 3 ? 0 : sl + 1;
    }
    __builtin_amdgcn_s_setprio(0);
    const int erow = row0 + wm * 128 + l31, ecol = col0 + wn * 64 + hi * 4, etn = tn;
    id += gridDim.x;
    if (id < ntiles) {
      TILE_DECODE(id, row0, col0, tn);
      gA = A + (size_t)(row0 + lrow) * lda + lc8 * 8;
      gB = Bt + (size_t)(col0 + lrow) * ldb + lc8 * 8;
      W_LOAD(0);
    }
    epi(acc, erow, ecol, etn);
  }
}

struct EpiInProj {
  u16* proj; float* small_;
  __device__ __forceinline__ void operator()(f32x16 (&acc)[4][2], int rbase, int cbase, int tn) const {
    if (tn < 24) {
#pragma unroll
      for (int m = 0; m < 4; ++m)
#pragma unroll
        for (int n = 0; n < 2; ++n)
#pragma unroll
          for (int g = 0; g < 4; ++g) {
            uint2 o;
            o.x = pack2(acc[m][n][g * 4 + 0], acc[m][n][g * 4 + 1]);
            o.y = pack2(acc[m][n][g * 4 + 2], acc[m][n][g * 4 + 3]);
            *(uint2*)(proj + (size_t)(rbase + m * 32) * PJ + cbase + n * 32 + g * 8) = o;
          }
    } else {
#pragma unroll
      for (int m = 0; m < 4; ++m)
#pragma unroll
        for (int g = 0; g < 4; ++g) {
          int c = cbase + g * 8 - 3072;
          if (c < 32)
            *(float4*)(small_ + (size_t)(rbase + m * 32) * 32 + c) =
                make_float4(acc[m][0][g * 4 + 0], acc[m][0][g * 4 + 1], acc[m][0][g * 4 + 2], acc[m][0][g * 4 + 3]);
        }
    }
  }
};
struct EpiResid {
  const float* xin; float* xout;
  __device__ __forceinline__ void operator()(f32x16 (&acc)[4][2], int rbase, int cbase, int tn) const {
#pragma unroll
    for (int m = 0; m < 4; ++m)
#pragma unroll
      for (int n = 0; n < 2; ++n)
#pragma unroll
        for (int g = 0; g < 4; ++g) {
          size_t idx = (size_t)(rbase + m * 32) * DM + cbase + n * 32 + g * 8;
          float4 x = *(const float4*)(xin + idx);
          x.x += acc[m][n][g * 4 + 0]; x.y += acc[m][n][g * 4 + 1]; x.z += acc[m][n][g * 4 + 2]; x.w += acc[m][n][g * 4 + 3];
          *(float4*)(xout + idx) = x;
        }
  }
};
struct EpiSwiGLU {
  u16* act;
  __device__ __forceinline__ void operator()(f32x16 (&acc)[4][2], int rbase, int cbase, int tn) const {
    int grp = cbase >> 6, c4 = cbase & 7;
#pragma unroll
    for (int m = 0; m < 4; ++m)
#pragma unroll
      for (int g = 0; g < 4; ++g) {
        float v[4];
#pragma unroll
        for (int r = 0; r < 4; ++r) {
          float gt = acc[m][0][g * 4 + r], up = acc[m][1][g * 4 + r];
          v[r] = gt / (1.f + __expf(-gt)) * up;
        }
        uint2 o;
        o.x = pack2(v[0], v[1]);
        o.y = pack2(v[2], v[3]);
        *(uint2*)(act + (size_t)(rbase + m * 32) * DFF + grp * 32 + g * 8 + c4) = o;
      }
  }
};

__device__ __forceinline__ void gdn_chunk_prep(KP p, int l, char* smem, int job) {
  const int b = job >> 10, h = (job >> 8) & 3, c = job & 255;
  const int tid = otid(), lane = tid & 63, wv = tid >> 6;
  float* sq = (float*)smem;
  float* sk = sq + 64 * 65;
  float* sv = sk + 64 * 65;
  float* sA = sv + 64 * 65;
  float* sgc = sA + 64 * 64;
  float* sbeta = sgc + 64;
  float* seg = sbeta + 64;
  float* sf2 = seg + 64;
  const u16* proj = (const u16*)(p->ws + OFF_PROJ);
  const float* small_ = (const float*)(p->ws + OFF_SMALL);
  const size_t tok0 = (size_t)b * T + c * 64;
  char* cb = p->ws + OFF_GDN + (size_t)((b * 4 + h) * 256 + c) * CHUNK_B;
  float* UT = (float*)cb;
  u16* NW = (u16*)(cb + 16384);
  u16* QD = (u16*)(cb + 24576);
  u16* KDT = (u16*)(cb + 32768);
  u16* QKM = (u16*)(cb + 40960);
  {
    const int d = lane, i0 = wv * 16;
    const int tl0 = c * 64 + i0;
    u16 raw[3][19];
#pragma unroll
    for (int seg_ = 0; seg_ < 3; ++seg_) {
      const int ch = seg_ * 256 + h * 64 + d;
#pragma unroll
      for (int i = 0; i < 19; ++i) {
        const int rel = i0 + i - 3;
        const size_t tk = (tl0 + i - 3 >= 0) ? (tok0 + rel) : tok0;
        raw[seg_][i] = proj[tk * PJ + ch];
      }
    }
#pragma unroll
    for (int seg_ = 0; seg_ < 3; ++seg_) {
      const int ch = seg_ * 256 + h * 64 + d;
      const float* cw = p->gdn_conv_w + (size_t)l * 4 * 768 + ch;
      const float w0 = cw[0], w1 = cw[768], w2 = cw[1536], w3 = cw[2304];
      float* dst = seg_ == 0 ? sq : (seg_ == 1 ? sk : sv);
      float xv[19];
#pragma unroll
      for (int i = 0; i < 19; ++i) xv[i] = (tl0 + i - 3 >= 0) ? bf2f(raw[seg_][i]) : 0.f;
#pragma unroll
      for (int i = 0; i < 16; ++i) {
        float y = w0 * xv[i] + w1 * xv[i + 1] + w2 * xv[i + 2] + w3 * xv[i + 3];
        dst[(i0 + i) * 65 + d] = y / (1.f + __expf(-y));
      }
    }
  }
  if (tid < 64) {
    float gb = small_[(tok0 + tid) * 32 + h], ga = small_[(tok0 + tid) * 32 + 4 + h];
    float xx = ga + p->gdn_dt_bias[l * 4 + h];
    float sp = fmaxf(xx, 0.f) + log1pf(__expf(-fabsf(xx)));
    float g = -__expf(p->gdn_a_log[l * 4 + h]) * sp;
#pragma unroll
    for (int o = 1; o < 64; o <<= 1) {
      float t = __shfl_up(g, o);
      if (lane >= o) g += t;
    }
    float beta = sigmoidf_(gb);
    float eg = __expf(g);
    sgc[tid] = g; sbeta[tid] = beta; seg[tid] = eg; sf2[tid] = beta * eg;
    if (tid == 63) ((float*)(p->ws + OFF_GL))[(b * 4 + h) * 256 + c] = eg;
  }
  __syncthreads();
  if (tid < 128) {
    float* rowp = (tid < 64 ? sq : sk) + (tid & 63) * 65;
    float ss = 0.f;
#pragma unroll 16
    for (int d = 0; d < 64; ++d) ss += rowp[d] * rowp[d];
    const float sc = rsqrtf(ss + 1e-6f) * (tid < 64 ? 0.125f : 1.f);
#pragma unroll 16
    for (int d = 0; d < 64; ++d) rowp[d] *= sc;
  }
  __syncthreads();
  {
    int ti = tid >> 4, tj = tid & 15;
    float kk[4][4], qk[4][4];
#pragma unroll
    for (int a = 0; a < 4; ++a)
#pragma unroll
      for (int bb = 0; bb < 4; ++bb) { kk[a][bb] = 0.f; qk[a][bb] = 0.f; }
    if (tj <= ti) {
      for (int d = 0; d < 64; ++d) {
        float ki[4], kj[4], qi[4];
#pragma unroll
        for (int a = 0; a < 4; ++a) {
          ki[a] = sk[(ti * 4 + a) * 65 + d];
          qi[a] = sq[(ti * 4 + a) * 65 + d];
          kj[a] = sk[(tj * 4 + a) * 65 + d];
        }
#pragma unroll
        for (int a = 0; a < 4; ++a)
#pragma unroll
          for (int bb = 0; bb < 4; ++bb) { kk[a][bb] += ki[a] * kj[bb]; qk[a][bb] += qi[a] * kj[bb]; }
      }
    }
#pragma unroll
    for (int a = 0; a < 4; ++a) {
      int i = ti * 4 + a;
      float gi = sgc[i], bi = sbeta[i];
      uint2 o;
      float qv[4];
#pragma unroll
      for (int bb = 0; bb < 4; ++bb) {
        int j = tj * 4 + bb;
        float dec = (j <= i) ? __expf(gi - sgc[j]) : 0.f;
        sA[i * 64 + j] = (j < i) ? bi * kk[a][bb] * dec : 0.f;
        qv[bb] = qk[a][bb] * dec;
      }
      o.x = pack2(qv[0], qv[1]); o.y = pack2(qv[2], qv[3]);
      *(uint2*)(QKM + i * 64 + tj * 4) = o;
    }
  }
  {
    float gl = sgc[63];
    for (int idx = tid; idx < 4096; idx += 256) {
      int i = idx >> 6, d = idx & 63;
      QD[idx] = f2bf(sq[i * 65 + d] * seg[i]);
      KDT[idx] = f2bf(sk[d * 65 + i] * __expf(gl - sgc[d]));
    }
  }
  __syncthreads();
  if (tid < 128) {
    int cidx = tid;
    const float* src = cidx < 64 ? sv + cidx : sk + (cidx - 64);
    const float* fac = cidx < 64 ? sbeta : sf2;
    float x[64];
#pragma unroll
    for (int i = 0; i < 64; ++i) {
      float s0 = src[i * 65] * fac[i], s1 = 0.f, s2 = 0.f, s3 = 0.f;
#pragma unroll
      for (int j = 0; j < i; ++j) {
        if ((j & 3) == 0) s0 -= sA[i * 64 + j] * x[j];
        else if ((j & 3) == 1) s1 -= sA[i * 64 + j] * x[j];
        else if ((j & 3) == 2) s2 -= sA[i * 64 + j] * x[j];
        else s3 -= sA[i * 64 + j] * x[j];
      }
      x[i] = (s0 + s1) + (s2 + s3);
    }
    if (cidx < 64) {
#pragma unroll
      for (int i = 0; i < 64; i += 4) *(float4*)(UT + cidx * 64 + i) = make_float4(x[i], x[i + 1], x[i + 2], x[i + 3]);
    } else {
#pragma unroll
      for (int i = 0; i < 64; ++i) NW[i * 64 + (cidx - 64)] = f2bf(-x[i]);
    }
  }
  __syncthreads();
}

__device__ __forceinline__ void gdn_scan(KP p, char* smem, int sid) {
  const int b = sid >> 4, h = (sid >> 2) & 3, v0 = (sid & 3) * 16;
  const int tid = otid(), lane = tid & 63, wv = tid >> 6, l15 = lane & 15, quad = lane >> 4;
  u16* Sb = (u16*)smem;
  u16* Vb = Sb + 16 * 72;
  f32x4 S = {0.f, 0.f, 0.f, 0.f};
  { u32 z0 = 0u; asm volatile("" : "+v"(z0)); *(uint2*)(Sb + l15 * 72 + 16 * wv + quad * 4) = make_uint2(z0, z0); }
  __syncthreads();
  const char* gbase = p->ws + OFF_GDN + (size_t)((b * 4 + h) * 256) * CHUNK_B;
  const float* GL = (const float*)(p->ws + OFF_GL) + (b * 4 + h) * 256;
  float* OG = (float*)(p->ws + OFF_OG);
  const int arow = (16 * wv + l15) * 64 + quad * 8;
  f32x4 u, un;
  bf16x8 wA[2], qdA[2], qkA[2], kdA[2], wAn[2], qdAn[2], qkAn[2], kdAn[2];
  float gl, gln;
  {
    const char* cb = gbase;
    u = *(const f32x4*)((const float*)cb + (v0 + l15) * 64 + 16 * wv + quad * 4);
#pragma unroll
    for (int ks = 0; ks < 2; ++ks) {
      wA[ks] = *(const bf16x8*)((const u16*)(cb + 16384) + arow + ks * 32);
      qdA[ks] = *(const bf16x8*)((const u16*)(cb + 24576) + arow + ks * 32);
      kdA[ks] = *(const bf16x8*)((const u16*)(cb + 32768) + arow + ks * 32);
      qkA[ks] = *(const bf16x8*)((const u16*)(cb + 40960) + arow + ks * 32);
    }
    gl = GL[0];
  }
  for (int c = 0; c < 256; ++c) {
    if (c + 1 < 256) {
      const char* cb = gbase + (size_t)(c + 1) * CHUNK_B;
      un = *(const f32x4*)((const float*)cb + (v0 + l15) * 64 + 16 * wv + quad * 4);
#pragma unroll
      for (int ks = 0; ks < 2; ++ks) {
        wAn[ks] = *(const bf16x8*)((const u16*)(cb + 16384) + arow + ks * 32);
        qdAn[ks] = *(const bf16x8*)((const u16*)(cb + 24576) + arow + ks * 32);
        kdAn[ks] = *(const bf16x8*)((const u16*)(cb + 32768) + arow + ks * 32);
        qkAn[ks] = *(const bf16x8*)((const u16*)(cb + 40960) + arow + ks * 32);
      }
      gln = GL[c + 1];
    }
    bf16x8 sB0 = *(const bf16x8*)(Sb + l15 * 72 + quad * 8);
    bf16x8 sB1 = *(const bf16x8*)(Sb + l15 * 72 + 32 + quad * 8);
    f32x4 vn = u;
    vn = mfma16(wA[0], sB0, vn);
    vn = mfma16(wA[1], sB1, vn);
    f32x4 o = {0.f, 0.f, 0.f, 0.f};
    o = mfma16(qdA[0], sB0, o);
    o = mfma16(qdA[1], sB1, o);
    *(uint2*)(Vb + l15 * 72 + 16 * wv + quad * 4) = make_uint2(pack2(vn[0], vn[1]), pack2(vn[2], vn[3]));
    __syncthreads();
    bf16x8 vB0 = *(const bf16x8*)(Vb + l15 * 72 + quad * 8);
    bf16x8 vB1 = *(const bf16x8*)(Vb + l15 * 72 + 32 + quad * 8);
    o = mfma16(qkA[0], vB0, o);
    o = mfma16(qkA[1], vB1, o);
    S[0] *= gl; S[1] *= gl; S[2] *= gl; S[3] *= gl;
    S = mfma16(kdA[0], vB0, S);
    S = mfma16(kdA[1], vB1, S);
    *(uint2*)(Sb + l15 * 72 + 16 * wv + quad * 4) = make_uint2(pack2(S[0], S[1]), pack2(S[2], S[3]));
    size_t orow = (size_t)b * T + c * 64 + 16 * wv + quad * 4;
#pragma unroll
    for (int r = 0; r < 4; ++r) OG[(orow + r) * 256 + h * 64 + v0 + l15] = o[r];
    __syncthreads();
    u = un; gl = gln;
#pragma unroll
    for (int ks = 0; ks < 2; ++ks) { wA[ks] = wAn[ks]; qdA[ks] = qdAn[ks]; kdA[ks] = kdAn[ks]; qkA[ks] = qkAn[ks]; }
  }
}

__device__ __forceinline__ void gdn_finalize(KP p, int l) {
  const int lane = otid() & 63, sub = lane >> 4, q4 = (lane & 15) * 4;
  const int gw = obid() * 4 + (otid() >> 6), nw = gridDim.x * 4;
  const float* OG = (const float*)(p->ws + OFF_OG);
  const u16* proj = (const u16*)(p->ws + OFF_PROJ);
  u16* mix = (u16*)(p->ws + OFF_H);
  const float4 gn = *(const float4*)(p->gdn_norm + l * 64 + q4);
  for (int base = gw * 16; base < NTOK * 4; base += nw * 16) {
    float4 o[4];
    uint2 zr[4];
#pragma unroll
    for (int u = 0; u < 4; ++u) {
      const int row = base + u * 4 + sub, t = row >> 2, h = row & 3;
      o[u] = *(const float4*)(OG + (size_t)row * 64 + q4);
      zr[u] = *(const uint2*)(proj + (size_t)t * PJ + C_GZ + h * 64 + q4);
    }
#pragma unroll
    for (int u = 0; u < 4; ++u) {
      const int row = base + u * 4 + sub, t = row >> 2, h = row & 3;
      float ss = o[u].x * o[u].x + o[u].y * o[u].y + o[u].z * o[u].z + o[u].w * o[u].w;
      ss += __shfl_xor(ss, 1); ss += __shfl_xor(ss, 2); ss += __shfl_xor(ss, 4); ss += __shfl_xor(ss, 8);
      const float rs = rsqrtf(ss * (1.f / 64.f) + 1e-6f);
      const float z0 = bf2f(zr[u].x & 0xffff), z1 = bf2f(zr[u].x >> 16), z2 = bf2f(zr[u].y & 0xffff), z3 = bf2f(zr[u].y >> 16);
      const float y0 = o[u].x * rs * gn.x * (z0 / (1.f + __expf(-z0)));
      const float y1 = o[u].y * rs * gn.y * (z1 / (1.f + __expf(-z1)));
      const float y2 = o[u].z * rs * gn.z * (z2 / (1.f + __expf(-z2)));
      const float y3 = o[u].w * rs * gn.w * (z3 / (1.f + __expf(-z3)));
      uint2 w;
      w.x = pack2(ZTEST == 4 ? 0.f : y0, ZTEST == 4 ? 0.f : y1);
      w.y = pack2(ZTEST == 4 ? 0.f : y2, ZTEST == 4 ? 0.f : y3);
      *(uint2*)(mix + (size_t)t * DM + h * 64 + q4) = w;
    }
  }
}

__device__ __forceinline__ void rope_table(KP p) {
  float* rp = (float*)(p->ws + OFF_ROPE);
  int gt = obid() * blockDim.x + otid(), nt = gridDim.x * blockDim.x;
  for (int idx = gt; idx < NTOK * 8; idx += nt) {
    int t = idx >> 3, i = idx & 7;
    float inv = (float)pow(500000.0, -(double)i / 8.0);
    float ang = (float)p->positions[t] * inv;
    rp[t * 16 + i] = (float)cos((double)ang);
    rp[t * 16 + 8 + i] = (float)sin((double)ang);
  }
}

__device__ __forceinline__ void nsa_token_prep(KP p, int l, char* smem, int tb) {
  const int tid = otid(), lane = tid & 63, wv = tid >> 6;
  const int b = tb >> 8, blk = tb & 255;
  u16* proj = (u16*)(p->ws + OFF_PROJ);
  const float* rope = (const float*)(p->ws + OFF_ROPE);
  const size_t tok0 = (size_t)tb * 64;
  for (int r = tid; r < 768; r += 256) {
    int i = r / 12, which = r % 12;
    size_t t = tok0 + i;
    int col; const float* gain;
    if (which < 8) { col = C_NQ + which * 64; gain = p->nsa_q_norm + l * 64; }
    else if (which < 10) { col = C_KSLC + (which - 8) * 64; gain = p->nsa_k_norm + (l * 3 + 1) * 64; }
    else { col = C_KWIN + (which - 10) * 64; gain = p->nsa_k_norm + (l * 3 + 2) * 64; }
    u16* rowp = proj + t * PJ + col;
    union { uint4 q; u16 h[8]; } v[8];
    float ss = 0.f;
#pragma unroll
    for (int c = 0; c < 8; ++c) {
      v[c].q = *(const uint4*)(rowp + c * 8);
#pragma unroll
      for (int e = 0; e < 8; ++e) { float x = bf2f(v[c].h[e]); ss += x * x; }
    }
    const float rs = rsqrtf(ss * (1.f / 64.f) + 1e-6f);
    float y0[16];
#pragma unroll
    for (int e = 0; e < 16; ++e) y0[e] = bf2f(v[e >> 3].h[e & 7]) * rs * gain[e];
    if (which >= 8) {
      const float* rp = rope + t * 16;
#pragma unroll
      for (int e = 0; e < 8; ++e) {
        float c = rp[e], sn = rp[8 + e];
        float a1 = y0[e], a2 = y0[8 + e];
        y0[e] = a1 * c - a2 * sn;
        y0[8 + e] = a2 * c + a1 * sn;
      }
    }
#pragma unroll
    for (int c = 0; c < 8; ++c) {
      uint4 o;
      float y[8];
#pragma unroll
      for (int e = 0; e < 8; ++e) y[e] = c < 2 ? y0[c * 8 + e] : bf2f(v[c].h[e]) * rs * gain[c * 8 + e];
      o.x = pack2(y[0], y[1]); o.y = pack2(y[2], y[3]); o.z = pack2(y[4], y[5]); o.w = pack2(y[6], y[7]);
      *(uint4*)(rowp + c * 8) = o;
    }
  }
  {
    u16* tt = (u16*)smem;
    uint4 vr[4][2];
#pragma unroll
    for (int z = 0; z < 4; ++z) {
      const int col = ((z >> 1) ? C_VWIN : C_VSLC) + (z & 1) * 64;
#pragma unroll
      for (int k = 0; k < 2; ++k) {
        const int q = tid + k * 256, i = q >> 3, c8 = q & 7;
        vr[z][k] = *(const uint4*)(proj + (tok0 + i) * PJ + col + c8 * 8);
      }
    }
#pragma unroll
    for (int z = 0; z < 4; ++z)
#pragma unroll
      for (int k = 0; k < 2; ++k) {
        const int q = tid + k * 256, i = q >> 3, c8 = q & 7;
        *(uint4*)(tt + (z * 64 + i) * 72 + c8 * 8) = vr[z][k];
      }
    __syncthreads();
#pragma unroll
    for (int z = 0; z < 4; ++z) {
      const int tensor = z >> 1, g = z & 1;
      u16* dst = (u16*)(p->ws + OFF_VT + (size_t)tensor * 8 * MiB) + ((size_t)((b * 2 + g) * 256 + blk)) * 4096;
#pragma unroll
      for (int k = 0; k < 2; ++k) {
        const int q = tid + k * 256, d = q >> 3, i8 = q & 7;
        union { uint4 v; u16 h[8]; } o;
#pragma unroll
        for (int e = 0; e < 8; ++e) o.h[e] = tt[(z * 64 + i8 * 8 + e) * 72 + d];
        *(uint4*)(dst + d * 64 + i8 * 8) = o.v;
      }
    }
    __syncthreads();
  }
  {
    const int cg8 = (tid & 31) * 8, t8 = (tid >> 5) * 8;
    u16* mix = (u16*)(p->ws + OFF_H);
    union U8 { uint4 v; u16 h[8]; };
    U8 cc[10], cx[10], cb[8];
#pragma unroll
    for (int k = 0; k < 10; ++k) {
      const int rel = t8 + k - 2;
      const bool ok = (blk > 0) || (rel >= 0);
      const size_t tk = ok ? (tok0 + rel) : tok0;
      cc[k].v = *(const uint4*)(proj + tk * PJ + C_CC + cg8);
      cx[k].v = *(const uint4*)(proj + tk * PJ + C_CX + cg8);
    }
#pragma unroll
    for (int k = 0; k < 8; ++k) cb[k].v = *(const uint4*)(proj + (tok0 + t8 + k) * PJ + C_CB + cg8);
    float w0[8], w1[8], w2[8];
    {
      const float* cw = p->conv_w + (size_t)l * 3 * 256 + cg8;
#pragma unroll
      for (int e = 0; e < 8; ++e) { w0[e] = cw[e]; w1[e] = cw[256 + e]; w2[e] = cw[512 + e]; }
    }
    float pr[10][8];
#pragma unroll
    for (int k = 0; k < 10; ++k) {
      const bool ok = (blk > 0) || (t8 + k - 2 >= 0);
#pragma unroll
      for (int e = 0; e < 8; ++e) pr[k][e] = ok ? bf2f(cc[k].h[e]) * bf2f(cx[k].h[e]) : 0.f;
    }
#pragma unroll
    for (int k = 0; k < 8; ++k) {
      float y[8];
#pragma unroll
      for (int e = 0; e < 8; ++e)
        y[e] = bf2f(cb[k].h[e]) * (w0[e] * pr[k][e] + w1[e] * pr[k + 1][e] + w2[e] * pr[k + 2][e]);
      uint4 o;
      o.x = pack2(y[0], y[1]); o.y = pack2(y[2], y[3]); o.z = pack2(y[4], y[5]); o.w = pack2(y[6], y[7]);
      *(uint4*)(mix + (tok0 + t8 + k) * DM + 768 + cg8) = o;
    }
  }
}

__device__ __forceinline__ void nsa_compress(KP p, int l, char* smem, int job) {
  const int tid = otid(), lane = tid & 63, wv = tid >> 6, l15 = lane & 15, quad = lane >> 4;
  const int which = job >> 6, b = (job >> 5) & 1, g = (job >> 4) & 1, tile = job & 15;
  const u16* proj = (const u16*)(p->ws + OFF_PROJ);
  const u16* W1T = (const u16*)(p->ws + OFF_W + W_C1) + (size_t)which * 64 * 2048;
  const u16* W2T = (const u16*)(p->ws + OFF_W + W_C2) + which * 4096;
  const float* pe = p->cmp_pe + (size_t)(l * 2 + which) * 32 * 64;
  const int blk0 = tile * 64 + wv * 16;
  int blk = blk0 + l15;
  int blkc = blk < 1023 ? blk : 1022;
  const u16* arow = proj + ((size_t)b * T + blkc * 16) * PJ + (which ? C_VCMP : C_KCMP) + g * 64;
  f32x4 acc[4];
#pragma unroll
  for (int n = 0; n < 4; ++n) acc[n] = f32x4{0.f, 0.f, 0.f, 0.f};
  for (int ks0 = 0; ks0 < 64; ks0 += 4) {
    uint4 raw[4];
    float4 pea[4], peb[4];
    bf16x8 bfr[4][4];
#pragma unroll
    for (int u = 0; u < 4; ++u) {
      const int ks = ks0 + u, tok = ks >> 1, d0 = (ks & 1) * 32 + quad * 8;
      raw[u] = *(const uint4*)(arow + (size_t)tok * PJ + d0);
      pea[u] = *(const float4*)(pe + tok * 64 + d0);
      peb[u] = *(const float4*)(pe + tok * 64 + d0 + 4);
#pragma unroll
      for (int n = 0; n < 4; ++n) bfr[u][n] = *(const bf16x8*)(W1T + (size_t)(n * 16 + l15) * 2048 + ks * 32 + quad * 8);
    }
#pragma unroll
    for (int u = 0; u < 4; ++u) {
      union { bf16x8 v; u32 w[4]; } af;
      af.w[0] = pack2(bf2f(raw[u].x & 0xffff) + pea[u].x, bf2f(raw[u].x >> 16) + pea[u].y);
      af.w[1] = pack2(bf2f(raw[u].y & 0xffff) + pea[u].z, bf2f(raw[u].y >> 16) + pea[u].w);
      af.w[2] = pack2(bf2f(raw[u].z & 0xffff) + peb[u].x, bf2f(raw[u].z >> 16) + peb[u].y);
      af.w[3] = pack2(bf2f(raw[u].w & 0xffff) + peb[u].z, bf2f(raw[u].w >> 16) + peb[u].w);
#pragma unroll
      for (int n = 0; n < 4; ++n) acc[n] = mfma16(af.v, bfr[u][n], acc[n]);
    }
  }
  u16* hid = (u16*)smem + wv * 16 * 72;
#pragma unroll
  for (int n = 0; n < 4; ++n)
#pragma unroll
    for (int r = 0; r < 4; ++r) {
      float x = acc[n][r];
      float u = 0.7978845608028654f * (x + 0.044715f * x * x * x);
      float gl = 0.5f * x * (1.f + tanhf(u));
      hid[(quad * 4 + r) * 72 + n * 16 + l15] = f2bf(gl);
    }
  __syncthreads();
  f32x4 o2[4];
#pragma unroll
  for (int n = 0; n < 4; ++n) o2[n] = f32x4{0.f, 0.f, 0.f, 0.f};
#pragma unroll
  for (int ks = 0; ks < 2; ++ks) {
    bf16x8 af = *(const bf16x8*)(hid + l15 * 72 + ks * 32 + quad * 8);
#pragma unroll
    for (int n = 0; n < 4; ++n) {
      bf16x8 bfr = *(const bf16x8*)(W2T + (n * 16 + l15) * 64 + ks * 32 + quad * 8);
      o2[n] = mfma16(af, bfr, o2[n]);
    }
  }
  __syncthreads();
  if (which == 0) {
    u16* KC = (u16*)(p->ws + OFF_KC) + (size_t)(b * 2 + g) * 1024 * 64;
    const float* kg = p->nsa_k_norm + (l * 3 + 0) * 64;
#pragma unroll
    for (int r = 0; r < 4; ++r) {
      float ss = 0.f;
#pragma unroll
      for (int n = 0; n < 4; ++n) ss += o2[n][r] * o2[n][r];
      ss += __shfl_xor(ss, 1); ss += __shfl_xor(ss, 2); ss += __shfl_xor(ss, 4); ss += __shfl_xor(ss, 8);
      float rs = rsqrtf(ss * (1.f / 64.f) + 1e-6f);
      int row = blk0 + quad * 4 + r;
#pragma unroll
      for (int n = 0; n < 4; ++n) {
        float v = row < 1023 ? o2[n][r] * rs * kg[n * 16 + l15] : 0.f;
        KC[(size_t)row * 64 + n * 16 + l15] = f2bf(v);
      }
    }
  } else {
    u16* VCT = (u16*)(p->ws + OFF_KC + 524288) + (size_t)(b * 2 + g) * 64 * 1024;
#pragma unroll
    for (int r = 0; r < 4; ++r) {
      int row = blk0 + quad * 4 + r;
#pragma unroll
      for (int n = 0; n < 4; ++n) {
        float v = row < 1023 ? o2[n][r] : 0.f;
        VCT[(size_t)(n * 16 + l15) * 1024 + row] = f2bf(v);
      }
    }
  }
}

template <int MODE, int NT>
__device__ __forceinline__ void flash2(const u16* __restrict__ Kg, int kld, const u16* __restrict__ VTg, int vblk,
                                       int vld, int h0, int h1, char* sStage, const u16* sQw, f32x4 (&O)[4][NT],
                                       float (&lsum)[NT], const float (&inv)[NT], const u32* sSelw, float* slc,
                                       int tq0) {
  const int tid = otid(), lane = tid & 63, wv = tid >> 6, l15 = lane & 15, quad = lane >> 4;
  const int krow = tid >> 3, kc = tid & 7;
  const u16* kptr = Kg + (size_t)krow * kld + kc * 8;
  const int kw = krow * 128 + ((kc ^ ((krow >> 1) & 7)) * 16);
  const int vd = tid >> 2, vc = tid & 3;
  const u16* vptr = VTg + (size_t)vd * vld + vc * 8;
  const int vw = 4096 + vd * 64 + ((vc ^ ((vd >> 2) & 3)) * 16);
  const int jb0 = h0 >> 1, nst = (h1 >> 1) - jb0 + 1;
  uint4 S0k0, S0k1, S0v0, S0v1, S1k0, S1k1, S1v0, S1v1;
#define F2_LOAD(S, i_)                                                                             \
  do {                                                                                             \
    const int jb_ = jb0 + (i_);                                                                    \
    S##k0 = *(const uint4*)(kptr + (size_t)(jb_ * 64) * kld);                                      \
    S##k1 = *(const uint4*)(kptr + (size_t)(jb_ * 64 + 32) * kld);                                 \
    if (MODE != 2) {                                                                               \
      S##v0 = *(const uint4*)(vptr + (size_t)jb_ * vblk);                                          \
      S##v1 = *(const uint4*)(vptr + (size_t)jb_ * vblk + 32);                                     \
    }                                                                                              \
  } while (0)
#define F2_WRITE(S, slot_)                                                     \
  do {                                                                         \
    char* sl_ = sStage + (slot_) * 16384;                                      \
    *(uint4*)(sl_ + kw) = S##k0;                                               \
    *(uint4*)(sl_ + 8192 + kw) = S##k1;                                        \
    if (MODE != 2) {                                                           \
      *(uint4*)(sl_ + vw) = S##v0;                                             \
      *(uint4*)(sl_ + 8192 + vw) = S##v1;                                      \
    }                                                                          \
  } while (0)
  if (0 < nst) F2_LOAD(S0, 0);
  if (1 < nst) F2_LOAD(S1, 1);
  const int koff = l15 * 128;
  const int ksw = (l15 >> 1) & 7;
  const int voff = 4096 + l15 * 64 + (quad & 1) * 8;
  const int vsw = (l15 >> 2) & 3;
  const int tq0u = __builtin_amdgcn_readfirstlane(tq0);
  const int lim0u = tq0u >= 31 ? ((tq0u - 31) >> 4) : -1;
  auto compute = [&](const int h, const char* st) __attribute__((always_inline)) {
    bool interior;
    if (MODE == 0) interior = (h * 32 + 31 <= tq0u) && (h * 32 > tq0u + NT * 4 - 1 - 512);
    else if (MODE == 1) interior = (h * 32 + 31 <= tq0u);
    else interior = (h * 32 + 31 <= lim0u);
    bool bv[NT], an[NT];
    bool anyw = false;
#pragma unroll
    for (int nt = 0; nt < NT; ++nt) {
      if (MODE == 1) {
        u32 w = sSelw[(nt * 4 + (l15 >> 2)) * 8 + (h >> 6)];
        bv[nt] = (w >> ((h >> 1) & 31)) & 1u;
      } else {
        bv[nt] = true;
      }
      an[nt] = MODE == 1 ? (bool)__any(bv[nt]) : true;
      anyw |= an[nt];
    }
    if (anyw) {
      bf16x8 kf[2][2], vf[4];
#pragma unroll
      for (int m2 = 0; m2 < 2; ++m2)
#pragma unroll
        for (int ks = 0; ks < 2; ++ks)
          kf[m2][ks] = *(const bf16x8*)(st + koff + m2 * 2048 + (((ks * 4 + quad) ^ ksw) * 16));
      if (MODE != 2) {
#pragma unroll
        for (int dt = 0; dt < 4; ++dt) {
          union { bf16x8 v; uint2 h2[2]; } u;
          u.h2[0] = *(const uint2*)(st + voff + dt * 1024 + (((quad >> 1) ^ vsw) * 16));
          u.h2[1] = *(const uint2*)(st + voff + dt * 1024 + (((2 + (quad >> 1)) ^ vsw) * 16));
          vf[dt] = u.v;
        }
      }
#pragma unroll
      for (int nt = 0; nt < NT; ++nt) {
        if (!an[nt]) continue;
        const int t = tq0 + nt * 4 + (l15 >> 2);
        const bf16x8 bq0 = *(const bf16x8*)(sQw + (nt * 16 + l15) * 72 + quad * 8);
        const bf16x8 bq1 = *(const bf16x8*)(sQw + (nt * 16 + l15) * 72 + 32 + quad * 8);
        f32x4 s[2];
#pragma unroll
        for (int m2 = 0; m2 < 2; ++m2) {
          s[m2] = f32x4{0.f, 0.f, 0.f, 0.f};
          s[m2] = mfma16(kf[m2][0], bq0, s[m2]);
          s[m2] = mfma16(kf[m2][1], bq1, s[m2]);
        }
        const float bias = MODE == 1 ? (bv[nt] ? 0.f : -1000.f) : (MODE == 3 ? inv[nt] : 0.f);
        if (interior) {
#pragma unroll
          for (int m2 = 0; m2 < 2; ++m2)
#pragma unroll
            for (int r = 0; r < 4; ++r) s[m2][r] = __builtin_amdgcn_exp2f(fmaf(s[m2][r], SC2, bias));
        } else {
          int base;
          if (MODE <= 1) base = h * 32 + quad * 4 - t;
          else base = h * 32 + quad * 4 - (t >= 31 ? ((t - 31) >> 4) : -1);
          asm volatile("" : "+v"(base));
#pragma unroll
          for (int m2 = 0; m2 < 2; ++m2)
#pragma unroll
            for (int r = 0; r < 4; ++r) {
              const int C = m2 * 16 + r;
              bool valid;
              if (MODE == 0) valid = base <= -C && base > -512 - C;
              else valid = base <= -C;
              float pvv = __builtin_amdgcn_exp2f(fmaf(s[m2][r], SC2, bias));
              s[m2][r] = valid ? pvv : 0.f;
            }
        }
        float ls = ((s[0][0] + s[0][1]) + (s[0][2] + s[0][3])) + ((s[1][0] + s[1][1]) + (s[1][2] + s[1][3]));
        if (MODE != 3) lsum[nt] += ls;
        if (MODE == 3) {
#pragma unroll
          for (int m2 = 0; m2 < 2; ++m2) {
            float ow = s[m2][0] + s[m2][1] + s[m2][2] + 0.5f * s[m2][3];
            float sp = 0.5f * s[m2][3];
            ow += __shfl_xor(ow, 1); ow += __shfl_xor(ow, 2);
            sp += __shfl_xor(sp, 1); sp += __shfl_xor(sp, 2);
            if ((l15 & 3) == 0) {
              const int j = h * 8 + m2 * 4 + quad;
              slc[(nt * 4 + (l15 >> 2)) * 256 + j] = ow;
              if (j + 1 < 256) slc[1024 + (nt * 4 + (l15 >> 2)) * 256 + j + 1] = sp;
            }
          }
        }
        if (MODE != 2) {
          bf16x8 P = pack8(s[0], s[1]);
#pragma unroll
          for (int dt = 0; dt < 4; ++dt) O[dt][nt] = mfma16(vf[dt], P, O[dt][nt]);
        }
      }
    }
  };
  if (0 < nst) F2_WRITE(S0, 0);
  if (2 < nst) F2_LOAD(S0, 2);
  RAW_BAR();
#define F2_ITER(u_, SN, sn_)                                            \
  if (i + (u_) < nst) {                                                 \
    const int ii_ = i + (u_);                                           \
    if (ii_ + 1 < nst) F2_WRITE(SN, sn_);                               \
    if (ii_ + 3 < nst) F2_LOAD(SN, ii_ + 3);                            \
    compute(2 * (jb0 + ii_), sStage + (u_) * 16384);                    \
    compute(2 * (jb0 + ii_) + 1, sStage + (u_) * 16384 + 8192);         \
    RAW_BAR();                                                          \
  }
  for (int i = 0; i < nst; i += 2) {
    F2_ITER(0, S1, 1)
    F2_ITER(1, S0, 0)
  }
}

__device__ __forceinline__ void nsa_phase_c(KP p, int l, char* smem) {
  const int tid = otid(), lane = tid & 63, wv = tid >> 6, l15 = lane & 15, quad = lane >> 4;
  char* sStage = smem;
  u16* sQw = (u16*)(smem + 32768) + wv * 16 * 72;
  float* own = (float*)(smem + 32768 + 9216) + wv * 2048;
  float* spl = own + 1024;
  const u16* proj = (const u16*)(p->ws + OFF_PROJ);
  const float* small_ = (const float*)(p->ws + OFF_SMALL);
  float* OC = (float*)(p->ws + OFF_OC);
  u32* SEL = (u32*)(p->ws + OFF_SEL);
  for (int job = obid(); job < 4096; job += gridDim.x) {
    const int qt = 1023 - (job >> 2), bg = job & 3, b = bg >> 1, g = bg & 1;
    const int t0 = qt * 16 + wv * 4;
    const int ql = l15 >> 2, r_ = l15 & 3, head = g * 4 + r_;
    const int t = t0 + ql;
    const size_t tok = (size_t)b * T + t;
    const u16* KC = (const u16*)(p->ws + OFF_KC) + (size_t)bg * 1024 * 64;
    const u16* VCT = (const u16*)(p->ws + OFF_KC + 524288) + (size_t)bg * 64 * 1024;
    {
      const u16* qrow = proj + tok * PJ + C_NQ + head * 64;
      *(bf16x8*)(sQw + l15 * 72 + quad * 8) = *(const bf16x8*)(qrow + quad * 8);
      *(bf16x8*)(sQw + l15 * 72 + 32 + quad * 8) = *(const bf16x8*)(qrow + 32 + quad * 8);
    }
    const int tmax = qt * 16 + 15;
    const int nvmax = tmax >= 31 ? ((tmax - 31) >> 4) + 1 : 0;
    const int h1 = ((nvmax + 31) >> 5) - 1;
    f32x4 O[4][1];
    float lsum[1] = {0.f}, inv[1] = {0.f};
#pragma unroll
    for (int dt = 0; dt < 4; ++dt) O[dt][0] = f32x4{0.f, 0.f, 0.f, 0.f};
    if (h1 >= 0) {
      flash2<2, 1>(KC, 64, VCT, 64, 1024, 0, h1, sStage, sQw, O, lsum, inv, nullptr, own, t0);
      float ls = lsum[0];
      ls += __shfl_xor(ls, 16);
      ls += __shfl_xor(ls, 32);
      inv[0] = ls > 0.f ? -log2f(ls) : -1000.f;
      flash2<3, 1>(KC, 64, VCT, 64, 1024, 0, h1, sStage, sQw, O, lsum, inv, nullptr, own, t0);
    }
    {
      float gc = ZTEST == 1 ? 0.f : sigmoidf_(small_[tok * 32 + 8 + head * 3 + 0]);
#pragma unroll
      for (int dt = 0; dt < 4; ++dt) {
        float4 o = make_float4(O[dt][0][0] * gc, O[dt][0][1] * gc, O[dt][0][2] * gc, O[dt][0][3] * gc);
        *(float4*)(OC + tok * 512 + head * 64 + dt * 16 + quad * 4) = o;
      }
    }
    __builtin_amdgcn_wave_barrier();
    for (int q = 0; q < 4; ++q) {
      const int tq = t0 + q, cur = tq >> 6;
      u32 word = 0;
      if (cur <= 15) {
        if (lane == 0) word = (2u << cur) - 1u;
      } else {
        u32 key[4];
#pragma unroll
        for (int k = 0; k < 4; ++k) {
          int j = lane + 64 * k;
          float v = own[q * 256 + j] + spl[q * 256 + j];
          key[k] = (j >= 1 && j <= cur - 2) ? (__float_as_uint(fmaxf(v, 0.f)) + 1u) : 0u;
        }
        u32 T = 0u;
        for (int bit = 30; bit >= 0; --bit) {
          const u32 cand = T | (1u << bit);
          int cnt = 0;
#pragma unroll
          for (int k = 0; k < 4; ++k) cnt += __popcll(__ballot(key[k] >= cand));
          if (cnt >= 13) T = cand;
        }
        int ngt = 0;
#pragma unroll
        for (int k = 0; k < 4; ++k) ngt += __popcll(__ballot(key[k] > T));
        int quota = 13 - ngt;
        const unsigned long long lt = (1ull << lane) - 1ull;
#pragma unroll
        for (int k = 0; k < 4; ++k) {
          const unsigned long long me = __ballot(key[k] == T);
          const bool take = key[k] > T || (key[k] == T && (int)__popcll(me & lt) < quota);
          const int ne = (int)__popcll(me);
          quota = quota > ne ? quota - ne : 0;
          const unsigned long long sm = __ballot(take);
          if (lane == 2 * k) word = (u32)sm;
          if (lane == 2 * k + 1) word = (u32)(sm >> 32);
        }
        if (lane == 0) word |= 1u;
        if (lane == (cur >> 5)) word |= 1u << (cur & 31);
        if (lane == ((cur - 1) >> 5)) word |= 1u << ((cur - 1) & 31);
      }
      if (lane < 8) SEL[(((size_t)b * 16384 + tq) * 2 + g) * 8 + lane] = word;
    }
    __builtin_amdgcn_wave_barrier();
  }
}

__device__ __forceinline__ void nsa_s_tile(KP p, int l, char* smem, int tile) {
  const int cur = 255 - (tile >> 2), bg = tile & 3, b = bg >> 1, g = bg & 1;
  const int tid = otid(), lane = tid & 63, wv = tid >> 6, l15 = lane & 15, quad = lane >> 4;
  char* sStage = smem;
  u16* sQw = (u16*)(smem + 32768) + wv * 64 * 72;
  u32* sSel = (u32*)(smem + 32768 + 36864);
  const u32* sSelw = sSel + wv * 16 * 8;
  const u16* proj = (const u16*)(p->ws + OFF_PROJ);
  const float* small_ = (const float*)(p->ws + OFF_SMALL);
  const float* rope = (const float*)(p->ws + OFF_ROPE);
  float* OC = (float*)(p->ws + OFF_OC);
  u16* mix = (u16*)(p->ws + OFF_H);
  const size_t tokb = (size_t)b * T;
  const int tq0 = cur * 64 + wv * 16;
  const int r_ = l15 & 3, head = g * 4 + r_;
  {
    const u32* SEL = (const u32*)(p->ws + OFF_SEL);
    int q = tid >> 2, w2 = (tid & 3) * 2;
    uint2 v = *(const uint2*)(SEL + ((tokb + cur * 64 + q) * 2 + g) * 8 + w2);
    *(uint2*)(sSel + q * 8 + w2) = v;
  }
#pragma unroll
  for (int nt = 0; nt < 4; ++nt) {
    const size_t tok = tokb + tq0 + nt * 4 + (l15 >> 2);
    const u16* qrow = proj + tok * PJ + C_NQ + head * 64;
    u16* qd = sQw + (nt * 16 + l15) * 72;
    *(bf16x8*)(qd + 32 + quad * 8) = *(const bf16x8*)(qrow + 32 + quad * 8);
    if (quad >= 2) {
      *(bf16x8*)(qd + quad * 8) = *(const bf16x8*)(qrow + quad * 8);
    } else {
      union { bf16x8 v; u16 h[8]; } x1, x2, o;
      x1.v = *(const bf16x8*)(qrow);
      x2.v = *(const bf16x8*)(qrow + 8);
      const float* rp = rope + tok * 16;
#pragma unroll
      for (int i = 0; i < 8; ++i) {
        float a = bf2f(x1.h[i]), bb = bf2f(x2.h[i]), c = rp[i], s = rp[8 + i];
        o.h[i] = f2bf(quad == 0 ? a * c - bb * s : bb * c + a * s);
      }
      *(bf16x8*)(qd + quad * 8) = o.v;
    }
  }
  f32x4 O[4][4];
  float lsum[4], inv[4] = {0.f, 0.f, 0.f, 0.f};
#pragma unroll
  for (int dt = 0; dt < 4; ++dt)
#pragma unroll
    for (int nt = 0; nt < 4; ++nt) O[dt][nt] = f32x4{0.f, 0.f, 0.f, 0.f};
#pragma unroll
  for (int nt = 0; nt < 4; ++nt) lsum[nt] = 0.f;
  {
    const u16* Kg = proj + tokb * PJ + C_KWIN + g * 64;
    const u16* VTg = (const u16*)(p->ws + OFF_VT + 8 * MiB) + (size_t)(bg * 256) * 4096;
    int h0 = 2 * cur - 16 < 0 ? 0 : 2 * cur - 16;
    flash2<0, 4>(Kg, PJ, VTg, 4096, 64, h0, 2 * cur + 1, sStage, sQw, O, lsum, inv, sSelw, nullptr, tq0);
  }
#pragma unroll
  for (int nt = 0; nt < 4; ++nt) {
    const size_t tok = tokb + tq0 + nt * 4 + (l15 >> 2);
    float ls = lsum[nt];
    ls += __shfl_xor(ls, 16);
    ls += __shfl_xor(ls, 32);
    float sc = ZTEST == 2 ? 0.f : sigmoidf_(small_[tok * 32 + 8 + head * 3 + 2]) / ls;
#pragma unroll
    for (int dt = 0; dt < 4; ++dt) {
      float4* op = (float4*)(OC + tok * 512 + head * 64 + dt * 16 + quad * 4);
      float4 o = *op;
      o.x += O[dt][nt][0] * sc; o.y += O[dt][nt][1] * sc; o.z += O[dt][nt][2] * sc; o.w += O[dt][nt][3] * sc;
      *op = o;
      O[dt][nt] = f32x4{0.f, 0.f, 0.f, 0.f};
    }
    lsum[nt] = 0.f;
  }
  {
    const u16* Kg = proj + tokb * PJ + C_KSLC + g * 64;
    const u16* VTg = (const u16*)(p->ws + OFF_VT) + (size_t)(bg * 256) * 4096;
    flash2<1, 4>(Kg, PJ, VTg, 4096, 64, 0, 2 * cur + 1, sStage, sQw, O, lsum, inv, sSelw, nullptr, tq0);
  }
#pragma unroll
  for (int nt = 0; nt < 4; ++nt) {
    const size_t tok = tokb + tq0 + nt * 4 + (l15 >> 2);
    float ls = lsum[nt];
    ls += __shfl_xor(ls, 16);
    ls += __shfl_xor(ls, 32);
    float sc = ZTEST == 3 ? 0.f : sigmoidf_(small_[tok * 32 + 8 + head * 3 + 1]) / ls;
#pragma unroll
    for (int dt = 0; dt < 4; ++dt) {
      float4 o = *(const float4*)(OC + tok * 512 + head * 64 + dt * 16 + quad * 4);
      uint2 w;
      w.x = pack2(o.x + O[dt][nt][0] * sc, o.y + O[dt][nt][1] * sc);
      w.y = pack2(o.z + O[dt][nt][2] * sc, o.w + O[dt][nt][3] * sc);
      *(uint2*)(mix + tok * DM + 256 + head * 64 + dt * 16 + quad * 4) = w;
    }
  }
}


#define XB_TMO      128
#define XB_XCNT(j)  (256  + 64 * (j))
#define XB_XSUB(j)  (1280 + 64 * (j))
#define XB_XGEN(j)  (2304 + 64 * (j))
#define XB_TOP      3328
#define XB_TOPGEN   3392
#define XCD_BAR_WORDS 3456
#define XB_SPIN_CAP (1u << 18)
#define LAS __attribute__((address_space(3)))
__device__ __forceinline__ unsigned xb_ld(unsigned* p) { return __hip_atomic_load(p, __ATOMIC_RELAXED, __HIP_MEMORY_SCOPE_AGENT); }
__device__ __forceinline__ unsigned xb_add(unsigned* p, unsigned v) { return __hip_atomic_fetch_add(p, v, __ATOMIC_RELAXED, __HIP_MEMORY_SCOPE_AGENT); }
__device__ __forceinline__ unsigned xb_xcc_id() { return (unsigned)__builtin_amdgcn_s_getreg((3 << 11) | 20) & 0xFu; }
#define XB_SPIN(cond, bar) do { unsigned _sp = 0; while (cond) { __builtin_amdgcn_s_sleep(1); \
    if ((++_sp & 255u) == 0u) { if (xb_ld(&(bar)[XB_TMO])) break; if (_sp > XB_SPIN_CAP) { atomicAdd(&(bar)[XB_TMO], 1u); break; } } } } while (0)
struct XcdBarrier { unsigned* bar; unsigned x; volatile LAS unsigned* st; };
__device__ __forceinline__ XcdBarrier xcd_barrier_post(unsigned* bar, volatile LAS unsigned* st) {
  XcdBarrier b; b.bar = bar; b.x = xb_xcc_id(); b.st = st;
  if (threadIdx.x == 0) (void)xb_add(&bar[XB_XCNT(b.x)], 1u);
  return b;
}
__device__ __forceinline__ void xcd_barrier_complete(unsigned* bar, unsigned x, unsigned& nloc, unsigned& nx) {
  const unsigned G = gridDim.x * gridDim.y * gridDim.z;
  unsigned sum, cnt, mine, sp = 0u;
  for (;;) {
    sum = 0u; cnt = 0u; mine = 0u;
#pragma unroll
    for (unsigned j = 0; j < 16; ++j) { const unsigned c = xb_ld(&bar[XB_XCNT(j)]); sum += c; cnt += (c > 0u) ? 1u : 0u; mine = (j == x) ? c : mine; }
    if (sum == G) break;
    __builtin_amdgcn_s_sleep(1);
    if ((++sp & 255u) == 0u) { if (xb_ld(&bar[XB_TMO])) break; if (sp > XB_SPIN_CAP) { atomicAdd(&bar[XB_TMO], 1u); break; } }
  }
  nloc = mine > 0u ? mine : 1u; nx = cnt > 0u ? cnt : 1u;
}
__device__ __forceinline__ void xcd_barrier(const XcdBarrier& b) {
  asm volatile("s_waitcnt vmcnt(0)" ::: "memory");
  __syncthreads();
  if (threadIdx.x == 0) {
    unsigned* bar = b.bar;
    __builtin_amdgcn_s_waitcnt(0);
    unsigned nloc = b.st[0], nx = b.st[1];
    if (nloc == 0u) { xcd_barrier_complete(bar, b.x, nloc, nx); b.st[0] = nloc; b.st[1] = nx; }
    const unsigned old = xb_add(&bar[XB_XSUB(b.x)], 1u);
    const unsigned gen = old / nloc;
    if (old + 1u == (gen + 1u) * nloc) {
      __builtin_amdgcn_fence(__ATOMIC_RELEASE, "agent");
      asm volatile("s_waitcnt vmcnt(0)" ::: "memory");
      const unsigned og = xb_add(&bar[XB_TOP], 1u);
      const unsigned tg = og / nx;
      if (og + 1u == (tg + 1u) * nx) xb_add(&bar[XB_TOPGEN], 1u);
      else XB_SPIN(xb_ld(&bar[XB_TOPGEN]) == tg, bar);
      __builtin_amdgcn_fence(__ATOMIC_ACQUIRE, "agent");
      xb_add(&bar[XB_XGEN(b.x)], 1u);
      asm volatile("s_waitcnt vmcnt(0)" ::: "memory");
    } else {
      XB_SPIN(xb_ld(&bar[XB_XGEN(b.x)]) == gen, bar);
      __builtin_amdgcn_fence(__ATOMIC_ACQUIRE, "agent");
      asm volatile("s_waitcnt vmcnt(0)" ::: "memory");
    }
  }
  __syncthreads();
}
#ifndef REPE
#define REPE 1
#endif
#ifndef REP3C
#define REP3C 1
#endif
#ifndef REP3
#define REP3 1
#endif
#ifndef XSYNC
#define XSYNC 0
#endif
#ifndef REP4
#define REP4 1
#endif
#ifndef REPSCAN
#define REPSCAN 1
#endif
#ifndef REPG
#define REPG 1
#endif
__global__ void __launch_bounds__(256, 2) hymba_mega(Params p_unused) {
  cg::grid_group grid = cg::this_grid();
  __shared__ uint4 xb_words;
  if (threadIdx.x == 0) xb_words = make_uint4(0u, 0u, 0u, 0u);
  __syncthreads();
  XcdBarrier xb = xcd_barrier_post((unsigned*)(kargs()->ws + OFF_CNT + 4096), (volatile LAS unsigned*)&xb_words);
  __shared__ __attribute__((aligned(16))) char smem[77824];
  __shared__ int s_tile;
  { KP p = kargs(); rope_table(p); }
  grid.sync();
#pragma unroll 1
  for (int l = 0; l < DEPTH; ++l) {
    {
      KP p = kargs();
      if (blockIdx.x == 0 && threadIdx.x == 0) { u32 z0 = 0u; asm volatile("" : "+v"(z0)); ((u32*)(p->ws + OFF_CNT))[0] = z0; }
      for (int re = 0; re < REPE; ++re) {
      convert_weights(p, l, smem);
      rmsnorm_rows(l == 0 ? p->x_in : p->out, p->attn_norm + l * DM, (u16*)(p->ws + OFF_H));
      }
    }
    xcd_barrier(xb);
    {
      KP p = kargs();
      for (int rep = 0; rep < REPG; ++rep)
      gemm_phase((const u16*)(p->ws + OFF_H), DM, (const u16*)(p->ws + OFF_W + W_IN), DM, DM, 128, 25, smem,
                 EpiInProj{(u16*)(p->ws + OFF_PROJ), (float*)(p->ws + OFF_SMALL)});
    }
    xcd_barrier(xb);
    {
      KP p = kargs();
      for (int job = obid(); job < 2048 + 512 + 128; job += gridDim.x) {
        if (job < 2048) gdn_chunk_prep(p, l, smem, job);
        else if (job < 2560) nsa_token_prep(p, l, smem, job - 2048);
        else nsa_compress(p, l, smem, job - 2560);
      }
    }
    xcd_barrier(xb);
#ifndef REP45
#define REP45 1
#endif
    for (int rep = 0; rep < REP45; ++rep) {
    {
      KP p = kargs();
      if (blockIdx.x == 0 && threadIdx.x == 0) { u32 z0 = 0u; asm volatile("" : "+v"(z0)); ((u32*)(p->ws + OFF_CNT))[0] = z0; }
      for (int r4 = 0; r4 < REP4; ++r4) nsa_phase_c(p, l, smem);
    }
    xcd_barrier(xb);
    {
      KP p = kargs();
      if (obid() < 32) for (int rs = 0; rs < REPSCAN; ++rs) gdn_scan(p, smem, obid());
      u32* CNT = (u32*)(p->ws + OFF_CNT);
      for (;;) {
        __syncthreads();
        if (threadIdx.x == 0) s_tile = (int)atomicAdd(&CNT[0], 1u);
        __syncthreads();
        int tile = s_tile;
        if (tile >= 1024) break;
        nsa_s_tile(p, l, smem, tile);
      }
    }
    xcd_barrier(xb);
    }
    {
      KP p = kargs();
      for (int re = 0; re < REPE; ++re) gdn_finalize(p, l);
      for (int xs = 0; xs < XSYNC; ++xs) xcd_barrier(xb);
    }
    xcd_barrier(xb);
    {
      KP p = kargs();
      gemm_phase((const u16*)(p->ws + OFF_H), DM, (const u16*)(p->ws + OFF_W + W_OUT), DM, DM, 128, 8, smem,
                 EpiResid{l == 0 ? p->x_in : p->out, p->out});
    }
    xcd_barrier(xb);
    {
      KP p = kargs();
      for (int re = 0; re < REPE; ++re) rmsnorm_rows(p->out, p->ffn_norm + l * DM, (u16*)(p->ws + OFF_H));
    }
    xcd_barrier(xb);
    {
      KP p = kargs();
      for (int rep = 0; rep < REPG; ++rep)
      gemm_phase((const u16*)(p->ws + OFF_H), DM, (const u16*)(p->ws + OFF_W + W_GU), DM, DM, 128, 44, smem,
                 EpiSwiGLU{(u16*)(p->ws + OFF_PROJ)});
    }
    xcd_barrier(xb);
    {
      KP p = kargs();
      gemm_phase((const u16*)(p->ws + OFF_PROJ), DFF, (const u16*)(p->ws + OFF_W + W_DOWN), DFF, DFF, 128, 8, smem,
                 EpiResid{p->out, p->out});
    }
    xcd_barrier(xb);
  }
}

extern "C" void kernel_launch(void* const* d_in, const int* in_sizes, int n_in, void* d_out, int out_size, void* d_ws,
                              size_t ws_size, hipStream_t stream) {
  static int grid_blocks = 0;
  if (!grid_blocks) {
    int dev = 0, cus = 0, per_cu = 0;
    hipGetDevice(&dev);
    hipDeviceGetAttribute(&cus, hipDeviceAttributeMultiprocessorCount, dev);
    hipOccupancyMaxActiveBlocksPerMultiprocessor(&per_cu, hymba_mega, 256, 0);
    if (per_cu > 2) per_cu = 2;
    if (per_cu < 1) per_cu = 1;
    grid_blocks = cus * per_cu;
    grid_blocks &= ~7;
  }
  Params p;
  memset(&p, 0, sizeof(p));
  p.x_in = (const float*)d_in[0]; p.positions = (const int*)d_in[1]; p.attn_norm = (const float*)d_in[2];
  p.w_in = (const float*)d_in[3]; p.gdn_conv_w = (const float*)d_in[4]; p.gdn_a_log = (const float*)d_in[5];
  p.gdn_dt_bias = (const float*)d_in[6]; p.gdn_norm = (const float*)d_in[7]; p.nsa_q_norm = (const float*)d_in[8];
  p.nsa_k_norm = (const float*)d_in[9]; p.cmp_pe = (const float*)d_in[10]; p.cmp_w1 = (const float*)d_in[11];
  p.cmp_w2 = (const float*)d_in[12]; p.conv_w = (const float*)d_in[13]; p.w_out = (const float*)d_in[14];
  p.ffn_norm = (const float*)d_in[15]; p.w_gate_up = (const float*)d_in[16]; p.w_down = (const float*)d_in[17];
  p.out = (float*)d_out; p.ws = (char*)d_ws;
  hipMemsetAsync((char*)d_ws + OFF_CNT, 0, 4096 + XCD_BAR_WORDS * 4, stream);
  void* args[] = {&p};
  hipError_t e = hipLaunchCooperativeKernel((void*)hymba_mega, dim3(grid_blocks), dim3(256), args, 0, stream);
  if (e != hipSuccess) fprintf(stderr, "cooperative launch failed: %s (grid %d)\n", hipGetErrorString(e), grid_blocks);
}
```

```cpp
#include <hip/hip_runtime.h>
#include <hip/hip_cooperative_groups.h>
#include <cstdio>
#include <cstring>
namespace cg = cooperative_groups;

#ifndef ZTEST
#define ZTEST 0
#endif
typedef unsigned short u16;
typedef unsigned int u32;
typedef __attribute__((ext_vector_type(8))) short bf16x8;
typedef __attribute__((ext_vector_type(4))) short bf16x4;
typedef __attribute__((ext_vector_type(4))) float f32x4;

constexpr int NB = 2, T = 16384, NTOK = NB * T, DM = 1024, DFF = 2816, DEPTH = 4;
constexpr int PJ = 3072;
constexpr int C_GQ = 0, C_GK = 256, C_GV = 512, C_GZ = 768, C_NQ = 1024, C_KCMP = 1536, C_VCMP = 1664,
              C_KSLC = 1792, C_VSLC = 1920, C_KWIN = 2048, C_VWIN = 2176, C_CB = 2304, C_CC = 2560, C_CX = 2816;
constexpr size_t MiB = 1ull << 20;
constexpr size_t OFF_H = 0, OFF_PROJ = 64 * MiB, OFF_SMALL = 256 * MiB, OFF_W = 260 * MiB, OFF_GDN = 288 * MiB,
                 OFF_OG = 384 * MiB, OFF_OC = 416 * MiB, OFF_VT = 480 * MiB, OFF_KC = 496 * MiB, OFF_SEL = 497 * MiB,
                 OFF_ROPE = 499 * MiB, OFF_GL = 501 * MiB, OFF_CNT = 501 * MiB + 65536;
constexpr size_t W_IN = 0, W_OUT = 6553600, W_GU = 8650752, W_DOWN = 20185088, W_C1 = 25952256, W_C2 = 26476544;
constexpr int CHUNK_B = 49152;
constexpr float SC2 = 0.125f * 1.4426950408889634f;

struct Params {
  const float* x_in; const int* positions; const float* attn_norm; const float* w_in; const float* gdn_conv_w;
  const float* gdn_a_log; const float* gdn_dt_bias; const float* gdn_norm; const float* nsa_q_norm;
  const float* nsa_k_norm; const float* cmp_pe; const float* cmp_w1; const float* cmp_w2; const float* conv_w;
  const float* w_out; const float* ffn_norm; const float* w_gate_up; const float* w_down;
  float* out; char* ws;
};


__device__ __forceinline__ int otid() { int t = threadIdx.x; asm volatile("" : "+v"(t)); return t; }
__device__ __forceinline__ int obid() { int t = blockIdx.x; asm volatile("" : "+s"(t)); return t; }
typedef const __attribute__((address_space(4))) Params* KP;
__device__ __forceinline__ KP kargs() {
  KP k = (KP)__builtin_amdgcn_kernarg_segment_ptr();
  asm volatile("" : "+s"(k));
  return k;
}

typedef __bf16 bf2_t __attribute__((ext_vector_type(2)));
typedef float f2_t __attribute__((ext_vector_type(2)));
__device__ __forceinline__ u32 pack2(float a, float b) {
  f2_t v = {a, b};
  bf2_t r = __builtin_convertvector(v, bf2_t);
  return __builtin_bit_cast(u32, r);
}
__device__ __forceinline__ u16 f2bf(float f) { return (u16)(pack2(f, 0.f) & 0xffffu); }
__device__ __forceinline__ float bf2f(u16 h) { return __uint_as_float(((u32)h) << 16); }
__device__ __forceinline__ float wave_sum(float v) {
#pragma unroll
  for (int o = 32; o; o >>= 1) v += __shfl_xor(v, o);
  return v;
}
__device__ __forceinline__ float sigmoidf_(float x) { return 1.f / (1.f + __expf(-x)); }
__device__ __forceinline__ f32x4 mfma16(bf16x8 a, bf16x8 b, f32x4 c) {
  return __builtin_amdgcn_mfma_f32_16x16x32_bf16(a, b, c, 0, 0, 0);
}
__device__ __forceinline__ bf16x8 pack8(f32x4 a, f32x4 b) {
  union { bf16x8 v; u32 u[4]; } r;
  r.u[0] = pack2(a[0], a[1]); r.u[1] = pack2(a[2], a[3]);
  r.u[2] = pack2(b[0], b[1]); r.u[3] = pack2(b[2], b[3]);
  return r.v;
}

__device__ __forceinline__ void rmsnorm_rows(const float* __restrict__ x, const float* __restrict__ gain, u16* __restrict__ h) {
  int lane = otid() & 63;
  int gw = obid() * 4 + (otid() >> 6), nw = gridDim.x * 4;
  for (int row = gw; row < NTOK; row += nw) {
    const float4* xr = (const float4*)(x + (size_t)row * DM);
    float4 v[4];
    float ss = 0.f;
#pragma unroll
    for (int i = 0; i < 4; ++i) {
      v[i] = xr[lane + 64 * i];
      ss += v[i].x * v[i].x + v[i].y * v[i].y + v[i].z * v[i].z + v[i].w * v[i].w;
    }
    ss = wave_sum(ss);
    float rs = rsqrtf(ss * (1.f / DM) + 1e-6f);
#pragma unroll
    for (int i = 0; i < 4; ++i) {
      float4 g = ((const float4*)gain)[lane + 64 * i];
      uint2 o;
      o.x = pack2(v[i].x * rs * g.x, v[i].y * rs * g.y);
      o.y = pack2(v[i].z * rs * g.z, v[i].w * rs * g.w);
      *(uint2*)(h + (size_t)row * DM + (lane + 64 * i) * 4) = o;
    }
  }
}

struct MapId { __device__ int operator()(int n) const { return n; } };
struct MapIn {
  __device__ int operator()(int n) const {
    if (n < 1024) return n;
    if (n < 2304) return n + 8;
    if (n < 3072) return n + 32;
    if (n < 3080) return n - 3072 + 1024;
    if (n < 3104) return n - 3080 + 2312;
    return -1;
  }
};
struct MapGU {
  __device__ int operator()(int n) const {
    int grp = n >> 6, r = n & 63;
    return r < 32 ? grp * 32 + r : DFF + grp * 32 + (r - 32);
  }
};
template <class Map>
__device__ __forceinline__ void transpose_tile(const float* __restrict__ src, int lds_, Map map, u16* __restrict__ dst, int ldd, int n0,
                               int k0, float* t) {
  int tid = otid();
#pragma unroll
  for (int i = 0; i < 16; ++i) {
    int k = i * 4 + (tid >> 6), n = tid & 63;
    int sn = map(n0 + n);
    t[k * 65 + n] = sn >= 0 ? src[(size_t)(k0 + k) * lds_ + sn] : 0.f;
  }
  __syncthreads();
#pragma unroll 4
  for (int i = 0; i < 16; ++i) {
    int n = i * 4 + (tid >> 6), k = tid & 63;
    dst[(size_t)(n0 + n) * ldd + k0 + k] = f2bf(t[k * 65 + n]);
  }
  __syncthreads();
}

__device__ __forceinline__ void convert_weights(KP p, int l, char* smem) {
  float* t = (float*)smem;
  char* W = p->ws + OFF_W;
  const int J0 = 800, J1 = J0 + 256, J2 = J1 + 1408, J3 = J2 + 704, J4 = J3 + 64, J5 = J4 + 2;
  for (int job = obid(); job < J5; job += gridDim.x) {
    if (job < J0) {
      transpose_tile(p->w_in + (size_t)l * DM * 3104, 3104, MapIn(), (u16*)(W + W_IN), 1024, (job >> 4) * 64,
                     (job & 15) * 64, t);
    } else if (job < J1) {
      int j = job - J0;
      transpose_tile(p->w_out + (size_t)l * DM * DM, 1024, MapId(), (u16*)(W + W_OUT), 1024, (j >> 4) * 64,
                     (j & 15) * 64, t);
    } else if (job < J2) {
      int j = job - J1;
      transpose_tile(p->w_gate_up + (size_t)l * DM * 2 * DFF, 2 * DFF, MapGU(), (u16*)(W + W_GU), 1024, (j >> 4) * 64,
                     (j & 15) * 64, t);
    } else if (job < J3) {
      int j = job - J2;
      transpose_tile(p->w_down + (size_t)l * DFF * DM, 1024, MapId(), (u16*)(W + W_DOWN), DFF, (j / 44) * 64,
                     (j % 44) * 64, t);
    } else if (job < J4) {
      int j = job - J3;
      int which = j >> 5, kt = j & 31;
      transpose_tile(p->cmp_w1 + (size_t)(l * 2 + which) * 2048 * 64, 64, MapId(),
                     (u16*)(W + W_C1) + (size_t)which * 64 * 2048, 2048, 0, kt * 64, t);
    } else {
      int which = job - J4;
      transpose_tile(p->cmp_w2 + (size_t)(l * 2 + which) * 64 * 64, 64, MapId(), (u16*)(W + W_C2) + which * 4096, 64, 0,
                     0, t);
    }
  }
}

#define WAIT_VM(n) asm volatile("s_waitcnt vmcnt(" #n ")" ::: "memory")
#define RAW_BAR() do { asm volatile("s_waitcnt lgkmcnt(0)" ::: "memory"); __builtin_amdgcn_s_barrier(); } while (0)
typedef __attribute__((ext_vector_type(16))) float f32x16;
template <class Epi>
__device__ __forceinline__ void gemm_phase(const u16* __restrict__ A, int lda, const u16* __restrict__ Bt, int ldb, int K, int ntm,
                           int ntn, char* smem, Epi epi) {
  const int tid = otid(), lane = tid & 63, wv = tid >> 6;
  const int wm = wv >> 1, wn = wv & 1, l31 = lane & 31, hi = lane >> 5;
  const int ntiles = ntm * ntn, nk = K >> 5;
  const int lrow = tid >> 3, lc8 = tid & 7;
  const int woff = lrow * 64 + (((lc8 & 3) ^ ((lrow >> 2) & 3)) * 16);
  const bool wodd = (lc8 >> 2) != 0;
  const int sw = (l31 >> 2) & 3;
  const int arow = (wm * 128 + l31) * 64, brow = 16384 + (wn * 64 + l31) * 64;
#define TILE_DECODE(id_, row0_, col0_, tn_)                                                  \
  do {                                                                                       \
    int xcd_ = (id_) & 7, loc_ = (id_) >> 3;                                                 \
    int per_rb_ = 8 * ntn;                                                                   \
    int rb_ = loc_ / per_rb_, rem_ = loc_ % per_rb_;                                         \
    int cb_ = rem_ >> 6, rem2_ = rem_ & 63;                                                  \
    int width_ = (cb_ + 1) * 8 <= ntn ? 8 : ntn - cb_ * 8;                                   \
    int tm_l_ = rb_ * 8 + rem2_ / width_;                                                    \
    tn_ = cb_ * 8 + rem2_ % width_;                                                          \
    row0_ = (tm_l_ * 8 + xcd_) * 256;                                                        \
    col0_ = tn_ * 128;                                                                       \
  } while (0)
#define W_LOAD(w_)                                                           \
  do {                                                                       \
    const u16* pa_ = gA + (w_) * 64;                                         \
    const u16* pb_ = gB + (w_) * 64;                                         \
    Ra0 = *(const uint4*)(pa_);           Ra1 = *(const uint4*)(pa_ + a32);  \
    Ra2 = *(const uint4*)(pa_ + 2 * a32); Ra3 = *(const uint4*)(pa_ + 3 * a32); \
    Ra4 = *(const uint4*)(pa_ + 4 * a32); Ra5 = *(const uint4*)(pa_ + 5 * a32); \
    Ra6 = *(const uint4*)(pa_ + 6 * a32); Ra7 = *(const uint4*)(pa_ + 7 * a32); \
    Rb0 = *(const uint4*)(pb_);           Rb1 = *(const uint4*)(pb_ + b32);  \
    Rb2 = *(const uint4*)(pb_ + 2 * b32); Rb3 = *(const uint4*)(pb_ + 3 * b32); \
  } while (0)
#define MF(accv, bv, av) accv = __builtin_amdgcn_mfma_f32_32x32x16_bf16(bv, av, accv, 0, 0, 0)
#define SB() __builtin_amdgcn_sched_barrier(0)
#define G_ITER(sl_, ODD, wnext_)                                                                 \
  do {                                                                                           \
    const char* st_ = smem + (sl_) * 24576;                                                      \
    const int s1_ = (sl_) + 1 >= 3 ? (sl_) - 2 : (sl_) + 1, s2_ = (sl_) + 2 >= 3 ? (sl_) - 1 : (sl_) + 2; \
    char* wr_ = smem + (wodd ? s2_ : s1_) * 24576 + woff;                                        \
    const int p0_ = ((0 + hi) ^ sw) * 16, p1_ = ((2 + hi) ^ sw) * 16;                            \
    bf16x8 b00 = *(const bf16x8*)(st_ + brow + p0_), b01 = *(const bf16x8*)(st_ + brow + 2048 + p0_); \
    bf16x8 a00 = *(const bf16x8*)(st_ + arow + p0_), a01 = *(const bf16x8*)(st_ + arow + 2048 + p0_); \
    bf16x8 a02 = *(const bf16x8*)(st_ + arow + 4096 + p0_), a03 = *(const bf16x8*)(st_ + arow + 6144 + p0_); \
    SB();                                                                                        \
    MF(acc[0][0], b00, a00); MF(acc[0][1], b01, a00);                                            \
    bf16x8 b10 = *(const bf16x8*)(st_ + brow + p1_), b11 = *(const bf16x8*)(st_ + brow + 2048 + p1_); \
    SB();                                                                                        \
    MF(acc[1][0], b00, a01); MF(acc[1][1], b01, a01);                                            \
    bf16x8 a10 = *(const bf16x8*)(st_ + arow + p1_), a11 = *(const bf16x8*)(st_ + arow + 2048 + p1_); \
    SB();                                                                                        \
    MF(acc[2][0], b00, a02); MF(acc[2][1], b01, a02);                                            \
    bf16x8 a12 = *(const bf16x8*)(st_ + arow + 4096 + p1_), a13 = *(const bf16x8*)(st_ + arow + 6144 + p1_); \
    SB();                                                                                        \
    MF(acc[3][0], b00, a03); MF(acc[3][1], b01, a03);                                            \
    if (ODD) { *(uint4*)(wr_) = Ra0; *(uint4*)(wr_ + 2048) = Ra1; *(uint4*)(wr_ + 4096) = Ra2; } \
    SB();                                                                                        \
    MF(acc[0][0], b10, a10); MF(acc[0][1], b11, a10);                                            \
    if (ODD) { *(uint4*)(wr_ + 6144) = Ra3; *(uint4*)(wr_ + 8192) = Ra4; *(uint4*)(wr_ + 10240) = Ra5; } \
    SB();                                                                                        \
    MF(acc[1][0], b10, a11); MF(acc[1][1], b11, a11);                                            \
    if (ODD) { *(uint4*)(wr_ + 12288) = Ra6; *(uint4*)(wr_ + 14336) = Ra7; *(uint4*)(wr_ + 16384) = Rb0; } \
    SB();                                                                                        \
    MF(acc[2][0], b10, a12); MF(acc[2][1], b11, a12);                                            \
    if (ODD) { *(uint4*)(wr_ + 18432) = Rb1; *(uint4*)(wr_ + 20480) = Rb2; *(uint4*)(wr_ + 22528) = Rb3; } \
    SB();                                                                                        \
    MF(acc[3][0], b10, a13); MF(acc[3][1], b11, a13);                                            \
    if (ODD) { const int wl_ = (wnext_) < nw ? (wnext_) : nw - 1; W_LOAD(wl_); }                 \
    RAW_BAR();                                                                                   \
  } while (0)
  const size_t a32 = (size_t)32 * lda, b32 = (size_t)32 * ldb;
  const int nw = nk >> 1;
  int id = obid();
  int row0 = 0, col0 = 0, tn = 0;
  const u16 *gA = A, *gB = Bt;
  uint4 Ra0, Ra1, Ra2, Ra3, Ra4, Ra5, Ra6, Ra7, Rb0, Rb1, Rb2, Rb3;
  if (id < ntiles) {
    TILE_DECODE(id, row0, col0, tn);
    gA = A + (size_t)(row0 + lrow) * lda + lc8 * 8;
    gB = Bt + (size_t)(col0 + lrow) * ldb + lc8 * 8;
    W_LOAD(0);
  }
  while (id < ntiles) {
    f32x16 acc[4][2];
#pragma unroll
    for (int m = 0; m < 4; ++m)
#pragma unroll
      for (int n = 0; n < 2; ++n)
#pragma unroll
        for (int r = 0; r < 16; ++r) acc[m][n][r] = 0.f;
    {
      char* wr_ = smem + (wodd ? 1 : 0) * 24576 + woff;
      *(uint4*)(wr_) = Ra0; *(uint4*)(wr_ + 2048) = Ra1; *(uint4*)(wr_ + 4096) = Ra2; *(uint4*)(wr_ + 6144) = Ra3;
      *(uint4*)(wr_ + 8192) = Ra4; *(uint4*)(wr_ + 10240) = Ra5; *(uint4*)(wr_ + 12288) = Ra6; *(uint4*)(wr_ + 14336) = Ra7;
      *(uint4*)(wr_ + 16384) = Rb0; *(uint4*)(wr_ + 18432) = Rb1; *(uint4*)(wr_ + 20480) = Rb2; *(uint4*)(wr_ + 22528) = Rb3;
    }
    W_LOAD(1);
    RAW_BAR();
    __builtin_amdgcn_s_setprio(1);
    int sl = 0;
    for (int w = 0; w < nw; ++w) {
      G_ITER(sl, false, 0);
      sl = sl + 1 >= 3 ? 0 : sl + 1;
      G_ITER(sl, true, w + 2);
      sl = sl + 1 >= 3 ? 0 : sl + 1;
    }
    __builtin_amdgcn_s_setprio(0);
    const int erow = row0 + wm * 128 + l31, ecol = col0 + wn * 64 + hi * 4, etn = tn;
    id += gridDim.x;
    if (id < ntiles) {
      TILE_DECODE(id, row0, col0, tn);
      gA = A + (size_t)(row0 + lrow) * lda + lc8 * 8;
      gB = Bt + (size_t)(col0 + lrow) * ldb + lc8 * 8;
      W_LOAD(0);
    }
    epi(acc, erow, ecol, etn);
  }
}

struct EpiInProj {
  u16* proj; float* small_;
  __device__ __forceinline__ void operator()(f32x16 (&acc)[4][2], int rbase, int cbase, int tn) const {
    if (tn < 24) {
#pragma unroll
      for (int m = 0; m < 4; ++m)
#pragma unroll
        for (int n = 0; n < 2; ++n)
#pragma unroll
          for (int g = 0; g < 4; ++g) {
            uint2 o;
            o.x = pack2(acc[m][n][g * 4 + 0], acc[m][n][g * 4 + 1]);
            o.y = pack2(acc[m][n][g * 4 + 2], acc[m][n][g * 4 + 3]);
            *(uint2*)(proj + (size_t)(rbase + m * 32) * PJ + cbase + n * 32 + g * 8) = o;
          }
    } else {
#pragma unroll
      for (int m = 0; m < 4; ++m)
#pragma unroll
        for (int g = 0; g < 4; ++g) {
          int c = cbase + g * 8 - 3072;
          if (c < 32)
            *(float4*)(small_ + (size_t)(rbase + m * 32) * 32 + c) =
                make_float4(acc[m][0][g * 4 + 0], acc[m][0][g * 4 + 1], acc[m][0][g * 4 + 2], acc[m][0][g * 4 + 3]);
        }
    }
  }
};
struct EpiResid {
  const float* xin; float* xout;
  __device__ __forceinline__ void operator()(f32x16 (&acc)[4][2], int rbase, int cbase, int tn) const {
#pragma unroll
    for (int m = 0; m < 4; ++m)
#pragma unroll
      for (int n = 0; n < 2; ++n)
#pragma unroll
        for (int g = 0; g < 4; ++g) {
          size_t idx = (size_t)(rbase + m * 32) * DM + cbase + n * 32 + g * 8;
          float4 x = *(const float4*)(xin + idx);
          x.x += acc[m][n][g * 4 + 0]; x.y += acc[m][n][g * 4 + 1]; x.z += acc[m][n][g * 4 + 2]; x.w += acc[m][n][g * 4 + 3];
          *(float4*)(xout + idx) = x;
        }
  }
};
struct EpiSwiGLU {
  u16* act;
  __device__ __forceinline__ void operator()(f32x16 (&acc)[4][2], int rbase, int cbase, int tn) const {
    int grp = cbase >> 6, c4 = cbase & 7;
#pragma unroll
    for (int m = 0; m < 4; ++m)
#pragma unroll
      for (int g = 0; g < 4; ++g) {
        float v[4];
#pragma unroll
        for (int r = 0; r < 4; ++r) {
          float gt = acc[m][0][g * 4 + r], up = acc[m][1][g * 4 + r];
          v[r] = gt / (1.f + __expf(-gt)) * up;
        }
        uint2 o;
        o.x = pack2(v[0], v[1]);
        o.y = pack2(v[2], v[3]);
        *(uint2*)(act + (size_t)(rbase + m * 32) * DFF + grp * 32 + g * 8 + c4) = o;
      }
  }
};

__device__ __forceinline__ void gdn_chunk_prep(KP p, int l, char* smem, int job) {
  const int b = job >> 10, h = (job >> 8) & 3, c = job & 255;
  const int tid = otid(), lane = tid & 63, wv = tid >> 6;
  float* sq = (float*)smem;
  float* sk = sq + 64 * 65;
  float* sv = sk + 64 * 65;
  float* sA = sv + 64 * 65;
  float* sgc = sA + 64 * 64;
  float* sbeta = sgc + 64;
  float* seg = sbeta + 64;
  float* sf2 = seg + 64;
  const u16* proj = (const u16*)(p->ws + OFF_PROJ);
  const float* small_ = (const float*)(p->ws + OFF_SMALL);
  const size_t tok0 = (size_t)b * T + c * 64;
  char* cb = p->ws + OFF_GDN + (size_t)((b * 4 + h) * 256 + c) * CHUNK_B;
  float* UT = (float*)cb;
  u16* NW = (u16*)(cb + 16384);
  u16* QD = (u16*)(cb + 24576);
  u16* KDT = (u16*)(cb + 32768);
  u16* QKM = (u16*)(cb + 40960);
  {
    const int d = lane, i0 = wv * 16;
    const int tl0 = c * 64 + i0;
    u16 raw[3][19];
#pragma unroll
    for (int seg_ = 0; seg_ < 3; ++seg_) {
      const int ch = seg_ * 256 + h * 64 + d;
#pragma unroll
      for (int i = 0; i < 19; ++i) {
        const int rel = i0 + i - 3;
        const size_t tk = (tl0 + i - 3 >= 0) ? (tok0 + rel) : tok0;
        raw[seg_][i] = proj[tk * PJ + ch];
      }
    }
#pragma unroll
    for (int seg_ = 0; seg_ < 3; ++seg_) {
      const int ch = seg_ * 256 + h * 64 + d;
      const float* cw = p->gdn_conv_w + (size_t)l * 4 * 768 + ch;
      const float w0 = cw[0], w1 = cw[768], w2 = cw[1536], w3 = cw[2304];
      float* dst = seg_ == 0 ? sq : (seg_ == 1 ? sk : sv);
      float xv[19];
#pragma unroll
      for (int i = 0; i < 19; ++i) xv[i] = (tl0 + i - 3 >= 0) ? bf2f(raw[seg_][i]) : 0.f;
#pragma unroll
      for (int i = 0; i < 16; ++i) {
        float y = w0 * xv[i] + w1 * xv[i + 1] + w2 * xv[i + 2] + w3 * xv[i + 3];
        dst[(i0 + i) * 65 + d] = y / (1.f + __expf(-y));
      }
    }
  }
  if (tid < 64) {
    float gb = small_[(tok0 + tid) * 32 + h], ga = small_[(tok0 + tid) * 32 + 4 + h];
    float xx = ga + p->gdn_dt_bias[l * 4 + h];
    float sp = fmaxf(xx, 0.f) + log1pf(__expf(-fabsf(xx)));
    float g = -__expf(p->gdn_a_log[l * 4 + h]) * sp;
#pragma unroll
    for (int o = 1; o < 64; o <<= 1) {
      float t = __shfl_up(g, o);
      if (lane >= o) g += t;
    }
    float beta = sigmoidf_(gb);
    float eg = __expf(g);
    sgc[tid] = g; sbeta[tid] = beta; seg[tid] = eg; sf2[tid] = beta * eg;
    if (tid == 63) ((float*)(p->ws + OFF_GL))[(b * 4 + h) * 256 + c] = eg;
  }
  __syncthreads();
  if (tid < 128) {
    float* rowp = (tid < 64 ? sq : sk) + (tid & 63) * 65;
    float ss = 0.f;
#pragma unroll 16
    for (int d = 0; d < 64; ++d) ss += rowp[d] * rowp[d];
    const float sc = rsqrtf(ss + 1e-6f) * (tid < 64 ? 0.125f : 1.f);
#pragma unroll 16
    for (int d = 0; d < 64; ++d) rowp[d] *= sc;
  }
  __syncthreads();
  {
    int ti = tid >> 4, tj = tid & 15;
    float kk[4][4], qk[4][4];
#pragma unroll
    for (int a = 0; a < 4; ++a)
#pragma unroll
      for (int bb = 0; bb < 4; ++bb) { kk[a][bb] = 0.f; qk[a][bb] = 0.f; }
    if (tj <= ti) {
      for (int d = 0; d < 64; ++d) {
        float ki[4], kj[4], qi[4];
#pragma unroll
        for (int a = 0; a < 4; ++a) {
          ki[a] = sk[(ti * 4 + a) * 65 + d];
          qi[a] = sq[(ti * 4 + a) * 65 + d];
          kj[a] = sk[(tj * 4 + a) * 65 + d];
        }
#pragma unroll
        for (int a = 0; a < 4; ++a)
#pragma unroll
          for (int bb = 0; bb < 4; ++bb) { kk[a][bb] += ki[a] * kj[bb]; qk[a][bb] += qi[a] * kj[bb]; }
      }
    }
#pragma unroll
    for (int a = 0; a < 4; ++a) {
      int i = ti * 4 + a;
      float gi = sgc[i], bi = sbeta[i];
      uint2 o;
      float qv[4];
#pragma unroll
      for (int bb = 0; bb < 4; ++bb) {
        int j = tj * 4 + bb;
        float dec = (j <= i) ? __expf(gi - sgc[j]) : 0.f;
        sA[i * 64 + j] = (j < i) ? bi * kk[a][bb] * dec : 0.f;
        qv[bb] = qk[a][bb] * dec;
      }
      o.x = pack2(qv[0], qv[1]); o.y = pack2(qv[2], qv[3]);
      *(uint2*)(QKM + i * 64 + tj * 4) = o;
    }
  }
  {
    float gl = sgc[63];
    for (int idx = tid; idx < 4096; idx += 256) {
      int i = idx >> 6, d = idx & 63;
      QD[idx] = f2bf(sq[i * 65 + d] * seg[i]);
      KDT[idx] = f2bf(sk[d * 65 + i] * __expf(gl - sgc[d]));
    }
  }
  __syncthreads();
  if (tid < 128) {
    int cidx = tid;
    const float* src = cidx < 64 ? sv + cidx : sk + (cidx - 64);
    const float* fac = cidx < 64 ? sbeta : sf2;
    float x[64];
#pragma unroll
    for (int i = 0; i < 64; ++i) {
      float s0 = src[i * 65] * fac[i], s1 = 0.f, s2 = 0.f, s3 = 0.f;
#pragma unroll
      for (int j = 0; j < i; ++j) {
        if ((j & 3) == 0) s0 -= sA[i * 64 + j] * x[j];
        else if ((j & 3) == 1) s1 -= sA[i * 64 + j] * x[j];
        else if ((j & 3) == 2) s2 -= sA[i * 64 + j] * x[j];
        else s3 -= sA[i * 64 + j] * x[j];
      }
      x[i] = (s0 + s1) + (s2 + s3);
    }
    if (cidx < 64) {
#pragma unroll
      for (int i = 0; i < 64; i += 4) *(float4*)(UT + cidx * 64 + i) = make_float4(x[i], x[i + 1], x[i + 2], x[i + 3]);
    } else {
#pragma unroll
      for (int i = 0; i < 64; ++i) NW[i * 64 + (cidx - 64)] = f2bf(-x[i]);
    }
  }
  __syncthreads();
}

__device__ __forceinline__ void gdn_scan(KP p, char* smem, int sid) {
  const int b = sid >> 4, h = (sid >> 2) & 3, v0 = (sid & 3) * 16;
  const int tid = otid(), lane = tid & 63, wv = tid >> 6, l15 = lane & 15, quad = lane >> 4;
  u16* Sb = (u16*)smem;
  u16* Vb = Sb + 16 * 72;
  f32x4 S = {0.f, 0.f, 0.f, 0.f};
  { u32 z0 = 0u; asm volatile("" : "+v"(z0)); *(uint2*)(Sb + l15 * 72 + 16 * wv + quad * 4) = make_uint2(z0, z0); }
  __syncthreads();
  const char* gbase = p->ws + OFF_GDN + (size_t)((b * 4 + h) * 256) * CHUNK_B;
  const float* GL = (const float*)(p->ws + OFF_GL) + (b * 4 + h) * 256;
  float* OG = (float*)(p->ws + OFF_OG);
  const int arow = (16 * wv + l15) * 64 + quad * 8;
  f32x4 u, un;
  bf16x8 wA[2], qdA[2], qkA[2], kdA[2], wAn[2], qdAn[2], qkAn[2], kdAn[2];
  float gl, gln;
  {
    const char* cb = gbase;
    u = *(const f32x4*)((const float*)cb + (v0 + l15) * 64 + 16 * wv + quad * 4);
#pragma unroll
    for (int ks = 0; ks < 2; ++ks) {
      wA[ks] = *(const bf16x8*)((const u16*)(cb + 16384) + arow + ks * 32);
      qdA[ks] = *(const bf16x8*)((const u16*)(cb + 24576) + arow + ks * 32);
      kdA[ks] = *(const bf16x8*)((const u16*)(cb + 32768) + arow + ks * 32);
      qkA[ks] = *(const bf16x8*)((const u16*)(cb + 40960) + arow + ks * 32);
    }
    gl = GL[0];
  }
  for (int c = 0; c < 256; ++c) {
    if (c + 1 < 256) {
      const char* cb = gbase + (size_t)(c + 1) * CHUNK_B;
      un = *(const f32x4*)((const float*)cb + (v0 + l15) * 64 + 16 * wv + quad * 4);
#pragma unroll
      for (int ks = 0; ks < 2; ++ks) {
        wAn[ks] = *(const bf16x8*)((const u16*)(cb + 16384) + arow + ks * 32);
        qdAn[ks] = *(const bf16x8*)((const u16*)(cb + 24576) + arow + ks * 32);
        kdAn[ks] = *(const bf16x8*)((const u16*)(cb + 32768) + arow + ks * 32);
        qkAn[ks] = *(const bf16x8*)((const u16*)(cb + 40960) + arow + ks * 32);
      }
      gln = GL[c + 1];
    }
    bf16x8 sB0 = *(const bf16x8*)(Sb + l15 * 72 + quad * 8);
    bf16x8 sB1 = *(const bf16x8*)(Sb + l15 * 72 + 32 + quad * 8);
    f32x4 vn = u;
    vn = mfma16(wA[0], sB0, vn);
    vn = mfma16(wA[1], sB1, vn);
    f32x4 o = {0.f, 0.f, 0.f, 0.f};
    o = mfma16(qdA[0], sB0, o);
    o = mfma16(qdA[1], sB1, o);
    *(uint2*)(Vb + l15 * 72 + 16 * wv + quad * 4) = make_uint2(pack2(vn[0], vn[1]), pack2(vn[2], vn[3]));
    __syncthreads();
    bf16x8 vB0 = *(const bf16x8*)(Vb + l15 * 72 + quad * 8);
    bf16x8 vB1 = *(const bf16x8*)(Vb + l15 * 72 + 32 + quad * 8);
    o = mfma16(qkA[0], vB0, o);
    o = mfma16(qkA[1], vB1, o);
    S[0] *= gl; S[1] *= gl; S[2] *= gl; S[3] *= gl;
    S = mfma16(kdA[0], vB0, S);
    S = mfma16(kdA[1], vB1, S);
    *(uint2*)(Sb + l15 * 72 + 16 * wv + quad * 4) = make_uint2(pack2(S[0], S[1]), pack2(S[2], S[3]));
    size_t orow = (size_t)b * T + c * 64 + 16 * wv + quad * 4;
#pragma unroll
    for (int r = 0; r < 4; ++r) OG[(orow + r) * 256 + h * 64 + v0 + l15] = o[r];
    __syncthreads();
    u = un; gl = gln;
#pragma unroll
    for (int ks = 0; ks < 2; ++ks) { wA[ks] = wAn[ks]; qdA[ks] = qdAn[ks]; kdA[ks] = kdAn[ks]; qkA[ks] = qkAn[ks]; }
  }
}

__device__ __forceinline__ void gdn_finalize(KP p, int l) {
  const int lane = otid() & 63, sub = lane >> 4, q4 = (lane & 15) * 4;
  const int gw = obid() * 4 + (otid() >> 6), nw = gridDim.x * 4;
  const float* OG = (const float*)(p->ws + OFF_OG);
  const u16* proj = (const u16*)(p->ws + OFF_PROJ);
  u16* mix = (u16*)(p->ws + OFF_H);
  const float4 gn = *(const float4*)(p->gdn_norm + l * 64 + q4);
  for (int base = gw * 16; base < NTOK * 4; base += nw * 16) {
    float4 o[4];
    uint2 zr[4];
#pragma unroll
    for (int u = 0; u < 4; ++u) {
      const int row = base + u * 4 + sub, t = row >> 2, h = row & 3;
      o[u] = *(const float4*)(OG + (size_t)row * 64 + q4);
      zr[u] = *(const uint2*)(proj + (size_t)t * PJ + C_GZ + h * 64 + q4);
    }
#pragma unroll
    for (int u = 0; u < 4; ++u) {
      const int row = base + u * 4 + sub, t = row >> 2, h = row & 3;
      float ss = o[u].x * o[u].x + o[u].y * o[u].y + o[u].z * o[u].z + o[u].w * o[u].w;
      ss += __shfl_xor(ss, 1); ss += __shfl_xor(ss, 2); ss += __shfl_xor(ss, 4); ss += __shfl_xor(ss, 8);
      const float rs = rsqrtf(ss * (1.f / 64.f) + 1e-6f);
      const float z0 = bf2f(zr[u].x & 0xffff), z1 = bf2f(zr[u].x >> 16), z2 = bf2f(zr[u].y & 0xffff), z3 = bf2f(zr[u].y >> 16);
      const float y0 = o[u].x * rs * gn.x * (z0 / (1.f + __expf(-z0)));
      const float y1 = o[u].y * rs * gn.y * (z1 / (1.f + __expf(-z1)));
      const float y2 = o[u].z * rs * gn.z * (z2 / (1.f + __expf(-z2)));
      const float y3 = o[u].w * rs * gn.w * (z3 / (1.f + __expf(-z3)));
      uint2 w;
      w.x = pack2(ZTEST == 4 ? 0.f : y0, ZTEST == 4 ? 0.f : y1);
      w.y = pack2(ZTEST == 4 ? 0.f : y2, ZTEST == 4 ? 0.f : y3);
      *(uint2*)(mix + (size_t)t * DM + h * 64 + q4) = w;
    }
  }
}

__device__ __forceinline__ void rope_table(KP p) {
  float* rp = (float*)(p->ws + OFF_ROPE);
  int gt = obid() * blockDim.x + otid(), nt = gridDim.x * blockDim.x;
  for (int idx = gt; idx < NTOK * 8; idx += nt) {
    int t = idx >> 3, i = idx & 7;
    float inv = (float)pow(500000.0, -(double)i / 8.0);
    float ang = (float)p->positions[t] * inv;
    rp[t * 16 + i] = (float)cos((double)ang);
    rp[t * 16 + 8 + i] = (float)sin((double)ang);
  }
}

__device__ __forceinline__ void nsa_token_prep(KP p, int l, char* smem, int tb) {
  const int tid = otid(), lane = tid & 63, wv = tid >> 6;
  const int b = tb >> 8, blk = tb & 255;
  u16* proj = (u16*)(p->ws + OFF_PROJ);
  const float* rope = (const float*)(p->ws + OFF_ROPE);
  const size_t tok0 = (size_t)tb * 64;
  for (int r = tid; r < 768; r += 256) {
    int i = r / 12, which = r % 12;
    size_t t = tok0 + i;
    int col; const float* gain;
    if (which < 8) { col = C_NQ + which * 64; gain = p->nsa_q_norm + l * 64; }
    else if (which < 10) { col = C_KSLC + (which - 8) * 64; gain = p->nsa_k_norm + (l * 3 + 1) * 64; }
    else { col = C_KWIN + (which - 10) * 64; gain = p->nsa_k_norm + (l * 3 + 2) * 64; }
    u16* rowp = proj + t * PJ + col;
    union { uint4 q; u16 h[8]; } v[8];
    float ss = 0.f;
#pragma unroll
    for (int c = 0; c < 8; ++c) {
      v[c].q = *(const uint4*)(rowp + c * 8);
#pragma unroll
      for (int e = 0; e < 8; ++e) { float x = bf2f(v[c].h[e]); ss += x * x; }
    }
    const float rs = rsqrtf(ss * (1.f / 64.f) + 1e-6f);
    float y0[16];
#pragma unroll
    for (int e = 0; e < 16; ++e) y0[e] = bf2f(v[e >> 3].h[e & 7]) * rs * gain[e];
    if (which >= 8) {
      const float* rp = rope + t * 16;
#pragma unroll
      for (int e = 0; e < 8; ++e) {
        float c = rp[e], sn = rp[8 + e];
        float a1 = y0[e], a2 = y0[8 + e];
        y0[e] = a1 * c - a2 * sn;
        y0[8 + e] = a2 * c + a1 * sn;
      }
    }
#pragma unroll
    for (int c = 0; c < 8; ++c) {
      uint4 o;
      float y[8];
#pragma unroll
      for (int e = 0; e < 8; ++e) y[e] = c < 2 ? y0[c * 8 + e] : bf2f(v[c].h[e]) * rs * gain[c * 8 + e];
      o.x = pack2(y[0], y[1]); o.y = pack2(y[2], y[3]); o.z = pack2(y[4], y[5]); o.w = pack2(y[6], y[7]);
      *(uint4*)(rowp + c * 8) = o;
    }
  }
  {
    u16* tt = (u16*)smem;
    uint4 vr[4][2];
#pragma unroll
    for (int z = 0; z < 4; ++z) {
      const int col = ((z >> 1) ? C_VWIN : C_VSLC) + (z & 1) * 64;
#pragma unroll
      for (int k = 0; k < 2; ++k) {
        const int q = tid + k * 256, i = q >> 3, c8 = q & 7;
        vr[z][k] = *(const uint4*)(proj + (tok0 + i) * PJ + col + c8 * 8);
      }
    }
#pragma unroll
    for (int z = 0; z < 4; ++z)
#pragma unroll
      for (int k = 0; k < 2; ++k) {
        const int q = tid + k * 256, i = q >> 3, c8 = q & 7;
        *(uint4*)(tt + (z * 64 + i) * 72 + c8 * 8) = vr[z][k];
      }
    __syncthreads();
#pragma unroll
    for (int z = 0; z < 4; ++z) {
      const int tensor = z >> 1, g = z & 1;
      u16* dst = (u16*)(p->ws + OFF_VT + (size_t)tensor * 8 * MiB) + ((size_t)((b * 2 + g) * 256 + blk)) * 4096;
#pragma unroll
      for (int k = 0; k < 2; ++k) {
        const int q = tid + k * 256, d = q >> 3, i8 = q & 7;
        union { uint4 v; u16 h[8]; } o;
#pragma unroll
        for (int e = 0; e < 8; ++e) {
          const int ok_ = (i8 >> 2) * 32 + (e < 4 ? (i8 & 3) * 4 + e : 16 + (i8 & 3) * 4 + e - 4);
          o.h[e] = tt[(z * 64 + ok_) * 72 + d];
        }
        *(uint4*)(dst + d * 64 + i8 * 8) = o.v;
      }
    }
    __syncthreads();
  }
  {
    const int cg8 = (tid & 31) * 8, t8 = (tid >> 5) * 8;
    u16* mix = (u16*)(p->ws + OFF_H);
    union U8 { uint4 v; u16 h[8]; };
    U8 cc[10], cx[10], cb[8];
#pragma unroll
    for (int k = 0; k < 10; ++k) {
      const int rel = t8 + k - 2;
      const bool ok = (blk > 0) || (rel >= 0);
      const size_t tk = ok ? (tok0 + rel) : tok0;
      cc[k].v = *(const uint4*)(proj + tk * PJ + C_CC + cg8);
      cx[k].v = *(const uint4*)(proj + tk * PJ + C_CX + cg8);
    }
#pragma unroll
    for (int k = 0; k < 8; ++k) cb[k].v = *(const uint4*)(proj + (tok0 + t8 + k) * PJ + C_CB + cg8);
    float w0[8], w1[8], w2[8];
    {
      const float* cw = p->conv_w + (size_t)l * 3 * 256 + cg8;
#pragma unroll
      for (int e = 0; e < 8; ++e) { w0[e] = cw[e]; w1[e] = cw[256 + e]; w2[e] = cw[512 + e]; }
    }
    float pr[10][8];
#pragma unroll
    for (int k = 0; k < 10; ++k) {
      const bool ok = (blk > 0) || (t8 + k - 2 >= 0);
#pragma unroll
      for (int e = 0; e < 8; ++e) pr[k][e] = ok ? bf2f(cc[k].h[e]) * bf2f(cx[k].h[e]) : 0.f;
    }
#pragma unroll
    for (int k = 0; k < 8; ++k) {
      float y[8];
#pragma unroll
      for (int e = 0; e < 8; ++e)
        y[e] = bf2f(cb[k].h[e]) * (w0[e] * pr[k][e] + w1[e] * pr[k + 1][e] + w2[e] * pr[k + 2][e]);
      uint4 o;
      o.x = pack2(y[0], y[1]); o.y = pack2(y[2], y[3]); o.z = pack2(y[4], y[5]); o.w = pack2(y[6], y[7]);
      *(uint4*)(mix + (tok0 + t8 + k) * DM + 768 + cg8) = o;
    }
  }
}

__device__ __forceinline__ void nsa_compress(KP p, int l, char* smem, int job) {
  const int tid = otid(), lane = tid & 63, wv = tid >> 6, l15 = lane & 15, quad = lane >> 4;
  const int which = job >> 6, b = (job >> 5) & 1, g = (job >> 4) & 1, tile = job & 15;
  const u16* proj = (const u16*)(p->ws + OFF_PROJ);
  const u16* W1T = (const u16*)(p->ws + OFF_W + W_C1) + (size_t)which * 64 * 2048;
  const u16* W2T = (const u16*)(p->ws + OFF_W + W_C2) + which * 4096;
  const float* pe = p->cmp_pe + (size_t)(l * 2 + which) * 32 * 64;
  const int blk0 = tile * 64 + wv * 16;
  int blk = blk0 + l15;
  int blkc = blk < 1023 ? blk : 1022;
  const u16* arow = proj + ((size_t)b * T + blkc * 16) * PJ + (which ? C_VCMP : C_KCMP) + g * 64;
  f32x4 acc[4];
#pragma unroll
  for (int n = 0; n < 4; ++n) acc[n] = f32x4{0.f, 0.f, 0.f, 0.f};
  for (int ks0 = 0; ks0 < 64; ks0 += 4) {
    uint4 raw[4];
    float4 pea[4], peb[4];
    bf16x8 bfr[4][4];
#pragma unroll
    for (int u = 0; u < 4; ++u) {
      const int ks = ks0 + u, tok = ks >> 1, d0 = (ks & 1) * 32 + quad * 8;
      raw[u] = *(const uint4*)(arow + (size_t)tok * PJ + d0);
      pea[u] = *(const float4*)(pe + tok * 64 + d0);
      peb[u] = *(const float4*)(pe + tok * 64 + d0 + 4);
#pragma unroll
      for (int n = 0; n < 4; ++n) bfr[u][n] = *(const bf16x8*)(W1T + (size_t)(n * 16 + l15) * 2048 + ks * 32 + quad * 8);
    }
#pragma unroll
    for (int u = 0; u < 4; ++u) {
      union { bf16x8 v; u32 w[4]; } af;
      af.w[0] = pack2(bf2f(raw[u].x & 0xffff) + pea[u].x, bf2f(raw[u].x >> 16) + pea[u].y);
      af.w[1] = pack2(bf2f(raw[u].y & 0xffff) + pea[u].z, bf2f(raw[u].y >> 16) + pea[u].w);
      af.w[2] = pack2(bf2f(raw[u].z & 0xffff) + peb[u].x, bf2f(raw[u].z >> 16) + peb[u].y);
      af.w[3] = pack2(bf2f(raw[u].w & 0xffff) + peb[u].z, bf2f(raw[u].w >> 16) + peb[u].w);
#pragma unroll
      for (int n = 0; n < 4; ++n) acc[n] = mfma16(af.v, bfr[u][n], acc[n]);
    }
  }
  u16* hid = (u16*)smem + wv * 16 * 72;
#pragma unroll
  for (int n = 0; n < 4; ++n)
#pragma unroll
    for (int r = 0; r < 4; ++r) {
      float x = acc[n][r];
      float u = 0.7978845608028654f * (x + 0.044715f * x * x * x);
      float gl = 0.5f * x * (1.f + tanhf(u));
      hid[(quad * 4 + r) * 72 + n * 16 + l15] = f2bf(gl);
    }
  __syncthreads();
  f32x4 o2[4];
#pragma unroll
  for (int n = 0; n < 4; ++n) o2[n] = f32x4{0.f, 0.f, 0.f, 0.f};
#pragma unroll
  for (int ks = 0; ks < 2; ++ks) {
    bf16x8 af = *(const bf16x8*)(hid + l15 * 72 + ks * 32 + quad * 8);
#pragma unroll
    for (int n = 0; n < 4; ++n) {
      bf16x8 bfr = *(const bf16x8*)(W2T + (n * 16 + l15) * 64 + ks * 32 + quad * 8);
      o2[n] = mfma16(af, bfr, o2[n]);
    }
  }
  __syncthreads();
  if (which == 0) {
    u16* KC = (u16*)(p->ws + OFF_KC) + (size_t)(b * 2 + g) * 1024 * 64;
    const float* kg = p->nsa_k_norm + (l * 3 + 0) * 64;
#pragma unroll
    for (int r = 0; r < 4; ++r) {
      float ss = 0.f;
#pragma unroll
      for (int n = 0; n < 4; ++n) ss += o2[n][r] * o2[n][r];
      ss += __shfl_xor(ss, 1); ss += __shfl_xor(ss, 2); ss += __shfl_xor(ss, 4); ss += __shfl_xor(ss, 8);
      float rs = rsqrtf(ss * (1.f / 64.f) + 1e-6f);
      int row = blk0 + quad * 4 + r;
#pragma unroll
      for (int n = 0; n < 4; ++n) {
        float v = row < 1023 ? o2[n][r] * rs * kg[n * 16 + l15] : 0.f;
        KC[(size_t)row * 64 + n * 16 + l15] = f2bf(v);
      }
    }
  } else {
    u16* VCT = (u16*)(p->ws + OFF_KC + 524288) + (size_t)(b * 2 + g) * 64 * 1024;
#pragma unroll
    for (int r = 0; r < 4; ++r) {
      int row = blk0 + quad * 4 + r;
#pragma unroll
      for (int n = 0; n < 4; ++n) {
        float v = row < 1023 ? o2[n][r] : 0.f;
        const int k32_ = row & 31;
        const int kp_ = k32_ < 16 ? (k32_ >> 2) * 8 + (k32_ & 3) : ((k32_ - 16) >> 2) * 8 + 4 + (k32_ & 3);
        VCT[(size_t)(n * 16 + l15) * 1024 + (row & ~31) + kp_] = f2bf(v);
      }
    }
  }
}

template <int MODE, int NT>
__device__ __forceinline__ void flash2(const u16* __restrict__ Kg, int kld, const u16* __restrict__ VTg, int vblk,
                                       int vld, int h0, int h1, char* sStage, const u16* sQw, f32x4 (&O)[4][NT],
                                       float (&lsum)[NT], const float (&inv)[NT], const u32* sSelw, float* slc,
                                       int tq0) {
  const int tid = otid(), lane = tid & 63, wv = tid >> 6, l15 = lane & 15, quad = lane >> 4;
  const int krow = tid >> 3, kc = tid & 7;
  const u16* kptr = Kg + (size_t)krow * kld + kc * 8;
  const int kw = krow * 128 + ((kc ^ ((krow >> 1) & 7)) * 16);
  const int vd = tid >> 2, vc = tid & 3;
  const u16* vptr = VTg + (size_t)vd * vld + vc * 8;
  const int vw = 4096 + vd * 64 + ((vc ^ ((0x1320 >> (4 * ((vd >> 2) & 3))) & 3)) * 16);
  const int jb0 = h0 >> 1, nst = (h1 >> 1) - jb0 + 1;
  uint4 S0k0, S0k1, S0v0, S0v1, S1k0, S1k1, S1v0, S1v1;
#define F2_LOAD(S, i_)                                                                             \
  do {                                                                                             \
    const int jb_ = jb0 + (i_);                                                                    \
    S##k0 = *(const uint4*)(kptr + (size_t)(jb_ * 64) * kld);                                      \
    S##k1 = *(const uint4*)(kptr + (size_t)(jb_ * 64 + 32) * kld);                                 \
    if (MODE != 2) {                                                                               \
      S##v0 = *(const uint4*)(vptr + (size_t)jb_ * vblk);                                          \
      S##v1 = *(const uint4*)(vptr + (size_t)jb_ * vblk + 32);                                     \
    }                                                                                              \
  } while (0)
#define F2_WRITE(S, slot_)                                                     \
  do {                                                                         \
    char* sl_ = sStage + (slot_) * 16384;                                      \
    *(uint4*)(sl_ + kw) = S##k0;                                               \
    *(uint4*)(sl_ + 8192 + kw) = S##k1;                                        \
    if (MODE != 2) {                                                           \
      *(uint4*)(sl_ + vw) = S##v0;                                             \
      *(uint4*)(sl_ + 8192 + vw) = S##v1;                                      \
    }                                                                          \
  } while (0)
  if (0 < nst) F2_LOAD(S0, 0);
  if (1 < nst) F2_LOAD(S1, 1);
  const int koff = l15 * 128;
  const int ksw = (l15 >> 1) & 7;
  const int voff = 4096 + l15 * 64 + ((quad ^ ((0x1320 >> (4 * ((l15 >> 2) & 3))) & 3)) * 16);
  const int tq0u = __builtin_amdgcn_readfirstlane(tq0);
  const int lim0u = tq0u >= 31 ? ((tq0u - 31) >> 4) : -1;
  f32x4 Lacc[NT];
#pragma unroll
  for (int nt = 0; nt < NT; ++nt) Lacc[nt] = f32x4{0.f, 0.f, 0.f, 0.f};
  bf16x8 ones_;
  { u32 o1 = 0x3f803f80u; asm volatile("" : "+v"(o1)); union { bf16x8 v; u32 u[4]; } oo; oo.u[0] = o1; oo.u[1] = o1; oo.u[2] = o1; oo.u[3] = o1; ones_ = oo.v; }
  auto compute = [&](const int h, const char* st) __attribute__((always_inline)) {
    bool interior;
    if (MODE == 0) interior = (h * 32 + 31 <= tq0u) && (h * 32 > tq0u + NT * 4 - 1 - 512);
    else if (MODE == 1) interior = (h * 32 + 31 <= tq0u);
    else interior = (h * 32 + 31 <= lim0u);
    bool bv[NT], an[NT];
    bool anyw = false;
#pragma unroll
    for (int nt = 0; nt < NT; ++nt) {
      if (MODE == 1) {
        u32 w = sSelw[(nt * 4 + (l15 >> 2)) * 8 + (h >> 6)];
        bv[nt] = (w >> ((h >> 1) & 31)) & 1u;
      } else {
        bv[nt] = true;
      }
      an[nt] = MODE == 1 ? (bool)__any(bv[nt]) : true;
      anyw |= an[nt];
    }
    if (anyw) {
      bf16x8 kf[2][2], vf[4];
#pragma unroll
      for (int m2 = 0; m2 < 2; ++m2)
#pragma unroll
        for (int ks = 0; ks < 2; ++ks)
          kf[m2][ks] = *(const bf16x8*)(st + koff + m2 * 2048 + (((ks * 4 + quad) ^ ksw) * 16));
      if (MODE != 2) {
#pragma unroll
        for (int dt = 0; dt < 4; ++dt) vf[dt] = *(const bf16x8*)(st + voff + dt * 1024);
      }
#pragma unroll
      for (int nt = 0; nt < NT; ++nt) {
        if (!an[nt]) continue;
        const int t = tq0 + nt * 4 + (l15 >> 2);
        const bf16x8 bq0 = *(const bf16x8*)(sQw + (nt * 16 + l15) * 72 + quad * 8);
        const bf16x8 bq1 = *(const bf16x8*)(sQw + (nt * 16 + l15) * 72 + 32 + quad * 8);
        f32x4 s[2];
#pragma unroll
        for (int m2 = 0; m2 < 2; ++m2) {
          s[m2] = f32x4{0.f, 0.f, 0.f, 0.f};
          s[m2] = mfma16(kf[m2][0], bq0, s[m2]);
          s[m2] = mfma16(kf[m2][1], bq1, s[m2]);
        }
        const float bias = MODE == 1 ? (bv[nt] ? 0.f : -1000.f) : (MODE == 3 ? inv[nt] : 0.f);
        if (interior) {
#pragma unroll
          for (int m2 = 0; m2 < 2; ++m2)
#pragma unroll
            for (int r = 0; r < 4; ++r) s[m2][r] = __builtin_amdgcn_exp2f(fmaf(s[m2][r], SC2, bias));
        } else {
          int base;
          if (MODE <= 1) base = h * 32 + quad * 4 - t;
          else base = h * 32 + quad * 4 - (t >= 31 ? ((t - 31) >> 4) : -1);
          asm volatile("" : "+v"(base));
#pragma unroll
          for (int m2 = 0; m2 < 2; ++m2)
#pragma unroll
            for (int r = 0; r < 4; ++r) {
              const int C = m2 * 16 + r;
              bool valid;
              if (MODE == 0) valid = base <= -C && base > -512 - C;
              else valid = base <= -C;
              float pvv = __builtin_amdgcn_exp2f(fmaf(s[m2][r], SC2, bias));
              s[m2][r] = valid ? pvv : 0.f;
            }
        }
        if (MODE == 2) {
          float ls = ((s[0][0] + s[0][1]) + (s[0][2] + s[0][3])) + ((s[1][0] + s[1][1]) + (s[1][2] + s[1][3]));
          lsum[nt] += ls;
        }
        if (MODE == 3) {
#pragma unroll
          for (int m2 = 0; m2 < 2; ++m2) {
            float ow = s[m2][0] + s[m2][1] + s[m2][2] + 0.5f * s[m2][3];
            float sp = 0.5f * s[m2][3];
            ow += __shfl_xor(ow, 1); ow += __shfl_xor(ow, 2);
            sp += __shfl_xor(sp, 1); sp += __shfl_xor(sp, 2);
            if ((l15 & 3) == 0) {
              const int j = h * 8 + m2 * 4 + quad;
              slc[(nt * 4 + (l15 >> 2)) * 256 + j] = ow;
              if (j + 1 < 256) slc[1024 + (nt * 4 + (l15 >> 2)) * 256 + j + 1] = sp;
            }
          }
        }
        if (MODE != 2) {
          bf16x8 P = pack8(s[0], s[1]);
#pragma unroll
          for (int dt = 0; dt < 4; ++dt) O[dt][nt] = mfma16(vf[dt], P, O[dt][nt]);
          if (MODE <= 1) Lacc[nt] = mfma16(ones_, P, Lacc[nt]);
        }
      }
    }
  };
  if (0 < nst) F2_WRITE(S0, 0);
  if (2 < nst) F2_LOAD(S0, 2);
  RAW_BAR();
#define F2_ITER(u_, SN, sn_)                                            \
  if (i + (u_) < nst) {                                                 \
    const int ii_ = i + (u_);                                           \
    if (ii_ + 1 < nst) F2_WRITE(SN, sn_);                               \
    if (ii_ + 3 < nst) F2_LOAD(SN, ii_ + 3);                            \
    compute(2 * (jb0 + ii_), sStage + (u_) * 16384);                    \
    compute(2 * (jb0 + ii_) + 1, sStage + (u_) * 16384 + 8192);         \
    RAW_BAR();                                                          \
  }
  for (int i = 0; i < nst; i += 2) {
    F2_ITER(0, S1, 1)
    F2_ITER(1, S0, 0)
  }
  if (MODE <= 1) {
#pragma unroll
    for (int nt = 0; nt < NT; ++nt) lsum[nt] += Lacc[nt][0] * 0.25f;
  }
}

__device__ __forceinline__ void nsa_phase_c(KP p, int l, char* smem) {
  const int tid = otid(), lane = tid & 63, wv = tid >> 6, l15 = lane & 15, quad = lane >> 4;
  char* sStage = smem;
  u16* sQw = (u16*)(smem + 32768) + wv * 16 * 72;
  float* own = (float*)(smem + 32768 + 9216) + wv * 2048;
  float* spl = own + 1024;
  const u16* proj = (const u16*)(p->ws + OFF_PROJ);
  const float* small_ = (const float*)(p->ws + OFF_SMALL);
  float* OC = (float*)(p->ws + OFF_OC);
  u32* SEL = (u32*)(p->ws + OFF_SEL);
  for (int job = obid(); job < 4096; job += gridDim.x) {
    const int qt = 1023 - (job >> 2), bg = job & 3, b = bg >> 1, g = bg & 1;
    const int t0 = qt * 16 + wv * 4;
    const int ql = l15 >> 2, r_ = l15 & 3, head = g * 4 + r_;
    const int t = t0 + ql;
    const size_t tok = (size_t)b * T + t;
    const u16* KC = (const u16*)(p->ws + OFF_KC) + (size_t)bg * 1024 * 64;
    const u16* VCT = (const u16*)(p->ws + OFF_KC + 524288) + (size_t)bg * 64 * 1024;
    {
      const u16* qrow = proj + tok * PJ + C_NQ + head * 64;
      *(bf16x8*)(sQw + l15 * 72 + quad * 8) = *(const bf16x8*)(qrow + quad * 8);
      *(bf16x8*)(sQw + l15 * 72 + 32 + quad * 8) = *(const bf16x8*)(qrow + 32 + quad * 8);
    }
    const int tmax = qt * 16 + 15;
    const int nvmax = tmax >= 31 ? ((tmax - 31) >> 4) + 1 : 0;
    const int h1 = ((nvmax + 31) >> 5) - 1;
    f32x4 O[4][1];
    float lsum[1] = {0.f}, inv[1] = {0.f};
#pragma unroll
    for (int dt = 0; dt < 4; ++dt) O[dt][0] = f32x4{0.f, 0.f, 0.f, 0.f};
    if (h1 >= 0) {
      flash2<2, 1>(KC, 64, VCT, 64, 1024, 0, h1, sStage, sQw, O, lsum, inv, nullptr, own, t0);
      float ls = lsum[0];
      ls += __shfl_xor(ls, 16);
      ls += __shfl_xor(ls, 32);
      inv[0] = ls > 0.f ? -log2f(ls) : -1000.f;
      flash2<3, 1>(KC, 64, VCT, 64, 1024, 0, h1, sStage, sQw, O, lsum, inv, nullptr, own, t0);
    }
    {
      float gc = ZTEST == 1 ? 0.f : sigmoidf_(small_[tok * 32 + 8 + head * 3 + 0]);
#pragma unroll
      for (int dt = 0; dt < 4; ++dt) {
        float4 o = make_float4(O[dt][0][0] * gc, O[dt][0][1] * gc, O[dt][0][2] * gc, O[dt][0][3] * gc);
        *(float4*)(OC + tok * 512 + head * 64 + dt * 16 + quad * 4) = o;
      }
    }
    __builtin_amdgcn_wave_barrier();
    for (int q = 0; q < 4; ++q) {
      const int tq = t0 + q, cur = tq >> 6;
      u32 word = 0;
      if (cur <= 15) {
        if (lane == 0) word = (2u << cur) - 1u;
      } else {
        u32 key[4];
#pragma unroll
        for (int k = 0; k < 4; ++k) {
          int j = lane + 64 * k;
          float v = own[q * 256 + j] + spl[q * 256 + j];
          key[k] = (j >= 1 && j <= cur - 2) ? (__float_as_uint(fmaxf(v, 0.f)) + 1u) : 0u;
        }
        u32 T = 0u;
        for (int bit = 30; bit >= 0; --bit) {
          const u32 cand = T | (1u << bit);
          int cnt = 0;
#pragma unroll
          for (int k = 0; k < 4; ++k) cnt += __popcll(__ballot(key[k] >= cand));
          if (cnt >= 13) T = cand;
        }
        int ngt = 0;
#pragma unroll
        for (int k = 0; k < 4; ++k) ngt += __popcll(__ballot(key[k] > T));
        int quota = 13 - ngt;
        const unsigned long long lt = (1ull << lane) - 1ull;
#pragma unroll
        for (int k = 0; k < 4; ++k) {
          const unsigned long long me = __ballot(key[k] == T);
          const bool take = key[k] > T || (key[k] == T && (int)__popcll(me & lt) < quota);
          const int ne = (int)__popcll(me);
          quota = quota > ne ? quota - ne : 0;
          const unsigned long long sm = __ballot(take);
          if (lane == 2 * k) word = (u32)sm;
          if (lane == 2 * k + 1) word = (u32)(sm >> 32);
        }
        if (lane == 0) word |= 1u;
        if (lane == (cur >> 5)) word |= 1u << (cur & 31);
        if (lane == ((cur - 1) >> 5)) word |= 1u << ((cur - 1) & 31);
      }
      if (lane < 8) SEL[(((size_t)b * 16384 + tq) * 2 + g) * 8 + lane] = word;
    }
    __builtin_amdgcn_wave_barrier();
  }
}

__device__ __forceinline__ void nsa_s_tile(KP p, int l, char* smem, int tile) {
  const int cur = 255 - (tile >> 2), bg = tile & 3, b = bg >> 1, g = bg & 1;
  const int tid = otid(), lane = tid & 63, wv = tid >> 6, l15 = lane & 15, quad = lane >> 4;
  char* sStage = smem;
  u16* sQw = (u16*)(smem + 32768) + wv * 64 * 72;
  u32* sSel = (u32*)(smem + 32768 + 36864);
  const u32* sSelw = sSel + wv * 16 * 8;
  const u16* proj = (const u16*)(p->ws + OFF_PROJ);
  const float* small_ = (const float*)(p->ws + OFF_SMALL);
  const float* rope = (const float*)(p->ws + OFF_ROPE);
  float* OC = (float*)(p->ws + OFF_OC);
  u16* mix = (u16*)(p->ws + OFF_H);
  const size_t tokb = (size_t)b * T;
  const int tq0 = cur * 64 + wv * 16;
  const int r_ = l15 & 3, head = g * 4 + r_;
  {
    const u32* SEL = (const u32*)(p->ws + OFF_SEL);
    int q = tid >> 2, w2 = (tid & 3) * 2;
    uint2 v = *(const uint2*)(SEL + ((tokb + cur * 64 + q) * 2 + g) * 8 + w2);
    *(uint2*)(sSel + q * 8 + w2) = v;
  }
#pragma unroll
  for (int nt = 0; nt < 4; ++nt) {
    const size_t tok = tokb + tq0 + nt * 4 + (l15 >> 2);
    const u16* qrow = proj + tok * PJ + C_NQ + head * 64;
    u16* qd = sQw + (nt * 16 + l15) * 72;
    *(bf16x8*)(qd + 32 + quad * 8) = *(const bf16x8*)(qrow + 32 + quad * 8);
    if (quad >= 2) {
      *(bf16x8*)(qd + quad * 8) = *(const bf16x8*)(qrow + quad * 8);
    } else {
      union { bf16x8 v; u16 h[8]; } x1, x2, o;
      x1.v = *(const bf16x8*)(qrow);
      x2.v = *(const bf16x8*)(qrow + 8);
      const float* rp = rope + tok * 16;
#pragma unroll
      for (int i = 0; i < 8; ++i) {
        float a = bf2f(x1.h[i]), bb = bf2f(x2.h[i]), c = rp[i], s = rp[8 + i];
        o.h[i] = f2bf(quad == 0 ? a * c - bb * s : bb * c + a * s);
      }
      *(bf16x8*)(qd + quad * 8) = o.v;
    }
  }
  f32x4 O[4][4];
  float lsum[4], inv[4] = {0.f, 0.f, 0.f, 0.f};
#pragma unroll
  for (int dt = 0; dt < 4; ++dt)
#pragma unroll
    for (int nt = 0; nt < 4; ++nt) O[dt][nt] = f32x4{0.f, 0.f, 0.f, 0.f};
#pragma unroll
  for (int nt = 0; nt < 4; ++nt) lsum[nt] = 0.f;
  {
    const u16* Kg = proj + tokb * PJ + C_KWIN + g * 64;
    const u16* VTg = (const u16*)(p->ws + OFF_VT + 8 * MiB) + (size_t)(bg * 256) * 4096;
    int h0 = 2 * cur - 16 < 0 ? 0 : 2 * cur - 16;
    flash2<0, 4>(Kg, PJ, VTg, 4096, 64, h0, 2 * cur + 1, sStage, sQw, O, lsum, inv, sSelw, nullptr, tq0);
  }
#pragma unroll
  for (int nt = 0; nt < 4; ++nt) {
    const size_t tok = tokb + tq0 + nt * 4 + (l15 >> 2);
    float ls = lsum[nt];
    ls += __shfl_xor(ls, 16);
    ls += __shfl_xor(ls, 32);
    float sc = ZTEST == 2 ? 0.f : sigmoidf_(small_[tok * 32 + 8 + head * 3 + 2]) / ls;
#pragma unroll
    for (int dt = 0; dt < 4; ++dt) {
      float4* op = (float4*)(OC + tok * 512 + head * 64 + dt * 16 + quad * 4);
      float4 o = *op;
      o.x += O[dt][nt][0] * sc; o.y += O[dt][nt][1] * sc; o.z += O[dt][nt][2] * sc; o.w += O[dt][nt][3] * sc;
      *op = o;
      O[dt][nt] = f32x4{0.f, 0.f, 0.f, 0.f};
    }
    lsum[nt] = 0.f;
  }
  {
    const u16* Kg = proj + tokb * PJ + C_KSLC + g * 64;
    const u16* VTg = (const u16*)(p->ws + OFF_VT) + (size_t)(bg * 256) * 4096;
    flash2<1, 4>(Kg, PJ, VTg, 4096, 64, 0, 2 * cur + 1, sStage, sQw, O, lsum, inv, sSelw, nullptr, tq0);
  }
#pragma unroll
  for (int nt = 0; nt < 4; ++nt) {
    const size_t tok = tokb + tq0 + nt * 4 + (l15 >> 2);
    float ls = lsum[nt];
    ls += __shfl_xor(ls, 16);
    ls += __shfl_xor(ls, 32);
    float sc = ZTEST == 3 ? 0.f : sigmoidf_(small_[tok * 32 + 8 + head * 3 + 1]) / ls;
#pragma unroll
    for (int dt = 0; dt < 4; ++dt) {
      float4 o = *(const float4*)(OC + tok * 512 + head * 64 + dt * 16 + quad * 4);
      uint2 w;
      w.x = pack2(o.x + O[dt][nt][0] * sc, o.y + O[dt][nt][1] * sc);
      w.y = pack2(o.z + O[dt][nt][2] * sc, o.w + O[dt][nt][3] * sc);
      *(uint2*)(mix + tok * DM + 256 + head * 64 + dt * 16 + quad * 4) = w;
    }
  }
}


#define XB_TMO      128
#define XB_XCNT(j)  (256  + 64 * (j))
#define XB_XSUB(j)  (1280 + 64 * (j))
#define XB_XGEN(j)  (2304 + 64 * (j))
#define XB_TOP      3328
#define XB_TOPGEN   3392
#define XCD_BAR_WORDS 3456
#define XB_SPIN_CAP (1u << 18)
#define LAS __attribute__((address_space(3)))
__device__ __forceinline__ unsigned xb_ld(unsigned* p) { return __hip_atomic_load(p, __ATOMIC_RELAXED, __HIP_MEMORY_SCOPE_AGENT); }
__device__ __forceinline__ unsigned xb_add(unsigned* p, unsigned v) { return __hip_atomic_fetch_add(p, v, __ATOMIC_RELAXED, __HIP_MEMORY_SCOPE_AGENT); }
__device__ __forceinline__ unsigned xb_xcc_id() { return (unsigned)__builtin_amdgcn_s_getreg((3 << 11) | 20) & 0xFu; }
#define XB_SPIN(cond, bar) do { unsigned _sp = 0; while (cond) { __builtin_amdgcn_s_sleep(1); \
    if ((++_sp & 255u) == 0u) { if (xb_ld(&(bar)[XB_TMO])) break; if (_sp > XB_SPIN_CAP) { atomicAdd(&(bar)[XB_TMO], 1u); break; } } } } while (0)
struct XcdBarrier { unsigned* bar; unsigned x; volatile LAS unsigned* st; };
__device__ __forceinline__ XcdBarrier xcd_barrier_post(unsigned* bar, volatile LAS unsigned* st) {
  XcdBarrier b; b.bar = bar; b.x = xb_xcc_id(); b.st = st;
  if (threadIdx.x == 0) (void)xb_add(&bar[XB_XCNT(b.x)], 1u);
  return b;
}
__device__ __forceinline__ void xcd_barrier_complete(unsigned* bar, unsigned x, unsigned& nloc, unsigned& nx) {
  const unsigned G = gridDim.x * gridDim.y * gridDim.z;
  unsigned sum, cnt, mine, sp = 0u;
  for (;;) {
    sum = 0u; cnt = 0u; mine = 0u;
#pragma unroll
    for (unsigned j = 0; j < 16; ++j) { const unsigned c = xb_ld(&bar[XB_XCNT(j)]); sum += c; cnt += (c > 0u) ? 1u : 0u; mine = (j == x) ? c : mine; }
    if (sum == G) break;
    __builtin_amdgcn_s_sleep(1);
    if ((++sp & 255u) == 0u) { if (xb_ld(&bar[XB_TMO])) break; if (sp > XB_SPIN_CAP) { atomicAdd(&bar[XB_TMO], 1u); break; } }
  }
  nloc = mine > 0u ? mine : 1u; nx = cnt > 0u ? cnt : 1u;
}
__device__ __forceinline__ void xcd_barrier(const XcdBarrier& b) {
  asm volatile("s_waitcnt vmcnt(0)" ::: "memory");
  __syncthreads();
  if (threadIdx.x == 0) {
    unsigned* bar = b.bar;
    __builtin_amdgcn_s_waitcnt(0);
    unsigned nloc = b.st[0], nx = b.st[1];
    if (nloc == 0u) { xcd_barrier_complete(bar, b.x, nloc, nx); b.st[0] = nloc; b.st[1] = nx; }
    const unsigned old = xb_add(&bar[XB_XSUB(b.x)], 1u);
    const unsigned gen = old / nloc;
    if (old + 1u == (gen + 1u) * nloc) {
      __builtin_amdgcn_fence(__ATOMIC_RELEASE, "agent");
      asm volatile("s_waitcnt vmcnt(0)" ::: "memory");
      const unsigned og = xb_add(&bar[XB_TOP], 1u);
      const unsigned tg = og / nx;
      if (og + 1u == (tg + 1u) * nx) xb_add(&bar[XB_TOPGEN], 1u);
      else XB_SPIN(xb_ld(&bar[XB_TOPGEN]) == tg, bar);
      __builtin_amdgcn_fence(__ATOMIC_ACQUIRE, "agent");
      xb_add(&bar[XB_XGEN(b.x)], 1u);
      asm volatile("s_waitcnt vmcnt(0)" ::: "memory");
    } else {
      XB_SPIN(xb_ld(&bar[XB_XGEN(b.x)]) == gen, bar);
      __builtin_amdgcn_fence(__ATOMIC_ACQUIRE, "agent");
      asm volatile("s_waitcnt vmcnt(0)" ::: "memory");
    }
  }
  __syncthreads();
}
#ifndef REPE
#define REPE 1
#endif
#ifndef REP3C
#define REP3C 1
#endif
#ifndef REP3
#define REP3 1
#endif
#ifndef XSYNC
#define XSYNC 0
#endif
#ifndef REP4
#define REP4 1
#endif
#ifndef REPSCAN
#define REPSCAN 1
#endif
#ifndef REPG
#define REPG 1
#endif
__global__ void __launch_bounds__(256, 2) hymba_mega(Params p_unused) {
  cg::grid_group grid = cg::this_grid();
  __shared__ uint4 xb_words;
  if (threadIdx.x == 0) xb_words = make_uint4(0u, 0u, 0u, 0u);
  __syncthreads();
  XcdBarrier xb = xcd_barrier_post((unsigned*)(kargs()->ws + OFF_CNT + 4096), (volatile LAS unsigned*)&xb_words);
  __shared__ __attribute__((aligned(16))) char smem[77824];
  __shared__ int s_tile;
  { KP p = kargs(); rope_table(p); }
  grid.sync();
#pragma unroll 1
  for (int l = 0; l < DEPTH; ++l) {
    {
      KP p = kargs();
      if (blockIdx.x == 0 && threadIdx.x == 0) { u32 z0 = 0u; asm volatile("" : "+v"(z0)); ((u32*)(p->ws + OFF_CNT))[0] = z0; }
      for (int re = 0; re < REPE; ++re) {
      convert_weights(p, l, smem);
      rmsnorm_rows(l == 0 ? p->x_in : p->out, p->attn_norm + l * DM, (u16*)(p->ws + OFF_H));
      }
    }
    xcd_barrier(xb);
    {
      KP p = kargs();
      for (int rep = 0; rep < REPG; ++rep)
      gemm_phase((const u16*)(p->ws + OFF_H), DM, (const u16*)(p->ws + OFF_W + W_IN), DM, DM, 128, 25, smem,
                 EpiInProj{(u16*)(p->ws + OFF_PROJ), (float*)(p->ws + OFF_SMALL)});
    }
    xcd_barrier(xb);
    {
      KP p = kargs();
      for (int job = obid(); job < 2048 + 512 + 128; job += gridDim.x) {
        if (job < 2048) gdn_chunk_prep(p, l, smem, job);
        else if (job < 2560) nsa_token_prep(p, l, smem, job - 2048);
        else nsa_compress(p, l, smem, job - 2560);
      }
    }
    xcd_barrier(xb);
#ifndef REP45
#define REP45 1
#endif
    for (int rep = 0; rep < REP45; ++rep) {
    {
      KP p = kargs();
      if (blockIdx.x == 0 && threadIdx.x == 0) { u32 z0 = 0u; asm volatile("" : "+v"(z0)); ((u32*)(p->ws + OFF_CNT))[0] = z0; }
      for (int r4 = 0; r4 < REP4; ++r4) nsa_phase_c(p, l, smem);
    }
    xcd_barrier(xb);
    {
      KP p = kargs();
      if (obid() < 32) for (int rs = 0; rs < REPSCAN; ++rs) gdn_scan(p, smem, obid());
      u32* CNT = (u32*)(p->ws + OFF_CNT);
      for (;;) {
        __syncthreads();
        if (threadIdx.x == 0) s_tile = (int)atomicAdd(&CNT[0], 1u);
        __syncthreads();
        int tile = s_tile;
        if (tile >= 1024) break;
        nsa_s_tile(p, l, smem, tile);
      }
    }
    xcd_barrier(xb);
    }
    {
      KP p = kargs();
      for (int re = 0; re < REPE; ++re) gdn_finalize(p, l);
      for (int xs = 0; xs < XSYNC; ++xs) xcd_barrier(xb);
    }
    xcd_barrier(xb);
    {
      KP p = kargs();
      gemm_phase((const u16*)(p->ws + OFF_H), DM, (const u16*)(p->ws + OFF_W + W_OUT), DM, DM, 128, 8, smem,
                 EpiResid{l == 0 ? p->x_in : p->out, p->out});
    }
    xcd_barrier(xb);
    {
      KP p = kargs();
      for (int re = 0; re < REPE; ++re) rmsnorm_rows(p->out, p->ffn_norm + l * DM, (u16*)(p->ws + OFF_H));
    }
    xcd_barrier(xb);
    {
      KP p = kargs();
      for (int rep = 0; rep < REPG; ++rep)
      gemm_phase((const u16*)(p->ws + OFF_H), DM, (const u16*)(p->ws + OFF_W + W_GU), DM, DM, 128, 44, smem,
                 EpiSwiGLU{(u16*)(p->ws + OFF_PROJ)});
    }
    xcd_barrier(xb);
    {
      KP p = kargs();
      gemm_phase((const u16*)(p->ws + OFF_PROJ), DFF, (const u16*)(p->ws + OFF_W + W_DOWN), DFF, DFF, 128, 8, smem,
                 EpiResid{p->out, p->out});
    }
    xcd_barrier(xb);
  }
}

extern "C" void kernel_launch(void* const* d_in, const int* in_sizes, int n_in, void* d_out, int out_size, void* d_ws,
                              size_t ws_size, hipStream_t stream) {
  static int grid_blocks = 0;
  if (!grid_blocks) {
    int dev = 0, cus = 0, per_cu = 0;
    hipGetDevice(&dev);
    hipDeviceGetAttribute(&cus, hipDeviceAttributeMultiprocessorCount, dev);
    hipOccupancyMaxActiveBlocksPerMultiprocessor(&per_cu, hymba_mega, 256, 0);
    if (per_cu > 2) per_cu = 2;
    if (per_cu < 1) per_cu = 1;
    grid_blocks = cus * per_cu;
    grid_blocks &= ~7;
  }
  Params p;
  memset(&p, 0, sizeof(p));
  p.x_in = (const float*)d_in[0]; p.positions = (const int*)d_in[1]; p.attn_norm = (const float*)d_in[2];
  p.w_in = (const float*)d_in[3]; p.gdn_conv_w = (const float*)d_in[4]; p.gdn_a_log = (const float*)d_in[5];
  p.gdn_dt_bias = (const float*)d_in[6]; p.gdn_norm = (const float*)d_in[7]; p.nsa_q_norm = (const float*)d_in[8];
  p.nsa_k_norm = (const float*)d_in[9]; p.cmp_pe = (const float*)d_in[10]; p.cmp_w1 = (const float*)d_in[11];
  p.cmp_w2 = (const float*)d_in[12]; p.conv_w = (const float*)d_in[13]; p.w_out = (const float*)d_in[14];
  p.ffn_norm = (const float*)d_in[15]; p.w_gate_up = (const float*)d_in[16]; p.w_down = (const float*)d_in[17];
  p.out = (float*)d_out; p.ws = (char*)d_ws;
  hipMemsetAsync((char*)d_ws + OFF_CNT, 0, 4096 + XCD_BAR_WORDS * 4, stream);
  void* args[] = {&p};
  hipError_t e = hipLaunchCooperativeKernel((void*)hymba_mega, dim3(grid_blocks), dim3(256), args, 0, stream);
  if (e != hipSuccess) fprintf(stderr, "cooperative launch failed: %s (grid %d)\n", hipGetErrorString(e), grid_blocks);
}
```

```cpp
#include <hip/hip_runtime.h>
#include <hip/hip_cooperative_groups.h>
#include <cstdio>
#include <cstring>
namespace cg = cooperative_groups;

#ifndef ZTEST
#define ZTEST 0
#endif
typedef unsigned short u16;
typedef unsigned int u32;
typedef __attribute__((ext_vector_type(8))) short bf16x8;
typedef __attribute__((ext_vector_type(4))) short bf16x4;
typedef __attribute__((ext_vector_type(4))) float f32x4;

constexpr int NB = 2, T = 16384, NTOK = NB * T, DM = 1024, DFF = 2816, DEPTH = 4;
constexpr int PJ = 3072;
constexpr int C_GQ = 0, C_GK = 256, C_GV = 512, C_GZ = 768, C_NQ = 1024, C_KCMP = 1536, C_VCMP = 1664,
              C_KSLC = 1792, C_VSLC = 1920, C_KWIN = 2048, C_VWIN = 2176, C_CB = 2304, C_CC = 2560, C_CX = 2816;
constexpr size_t MiB = 1ull << 20;
constexpr size_t OFF_H = 0, OFF_PROJ = 64 * MiB, OFF_SMALL = 256 * MiB, OFF_W = 260 * MiB, OFF_GDN = 288 * MiB,
                 OFF_OG = 384 * MiB, OFF_OC = 416 * MiB, OFF_VT = 480 * MiB, OFF_KC = 496 * MiB, OFF_SEL = 497 * MiB,
                 OFF_ROPE = 499 * MiB, OFF_GL = 501 * MiB, OFF_CNT = 501 * MiB + 65536;
constexpr size_t W_IN = 0, W_OUT = 6553600, W_GU = 8650752, W_DOWN = 20185088, W_C1 = 25952256, W_C2 = 26476544;
constexpr int CHUNK_B = 49152;
constexpr float SC2 = 0.125f * 1.4426950408889634f;

struct Params {
  const float* x_in; const int* positions; const float* attn_norm; const float* w_in; const float* gdn_conv_w;
  const float* gdn_a_log; const float* gdn_dt_bias; const float* gdn_norm; const float* nsa_q_norm;
  const float* nsa_k_norm; const float* cmp_pe; const float* cmp_w1; const float* cmp_w2; const float* conv_w;
  const float* w_out; const float* ffn_norm; const float* w_gate_up; const float* w_down;
  float* out; char* ws;
};


__device__ __forceinline__ int otid() { int t = threadIdx.x; asm volatile("" : "+v"(t)); return t; }
__device__ __forceinline__ int obid() { int t = blockIdx.x; asm volatile("" : "+s"(t)); return t; }
typedef const __attribute__((address_space(4))) Params* KP;
__device__ __forceinline__ KP kargs() {
  KP k = (KP)__builtin_amdgcn_kernarg_segment_ptr();
  asm volatile("" : "+s"(k));
  return k;
}

typedef __bf16 bf2_t __attribute__((ext_vector_type(2)));
typedef float f2_t __attribute__((ext_vector_type(2)));
__device__ __forceinline__ u32 pack2(float a, float b) {
  f2_t v = {a, b};
  bf2_t r = __builtin_convertvector(v, bf2_t);
  return __builtin_bit_cast(u32, r);
}
__device__ __forceinline__ u16 f2bf(float f) { return (u16)(pack2(f, 0.f) & 0xffffu); }
__device__ __forceinline__ float bf2f(u16 h) { return __uint_as_float(((u32)h) << 16); }
__device__ __forceinline__ float wave_sum(float v) {
#pragma unroll
  for (int o = 32; o; o >>= 1) v += __shfl_xor(v, o);
  return v;
}
__device__ __forceinline__ float sigmoidf_(float x) { return 1.f / (1.f + __expf(-x)); }
__device__ __forceinline__ f32x4 mfma16(bf16x8 a, bf16x8 b, f32x4 c) {
  return __builtin_amdgcn_mfma_f32_16x16x32_bf16(a, b, c, 0, 0, 0);
}
__device__ __forceinline__ bf16x8 pack8(f32x4 a, f32x4 b) {
  union { bf16x8 v; u32 u[4]; } r;
  r.u[0] = pack2(a[0], a[1]); r.u[1] = pack2(a[2], a[3]);
  r.u[2] = pack2(b[0], b[1]); r.u[3] = pack2(b[2], b[3]);
  return r.v;
}

__device__ __forceinline__ void rmsnorm_rows(const float* __restrict__ x, const float* __restrict__ gain, u16* __restrict__ h) {
  int lane = otid() & 63;
  int gw = obid() * 4 + (otid() >> 6), nw = gridDim.x * 4;
  for (int row = gw; row < NTOK; row += nw) {
    const float4* xr = (const float4*)(x + (size_t)row * DM);
    float4 v[4];
    float ss = 0.f;
#pragma unroll
    for (int i = 0; i < 4; ++i) {
      v[i] = xr[lane + 64 * i];
      ss += v[i].x * v[i].x + v[i].y * v[i].y + v[i].z * v[i].z + v[i].w * v[i].w;
    }
    ss = wave_sum(ss);
    float rs = rsqrtf(ss * (1.f / DM) + 1e-6f);
#pragma unroll
    for (int i = 0; i < 4; ++i) {
      float4 g = ((const float4*)gain)[lane + 64 * i];
      uint2 o;
      o.x = pack2(v[i].x * rs * g.x, v[i].y * rs * g.y);
      o.y = pack2(v[i].z * rs * g.z, v[i].w * rs * g.w);
      *(uint2*)(h + (size_t)row * DM + (lane + 64 * i) * 4) = o;
    }
  }
}

struct MapId { __device__ int operator()(int n) const { return n; } };
struct MapIn {
  __device__ int operator()(int n) const {
    if (n < 1024) return n;
    if (n < 2304) return n + 8;
    if (n < 3072) return n + 32;
    if (n < 3080) return n - 3072 + 1024;
    if (n < 3104) return n - 3080 + 2312;
    return -1;
  }
};
struct MapGU {
  __device__ int operator()(int n) const {
    int grp = n >> 6, r = n & 63;
    return r < 32 ? grp * 32 + r : DFF + grp * 32 + (r - 32);
  }
};
template <class Map>
__device__ __forceinline__ void transpose_tile(const float* __restrict__ src, int lds_, Map map, u16* __restrict__ dst, int ldd, int n0,
                               int k0, float* t) {
  int tid = otid();
#pragma unroll
  for (int i = 0; i < 16; ++i) {
    int k = i * 4 + (tid >> 6), n = tid & 63;
    int sn = map(n0 + n);
    t[k * 65 + n] = sn >= 0 ? src[(size_t)(k0 + k) * lds_ + sn] : 0.f;
  }
  __syncthreads();
#pragma unroll 4
  for (int i = 0; i < 16; ++i) {
    int n = i * 4 + (tid >> 6), k = tid & 63;
    dst[(size_t)(n0 + n) * ldd + k0 + k] = f2bf(t[k * 65 + n]);
  }
  __syncthreads();
}

__device__ __forceinline__ void convert_weights(KP p, int l, char* smem) {
  float* t = (float*)smem;
  char* W = p->ws + OFF_W;
  const int J0 = 800, J1 = J0 + 256, J2 = J1 + 1408, J3 = J2 + 704, J4 = J3 + 64, J5 = J4 + 2;
  for (int job = obid(); job < J5; job += gridDim.x) {
    if (job < J0) {
      transpose_tile(p->w_in + (size_t)l * DM * 3104, 3104, MapIn(), (u16*)(W + W_IN), 1024, (job >> 4) * 64,
                     (job & 15) * 64, t);
    } else if (job < J1) {
      int j = job - J0;
      transpose_tile(p->w_out + (size_t)l * DM * DM, 1024, MapId(), (u16*)(W + W_OUT), 1024, (j >> 4) * 64,
                     (j & 15) * 64, t);
    } else if (job < J2) {
      int j = job - J1;
      transpose_tile(p->w_gate_up + (size_t)l * DM * 2 * DFF, 2 * DFF, MapGU(), (u16*)(W + W_GU), 1024, (j >> 4) * 64,
                     (j & 15) * 64, t);
    } else if (job < J3) {
      int j = job - J2;
      transpose_tile(p->w_down + (size_t)l * DFF * DM, 1024, MapId(), (u16*)(W + W_DOWN), DFF, (j / 44) * 64,
                     (j % 44) * 64, t);
    } else if (job < J4) {
      int j = job - J3;
      int which = j >> 5, kt = j & 31;
      transpose_tile(p->cmp_w1 + (size_t)(l * 2 + which) * 2048 * 64, 64, MapId(),
                     (u16*)(W + W_C1) + (size_t)which * 64 * 2048, 2048, 0, kt * 64, t);
    } else {
      int which = job - J4;
      transpose_tile(p->cmp_w2 + (size_t)(l * 2 + which) * 64 * 64, 64, MapId(), (u16*)(W + W_C2) + which * 4096, 64, 0,
                     0, t);
    }
  }
}

#define WAIT_VM(n) asm volatile("s_waitcnt vmcnt(" #n ")" ::: "memory")
#define RAW_BAR() do { asm volatile("s_waitcnt lgkmcnt(0)" ::: "memory"); __builtin_amdgcn_s_barrier(); } while (0)
typedef __attribute__((ext_vector_type(16))) float f32x16;
template <class Epi>
__device__ __forceinline__ void gemm_phase(const u16* __restrict__ A, int lda, const u16* __restrict__ Bt, int ldb, int K, int ntm,
                           int ntn, char* smem, Epi epi) {
  const int tid = otid(), lane = tid & 63, wv = tid >> 6;
  const int wm = wv >> 1, wn = wv & 1, l31 = lane & 31, hi = lane >> 5;
  const int ntiles = ntm * ntn, nk = K >> 5;
  const int lrow = tid >> 3, lc8 = tid & 7;
  const int woff = lrow * 64 + (((lc8 & 3) ^ ((lrow >> 2) & 3)) * 16);
  const bool wodd = (lc8 >> 2) != 0;
  const int sw = (l31 >> 2) & 3;
  const int arow = (wm * 128 + l31) * 64, brow = 16384 + (wn * 64 + l31) * 64;
#define TILE_DECODE(id_, row0_, col0_, tn_)                                                  \
  do {                                                                                       \
    int xcd_ = (id_) & 7, loc_ = (id_) >> 3;                                                 \
    int per_rb_ = 8 * ntn;                                                                   \
    int rb_ = loc_ / per_rb_, rem_ = loc_ % per_rb_;                                         \
    int cb_ = rem_ >> 6, rem2_ = rem_ & 63;                                                  \
    int width_ = (cb_ + 1) * 8 <= ntn ? 8 : ntn - cb_ * 8;                                   \
    int tm_l_ = rb_ * 8 + rem2_ / width_;                                                    \
    tn_ = cb_ * 8 + rem2_ % width_;                                                          \
    row0_ = (tm_l_ * 8 + xcd_) * 256;                                                        \
    col0_ = tn_ * 128;                                                                       \
  } while (0)
#define W_LOAD(w_)                                                           \
  do {                                                                       \
    const u16* pa_ = gA + (w_) * 64;                                         \
    const u16* pb_ = gB + (w_) * 64;                                         \
    Ra0 = *(const uint4*)(pa_);           Ra1 = *(const uint4*)(pa_ + a32);  \
    Ra2 = *(const uint4*)(pa_ + 2 * a32); Ra3 = *(const uint4*)(pa_ + 3 * a32); \
    Ra4 = *(const uint4*)(pa_ + 4 * a32); Ra5 = *(const uint4*)(pa_ + 5 * a32); \
    Ra6 = *(const uint4*)(pa_ + 6 * a32); Ra7 = *(const uint4*)(pa_ + 7 * a32); \
    Rb0 = *(const uint4*)(pb_);           Rb1 = *(const uint4*)(pb_ + b32);  \
    Rb2 = *(const uint4*)(pb_ + 2 * b32); Rb3 = *(const uint4*)(pb_ + 3 * b32); \
  } while (0)
#define MF(accv, bv, av) accv = __builtin_amdgcn_mfma_f32_32x32x16_bf16(bv, av, accv, 0, 0, 0)
#define SB() __builtin_amdgcn_sched_barrier(0)
#define G_ITER(sl_, ODD, wnext_)                                                                 \
  do {                                                                                           \
    const char* st_ = smem + (sl_) * 24576;                                                      \
    const int s1_ = (sl_) + 1 >= 3 ? (sl_) - 2 : (sl_) + 1, s2_ = (sl_) + 2 >= 3 ? (sl_) - 1 : (sl_) + 2; \
    char* wr_ = smem + (wodd ? s2_ : s1_) * 24576 + woff;                                        \
    const int p0_ = ((0 + hi) ^ sw) * 16, p1_ = ((2 + hi) ^ sw) * 16;                            \
    bf16x8 b00 = *(const bf16x8*)(st_ + brow + p0_), b01 = *(const bf16x8*)(st_ + brow + 2048 + p0_); \
    bf16x8 a00 = *(const bf16x8*)(st_ + arow + p0_), a01 = *(const bf16x8*)(st_ + arow + 2048 + p0_); \
    bf16x8 a02 = *(const bf16x8*)(st_ + arow + 4096 + p0_), a03 = *(const bf16x8*)(st_ + arow + 6144 + p0_); \
    SB();                                                                                        \
    MF(acc[0][0], b00, a00); MF(acc[0][1], b01, a00);                                            \
    bf16x8 b10 = *(const bf16x8*)(st_ + brow + p1_), b11 = *(const bf16x8*)(st_ + brow + 2048 + p1_); \
    SB();                                                                                        \
    MF(acc[1][0], b00, a01); MF(acc[1][1], b01, a01);                                            \
    bf16x8 a10 = *(const bf16x8*)(st_ + arow + p1_), a11 = *(const bf16x8*)(st_ + arow + 2048 + p1_); \
    SB();                                                                                        \
    MF(acc[2][0], b00, a02); MF(acc[2][1], b01, a02);                                            \
    bf16x8 a12 = *(const bf16x8*)(st_ + arow + 4096 + p1_), a13 = *(const bf16x8*)(st_ + arow + 6144 + p1_); \
    SB();                                                                                        \
    MF(acc[3][0], b00, a03); MF(acc[3][1], b01, a03);                                            \
    if (ODD) { *(uint4*)(wr_) = Ra0; *(uint4*)(wr_ + 2048) = Ra1; *(uint4*)(wr_ + 4096) = Ra2; } \
    SB();                                                                                        \
    MF(acc[0][0], b10, a10); MF(acc[0][1], b11, a10);                                            \
    if (ODD) { *(uint4*)(wr_ + 6144) = Ra3; *(uint4*)(wr_ + 8192) = Ra4; *(uint4*)(wr_ + 10240) = Ra5; } \
    SB();                                                                                        \
    MF(acc[1][0], b10, a11); MF(acc[1][1], b11, a11);                                            \
    if (ODD) { *(uint4*)(wr_ + 12288) = Ra6; *(uint4*)(wr_ + 14336) = Ra7; *(uint4*)(wr_ + 16384) = Rb0; } \
    SB();                                                                                        \
    MF(acc[2][0], b10, a12); MF(acc[2][1], b11, a12);                                            \
    if (ODD) { *(uint4*)(wr_ + 18432) = Rb1; *(uint4*)(wr_ + 20480) = Rb2; *(uint4*)(wr_ + 22528) = Rb3; } \
    SB();                                                                                        \
    MF(acc[3][0], b10, a13); MF(acc[3][1], b11, a13);                                            \
    if (ODD) { const int wl_ = (wnext_) < nw ? (wnext_) : nw - 1; W_LOAD(wl_); }                 \
    RAW_BAR();                                                                                   \
  } while (0)
  const size_t a32 = (size_t)32 * lda, b32 = (size_t)32 * ldb;
  const int nw = nk >> 1;
  int id = obid();
  int row0 = 0, col0 = 0, tn = 0;
  const u16 *gA = A, *gB = Bt;
  uint4 Ra0, Ra1, Ra2, Ra3, Ra4, Ra5, Ra6, Ra7, Rb0, Rb1, Rb2, Rb3;
  if (id < ntiles) {
    TILE_DECODE(id, row0, col0, tn);
    gA = A + (size_t)(row0 + lrow) * lda + lc8 * 8;
    gB = Bt + (size_t)(col0 + lrow) * ldb + lc8 * 8;
    W_LOAD(0);
  }
  while (id < ntiles) {
    f32x16 acc[4][2];
#pragma unroll
    for (int m = 0; m < 4; ++m)
#pragma unroll
      for (int n = 0; n < 2; ++n)
#pragma unroll
        for (int r = 0; r < 16; ++r) acc[m][n][r] = 0.f;
    {
      char* wr_ = smem + (wodd ? 1 : 0) * 24576 + woff;
      *(uint4*)(wr_) = Ra0; *(uint4*)(wr_ + 2048) = Ra1; *(uint4*)(wr_ + 4096) = Ra2; *(uint4*)(wr_ + 6144) = Ra3;
      *(uint4*)(wr_ + 8192) = Ra4; *(uint4*)(wr_ + 10240) = Ra5; *(uint4*)(wr_ + 12288) = Ra6; *(uint4*)(wr_ + 14336) = Ra7;
      *(uint4*)(wr_ + 16384) = Rb0; *(uint4*)(wr_ + 18432) = Rb1; *(uint4*)(wr_ + 20480) = Rb2; *(uint4*)(wr_ + 22528) = Rb3;
    }
    W_LOAD(1);
    RAW_BAR();
    __builtin_amdgcn_s_setprio(1);
    int sl = 0;
    for (int w = 0; w < nw; ++w) {
      G_ITER(sl, false, 0);
      sl = sl + 1 >= 3 ? 0 : sl + 1;
      G_ITER(sl, true, w + 2);
      sl = sl + 1 >= 3 ? 0 : sl + 1;
    }
    __builtin_amdgcn_s_setprio(0);
    const int erow = row0 + wm * 128 + l31, ecol = col0 + wn * 64 + hi * 4, etn = tn;
    id += gridDim.x;
    if (id < ntiles) {
      TILE_DECODE(id, row0, col0, tn);
      gA = A + (size_t)(row0 + lrow) * lda + lc8 * 8;
      gB = Bt + (size_t)(col0 + lrow) * ldb + lc8 * 8;
      W_LOAD(0);
    }
    epi(acc, erow, ecol, etn);
  }
}

struct EpiInProj {
  u16* proj; float* small_;
  __device__ __forceinline__ void operator()(f32x16 (&acc)[4][2], int rbase, int cbase, int tn) const {
    if (tn < 24) {
#pragma unroll
      for (int m = 0; m < 4; ++m)
#pragma unroll
        for (int n = 0; n < 2; ++n)
#pragma unroll
          for (int g = 0; g < 4; ++g) {
            uint2 o;
            o.x = pack2(acc[m][n][g * 4 + 0], acc[m][n][g * 4 + 1]);
            o.y = pack2(acc[m][n][g * 4 + 2], acc[m][n][g * 4 + 3]);
            *(uint2*)(proj + (size_t)(rbase + m * 32) * PJ + cbase + n * 32 + g * 8) = o;
          }
    } else {
#pragma unroll
      for (int m = 0; m < 4; ++m)
#pragma unroll
        for (int g = 0; g < 4; ++g) {
          int c = cbase + g * 8 - 3072;
          if (c < 32)
            *(float4*)(small_ + (size_t)(rbase + m * 32) * 32 + c) =
                make_float4(acc[m][0][g * 4 + 0], acc[m][0][g * 4 + 1], acc[m][0][g * 4 + 2], acc[m][0][g * 4 + 3]);
        }
    }
  }
};
struct EpiResid {
  const float* xin; float* xout;
  __device__ __forceinline__ void operator()(f32x16 (&acc)[4][2], int rbase, int cbase, int tn) const {
#pragma unroll
    for (int m = 0; m < 4; ++m)
#pragma unroll
      for (int n = 0; n < 2; ++n)
#pragma unroll
        for (int g = 0; g < 4; ++g) {
          size_t idx = (size_t)(rbase + m * 32) * DM + cbase + n * 32 + g * 8;
          float4 x = *(const float4*)(xin + idx);
          x.x += acc[m][n][g * 4 + 0]; x.y += acc[m][n][g * 4 + 1]; x.z += acc[m][n][g * 4 + 2]; x.w += acc[m][n][g * 4 + 3];
          *(float4*)(xout + idx) = x;
        }
  }
};
struct EpiSwiGLU {
  u16* act;
  __device__ __forceinline__ void operator()(f32x16 (&acc)[4][2], int rbase, int cbase, int tn) const {
    int grp = cbase >> 6, c4 = cbase & 7;
#pragma unroll
    for (int m = 0; m < 4; ++m)
#pragma unroll
      for (int g = 0; g < 4; ++g) {
        float v[4];
#pragma unroll
        for (int r = 0; r < 4; ++r) {
          float gt = acc[m][0][g * 4 + r], up = acc[m][1][g * 4 + r];
          v[r] = gt / (1.f + __expf(-gt)) * up;
        }
        uint2 o;
        o.x = pack2(v[0], v[1]);
        o.y = pack2(v[2], v[3]);
        *(uint2*)(act + (size_t)(rbase + m * 32) * DFF + grp * 32 + g * 8 + c4) = o;
      }
  }
};

__device__ __forceinline__ void gdn_chunk_prep(KP p, int l, char* smem, int job) {
  const int b = job >> 10, h = (job >> 8) & 3, c = job & 255;
  const int tid = otid(), lane = tid & 63, wv = tid >> 6;
  float* sq = (float*)smem;
  float* sk = sq + 64 * 65;
  float* sv = sk + 64 * 65;
  float* sA = sv + 64 * 65;
  float* sgc = sA + 64 * 64;
  float* sbeta = sgc + 64;
  float* seg = sbeta + 64;
  float* sf2 = seg + 64;
  const u16* proj = (const u16*)(p->ws + OFF_PROJ);
  const float* small_ = (const float*)(p->ws + OFF_SMALL);
  const size_t tok0 = (size_t)b * T + c * 64;
  char* cb = p->ws + OFF_GDN + (size_t)((b * 4 + h) * 256 + c) * CHUNK_B;
  float* UT = (float*)cb;
  u16* NW = (u16*)(cb + 16384);
  u16* QD = (u16*)(cb + 24576);
  u16* KDT = (u16*)(cb + 32768);
  u16* QKM = (u16*)(cb + 40960);
  {
    const int d = lane, i0 = wv * 16;
    const int tl0 = c * 64 + i0;
    u16 raw[3][19];
#pragma unroll
    for (int seg_ = 0; seg_ < 3; ++seg_) {
      const int ch = seg_ * 256 + h * 64 + d;
#pragma unroll
      for (int i = 0; i < 19; ++i) {
        const int rel = i0 + i - 3;
        const size_t tk = (tl0 + i - 3 >= 0) ? (tok0 + rel) : tok0;
        raw[seg_][i] = proj[tk * PJ + ch];
      }
    }
#pragma unroll
    for (int seg_ = 0; seg_ < 3; ++seg_) {
      const int ch = seg_ * 256 + h * 64 + d;
      const float* cw = p->gdn_conv_w + (size_t)l * 4 * 768 + ch;
      const float w0 = cw[0], w1 = cw[768], w2 = cw[1536], w3 = cw[2304];
      float* dst = seg_ == 0 ? sq : (seg_ == 1 ? sk : sv);
      float xv[19];
#pragma unroll
      for (int i = 0; i < 19; ++i) xv[i] = (tl0 + i - 3 >= 0) ? bf2f(raw[seg_][i]) : 0.f;
#pragma unroll
      for (int i = 0; i < 16; ++i) {
        float y = w0 * xv[i] + w1 * xv[i + 1] + w2 * xv[i + 2] + w3 * xv[i + 3];
        dst[(i0 + i) * 65 + d] = y / (1.f + __expf(-y));
      }
    }
  }
  if (tid < 64) {
    float gb = small_[(tok0 + tid) * 32 + h], ga = small_[(tok0 + tid) * 32 + 4 + h];
    float xx = ga + p->gdn_dt_bias[l * 4 + h];
    float sp = fmaxf(xx, 0.f) + log1pf(__expf(-fabsf(xx)));
    float g = -__expf(p->gdn_a_log[l * 4 + h]) * sp;
#pragma unroll
    for (int o = 1; o < 64; o <<= 1) {
      float t = __shfl_up(g, o);
      if (lane >= o) g += t;
    }
    float beta = sigmoidf_(gb);
    float eg = __expf(g);
    sgc[tid] = g; sbeta[tid] = beta; seg[tid] = eg; sf2[tid] = beta * eg;
    if (tid == 63) ((float*)(p->ws + OFF_GL))[(b * 4 + h) * 256 + c] = eg;
  }
  __syncthreads();
  if (tid < 128) {
    float* rowp = (tid < 64 ? sq : sk) + (tid & 63) * 65;
    float ss = 0.f;
#pragma unroll 16
    for (int d = 0; d < 64; ++d) ss += rowp[d] * rowp[d];
    const float sc = rsqrtf(ss + 1e-6f) * (tid < 64 ? 0.125f : 1.f);
#pragma unroll 16
    for (int d = 0; d < 64; ++d) rowp[d] *= sc;
  }
  __syncthreads();
  {
    int ti = tid >> 4, tj = tid & 15;
    float kk[4][4], qk[4][4];
#pragma unroll
    for (int a = 0; a < 4; ++a)
#pragma unroll
      for (int bb = 0; bb < 4; ++bb) { kk[a][bb] = 0.f; qk[a][bb] = 0.f; }
    if (tj <= ti) {
      for (int d = 0; d < 64; ++d) {
        float ki[4], kj[4], qi[4];
#pragma unroll
        for (int a = 0; a < 4; ++a) {
          ki[a] = sk[(ti * 4 + a) * 65 + d];
          qi[a] = sq[(ti * 4 + a) * 65 + d];
          kj[a] = sk[(tj * 4 + a) * 65 + d];
        }
#pragma unroll
        for (int a = 0; a < 4; ++a)
#pragma unroll
          for (int bb = 0; bb < 4; ++bb) { kk[a][bb] += ki[a] * kj[bb]; qk[a][bb] += qi[a] * kj[bb]; }
      }
    }
#pragma unroll
    for (int a = 0; a < 4; ++a) {
      int i = ti * 4 + a;
      float gi = sgc[i], bi = sbeta[i];
      uint2 o;
      float qv[4];
#pragma unroll
      for (int bb = 0; bb < 4; ++bb) {
        int j = tj * 4 + bb;
        float dec = (j <= i) ? __expf(gi - sgc[j]) : 0.f;
        sA[i * 64 + j] = (j < i) ? bi * kk[a][bb] * dec : 0.f;
        qv[bb] = qk[a][bb] * dec;
      }
      o.x = pack2(qv[0], qv[1]); o.y = pack2(qv[2], qv[3]);
      *(uint2*)(QKM + i * 64 + tj * 4) = o;
    }
  }
  {
    float gl = sgc[63];
    for (int idx = tid; idx < 4096; idx += 256) {
      int i = idx >> 6, d = idx & 63;
      QD[idx] = f2bf(sq[i * 65 + d] * seg[i]);
      KDT[idx] = f2bf(sk[d * 65 + i] * __expf(gl - sgc[d]));
    }
  }
  __syncthreads();
  if (tid < 128) {
    int cidx = tid;
    const float* src = cidx < 64 ? sv + cidx : sk + (cidx - 64);
    const float* fac = cidx < 64 ? sbeta : sf2;
    float x[64];
#pragma unroll
    for (int i = 0; i < 64; ++i) {
      float s0 = src[i * 65] * fac[i], s1 = 0.f, s2 = 0.f, s3 = 0.f;
#pragma unroll
      for (int j = 0; j < i; ++j) {
        if ((j & 3) == 0) s0 -= sA[i * 64 + j] * x[j];
        else if ((j & 3) == 1) s1 -= sA[i * 64 + j] * x[j];
        else if ((j & 3) == 2) s2 -= sA[i * 64 + j] * x[j];
        else s3 -= sA[i * 64 + j] * x[j];
      }
      x[i] = (s0 + s1) + (s2 + s3);
    }
    if (cidx < 64) {
#pragma unroll
      for (int i = 0; i < 64; i += 4) *(float4*)(UT + cidx * 64 + i) = make_float4(x[i], x[i + 1], x[i + 2], x[i + 3]);
    } else {
#pragma unroll
      for (int i = 0; i < 64; ++i) NW[i * 64 + (cidx - 64)] = f2bf(-x[i]);
    }
  }
  __syncthreads();
}

__device__ __forceinline__ void gdn_scan(KP p, char* smem, int sid) {
  const int b = sid >> 4, h = (sid >> 2) & 3, v0 = (sid & 3) * 16;
  const int tid = otid(), lane = tid & 63, wv = tid >> 6, l15 = lane & 15, quad = lane >> 4;
  u16* Sb = (u16*)smem;
  u16* Vb = Sb + 16 * 72;
  f32x4 S = {0.f, 0.f, 0.f, 0.f};
  { u32 z0 = 0u; asm volatile("" : "+v"(z0)); *(uint2*)(Sb + l15 * 72 + 16 * wv + quad * 4) = make_uint2(z0, z0); }
  __syncthreads();
  const char* gbase = p->ws + OFF_GDN + (size_t)((b * 4 + h) * 256) * CHUNK_B;
  const float* GL = (const float*)(p->ws + OFF_GL) + (b * 4 + h) * 256;
  float* OG = (float*)(p->ws + OFF_OG);
  const int arow = (16 * wv + l15) * 64 + quad * 8;
  f32x4 u, un;
  bf16x8 wA[2], qdA[2], qkA[2], kdA[2], wAn[2], qdAn[2], qkAn[2], kdAn[2];
  float gl, gln;
  {
    const char* cb = gbase;
    u = *(const f32x4*)((const float*)cb + (v0 + l15) * 64 + 16 * wv + quad * 4);
#pragma unroll
    for (int ks = 0; ks < 2; ++ks) {
      wA[ks] = *(const bf16x8*)((const u16*)(cb + 16384) + arow + ks * 32);
      qdA[ks] = *(const bf16x8*)((const u16*)(cb + 24576) + arow + ks * 32);
      kdA[ks] = *(const bf16x8*)((const u16*)(cb + 32768) + arow + ks * 32);
      qkA[ks] = *(const bf16x8*)((const u16*)(cb + 40960) + arow + ks * 32);
    }
    gl = GL[0];
  }
  for (int c = 0; c < 256; ++c) {
    if (c + 1 < 256) {
      const char* cb = gbase + (size_t)(c + 1) * CHUNK_B;
      un = *(const f32x4*)((const float*)cb + (v0 + l15) * 64 + 16 * wv + quad * 4);
#pragma unroll
      for (int ks = 0; ks < 2; ++ks) {
        wAn[ks] = *(const bf16x8*)((const u16*)(cb + 16384) + arow + ks * 32);
        qdAn[ks] = *(const bf16x8*)((const u16*)(cb + 24576) + arow + ks * 32);
        kdAn[ks] = *(const bf16x8*)((const u16*)(cb + 32768) + arow + ks * 32);
        qkAn[ks] = *(const bf16x8*)((const u16*)(cb + 40960) + arow + ks * 32);
      }
      gln = GL[c + 1];
    }
    bf16x8 sB0 = *(const bf16x8*)(Sb + l15 * 72 + quad * 8);
    bf16x8 sB1 = *(const bf16x8*)(Sb + l15 * 72 + 32 + quad * 8);
    f32x4 vn = u;
    vn = mfma16(wA[0], sB0, vn);
    vn = mfma16(wA[1], sB1, vn);
    f32x4 o = {0.f, 0.f, 0.f, 0.f};
    o = mfma16(qdA[0], sB0, o);
    o = mfma16(qdA[1], sB1, o);
    *(uint2*)(Vb + l15 * 72 + 16 * wv + quad * 4) = make_uint2(pack2(vn[0], vn[1]), pack2(vn[2], vn[3]));
    __syncthreads();
    bf16x8 vB0 = *(const bf16x8*)(Vb + l15 * 72 + quad * 8);
    bf16x8 vB1 = *(const bf16x8*)(Vb + l15 * 72 + 32 + quad * 8);
    o = mfma16(qkA[0], vB0, o);
    o = mfma16(qkA[1], vB1, o);
    S[0] *= gl; S[1] *= gl; S[2] *= gl; S[3] *= gl;
    S = mfma16(kdA[0], vB0, S);
    S = mfma16(kdA[1], vB1, S);
    *(uint2*)(Sb + l15 * 72 + 16 * wv + quad * 4) = make_uint2(pack2(S[0], S[1]), pack2(S[2], S[3]));
    size_t orow = (size_t)b * T + c * 64 + 16 * wv + quad * 4;
#pragma unroll
    for (int r = 0; r < 4; ++r) OG[(orow + r) * 256 + h * 64 + v0 + l15] = o[r];
    __syncthreads();
    u = un; gl = gln;
#pragma unroll
    for (int ks = 0; ks < 2; ++ks) { wA[ks] = wAn[ks]; qdA[ks] = qdAn[ks]; kdA[ks] = kdAn[ks]; qkA[ks] = qkAn[ks]; }
  }
}

__device__ __forceinline__ void gdn_finalize(KP p, int l) {
  const int lane = otid() & 63, sub = lane >> 4, q4 = (lane & 15) * 4;
  const int gw = obid() * 4 + (otid() >> 6), nw = gridDim.x * 4;
  const float* OG = (const float*)(p->ws + OFF_OG);
  const u16* proj = (const u16*)(p->ws + OFF_PROJ);
  u16* mix = (u16*)(p->ws + OFF_H);
  const float4 gn = *(const float4*)(p->gdn_norm + l * 64 + q4);
  for (int base = gw * 16; base < NTOK * 4; base += nw * 16) {
    float4 o[4];
    uint2 zr[4];
#pragma unroll
    for (int u = 0; u < 4; ++u) {
      const int row = base + u * 4 + sub, t = row >> 2, h = row & 3;
      o[u] = *(const float4*)(OG + (size_t)row * 64 + q4);
      zr[u] = *(const uint2*)(proj + (size_t)t * PJ + C_GZ + h * 64 + q4);
    }
#pragma unroll
    for (int u = 0; u < 4; ++u) {
      const int row = base + u * 4 + sub, t = row >> 2, h = row & 3;
      float ss = o[u].x * o[u].x + o[u].y * o[u].y + o[u].z * o[u].z + o[u].w * o[u].w;
      ss += __shfl_xor(ss, 1); ss += __shfl_xor(ss, 2); ss += __shfl_xor(ss, 4); ss += __shfl_xor(ss, 8);
      const float rs = rsqrtf(ss * (1.f / 64.f) + 1e-6f);
      const float z0 = bf2f(zr[u].x & 0xffff), z1 = bf2f(zr[u].x >> 16), z2 = bf2f(zr[u].y & 0xffff), z3 = bf2f(zr[u].y >> 16);
      const float y0 = o[u].x * rs * gn.x * (z0 / (1.f + __expf(-z0)));
      const float y1 = o[u].y * rs * gn.y * (z1 / (1.f + __expf(-z1)));
      const float y2 = o[u].z * rs * gn.z * (z2 / (1.f + __expf(-z2)));
      const float y3 = o[u].w * rs * gn.w * (z3 / (1.f + __expf(-z3)));
      uint2 w;
      w.x = pack2(ZTEST == 4 ? 0.f : y0, ZTEST == 4 ? 0.f : y1);
      w.y = pack2(ZTEST == 4 ? 0.f : y2, ZTEST == 4 ? 0.f : y3);
      *(uint2*)(mix + (size_t)t * DM + h * 64 + q4) = w;
    }
  }
}

__device__ __forceinline__ void rope_table(KP p) {
  float* rp = (float*)(p->ws + OFF_ROPE);
  int gt = obid() * blockDim.x + otid(), nt = gridDim.x * blockDim.x;
  for (int idx = gt; idx < NTOK * 8; idx += nt) {
    int t = idx >> 3, i = idx & 7;
    float inv = (float)pow(500000.0, -(double)i / 8.0);
    float ang = (float)p->positions[t] * inv;
    rp[t * 16 + i] = (float)cos((double)ang);
    rp[t * 16 + 8 + i] = (float)sin((double)ang);
  }
}

__device__ __forceinline__ void nsa_token_prep(KP p, int l, char* smem, int tb) {
  const int tid = otid(), lane = tid & 63, wv = tid >> 6;
  const int b = tb >> 8, blk = tb & 255;
  u16* proj = (u16*)(p->ws + OFF_PROJ);
  const float* rope = (const float*)(p->ws + OFF_ROPE);
  const size_t tok0 = (size_t)tb * 64;
  for (int r = tid; r < 768; r += 256) {
    int i = r / 12, which = r % 12;
    size_t t = tok0 + i;
    int col; const float* gain;
    if (which < 8) { col = C_NQ + which * 64; gain = p->nsa_q_norm + l * 64; }
    else if (which < 10) { col = C_KSLC + (which - 8) * 64; gain = p->nsa_k_norm + (l * 3 + 1) * 64; }
    else { col = C_KWIN + (which - 10) * 64; gain = p->nsa_k_norm + (l * 3 + 2) * 64; }
    u16* rowp = proj + t * PJ + col;
    union { uint4 q; u16 h[8]; } v[8];
    float ss = 0.f;
#pragma unroll
    for (int c = 0; c < 8; ++c) {
      v[c].q = *(const uint4*)(rowp + c * 8);
#pragma unroll
      for (int e = 0; e < 8; ++e) { float x = bf2f(v[c].h[e]); ss += x * x; }
    }
    const float rs = rsqrtf(ss * (1.f / 64.f) + 1e-6f);
    float y0[16];
#pragma unroll
    for (int e = 0; e < 16; ++e) y0[e] = bf2f(v[e >> 3].h[e & 7]) * rs * gain[e];
    if (which >= 8) {
      const float* rp = rope + t * 16;
#pragma unroll
      for (int e = 0; e < 8; ++e) {
        float c = rp[e], sn = rp[8 + e];
        float a1 = y0[e], a2 = y0[8 + e];
        y0[e] = a1 * c - a2 * sn;
        y0[8 + e] = a2 * c + a1 * sn;
      }
    }
#pragma unroll
    for (int c = 0; c < 8; ++c) {
      uint4 o;
      float y[8];
#pragma unroll
      for (int e = 0; e < 8; ++e) y[e] = c < 2 ? y0[c * 8 + e] : bf2f(v[c].h[e]) * rs * gain[c * 8 + e];
      o.x = pack2(y[0], y[1]); o.y = pack2(y[2], y[3]); o.z = pack2(y[4], y[5]); o.w = pack2(y[6], y[7]);
      *(uint4*)(rowp + c * 8) = o;
    }
  }
  {
    u16* tt = (u16*)smem;
    uint4 vr[4][2];
#pragma unroll
    for (int z = 0; z < 4; ++z) {
      const int col = ((z >> 1) ? C_VWIN : C_VSLC) + (z & 1) * 64;
#pragma unroll
      for (int k = 0; k < 2; ++k) {
        const int q = tid + k * 256, i = q >> 3, c8 = q & 7;
        vr[z][k] = *(const uint4*)(proj + (tok0 + i) * PJ + col + c8 * 8);
      }
    }
#pragma unroll
    for (int z = 0; z < 4; ++z)
#pragma unroll
      for (int k = 0; k < 2; ++k) {
        const int q = tid + k * 256, i = q >> 3, c8 = q & 7;
        *(uint4*)(tt + (z * 64 + i) * 72 + c8 * 8) = vr[z][k];
      }
    __syncthreads();
#pragma unroll
    for (int z = 0; z < 4; ++z) {
      const int tensor = z >> 1, g = z & 1;
      u16* dst = (u16*)(p->ws + OFF_VT + (size_t)tensor * 8 * MiB) + ((size_t)((b * 2 + g) * 256 + blk)) * 4096;
#pragma unroll
      for (int k = 0; k < 2; ++k) {
        const int q = tid + k * 256, d = q >> 3, i8 = q & 7;
        union { uint4 v; u16 h[8]; } o;
#pragma unroll
        for (int e = 0; e < 8; ++e) {
          const int ok_ = (i8 >> 2) * 32 + (e < 4 ? (i8 & 3) * 4 + e : 16 + (i8 & 3) * 4 + e - 4);
          o.h[e] = tt[(z * 64 + ok_) * 72 + d];
        }
        *(uint4*)(dst + d * 64 + i8 * 8) = o.v;
      }
    }
    __syncthreads();
  }
  {
    const int cg8 = (tid & 31) * 8, t8 = (tid >> 5) * 8;
    u16* mix = (u16*)(p->ws + OFF_H);
    union U8 { uint4 v; u16 h[8]; };
    U8 cc[10], cx[10], cb[8];
#pragma unroll
    for (int k = 0; k < 10; ++k) {
      const int rel = t8 + k - 2;
      const bool ok = (blk > 0) || (rel >= 0);
      const size_t tk = ok ? (tok0 + rel) : tok0;
      cc[k].v = *(const uint4*)(proj + tk * PJ + C_CC + cg8);
      cx[k].v = *(const uint4*)(proj + tk * PJ + C_CX + cg8);
    }
#pragma unroll
    for (int k = 0; k < 8; ++k) cb[k].v = *(const uint4*)(proj + (tok0 + t8 + k) * PJ + C_CB + cg8);
    float w0[8], w1[8], w2[8];
    {
      const float* cw = p->conv_w + (size_t)l * 3 * 256 + cg8;
#pragma unroll
      for (int e = 0; e < 8; ++e) { w0[e] = cw[e]; w1[e] = cw[256 + e]; w2[e] = cw[512 + e]; }
    }
    float pr[10][8];
#pragma unroll
    for (int k = 0; k < 10; ++k) {
      const bool ok = (blk > 0) || (t8 + k - 2 >= 0);
#pragma unroll
      for (int e = 0; e < 8; ++e) pr[k][e] = ok ? bf2f(cc[k].h[e]) * bf2f(cx[k].h[e]) : 0.f;
    }
#pragma unroll
    for (int k = 0; k < 8; ++k) {
      float y[8];
#pragma unroll
      for (int e = 0; e < 8; ++e)
        y[e] = bf2f(cb[k].h[e]) * (w0[e] * pr[k][e] + w1[e] * pr[k + 1][e] + w2[e] * pr[k + 2][e]);
      uint4 o;
      o.x = pack2(y[0], y[1]); o.y = pack2(y[2], y[3]); o.z = pack2(y[4], y[5]); o.w = pack2(y[6], y[7]);
      *(uint4*)(mix + (tok0 + t8 + k) * DM + 768 + cg8) = o;
    }
  }
}

__device__ __forceinline__ void nsa_compress(KP p, int l, char* smem, int job) {
  const int tid = otid(), lane = tid & 63, wv = tid >> 6, l15 = lane & 15, quad = lane >> 4;
  const int which = job >> 6, b = (job >> 5) & 1, g = (job >> 4) & 1, tile = job & 15;
  const u16* proj = (const u16*)(p->ws + OFF_PROJ);
  const u16* W1T = (const u16*)(p->ws + OFF_W + W_C1) + (size_t)which * 64 * 2048;
  const u16* W2T = (const u16*)(p->ws + OFF_W + W_C2) + which * 4096;
  const float* pe = p->cmp_pe + (size_t)(l * 2 + which) * 32 * 64;
  const int blk0 = tile * 64 + wv * 16;
  int blk = blk0 + l15;
  int blkc = blk < 1023 ? blk : 1022;
  const u16* arow = proj + ((size_t)b * T + blkc * 16) * PJ + (which ? C_VCMP : C_KCMP) + g * 64;
  f32x4 acc[4];
#pragma unroll
  for (int n = 0; n < 4; ++n) acc[n] = f32x4{0.f, 0.f, 0.f, 0.f};
  for (int ks0 = 0; ks0 < 64; ks0 += 4) {
    uint4 raw[4];
    float4 pea[4], peb[4];
    bf16x8 bfr[4][4];
#pragma unroll
    for (int u = 0; u < 4; ++u) {
      const int ks = ks0 + u, tok = ks >> 1, d0 = (ks & 1) * 32 + quad * 8;
      raw[u] = *(const uint4*)(arow + (size_t)tok * PJ + d0);
      pea[u] = *(const float4*)(pe + tok * 64 + d0);
      peb[u] = *(const float4*)(pe + tok * 64 + d0 + 4);
#pragma unroll
      for (int n = 0; n < 4; ++n) bfr[u][n] = *(const bf16x8*)(W1T + (size_t)(n * 16 + l15) * 2048 + ks * 32 + quad * 8);
    }
#pragma unroll
    for (int u = 0; u < 4; ++u) {
      union { bf16x8 v; u32 w[4]; } af;
      af.w[0] = pack2(bf2f(raw[u].x & 0xffff) + pea[u].x, bf2f(raw[u].x >> 16) + pea[u].y);
      af.w[1] = pack2(bf2f(raw[u].y & 0xffff) + pea[u].z, bf2f(raw[u].y >> 16) + pea[u].w);
      af.w[2] = pack2(bf2f(raw[u].z & 0xffff) + peb[u].x, bf2f(raw[u].z >> 16) + peb[u].y);
      af.w[3] = pack2(bf2f(raw[u].w & 0xffff) + peb[u].z, bf2f(raw[u].w >> 16) + peb[u].w);
#pragma unroll
      for (int n = 0; n < 4; ++n) acc[n] = mfma16(af.v, bfr[u][n], acc[n]);
    }
  }
  u16* hid = (u16*)smem + wv * 16 * 72;
#pragma unroll
  for (int n = 0; n < 4; ++n)
#pragma unroll
    for (int r = 0; r < 4; ++r) {
      float x = acc[n][r];
      float u = 0.7978845608028654f * (x + 0.044715f * x * x * x);
      float gl = 0.5f * x * (1.f + tanhf(u));
      hid[(quad * 4 + r) * 72 + n * 16 + l15] = f2bf(gl);
    }
  __syncthreads();
  f32x4 o2[4];
#pragma unroll
  for (int n = 0; n < 4; ++n) o2[n] = f32x4{0.f, 0.f, 0.f, 0.f};
#pragma unroll
  for (int ks = 0; ks < 2; ++ks) {
    bf16x8 af = *(const bf16x8*)(hid + l15 * 72 + ks * 32 + quad * 8);
#pragma unroll
    for (int n = 0; n < 4; ++n) {
      bf16x8 bfr = *(const bf16x8*)(W2T + (n * 16 + l15) * 64 + ks * 32 + quad * 8);
      o2[n] = mfma16(af, bfr, o2[n]);
    }
  }
  __syncthreads();
  if (which == 0) {
    u16* KC = (u16*)(p->ws + OFF_KC) + (size_t)(b * 2 + g) * 1024 * 64;
    const float* kg = p->nsa_k_norm + (l * 3 + 0) * 64;
#pragma unroll
    for (int r = 0; r < 4; ++r) {
      float ss = 0.f;
#pragma unroll
      for (int n = 0; n < 4; ++n) ss += o2[n][r] * o2[n][r];
      ss += __shfl_xor(ss, 1); ss += __shfl_xor(ss, 2); ss += __shfl_xor(ss, 4); ss += __shfl_xor(ss, 8);
      float rs = rsqrtf(ss * (1.f / 64.f) + 1e-6f);
      int row = blk0 + quad * 4 + r;
#pragma unroll
      for (int n = 0; n < 4; ++n) {
        float v = row < 1023 ? o2[n][r] * rs * kg[n * 16 + l15] : 0.f;
        KC[(size_t)row * 64 + n * 16 + l15] = f2bf(v);
      }
    }
  } else {
    u16* VCT = (u16*)(p->ws + OFF_KC + 524288) + (size_t)(b * 2 + g) * 64 * 1024;
#pragma unroll
    for (int r = 0; r < 4; ++r) {
      int row = blk0 + quad * 4 + r;
#pragma unroll
      for (int n = 0; n < 4; ++n) {
        float v = row < 1023 ? o2[n][r] : 0.f;
        const int k32_ = row & 31;
        const int kp_ = k32_ < 16 ? (k32_ >> 2) * 8 + (k32_ & 3) : ((k32_ - 16) >> 2) * 8 + 4 + (k32_ & 3);
        VCT[(size_t)(n * 16 + l15) * 1024 + (row & ~31) + kp_] = f2bf(v);
      }
    }
  }
}

template <int MODE, int NT>
__device__ __forceinline__ void flash2(const u16* __restrict__ Kg, int kld, const u16* __restrict__ VTg, int vblk,
                                       int vld, int h0, int h1, char* sStage, const u16* sQw, f32x4 (&O)[4][NT],
                                       float (&lsum)[NT], const float (&inv)[NT], const u32* sSelw, float* slc,
                                       int tq0) {
  const int tid = otid(), lane = tid & 63, wv = tid >> 6, l15 = lane & 15, quad = lane >> 4;
  const int krow = tid >> 3, kc = tid & 7;
  const u16* kptr = Kg + (size_t)krow * kld + kc * 8;
  const int kw = krow * 128 + ((kc ^ ((krow >> 1) & 7)) * 16);
  const int vd = tid >> 2, vc = tid & 3;
  const u16* vptr = VTg + (size_t)vd * vld + vc * 8;
  const int vw = 4096 + vd * 64 + ((vc ^ ((0x1320 >> (4 * ((vd >> 2) & 3))) & 3)) * 16);
  const int jb0 = h0 >> 1, nst = (h1 >> 1) - jb0 + 1;
  uint4 S0k0, S0k1, S0v0, S0v1, S1k0, S1k1, S1v0, S1v1;
#define F2_LOAD(S, i_)                                                                             \
  do {                                                                                             \
    const int jb_ = jb0 + (i_);                                                                    \
    S##k0 = *(const uint4*)(kptr + (size_t)(jb_ * 64) * kld);                                      \
    S##k1 = *(const uint4*)(kptr + (size_t)(jb_ * 64 + 32) * kld);                                 \
    if (MODE != 2) {                                                                               \
      S##v0 = *(const uint4*)(vptr + (size_t)jb_ * vblk);                                          \
      S##v1 = *(const uint4*)(vptr + (size_t)jb_ * vblk + 32);                                     \
    }                                                                                              \
  } while (0)
#define F2_WRITE(S, slot_)                                                     \
  do {                                                                         \
    char* sl_ = sStage + (slot_) * 16384;                                      \
    *(uint4*)(sl_ + kw) = S##k0;                                               \
    *(uint4*)(sl_ + 8192 + kw) = S##k1;                                        \
    if (MODE != 2) {                                                           \
      *(uint4*)(sl_ + vw) = S##v0;                                             \
      *(uint4*)(sl_ + 8192 + vw) = S##v1;                                      \
    }                                                                          \
  } while (0)
  if (0 < nst) F2_LOAD(S0, 0);
  if (1 < nst) F2_LOAD(S1, 1);
  const int koff = l15 * 128;
  const int ksw = (l15 >> 1) & 7;
  const int voff = 4096 + l15 * 64 + ((quad ^ ((0x1320 >> (4 * ((l15 >> 2) & 3))) & 3)) * 16);
  const int tq0u = __builtin_amdgcn_readfirstlane(tq0);
  const int lim0u = tq0u >= 31 ? ((tq0u - 31) >> 4) : -1;
  bf16x8 bqr[NT][2];
#pragma unroll
  for (int nt = 0; nt < NT; ++nt) {
    bqr[nt][0] = *(const bf16x8*)(sQw + (nt * 16 + l15) * 72 + quad * 8);
    bqr[nt][1] = *(const bf16x8*)(sQw + (nt * 16 + l15) * 72 + 32 + quad * 8);
  }
  f32x4 Lacc[NT];
#pragma unroll
  for (int nt = 0; nt < NT; ++nt) Lacc[nt] = f32x4{0.f, 0.f, 0.f, 0.f};
  bf16x8 ones_;
  { u32 o1 = 0x3f803f80u; asm volatile("" : "+v"(o1)); union { bf16x8 v; u32 u[4]; } oo; oo.u[0] = o1; oo.u[1] = o1; oo.u[2] = o1; oo.u[3] = o1; ones_ = oo.v; }
  auto compute = [&](const int h, const char* st) __attribute__((always_inline)) {
    bool interior;
    if (MODE == 0) interior = (h * 32 + 31 <= tq0u) && (h * 32 > tq0u + NT * 4 - 1 - 512);
    else if (MODE == 1) interior = (h * 32 + 31 <= tq0u);
    else interior = (h * 32 + 31 <= lim0u);
    bool bv[NT], an[NT];
    bool anyw = false;
#pragma unroll
    for (int nt = 0; nt < NT; ++nt) {
      if (MODE == 1) {
        u32 w = sSelw[(nt * 4 + (l15 >> 2)) * 8 + (h >> 6)];
        bv[nt] = (w >> ((h >> 1) & 31)) & 1u;
      } else {
        bv[nt] = true;
      }
      an[nt] = MODE == 1 ? (bool)__any(bv[nt]) : true;
      anyw |= an[nt];
    }
    if (anyw) {
      bf16x8 kf[2][2], vf[4];
#pragma unroll
      for (int m2 = 0; m2 < 2; ++m2)
#pragma unroll
        for (int ks = 0; ks < 2; ++ks)
          kf[m2][ks] = *(const bf16x8*)(st + koff + m2 * 2048 + (((ks * 4 + quad) ^ ksw) * 16));
      if (MODE != 2) {
#pragma unroll
        for (int dt = 0; dt < 4; ++dt) vf[dt] = *(const bf16x8*)(st + voff + dt * 1024);
      }
#pragma unroll
      for (int nt = 0; nt < NT; ++nt) {
        if (!an[nt]) continue;
        const int t = tq0 + nt * 4 + (l15 >> 2);
        const bf16x8 bq0 = bqr[nt][0], bq1 = bqr[nt][1];
        f32x4 s[2];
#pragma unroll
        for (int m2 = 0; m2 < 2; ++m2) {
          s[m2] = f32x4{0.f, 0.f, 0.f, 0.f};
          s[m2] = mfma16(kf[m2][0], bq0, s[m2]);
          s[m2] = mfma16(kf[m2][1], bq1, s[m2]);
        }
        const float bias = MODE == 3 ? inv[nt] : 0.f;
        if (interior) {
#pragma unroll
          for (int m2 = 0; m2 < 2; ++m2)
#pragma unroll
            for (int r = 0; r < 4; ++r)
              s[m2][r] = MODE <= 1 ? __builtin_amdgcn_exp2f(s[m2][r])
                                   : __builtin_amdgcn_exp2f(fmaf(s[m2][r], SC2, bias));
        } else {
          int base;
          if (MODE <= 1) base = h * 32 + quad * 4 - t;
          else base = h * 32 + quad * 4 - (t >= 31 ? ((t - 31) >> 4) : -1);
          asm volatile("" : "+v"(base));
#pragma unroll
          for (int m2 = 0; m2 < 2; ++m2)
#pragma unroll
            for (int r = 0; r < 4; ++r) {
              const int C = m2 * 16 + r;
              bool valid;
              if (MODE == 0) valid = base <= -C && base > -512 - C;
              else valid = base <= -C;
              float pvv = MODE <= 1 ? __builtin_amdgcn_exp2f(s[m2][r]) : __builtin_amdgcn_exp2f(fmaf(s[m2][r], SC2, bias));
              s[m2][r] = valid ? pvv : 0.f;
            }
        }
        if (MODE == 2) {
          float ls = ((s[0][0] + s[0][1]) + (s[0][2] + s[0][3])) + ((s[1][0] + s[1][1]) + (s[1][2] + s[1][3]));
          lsum[nt] += ls;
        }
        if (MODE == 3) {
#pragma unroll
          for (int m2 = 0; m2 < 2; ++m2) {
            float ow = s[m2][0] + s[m2][1] + s[m2][2] + 0.5f * s[m2][3];
            float sp = 0.5f * s[m2][3];
            ow += __shfl_xor(ow, 1); ow += __shfl_xor(ow, 2);
            sp += __shfl_xor(sp, 1); sp += __shfl_xor(sp, 2);
            if ((l15 & 3) == 0) {
              const int j = h * 8 + m2 * 4 + quad;
              slc[(nt * 4 + (l15 >> 2)) * 256 + j] = ow;
              if (j + 1 < 256) slc[1024 + (nt * 4 + (l15 >> 2)) * 256 + j + 1] = sp;
            }
          }
        }
        if (MODE != 2) {
          bf16x8 P = pack8(s[0], s[1]);
          if (MODE == 1) {
            union { bf16x8 v; u32 u[4]; } pm; pm.v = P;
            const u32 keep = bv[nt] ? 0xffffffffu : 0u;
            pm.u[0] &= keep; pm.u[1] &= keep; pm.u[2] &= keep; pm.u[3] &= keep;
            P = pm.v;
          }
#pragma unroll
          for (int dt = 0; dt < 4; ++dt) O[dt][nt] = mfma16(vf[dt], P, O[dt][nt]);
          if (MODE <= 1) Lacc[nt] = mfma16(ones_, P, Lacc[nt]);
        }
      }
    }
  };
  if (0 < nst) F2_WRITE(S0, 0);
  if (2 < nst) F2_LOAD(S0, 2);
  RAW_BAR();
#define F2_ITER(u_, SN, sn_)                                            \
  if (i + (u_) < nst) {                                                 \
    const int ii_ = i + (u_);                                           \
    if (ii_ + 1 < nst) F2_WRITE(SN, sn_);                               \
    if (ii_ + 3 < nst) F2_LOAD(SN, ii_ + 3);                            \
    compute(2 * (jb0 + ii_), sStage + (u_) * 16384);                    \
    compute(2 * (jb0 + ii_) + 1, sStage + (u_) * 16384 + 8192);         \
    RAW_BAR();                                                          \
  }
  for (int i = 0; i < nst; i += 2) {
    F2_ITER(0, S1, 1)
    F2_ITER(1, S0, 0)
  }
  if (MODE <= 1) {
#pragma unroll
    for (int nt = 0; nt < NT; ++nt) lsum[nt] += Lacc[nt][0] * 0.25f;
  }
}

__device__ __forceinline__ void nsa_phase_c(KP p, int l, char* smem) {
  const int tid = otid(), lane = tid & 63, wv = tid >> 6, l15 = lane & 15, quad = lane >> 4;
  char* sStage = smem;
  u16* sQw = (u16*)(smem + 32768) + wv * 16 * 72;
  float* own = (float*)(smem + 32768 + 9216) + wv * 2048;
  float* spl = own + 1024;
  const u16* proj = (const u16*)(p->ws + OFF_PROJ);
  const float* small_ = (const float*)(p->ws + OFF_SMALL);
  float* OC = (float*)(p->ws + OFF_OC);
  u32* SEL = (u32*)(p->ws + OFF_SEL);
  for (int job = obid(); job < 4096; job += gridDim.x) {
    const int qt = 1023 - (job >> 2), bg = job & 3, b = bg >> 1, g = bg & 1;
    const int t0 = qt * 16 + wv * 4;
    const int ql = l15 >> 2, r_ = l15 & 3, head = g * 4 + r_;
    const int t = t0 + ql;
    const size_t tok = (size_t)b * T + t;
    const u16* KC = (const u16*)(p->ws + OFF_KC) + (size_t)bg * 1024 * 64;
    const u16* VCT = (const u16*)(p->ws + OFF_KC + 524288) + (size_t)bg * 64 * 1024;
    {
      const u16* qrow = proj + tok * PJ + C_NQ + head * 64;
      *(bf16x8*)(sQw + l15 * 72 + quad * 8) = *(const bf16x8*)(qrow + quad * 8);
      *(bf16x8*)(sQw + l15 * 72 + 32 + quad * 8) = *(const bf16x8*)(qrow + 32 + quad * 8);
    }
    const int tmax = qt * 16 + 15;
    const int nvmax = tmax >= 31 ? ((tmax - 31) >> 4) + 1 : 0;
    const int h1 = ((nvmax + 31) >> 5) - 1;
    f32x4 O[4][1];
    float lsum[1] = {0.f}, inv[1] = {0.f};
#pragma unroll
    for (int dt = 0; dt < 4; ++dt) O[dt][0] = f32x4{0.f, 0.f, 0.f, 0.f};
    if (h1 >= 0) {
      flash2<2, 1>(KC, 64, VCT, 64, 1024, 0, h1, sStage, sQw, O, lsum, inv, nullptr, own, t0);
      float ls = lsum[0];
      ls += __shfl_xor(ls, 16);
      ls += __shfl_xor(ls, 32);
      inv[0] = ls > 0.f ? -log2f(ls) : -1000.f;
      flash2<3, 1>(KC, 64, VCT, 64, 1024, 0, h1, sStage, sQw, O, lsum, inv, nullptr, own, t0);
    }
    {
      float gc = ZTEST == 1 ? 0.f : sigmoidf_(small_[tok * 32 + 8 + head * 3 + 0]);
#pragma unroll
      for (int dt = 0; dt < 4; ++dt) {
        float4 o = make_float4(O[dt][0][0] * gc, O[dt][0][1] * gc, O[dt][0][2] * gc, O[dt][0][3] * gc);
        *(float4*)(OC + tok * 512 + head * 64 + dt * 16 + quad * 4) = o;
      }
    }
    __builtin_amdgcn_wave_barrier();
    for (int q = 0; q < 4; ++q) {
      const int tq = t0 + q, cur = tq >> 6;
      u32 word = 0;
      if (cur <= 15) {
        if (lane == 0) word = (2u << cur) - 1u;
      } else {
        u32 key[4];
#pragma unroll
        for (int k = 0; k < 4; ++k) {
          int j = lane + 64 * k;
          float v = own[q * 256 + j] + spl[q * 256 + j];
          key[k] = (j >= 1 && j <= cur - 2) ? (__float_as_uint(fmaxf(v, 0.f)) + 1u) : 0u;
        }
        u32 T = 0u;
        for (int bit = 30; bit >= 0; --bit) {
          const u32 cand = T | (1u << bit);
          int cnt = 0;
#pragma unroll
          for (int k = 0; k < 4; ++k) cnt += __popcll(__ballot(key[k] >= cand));
          if (cnt >= 13) T = cand;
        }
        int ngt = 0;
#pragma unroll
        for (int k = 0; k < 4; ++k) ngt += __popcll(__ballot(key[k] > T));
        int quota = 13 - ngt;
        const unsigned long long lt = (1ull << lane) - 1ull;
#pragma unroll
        for (int k = 0; k < 4; ++k) {
          const unsigned long long me = __ballot(key[k] == T);
          const bool take = key[k] > T || (key[k] == T && (int)__popcll(me & lt) < quota);
          const int ne = (int)__popcll(me);
          quota = quota > ne ? quota - ne : 0;
          const unsigned long long sm = __ballot(take);
          if (lane == 2 * k) word = (u32)sm;
          if (lane == 2 * k + 1) word = (u32)(sm >> 32);
        }
        if (lane == 0) word |= 1u;
        if (lane == (cur >> 5)) word |= 1u << (cur & 31);
        if (lane == ((cur - 1) >> 5)) word |= 1u << ((cur - 1) & 31);
      }
      if (lane < 8) SEL[(((size_t)b * 16384 + tq) * 2 + g) * 8 + lane] = word;
    }
    __builtin_amdgcn_wave_barrier();
  }
}

__device__ __forceinline__ void nsa_s_tile(KP p, int l, char* smem, int tile) {
  const int cur = 255 - (tile >> 2), bg = tile & 3, b = bg >> 1, g = bg & 1;
  const int tid = otid(), lane = tid & 63, wv = tid >> 6, l15 = lane & 15, quad = lane >> 4;
  char* sStage = smem;
  u16* sQw = (u16*)(smem + 32768) + wv * 64 * 72;
  u32* sSel = (u32*)(smem + 32768 + 36864);
  const u32* sSelw = sSel + wv * 16 * 8;
  const u16* proj = (const u16*)(p->ws + OFF_PROJ);
  const float* small_ = (const float*)(p->ws + OFF_SMALL);
  const float* rope = (const float*)(p->ws + OFF_ROPE);
  float* OC = (float*)(p->ws + OFF_OC);
  u16* mix = (u16*)(p->ws + OFF_H);
  const size_t tokb = (size_t)b * T;
  const int tq0 = cur * 64 + wv * 16;
  const int r_ = l15 & 3, head = g * 4 + r_;
  {
    const u32* SEL = (const u32*)(p->ws + OFF_SEL);
    int q = tid >> 2, w2 = (tid & 3) * 2;
    uint2 v = *(const uint2*)(SEL + ((tokb + cur * 64 + q) * 2 + g) * 8 + w2);
    *(uint2*)(sSel + q * 8 + w2) = v;
  }
#pragma unroll
  for (int nt = 0; nt < 4; ++nt) {
    const size_t tok = tokb + tq0 + nt * 4 + (l15 >> 2);
    const u16* qrow = proj + tok * PJ + C_NQ + head * 64;
    u16* qd = sQw + (nt * 16 + l15) * 72;
    {
      union { bf16x8 v; u16 h[8]; } xi, xo;
      xi.v = *(const bf16x8*)(qrow + 32 + quad * 8);
#pragma unroll
      for (int i = 0; i < 8; ++i) xo.h[i] = f2bf(bf2f(xi.h[i]) * SC2);
      *(bf16x8*)(qd + 32 + quad * 8) = xo.v;
    }
    if (quad >= 2) {
      union { bf16x8 v; u16 h[8]; } xi, xo;
      xi.v = *(const bf16x8*)(qrow + quad * 8);
#pragma unroll
      for (int i = 0; i < 8; ++i) xo.h[i] = f2bf(bf2f(xi.h[i]) * SC2);
      *(bf16x8*)(qd + quad * 8) = xo.v;
    } else {
      union { bf16x8 v; u16 h[8]; } x1, x2, o;
      x1.v = *(const bf16x8*)(qrow);
      x2.v = *(const bf16x8*)(qrow + 8);
      const float* rp = rope + tok * 16;
#pragma unroll
      for (int i = 0; i < 8; ++i) {
        float a = bf2f(x1.h[i]), bb = bf2f(x2.h[i]), c = rp[i], sn = rp[8 + i];
        o.h[i] = f2bf((quad == 0 ? a * c - bb * sn : bb * c + a * sn) * SC2);
      }
      *(bf16x8*)(qd + quad * 8) = o.v;
    }
  }
  f32x4 O[4][4];
  float lsum[4], inv[4] = {0.f, 0.f, 0.f, 0.f};
#pragma unroll
  for (int dt = 0; dt < 4; ++dt)
#pragma unroll
    for (int nt = 0; nt < 4; ++nt) O[dt][nt] = f32x4{0.f, 0.f, 0.f, 0.f};
#pragma unroll
  for (int nt = 0; nt < 4; ++nt) lsum[nt] = 0.f;
  {
    const u16* Kg = proj + tokb * PJ + C_KWIN + g * 64;
    const u16* VTg = (const u16*)(p->ws + OFF_VT + 8 * MiB) + (size_t)(bg * 256) * 4096;
    int h0 = 2 * cur - 16 < 0 ? 0 : 2 * cur - 16;
    flash2<0, 4>(Kg, PJ, VTg, 4096, 64, h0, 2 * cur + 1, sStage, sQw, O, lsum, inv, sSelw, nullptr, tq0);
  }
#pragma unroll
  for (int nt = 0; nt < 4; ++nt) {
    const size_t tok = tokb + tq0 + nt * 4 + (l15 >> 2);
    float ls = lsum[nt];
    ls += __shfl_xor(ls, 16);
    ls += __shfl_xor(ls, 32);
    float sc = ZTEST == 2 ? 0.f : sigmoidf_(small_[tok * 32 + 8 + head * 3 + 2]) / ls;
#pragma unroll
    for (int dt = 0; dt < 4; ++dt) {
      float4* op = (float4*)(OC + tok * 512 + head * 64 + dt * 16 + quad * 4);
      float4 o = *op;
      o.x += O[dt][nt][0] * sc; o.y += O[dt][nt][1] * sc; o.z += O[dt][nt][2] * sc; o.w += O[dt][nt][3] * sc;
      *op = o;
      O[dt][nt] = f32x4{0.f, 0.f, 0.f, 0.f};
    }
    lsum[nt] = 0.f;
  }
  {
    const u16* Kg = proj + tokb * PJ + C_KSLC + g * 64;
    const u16* VTg = (const u16*)(p->ws + OFF_VT) + (size_t)(bg * 256) * 4096;
    flash2<1, 4>(Kg, PJ, VTg, 4096, 64, 0, 2 * cur + 1, sStage, sQw, O, lsum, inv, sSelw, nullptr, tq0);
  }
#pragma unroll
  for (int nt = 0; nt < 4; ++nt) {
    const size_t tok = tokb + tq0 + nt * 4 + (l15 >> 2);
    float ls = lsum[nt];
    ls += __shfl_xor(ls, 16);
    ls += __shfl_xor(ls, 32);
    float sc = ZTEST == 3 ? 0.f : sigmoidf_(small_[tok * 32 + 8 + head * 3 + 1]) / ls;
#pragma unroll
    for (int dt = 0; dt < 4; ++dt) {
      float4 o = *(const float4*)(OC + tok * 512 + head * 64 + dt * 16 + quad * 4);
      uint2 w;
      w.x = pack2(o.x + O[dt][nt][0] * sc, o.y + O[dt][nt][1] * sc);
      w.y = pack2(o.z + O[dt][nt][2] * sc, o.w + O[dt][nt][3] * sc);
      *(uint2*)(mix + tok * DM + 256 + head * 64 + dt * 16 + quad * 4) = w;
    }
  }
}


#define XB_TMO      128
#define XB_XCNT(j)  (256  + 64 * (j))
#define XB_XSUB(j)  (1280 + 64 * (j))
#define XB_XGEN(j)  (2304 + 64 * (j))
#define XB_TOP      3328
#define XB_TOPGEN   3392
#define XCD_BAR_WORDS 3456
#define XB_SPIN_CAP (1u << 18)
#define LAS __attribute__((address_space(3)))
__device__ __forceinline__ unsigned xb_ld(unsigned* p) { return __hip_atomic_load(p, __ATOMIC_RELAXED, __HIP_MEMORY_SCOPE_AGENT); }
__device__ __forceinline__ unsigned xb_add(unsigned* p, unsigned v) { return __hip_atomic_fetch_add(p, v, __ATOMIC_RELAXED, __HIP_MEMORY_SCOPE_AGENT); }
__device__ __forceinline__ unsigned xb_xcc_id() { return (unsigned)__builtin_amdgcn_s_getreg((3 << 11) | 20) & 0xFu; }
#define XB_SPIN(cond, bar) do { unsigned _sp = 0; while (cond) { __builtin_amdgcn_s_sleep(1); \
    if ((++_sp & 255u) == 0u) { if (xb_ld(&(bar)[XB_TMO])) break; if (_sp > XB_SPIN_CAP) { atomicAdd(&(bar)[XB_TMO], 1u); break; } } } } while (0)
struct XcdBarrier { unsigned* bar; unsigned x; volatile LAS unsigned* st; };
__device__ __forceinline__ XcdBarrier xcd_barrier_post(unsigned* bar, volatile LAS unsigned* st) {
  XcdBarrier b; b.bar = bar; b.x = xb_xcc_id(); b.st = st;
  if (threadIdx.x == 0) (void)xb_add(&bar[XB_XCNT(b.x)], 1u);
  return b;
}
__device__ __forceinline__ void xcd_barrier_complete(unsigned* bar, unsigned x, unsigned& nloc, unsigned& nx) {
  const unsigned G = gridDim.x * gridDim.y * gridDim.z;
  unsigned sum, cnt, mine, sp = 0u;
  for (;;) {
    sum = 0u; cnt = 0u; mine = 0u;
#pragma unroll
    for (unsigned j = 0; j < 16; ++j) { const unsigned c = xb_ld(&bar[XB_XCNT(j)]); sum += c; cnt += (c > 0u) ? 1u : 0u; mine = (j == x) ? c : mine; }
    if (sum == G) break;
    __builtin_amdgcn_s_sleep(1);
    if ((++sp & 255u) == 0u) { if (xb_ld(&bar[XB_TMO])) break; if (sp > XB_SPIN_CAP) { atomicAdd(&bar[XB_TMO], 1u); break; } }
  }
  nloc = mine > 0u ? mine : 1u; nx = cnt > 0u ? cnt : 1u;
}
__device__ __forceinline__ void xcd_barrier(const XcdBarrier& b) {
  asm volatile("s_waitcnt vmcnt(0)" ::: "memory");
  __syncthreads();
  if (threadIdx.x == 0) {
    unsigned* bar = b.bar;
    __builtin_amdgcn_s_waitcnt(0);
    unsigned nloc = b.st[0], nx = b.st[1];
    if (nloc == 0u) { xcd_barrier_complete(bar, b.x, nloc, nx); b.st[0] = nloc; b.st[1] = nx; }
    const unsigned old = xb_add(&bar[XB_XSUB(b.x)], 1u);
    const unsigned gen = old / nloc;
    if (old + 1u == (gen + 1u) * nloc) {
      __builtin_amdgcn_fence(__ATOMIC_RELEASE, "agent");
      asm volatile("s_waitcnt vmcnt(0)" ::: "memory");
      const unsigned og = xb_add(&bar[XB_TOP], 1u);
      const unsigned tg = og / nx;
      if (og + 1u == (tg + 1u) * nx) xb_add(&bar[XB_TOPGEN], 1u);
      else XB_SPIN(xb_ld(&bar[XB_TOPGEN]) == tg, bar);
      __builtin_amdgcn_fence(__ATOMIC_ACQUIRE, "agent");
      xb_add(&bar[XB_XGEN(b.x)], 1u);
      asm volatile("s_waitcnt vmcnt(0)" ::: "memory");
    } else {
      XB_SPIN(xb_ld(&bar[XB_XGEN(b.x)]) == gen, bar);
      __builtin_amdgcn_fence(__ATOMIC_ACQUIRE, "agent");
      asm volatile("s_waitcnt vmcnt(0)" ::: "memory");
    }
  }
  __syncthreads();
}
#ifndef REPE
#define REPE 1
#endif
#ifndef REP3C
#define REP3C 1
#endif
#ifndef REP3
#define REP3 1
#endif
#ifndef XSYNC
#define XSYNC 0
#endif
#ifndef REP4
#define REP4 1
#endif
#ifndef REPSCAN
#define REPSCAN 1
#endif
#ifndef REPG
#define REPG 1
#endif
__global__ void __launch_bounds__(256, 2) hymba_mega(Params p_unused) {
  cg::grid_group grid = cg::this_grid();
  __shared__ uint4 xb_words;
  if (threadIdx.x == 0) xb_words = make_uint4(0u, 0u, 0u, 0u);
  __syncthreads();
  XcdBarrier xb = xcd_barrier_post((unsigned*)(kargs()->ws + OFF_CNT + 4096), (volatile LAS unsigned*)&xb_words);
  __shared__ __attribute__((aligned(16))) char smem[77824];
  __shared__ int s_tile;
  { KP p = kargs(); rope_table(p); }
  grid.sync();
#pragma unroll 1
  for (int l = 0; l < DEPTH; ++l) {
    {
      KP p = kargs();
      if (blockIdx.x == 0 && threadIdx.x == 0) { u32 z0 = 0u; asm volatile("" : "+v"(z0)); ((u32*)(p->ws + OFF_CNT))[0] = z0; }
      for (int re = 0; re < REPE; ++re) {
      convert_weights(p, l, smem);
      rmsnorm_rows(l == 0 ? p->x_in : p->out, p->attn_norm + l * DM, (u16*)(p->ws + OFF_H));
      }
    }
    xcd_barrier(xb);
    {
      KP p = kargs();
      for (int rep = 0; rep < REPG; ++rep)
      gemm_phase((const u16*)(p->ws + OFF_H), DM, (const u16*)(p->ws + OFF_W + W_IN), DM, DM, 128, 25, smem,
                 EpiInProj{(u16*)(p->ws + OFF_PROJ), (float*)(p->ws + OFF_SMALL)});
    }
    xcd_barrier(xb);
    {
      KP p = kargs();
      for (int job = obid(); job < 2048 + 512 + 128; job += gridDim.x) {
        if (job < 2048) gdn_chunk_prep(p, l, smem, job);
        else if (job < 2560) nsa_token_prep(p, l, smem, job - 2048);
        else nsa_compress(p, l, smem, job - 2560);
      }
    }
    xcd_barrier(xb);
#ifndef REP45
#define REP45 1
#endif
    for (int rep = 0; rep < REP45; ++rep) {
    {
      KP p = kargs();
      if (blockIdx.x == 0 && threadIdx.x == 0) { u32 z0 = 0u; asm volatile("" : "+v"(z0)); ((u32*)(p->ws + OFF_CNT))[0] = z0; }
      for (int r4 = 0; r4 < REP4; ++r4) nsa_phase_c(p, l, smem);
    }
    xcd_barrier(xb);
    {
      KP p = kargs();
      if (obid() < 32) for (int rs = 0; rs < REPSCAN; ++rs) gdn_scan(p, smem, obid());
      u32* CNT = (u32*)(p->ws + OFF_CNT);
      for (;;) {
        __syncthreads();
        if (threadIdx.x == 0) s_tile = (int)atomicAdd(&CNT[0], 1u);
        __syncthreads();
        int tile = s_tile;
        if (tile >= 1024) break;
        nsa_s_tile(p, l, smem, tile);
      }
    }
    xcd_barrier(xb);
    }
    {
      KP p = kargs();
      for (int re = 0; re < REPE; ++re) gdn_finalize(p, l);
      for (int xs = 0; xs < XSYNC; ++xs) xcd_barrier(xb);
    }
    xcd_barrier(xb);
    {
      KP p = kargs();
      gemm_phase((const u16*)(p->ws + OFF_H), DM, (const u16*)(p->ws + OFF_W + W_OUT), DM, DM, 128, 8, smem,
                 EpiResid{l == 0 ? p->x_in : p->out, p->out});
    }
    xcd_barrier(xb);
    {
      KP p = kargs();
      for (int re = 0; re < REPE; ++re) rmsnorm_rows(p->out, p->ffn_norm + l * DM, (u16*)(p->ws + OFF_H));
    }
    xcd_barrier(xb);
    {
      KP p = kargs();
      for (int rep = 0; rep < REPG; ++rep)
      gemm_phase((const u16*)(p->ws + OFF_H), DM, (const u16*)(p->ws + OFF_W + W_GU), DM, DM, 128, 44, smem,
                 EpiSwiGLU{(u16*)(p->ws + OFF_PROJ)});
    }
    xcd_barrier(xb);
    {
      KP p = kargs();
      gemm_phase((const u16*)(p->ws + OFF_PROJ), DFF, (const u16*)(p->ws + OFF_W + W_DOWN), DFF, DFF, 128, 8, smem,
                 EpiResid{p->out, p->out});
    }
    xcd_barrier(xb);
  }
}

extern "C" void kernel_launch(void* const* d_in, const int* in_sizes, int n_in, void* d_out, int out_size, void* d_ws,
                              size_t ws_size, hipStream_t stream) {
  static int grid_blocks = 0;
  if (!grid_blocks) {
    int dev = 0, cus = 0, per_cu = 0;
    hipGetDevice(&dev);
    hipDeviceGetAttribute(&cus, hipDeviceAttributeMultiprocessorCount, dev);
    hipOccupancyMaxActiveBlocksPerMultiprocessor(&per_cu, hymba_mega, 256, 0);
    if (per_cu > 2) per_cu = 2;
    if (per_cu < 1) per_cu = 1;
    grid_blocks = cus * per_cu;
    grid_blocks &= ~7;
  }
  Params p;
  memset(&p, 0, sizeof(p));
  p.x_in = (const float*)d_in[0]; p.positions = (const int*)d_in[1]; p.attn_norm = (const float*)d_in[2];
  p.w_in = (const float*)d_in[3]; p.gdn_conv_w = (const float*)d_in[4]; p.gdn_a_log = (const float*)d_in[5];
  p.gdn_dt_bias = (const float*)d_in[6]; p.gdn_norm = (const float*)d_in[7]; p.nsa_q_norm = (const float*)d_in[8];
  p.nsa_k_norm = (const float*)d_in[9]; p.cmp_pe = (const float*)d_in[10]; p.cmp_w1 = (const float*)d_in[11];
  p.cmp_w2 = (const float*)d_in[12]; p.conv_w = (const float*)d_in[13]; p.w_out = (const float*)d_in[14];
  p.ffn_norm = (const float*)d_in[15]; p.w_gate_up = (const float*)d_in[16]; p.w_down = (const float*)d_in[17];
  p.out = (float*)d_out; p.ws = (char*)d_ws;
  hipMemsetAsync((char*)d_ws + OFF_CNT, 0, 4096 + XCD_BAR_WORDS * 4, stream);
  void* args[] = {&p};
  hipError_t e = hipLaunchCooperativeKernel((void*)hymba_mega, dim3(grid_blocks), dim3(256), args, 0, stream);
  if (e != hipSuccess) fprintf(stderr, "cooperative launch failed: %s (grid %d)\n", hipGetErrorString(e), grid_blocks);
}
```

```cpp
#include <hip/hip_runtime.h>
#include <hip/hip_cooperative_groups.h>
#include <cstdio>
#include <cstring>
namespace cg = cooperative_groups;

#ifndef ZTEST
#define ZTEST 0
#endif
typedef unsigned short u16;
typedef unsigned int u32;
typedef __attribute__((ext_vector_type(8))) short bf16x8;
typedef __attribute__((ext_vector_type(4))) short bf16x4;
typedef __attribute__((ext_vector_type(4))) float f32x4;

constexpr int NB = 2, T = 16384, NTOK = NB * T, DM = 1024, DFF = 2816, DEPTH = 4;
constexpr int PJ = 3072;
constexpr int C_GQ = 0, C_GK = 256, C_GV = 512, C_GZ = 768, C_NQ = 1024, C_KCMP = 1536, C_VCMP = 1664,
              C_KSLC = 1792, C_VSLC = 1920, C_KWIN = 2048, C_VWIN = 2176, C_CB = 2304, C_CC = 2560, C_CX = 2816;
constexpr size_t MiB = 1ull << 20;
constexpr size_t OFF_H = 0, OFF_PROJ = 64 * MiB, OFF_SMALL = 256 * MiB, OFF_W = 260 * MiB, OFF_GDN = 288 * MiB,
                 OFF_OG = 384 * MiB, OFF_OC = 416 * MiB, OFF_VT = 480 * MiB, OFF_KC = 496 * MiB, OFF_SEL = 497 * MiB,
                 OFF_ROPE = 499 * MiB, OFF_GL = 501 * MiB, OFF_CNT = 501 * MiB + 65536;
constexpr size_t W_IN = 0, W_OUT = 6553600, W_GU = 8650752, W_DOWN = 20185088, W_C1 = 25952256, W_C2 = 26476544;
constexpr int CHUNK_B = 49152;
constexpr float SC2 = 0.125f * 1.4426950408889634f;

struct Params {
  const float* x_in; const int* positions; const float* attn_norm; const float* w_in; const float* gdn_conv_w;
  const float* gdn_a_log; const float* gdn_dt_bias; const float* gdn_norm; const float* nsa_q_norm;
  const float* nsa_k_norm; const float* cmp_pe; const float* cmp_w1; const float* cmp_w2; const float* conv_w;
  const float* w_out; const float* ffn_norm; const float* w_gate_up; const float* w_down;
  float* out; char* ws;
};


__device__ __forceinline__ int otid() { int t = threadIdx.x; asm volatile("" : "+v"(t)); return t; }
__device__ __forceinline__ int obid() { int t = blockIdx.x; asm volatile("" : "+s"(t)); return t; }
typedef const __attribute__((address_space(4))) Params* KP;
__device__ __forceinline__ KP kargs() {
  KP k = (KP)__builtin_amdgcn_kernarg_segment_ptr();
  asm volatile("" : "+s"(k));
  return k;
}

typedef __bf16 bf2_t __attribute__((ext_vector_type(2)));
typedef float f2_t __attribute__((ext_vector_type(2)));
__device__ __forceinline__ u32 pack2(float a, float b) {
  f2_t v = {a, b};
  bf2_t r = __builtin_convertvector(v, bf2_t);
  return __builtin_bit_cast(u32, r);
}
__device__ __forceinline__ u16 f2bf(float f) { return (u16)(pack2(f, 0.f) & 0xffffu); }
__device__ __forceinline__ float bf2f(u16 h) { return __uint_as_float(((u32)h) << 16); }
__device__ __forceinline__ float wave_sum(float v) {
#pragma unroll
  for (int o = 32; o; o >>= 1) v += __shfl_xor(v, o);
  return v;
}
__device__ __forceinline__ float dpp_xor1(float v) {
  return __int_as_float(__builtin_amdgcn_update_dpp(0, __float_as_int(v), 0xB1, 0xF, 0xF, true));
}
__device__ __forceinline__ float dpp_xor2(float v) {
  return __int_as_float(__builtin_amdgcn_update_dpp(0, __float_as_int(v), 0x4E, 0xF, 0xF, true));
}
__device__ __forceinline__ float sigmoidf_(float x) { return 1.f / (1.f + __expf(-x)); }
__device__ __forceinline__ f32x4 mfma16(bf16x8 a, bf16x8 b, f32x4 c) {
  return __builtin_amdgcn_mfma_f32_16x16x32_bf16(a, b, c, 0, 0, 0);
}
__device__ __forceinline__ bf16x8 pack8(f32x4 a, f32x4 b) {
  union { bf16x8 v; u32 u[4]; } r;
  r.u[0] = pack2(a[0], a[1]); r.u[1] = pack2(a[2], a[3]);
  r.u[2] = pack2(b[0], b[1]); r.u[3] = pack2(b[2], b[3]);
  return r.v;
}

__device__ __forceinline__ void rmsnorm_rows(const float* __restrict__ x, const float* __restrict__ gain, u16* __restrict__ h) {
  int lane = otid() & 63;
  int gw = obid() * 4 + (otid() >> 6), nw = gridDim.x * 4;
  for (int row = gw; row < NTOK; row += nw) {
    const float4* xr = (const float4*)(x + (size_t)row * DM);
    float4 v[4];
    float ss = 0.f;
#pragma unroll
    for (int i = 0; i < 4; ++i) {
      v[i] = xr[lane + 64 * i];
      ss += v[i].x * v[i].x + v[i].y * v[i].y + v[i].z * v[i].z + v[i].w * v[i].w;
    }
    ss = wave_sum(ss);
    float rs = rsqrtf(ss * (1.f / DM) + 1e-6f);
#pragma unroll
    for (int i = 0; i < 4; ++i) {
      float4 g = ((const float4*)gain)[lane + 64 * i];
      uint2 o;
      o.x = pack2(v[i].x * rs * g.x, v[i].y * rs * g.y);
      o.y = pack2(v[i].z * rs * g.z, v[i].w * rs * g.w);
      *(uint2*)(h + (size_t)row * DM + (lane + 64 * i) * 4) = o;
    }
  }
}

struct MapId { __device__ int operator()(int n) const { return n; } };
struct MapIn {
  __device__ int operator()(int n) const {
    if (n < 1024) return n;
    if (n < 2304) return n + 8;
    if (n < 3072) return n + 32;
    if (n < 3080) return n - 3072 + 1024;
    if (n < 3104) return n - 3080 + 2312;
    return -1;
  }
};
struct MapGU {
  __device__ int operator()(int n) const {
    int grp = n >> 6, r = n & 63;
    return r < 32 ? grp * 32 + r : DFF + grp * 32 + (r - 32);
  }
};
template <class Map>
__device__ __forceinline__ void transpose_tile(const float* __restrict__ src, int lds_, Map map, u16* __restrict__ dst, int ldd, int n0,
                               int k0, float* t) {
  int tid = otid();
#pragma unroll
  for (int i = 0; i < 16; ++i) {
    int k = i * 4 + (tid >> 6), n = tid & 63;
    int sn = map(n0 + n);
    t[k * 65 + n] = sn >= 0 ? src[(size_t)(k0 + k) * lds_ + sn] : 0.f;
  }
  __syncthreads();
#pragma unroll 4
  for (int i = 0; i < 16; ++i) {
    int n = i * 4 + (tid >> 6), k = tid & 63;
    dst[(size_t)(n0 + n) * ldd + k0 + k] = f2bf(t[k * 65 + n]);
  }
  __syncthreads();
}

__device__ __forceinline__ void convert_weights(KP p, int l, char* smem) {
  float* t = (float*)smem;
  char* W = p->ws + OFF_W;
  const int J0 = 800, J1 = J0 + 256, J2 = J1 + 1408, J3 = J2 + 704, J4 = J3 + 64, J5 = J4 + 2;
  for (int job = obid(); job < J5; job += gridDim.x) {
    if (job < J0) {
      transpose_tile(p->w_in + (size_t)l * DM * 3104, 3104, MapIn(), (u16*)(W + W_IN), 1024, (job >> 4) * 64,
                     (job & 15) * 64, t);
    } else if (job < J1) {
      int j = job - J0;
      transpose_tile(p->w_out + (size_t)l * DM * DM, 1024, MapId(), (u16*)(W + W_OUT), 1024, (j >> 4) * 64,
                     (j & 15) * 64, t);
    } else if (job < J2) {
      int j = job - J1;
      transpose_tile(p->w_gate_up + (size_t)l * DM * 2 * DFF, 2 * DFF, MapGU(), (u16*)(W + W_GU), 1024, (j >> 4) * 64,
                     (j & 15) * 64, t);
    } else if (job < J3) {
      int j = job - J2;
      transpose_tile(p->w_down + (size_t)l * DFF * DM, 1024, MapId(), (u16*)(W + W_DOWN), DFF, (j / 44) * 64,
                     (j % 44) * 64, t);
    } else if (job < J4) {
      int j = job - J3;
      int which = j >> 5, kt = j & 31;
      transpose_tile(p->cmp_w1 + (size_t)(l * 2 + which) * 2048 * 64, 64, MapId(),
                     (u16*)(W + W_C1) + (size_t)which * 64 * 2048, 2048, 0, kt * 64, t);
    } else {
      int which = job - J4;
      transpose_tile(p->cmp_w2 + (size_t)(l * 2 + which) * 64 * 64, 64, MapId(), (u16*)(W + W_C2) + which * 4096, 64, 0,
                     0, t);
    }
  }
}

#define WAIT_VM(n) asm volatile("s_waitcnt vmcnt(" #n ")" ::: "memory")
#define RAW_BAR() do { asm volatile("s_waitcnt lgkmcnt(0)" ::: "memory"); __builtin_amdgcn_s_barrier(); } while (0)
typedef __attribute__((ext_vector_type(16))) float f32x16;
template <class Epi>
__device__ __forceinline__ void gemm_phase(const u16* __restrict__ A, int lda, const u16* __restrict__ Bt, int ldb, int K, int ntm,
                           int ntn, char* smem, Epi epi) {
  const int tid = otid(), lane = tid & 63, wv = tid >> 6;
  const int wm = wv >> 1, wn = wv & 1, l31 = lane & 31, hi = lane >> 5;
  const int ntiles = ntm * ntn, nk = K >> 5;
  const int lrow = tid >> 3, lc8 = tid & 7;
  const int woff = lrow * 64 + (((lc8 & 3) ^ ((lrow >> 2) & 3)) * 16);
  const bool wodd = (lc8 >> 2) != 0;
  const int sw = (l31 >> 2) & 3;
  const int arow = (wm * 128 + l31) * 64, brow = 16384 + (wn * 64 + l31) * 64;
#define TILE_DECODE(id_, row0_, col0_, tn_)                                                  \
  do {                                                                                       \
    int xcd_ = (id_) & 7, loc_ = (id_) >> 3;                                                 \
    int per_rb_ = 8 * ntn;                                                                   \
    int rb_ = loc_ / per_rb_, rem_ = loc_ % per_rb_;                                         \
    int cb_ = rem_ >> 6, rem2_ = rem_ & 63;                                                  \
    int width_ = (cb_ + 1) * 8 <= ntn ? 8 : ntn - cb_ * 8;                                   \
    int tm_l_ = rb_ * 8 + rem2_ / width_;                                                    \
    tn_ = cb_ * 8 + rem2_ % width_;                                                          \
    row0_ = (tm_l_ * 8 + xcd_) * 256;                                                        \
    col0_ = tn_ * 128;                                                                       \
  } while (0)
#define W_LOAD(w_)                                                           \
  do {                                                                       \
    const u16* pa_ = gA + (w_) * 64;                                         \
    const u16* pb_ = gB + (w_) * 64;                                         \
    Ra0 = *(const uint4*)(pa_);           Ra1 = *(const uint4*)(pa_ + a32);  \
    Ra2 = *(const uint4*)(pa_ + 2 * a32); Ra3 = *(const uint4*)(pa_ + 3 * a32); \
    Ra4 = *(const uint4*)(pa_ + 4 * a32); Ra5 = *(const uint4*)(pa_ + 5 * a32); \
    Ra6 = *(const uint4*)(pa_ + 6 * a32); Ra7 = *(const uint4*)(pa_ + 7 * a32); \
    Rb0 = *(const uint4*)(pb_);           Rb1 = *(const uint4*)(pb_ + b32);  \
    Rb2 = *(const uint4*)(pb_ + 2 * b32); Rb3 = *(const uint4*)(pb_ + 3 * b32); \
  } while (0)
#define MF(accv, bv, av) accv = __builtin_amdgcn_mfma_f32_32x32x16_bf16(bv, av, accv, 0, 0, 0)
#define SB() __builtin_amdgcn_sched_barrier(0)
#define G_ITER(sl_, ODD, wnext_)                                                                 \
  do {                                                                                           \
    const char* st_ = smem + (sl_) * 24576;                                                      \
    const int s1_ = (sl_) + 1 >= 3 ? (sl_) - 2 : (sl_) + 1, s2_ = (sl_) + 2 >= 3 ? (sl_) - 1 : (sl_) + 2; \
    char* wr_ = smem + (wodd ? s2_ : s1_) * 24576 + woff;                                        \
    const int p0_ = ((0 + hi) ^ sw) * 16, p1_ = ((2 + hi) ^ sw) * 16;                            \
    bf16x8 b00 = *(const bf16x8*)(st_ + brow + p0_), b01 = *(const bf16x8*)(st_ + brow + 2048 + p0_); \
    bf16x8 a00 = *(const bf16x8*)(st_ + arow + p0_), a01 = *(const bf16x8*)(st_ + arow + 2048 + p0_); \
    bf16x8 a02 = *(const bf16x8*)(st_ + arow + 4096 + p0_), a03 = *(const bf16x8*)(st_ + arow + 6144 + p0_); \
    SB();                                                                                        \
    MF(acc[0][0], b00, a00); MF(acc[0][1], b01, a00);                                            \
    bf16x8 b10 = *(const bf16x8*)(st_ + brow + p1_), b11 = *(const bf16x8*)(st_ + brow + 2048 + p1_); \
    SB();                                                                                        \
    MF(acc[1][0], b00, a01); MF(acc[1][1], b01, a01);                                            \
    bf16x8 a10 = *(const bf16x8*)(st_ + arow + p1_), a11 = *(const bf16x8*)(st_ + arow + 2048 + p1_); \
    SB();                                                                                        \
    MF(acc[2][0], b00, a02); MF(acc[2][1], b01, a02);                                            \
    bf16x8 a12 = *(const bf16x8*)(st_ + arow + 4096 + p1_), a13 = *(const bf16x8*)(st_ + arow + 6144 + p1_); \
    SB();                                                                                        \
    MF(acc[3][0], b00, a03); MF(acc[3][1], b01, a03);                                            \
    if (ODD) { *(uint4*)(wr_) = Ra0; *(uint4*)(wr_ + 2048) = Ra1; *(uint4*)(wr_ + 4096) = Ra2; } \
    SB();                                                                                        \
    MF(acc[0][0], b10, a10); MF(acc[0][1], b11, a10);                                            \
    if (ODD) { *(uint4*)(wr_ + 6144) = Ra3; *(uint4*)(wr_ + 8192) = Ra4; *(uint4*)(wr_ + 10240) = Ra5; } \
    SB();                                                                                        \
    MF(acc[1][0], b10, a11); MF(acc[1][1], b11, a11);                                            \
    if (ODD) { *(uint4*)(wr_ + 12288) = Ra6; *(uint4*)(wr_ + 14336) = Ra7; *(uint4*)(wr_ + 16384) = Rb0; } \
    SB();                                                                                        \
    MF(acc[2][0], b10, a12); MF(acc[2][1], b11, a12);                                            \
    if (ODD) { *(uint4*)(wr_ + 18432) = Rb1; *(uint4*)(wr_ + 20480) = Rb2; *(uint4*)(wr_ + 22528) = Rb3; } \
    SB();                                                                                        \
    MF(acc[3][0], b10, a13); MF(acc[3][1], b11, a13);                                            \
    if (ODD) { const int wl_ = (wnext_) < nw ? (wnext_) : nw - 1; W_LOAD(wl_); }                 \
    RAW_BAR();                                                                                   \
  } while (0)
  const size_t a32 = (size_t)32 * lda, b32 = (size_t)32 * ldb;
  const int nw = nk >> 1;
  int id = obid();
  int row0 = 0, col0 = 0, tn = 0;
  const u16 *gA = A, *gB = Bt;
  uint4 Ra0, Ra1, Ra2, Ra3, Ra4, Ra5, Ra6, Ra7, Rb0, Rb1, Rb2, Rb3;
  if (id < ntiles) {
    TILE_DECODE(id, row0, col0, tn);
    gA = A + (size_t)(row0 + lrow) * lda + lc8 * 8;
    gB = Bt + (size_t)(col0 + lrow) * ldb + lc8 * 8;
    W_LOAD(0);
  }
  while (id < ntiles) {
    f32x16 acc[4][2];
#pragma unroll
    for (int m = 0; m < 4; ++m)
#pragma unroll
      for (int n = 0; n < 2; ++n)
#pragma unroll
        for (int r = 0; r < 16; ++r) acc[m][n][r] = 0.f;
    {
      char* wr_ = smem + (wodd ? 1 : 0) * 24576 + woff;
      *(uint4*)(wr_) = Ra0; *(uint4*)(wr_ + 2048) = Ra1; *(uint4*)(wr_ + 4096) = Ra2; *(uint4*)(wr_ + 6144) = Ra3;
      *(uint4*)(wr_ + 8192) = Ra4; *(uint4*)(wr_ + 10240) = Ra5; *(uint4*)(wr_ + 12288) = Ra6; *(uint4*)(wr_ + 14336) = Ra7;
      *(uint4*)(wr_ + 16384) = Rb0; *(uint4*)(wr_ + 18432) = Rb1; *(uint4*)(wr_ + 20480) = Rb2; *(uint4*)(wr_ + 22528) = Rb3;
    }
    W_LOAD(1);
    RAW_BAR();
    __builtin_amdgcn_s_setprio(1);
    int sl = 0;
    for (int w = 0; w < nw; ++w) {
      G_ITER(sl, false, 0);
      sl = sl + 1 >= 3 ? 0 : sl + 1;
      G_ITER(sl, true, w + 2);
      sl = sl + 1 >= 3 ? 0 : sl + 1;
    }
    __builtin_amdgcn_s_setprio(0);
    const int erow = row0 + wm * 128 + l31, ecol = col0 + wn * 64 + hi * 4, etn = tn;
    id += gridDim.x;
    if (id < ntiles) {
      TILE_DECODE(id, row0, col0, tn);
      gA = A + (size_t)(row0 + lrow) * lda + lc8 * 8;
      gB = Bt + (size_t)(col0 + lrow) * ldb + lc8 * 8;
      W_LOAD(0);
    }
    epi(acc, erow, ecol, etn);
  }
}

struct EpiInProj {
  u16* proj; float* small_;
  __device__ __forceinline__ void operator()(f32x16 (&acc)[4][2], int rbase, int cbase, int tn) const {
    if (tn < 24) {
#pragma unroll
      for (int m = 0; m < 4; ++m)
#pragma unroll
        for (int n = 0; n < 2; ++n)
#pragma unroll
          for (int g = 0; g < 4; ++g) {
            uint2 o;
            o.x = pack2(acc[m][n][g * 4 + 0], acc[m][n][g * 4 + 1]);
            o.y = pack2(acc[m][n][g * 4 + 2], acc[m][n][g * 4 + 3]);
            *(uint2*)(proj + (size_t)(rbase + m * 32) * PJ + cbase + n * 32 + g * 8) = o;
          }
    } else {
#pragma unroll
      for (int m = 0; m < 4; ++m)
#pragma unroll
        for (int g = 0; g < 4; ++g) {
          int c = cbase + g * 8 - 3072;
          if (c < 32)
            *(float4*)(small_ + (size_t)(rbase + m * 32) * 32 + c) =
                make_float4(acc[m][0][g * 4 + 0], acc[m][0][g * 4 + 1], acc[m][0][g * 4 + 2], acc[m][0][g * 4 + 3]);
        }
    }
  }
};
struct EpiResid {
  const float* xin; float* xout;
  __device__ __forceinline__ void operator()(f32x16 (&acc)[4][2], int rbase, int cbase, int tn) const {
#pragma unroll
    for (int m = 0; m < 4; ++m)
#pragma unroll
      for (int n = 0; n < 2; ++n)
#pragma unroll
        for (int g = 0; g < 4; ++g) {
          size_t idx = (size_t)(rbase + m * 32) * DM + cbase + n * 32 + g * 8;
          float4 x = *(const float4*)(xin + idx);
          x.x += acc[m][n][g * 4 + 0]; x.y += acc[m][n][g * 4 + 1]; x.z += acc[m][n][g * 4 + 2]; x.w += acc[m][n][g * 4 + 3];
          *(float4*)(xout + idx) = x;
        }
  }
};
struct EpiSwiGLU {
  u16* act;
  __device__ __forceinline__ void operator()(f32x16 (&acc)[4][2], int rbase, int cbase, int tn) const {
    int grp = cbase >> 6, c4 = cbase & 7;
#pragma unroll
    for (int m = 0; m < 4; ++m)
#pragma unroll
      for (int g = 0; g < 4; ++g) {
        float v[4];
#pragma unroll
        for (int r = 0; r < 4; ++r) {
          float gt = acc[m][0][g * 4 + r], up = acc[m][1][g * 4 + r];
          v[r] = gt / (1.f + __expf(-gt)) * up;
        }
        uint2 o;
        o.x = pack2(v[0], v[1]);
        o.y = pack2(v[2], v[3]);
        *(uint2*)(act + (size_t)(rbase + m * 32) * DFF + grp * 32 + g * 8 + c4) = o;
      }
  }
};

__device__ __forceinline__ void gdn_chunk_prep(KP p, int l, char* smem, int job) {
  const int b = job >> 10, h = (job >> 8) & 3, c = job & 255;
  const int tid = otid(), lane = tid & 63, wv = tid >> 6;
  float* sq = (float*)smem;
  float* sk = sq + 64 * 65;
  float* sv = sk + 64 * 65;
  float* sA = sv + 64 * 65;
  float* sgc = sA + 64 * 64;
  float* sbeta = sgc + 64;
  float* seg = sbeta + 64;
  float* sf2 = seg + 64;
  const u16* proj = (const u16*)(p->ws + OFF_PROJ);
  const float* small_ = (const float*)(p->ws + OFF_SMALL);
  const size_t tok0 = (size_t)b * T + c * 64;
  char* cb = p->ws + OFF_GDN + (size_t)((b * 4 + h) * 256 + c) * CHUNK_B;
  float* UT = (float*)cb;
  u16* NW = (u16*)(cb + 16384);
  u16* QD = (u16*)(cb + 24576);
  u16* KDT = (u16*)(cb + 32768);
  u16* QKM = (u16*)(cb + 40960);
  {
    const int d = lane, i0 = wv * 16;
    const int tl0 = c * 64 + i0;
    u16 raw[3][19];
#pragma unroll
    for (int seg_ = 0; seg_ < 3; ++seg_) {
      const int ch = seg_ * 256 + h * 64 + d;
#pragma unroll
      for (int i = 0; i < 19; ++i) {
        const int rel = i0 + i - 3;
        const size_t tk = (tl0 + i - 3 >= 0) ? (tok0 + rel) : tok0;
        raw[seg_][i] = proj[tk * PJ + ch];
      }
    }
#pragma unroll
    for (int seg_ = 0; seg_ < 3; ++seg_) {
      const int ch = seg_ * 256 + h * 64 + d;
      const float* cw = p->gdn_conv_w + (size_t)l * 4 * 768 + ch;
      const float w0 = cw[0], w1 = cw[768], w2 = cw[1536], w3 = cw[2304];
      float* dst = seg_ == 0 ? sq : (seg_ == 1 ? sk : sv);
      float xv[19];
#pragma unroll
      for (int i = 0; i < 19; ++i) xv[i] = (tl0 + i - 3 >= 0) ? bf2f(raw[seg_][i]) : 0.f;
#pragma unroll
      for (int i = 0; i < 16; ++i) {
        float y = w0 * xv[i] + w1 * xv[i + 1] + w2 * xv[i + 2] + w3 * xv[i + 3];
        dst[(i0 + i) * 65 + d] = y / (1.f + __expf(-y));
      }
    }
  }
  if (tid < 64) {
    float gb = small_[(tok0 + tid) * 32 + h], ga = small_[(tok0 + tid) * 32 + 4 + h];
    float xx = ga + p->gdn_dt_bias[l * 4 + h];
    float sp = fmaxf(xx, 0.f) + log1pf(__expf(-fabsf(xx)));
    float g = -__expf(p->gdn_a_log[l * 4 + h]) * sp;
#pragma unroll
    for (int o = 1; o < 64; o <<= 1) {
      float t = __shfl_up(g, o);
      if (lane >= o) g += t;
    }
    float beta = sigmoidf_(gb);
    float eg = __expf(g);
    sgc[tid] = g; sbeta[tid] = beta; seg[tid] = eg; sf2[tid] = beta * eg;
    if (tid == 63) ((float*)(p->ws + OFF_GL))[(b * 4 + h) * 256 + c] = eg;
  }
  __syncthreads();
  if (tid < 128) {
    float* rowp = (tid < 64 ? sq : sk) + (tid & 63) * 65;
    float ss = 0.f;
#pragma unroll 16
    for (int d = 0; d < 64; ++d) ss += rowp[d] * rowp[d];
    const float sc = rsqrtf(ss + 1e-6f) * (tid < 64 ? 0.125f : 1.f);
#pragma unroll 16
    for (int d = 0; d < 64; ++d) rowp[d] *= sc;
  }
  __syncthreads();
  {
    int ti = tid >> 4, tj = tid & 15;
    float kk[4][4], qk[4][4];
#pragma unroll
    for (int a = 0; a < 4; ++a)
#pragma unroll
      for (int bb = 0; bb < 4; ++bb) { kk[a][bb] = 0.f; qk[a][bb] = 0.f; }
    if (tj <= ti) {
      for (int d = 0; d < 64; ++d) {
        float ki[4], kj[4], qi[4];
#pragma unroll
        for (int a = 0; a < 4; ++a) {
          ki[a] = sk[(ti * 4 + a) * 65 + d];
          qi[a] = sq[(ti * 4 + a) * 65 + d];
          kj[a] = sk[(tj * 4 + a) * 65 + d];
        }
#pragma unroll
        for (int a = 0; a < 4; ++a)
#pragma unroll
          for (int bb = 0; bb < 4; ++bb) { kk[a][bb] += ki[a] * kj[bb]; qk[a][bb] += qi[a] * kj[bb]; }
      }
    }
#pragma unroll
    for (int a = 0; a < 4; ++a) {
      int i = ti * 4 + a;
      float gi = sgc[i], bi = sbeta[i];
      uint2 o;
      float qv[4];
#pragma unroll
      for (int bb = 0; bb < 4; ++bb) {
        int j = tj * 4 + bb;
        float dec = (j <= i) ? __expf(gi - sgc[j]) : 0.f;
        sA[i * 64 + j] = (j < i) ? bi * kk[a][bb] * dec : 0.f;
        qv[bb] = qk[a][bb] * dec;
      }
      o.x = pack2(qv[0], qv[1]); o.y = pack2(qv[2], qv[3]);
      *(uint2*)(QKM + i * 64 + tj * 4) = o;
    }
  }
  {
    float gl = sgc[63];
    for (int idx = tid; idx < 4096; idx += 256) {
      int i = idx >> 6, d = idx & 63;
      QD[idx] = f2bf(sq[i * 65 + d] * seg[i]);
      KDT[idx] = f2bf(sk[d * 65 + i] * __expf(gl - sgc[d]));
    }
  }
  __syncthreads();
  if (tid < 128) {
    int cidx = tid;
    const float* src = cidx < 64 ? sv + cidx : sk + (cidx - 64);
    const float* fac = cidx < 64 ? sbeta : sf2;
    float x[64];
#pragma unroll
    for (int i = 0; i < 64; ++i) {
      float s0 = src[i * 65] * fac[i], s1 = 0.f, s2 = 0.f, s3 = 0.f;
#pragma unroll
      for (int j = 0; j < i; ++j) {
        if ((j & 3) == 0) s0 -= sA[i * 64 + j] * x[j];
        else if ((j & 3) == 1) s1 -= sA[i * 64 + j] * x[j];
        else if ((j & 3) == 2) s2 -= sA[i * 64 + j] * x[j];
        else s3 -= sA[i * 64 + j] * x[j];
      }
      x[i] = (s0 + s1) + (s2 + s3);
    }
    if (cidx < 64) {
#pragma unroll
      for (int i = 0; i < 64; i += 4) *(float4*)(UT + cidx * 64 + i) = make_float4(x[i], x[i + 1], x[i + 2], x[i + 3]);
    } else {
#pragma unroll
      for (int i = 0; i < 64; ++i) NW[i * 64 + (cidx - 64)] = f2bf(-x[i]);
    }
  }
  __syncthreads();
}

__device__ __forceinline__ void gdn_scan(KP p, char* smem, int sid) {
  const int b = sid >> 4, h = (sid >> 2) & 3, v0 = (sid & 3) * 16;
  const int tid = otid(), lane = tid & 63, wv = tid >> 6, l15 = lane & 15, quad = lane >> 4;
  u16* Sb = (u16*)smem;
  u16* Vb = Sb + 16 * 72;
  f32x4 S = {0.f, 0.f, 0.f, 0.f};
  { u32 z0 = 0u; asm volatile("" : "+v"(z0)); *(uint2*)(Sb + l15 * 72 + 16 * wv + quad * 4) = make_uint2(z0, z0); }
  __syncthreads();
  const char* gbase = p->ws + OFF_GDN + (size_t)((b * 4 + h) * 256) * CHUNK_B;
  const float* GL = (const float*)(p->ws + OFF_GL) + (b * 4 + h) * 256;
  float* OG = (float*)(p->ws + OFF_OG);
  const int arow = (16 * wv + l15) * 64 + quad * 8;
  f32x4 u, un;
  bf16x8 wA[2], qdA[2], qkA[2], kdA[2], wAn[2], qdAn[2], qkAn[2], kdAn[2];
  float gl, gln;
  {
    const char* cb = gbase;
    u = *(const f32x4*)((const float*)cb + (v0 + l15) * 64 + 16 * wv + quad * 4);
#pragma unroll
    for (int ks = 0; ks < 2; ++ks) {
      wA[ks] = *(const bf16x8*)((const u16*)(cb + 16384) + arow + ks * 32);
      qdA[ks] = *(const bf16x8*)((const u16*)(cb + 24576) + arow + ks * 32);
      kdA[ks] = *(const bf16x8*)((const u16*)(cb + 32768) + arow + ks * 32);
      qkA[ks] = *(const bf16x8*)((const u16*)(cb + 40960) + arow + ks * 32);
    }
    gl = GL[0];
  }
  for (int c = 0; c < 256; ++c) {
    if (c + 1 < 256) {
      const char* cb = gbase + (size_t)(c + 1) * CHUNK_B;
      un = *(const f32x4*)((const float*)cb + (v0 + l15) * 64 + 16 * wv + quad * 4);
#pragma unroll
      for (int ks = 0; ks < 2; ++ks) {
        wAn[ks] = *(const bf16x8*)((const u16*)(cb + 16384) + arow + ks * 32);
        qdAn[ks] = *(const bf16x8*)((const u16*)(cb + 24576) + arow + ks * 32);
        kdAn[ks] = *(const bf16x8*)((const u16*)(cb + 32768) + arow + ks * 32);
        qkAn[ks] = *(const bf16x8*)((const u16*)(cb + 40960) + arow + ks * 32);
      }
      gln = GL[c + 1];
    }
    bf16x8 sB0 = *(const bf16x8*)(Sb + l15 * 72 + quad * 8);
    bf16x8 sB1 = *(const bf16x8*)(Sb + l15 * 72 + 32 + quad * 8);
    f32x4 vn = u;
    vn = mfma16(wA[0], sB0, vn);
    vn = mfma16(wA[1], sB1, vn);
    f32x4 o = {0.f, 0.f, 0.f, 0.f};
    o = mfma16(qdA[0], sB0, o);
    o = mfma16(qdA[1], sB1, o);
    *(uint2*)(Vb + l15 * 72 + 16 * wv + quad * 4) = make_uint2(pack2(vn[0], vn[1]), pack2(vn[2], vn[3]));
    __syncthreads();
    bf16x8 vB0 = *(const bf16x8*)(Vb + l15 * 72 + quad * 8);
    bf16x8 vB1 = *(const bf16x8*)(Vb + l15 * 72 + 32 + quad * 8);
    o = mfma16(qkA[0], vB0, o);
    o = mfma16(qkA[1], vB1, o);
    S[0] *= gl; S[1] *= gl; S[2] *= gl; S[3] *= gl;
    S = mfma16(kdA[0], vB0, S);
    S = mfma16(kdA[1], vB1, S);
    *(uint2*)(Sb + l15 * 72 + 16 * wv + quad * 4) = make_uint2(pack2(S[0], S[1]), pack2(S[2], S[3]));
    size_t orow = (size_t)b * T + c * 64 + 16 * wv + quad * 4;
#pragma unroll
    for (int r = 0; r < 4; ++r) OG[(orow + r) * 256 + h * 64 + v0 + l15] = o[r];
    __syncthreads();
    u = un; gl = gln;
#pragma unroll
    for (int ks = 0; ks < 2; ++ks) { wA[ks] = wAn[ks]; qdA[ks] = qdAn[ks]; kdA[ks] = kdAn[ks]; qkA[ks] = qkAn[ks]; }
  }
}

__device__ __forceinline__ void gdn_finalize(KP p, int l) {
  const int lane = otid() & 63, sub = lane >> 4, q4 = (lane & 15) * 4;
  const int gw = obid() * 4 + (otid() >> 6), nw = gridDim.x * 4;
  const float* OG = (const float*)(p->ws + OFF_OG);
  const u16* proj = (const u16*)(p->ws + OFF_PROJ);
  u16* mix = (u16*)(p->ws + OFF_H);
  const float4 gn = *(const float4*)(p->gdn_norm + l * 64 + q4);
  for (int base = gw * 16; base < NTOK * 4; base += nw * 16) {
    float4 o[4];
    uint2 zr[4];
#pragma unroll
    for (int u = 0; u < 4; ++u) {
      const int row = base + u * 4 + sub, t = row >> 2, h = row & 3;
      o[u] = *(const float4*)(OG + (size_t)row * 64 + q4);
      zr[u] = *(const uint2*)(proj + (size_t)t * PJ + C_GZ + h * 64 + q4);
    }
#pragma unroll
    for (int u = 0; u < 4; ++u) {
      const int row = base + u * 4 + sub, t = row >> 2, h = row & 3;
      float ss = o[u].x * o[u].x + o[u].y * o[u].y + o[u].z * o[u].z + o[u].w * o[u].w;
      ss += __shfl_xor(ss, 1); ss += __shfl_xor(ss, 2); ss += __shfl_xor(ss, 4); ss += __shfl_xor(ss, 8);
      const float rs = rsqrtf(ss * (1.f / 64.f) + 1e-6f);
      const float z0 = bf2f(zr[u].x & 0xffff), z1 = bf2f(zr[u].x >> 16), z2 = bf2f(zr[u].y & 0xffff), z3 = bf2f(zr[u].y >> 16);
      const float y0 = o[u].x * rs * gn.x * (z0 / (1.f + __expf(-z0)));
      const float y1 = o[u].y * rs * gn.y * (z1 / (1.f + __expf(-z1)));
      const float y2 = o[u].z * rs * gn.z * (z2 / (1.f + __expf(-z2)));
      const float y3 = o[u].w * rs * gn.w * (z3 / (1.f + __expf(-z3)));
      uint2 w;
      w.x = pack2(ZTEST == 4 ? 0.f : y0, ZTEST == 4 ? 0.f : y1);
      w.y = pack2(ZTEST == 4 ? 0.f : y2, ZTEST == 4 ? 0.f : y3);
      *(uint2*)(mix + (size_t)t * DM + h * 64 + q4) = w;
    }
  }
}

__device__ __forceinline__ void rope_table(KP p) {
  float* rp = (float*)(p->ws + OFF_ROPE);
  int gt = obid() * blockDim.x + otid(), nt = gridDim.x * blockDim.x;
  for (int idx = gt; idx < NTOK * 8; idx += nt) {
    int t = idx >> 3, i = idx & 7;
    float inv = (float)pow(500000.0, -(double)i / 8.0);
    float ang = (float)p->positions[t] * inv;
    rp[t * 16 + i] = (float)cos((double)ang);
    rp[t * 16 + 8 + i] = (float)sin((double)ang);
  }
}

__device__ __forceinline__ void nsa_token_prep(KP p, int l, char* smem, int tb) {
  const int tid = otid(), lane = tid & 63, wv = tid >> 6;
  const int b = tb >> 8, blk = tb & 255;
  u16* proj = (u16*)(p->ws + OFF_PROJ);
  const float* rope = (const float*)(p->ws + OFF_ROPE);
  const size_t tok0 = (size_t)tb * 64;
  for (int r = tid; r < 768; r += 256) {
    int i = r / 12, which = r % 12;
    size_t t = tok0 + i;
    int col; const float* gain;
    if (which < 8) { col = C_NQ + which * 64; gain = p->nsa_q_norm + l * 64; }
    else if (which < 10) { col = C_KSLC + (which - 8) * 64; gain = p->nsa_k_norm + (l * 3 + 1) * 64; }
    else { col = C_KWIN + (which - 10) * 64; gain = p->nsa_k_norm + (l * 3 + 2) * 64; }
    u16* rowp = proj + t * PJ + col;
    union { uint4 q; u16 h[8]; } v[8];
    float ss = 0.f;
#pragma unroll
    for (int c = 0; c < 8; ++c) {
      v[c].q = *(const uint4*)(rowp + c * 8);
#pragma unroll
      for (int e = 0; e < 8; ++e) { float x = bf2f(v[c].h[e]); ss += x * x; }
    }
    const float rs = rsqrtf(ss * (1.f / 64.f) + 1e-6f);
    float y0[16];
#pragma unroll
    for (int e = 0; e < 16; ++e) y0[e] = bf2f(v[e >> 3].h[e & 7]) * rs * gain[e];
    if (which >= 8) {
      const float* rp = rope + t * 16;
#pragma unroll
      for (int e = 0; e < 8; ++e) {
        float c = rp[e], sn = rp[8 + e];
        float a1 = y0[e], a2 = y0[8 + e];
        y0[e] = a1 * c - a2 * sn;
        y0[8 + e] = a2 * c + a1 * sn;
      }
    }
#pragma unroll
    for (int c = 0; c < 8; ++c) {
      uint4 o;
      float y[8];
#pragma unroll
      for (int e = 0; e < 8; ++e) y[e] = c < 2 ? y0[c * 8 + e] : bf2f(v[c].h[e]) * rs * gain[c * 8 + e];
      o.x = pack2(y[0], y[1]); o.y = pack2(y[2], y[3]); o.z = pack2(y[4], y[5]); o.w = pack2(y[6], y[7]);
      *(uint4*)(rowp + c * 8) = o;
    }
  }
  {
    u16* tt = (u16*)smem;
    uint4 vr[4][2];
#pragma unroll
    for (int z = 0; z < 4; ++z) {
      const int col = ((z >> 1) ? C_VWIN : C_VSLC) + (z & 1) * 64;
#pragma unroll
      for (int k = 0; k < 2; ++k) {
        const int q = tid + k * 256, i = q >> 3, c8 = q & 7;
        vr[z][k] = *(const uint4*)(proj + (tok0 + i) * PJ + col + c8 * 8);
      }
    }
#pragma unroll
    for (int z = 0; z < 4; ++z)
#pragma unroll
      for (int k = 0; k < 2; ++k) {
        const int q = tid + k * 256, i = q >> 3, c8 = q & 7;
        *(uint4*)(tt + (z * 64 + i) * 72 + c8 * 8) = vr[z][k];
      }
    __syncthreads();
#pragma unroll
    for (int z = 0; z < 4; ++z) {
      const int tensor = z >> 1, g = z & 1;
      u16* dst = (u16*)(p->ws + OFF_VT + (size_t)tensor * 8 * MiB) + ((size_t)((b * 2 + g) * 256 + blk)) * 4096;
#pragma unroll
      for (int k = 0; k < 2; ++k) {
        const int q = tid + k * 256, d = q >> 3, i8 = q & 7;
        union { uint4 v; u16 h[8]; } o;
#pragma unroll
        for (int e = 0; e < 8; ++e) {
          const int ok_ = (i8 >> 2) * 32 + (e < 4 ? (i8 & 3) * 4 + e : 16 + (i8 & 3) * 4 + e - 4);
          o.h[e] = tt[(z * 64 + ok_) * 72 + d];
        }
        *(uint4*)(dst + d * 64 + i8 * 8) = o.v;
      }
    }
    __syncthreads();
  }
  {
    const int cg8 = (tid & 31) * 8, t8 = (tid >> 5) * 8;
    u16* mix = (u16*)(p->ws + OFF_H);
    union U8 { uint4 v; u16 h[8]; };
    U8 cc[10], cx[10], cb[8];
#pragma unroll
    for (int k = 0; k < 10; ++k) {
      const int rel = t8 + k - 2;
      const bool ok = (blk > 0) || (rel >= 0);
      const size_t tk = ok ? (tok0 + rel) : tok0;
      cc[k].v = *(const uint4*)(proj + tk * PJ + C_CC + cg8);
      cx[k].v = *(const uint4*)(proj + tk * PJ + C_CX + cg8);
    }
#pragma unroll
    for (int k = 0; k < 8; ++k) cb[k].v = *(const uint4*)(proj + (tok0 + t8 + k) * PJ + C_CB + cg8);
    float w0[8], w1[8], w2[8];
    {
      const float* cw = p->conv_w + (size_t)l * 3 * 256 + cg8;
#pragma unroll
      for (int e = 0; e < 8; ++e) { w0[e] = cw[e]; w1[e] = cw[256 + e]; w2[e] = cw[512 + e]; }
    }
    float pr[10][8];
#pragma unroll
    for (int k = 0; k < 10; ++k) {
      const bool ok = (blk > 0) || (t8 + k - 2 >= 0);
#pragma unroll
      for (int e = 0; e < 8; ++e) pr[k][e] = ok ? bf2f(cc[k].h[e]) * bf2f(cx[k].h[e]) : 0.f;
    }
#pragma unroll
    for (int k = 0; k < 8; ++k) {
      float y[8];
#pragma unroll
      for (int e = 0; e < 8; ++e)
        y[e] = bf2f(cb[k].h[e]) * (w0[e] * pr[k][e] + w1[e] * pr[k + 1][e] + w2[e] * pr[k + 2][e]);
      uint4 o;
      o.x = pack2(y[0], y[1]); o.y = pack2(y[2], y[3]); o.z = pack2(y[4], y[5]); o.w = pack2(y[6], y[7]);
      *(uint4*)(mix + (tok0 + t8 + k) * DM + 768 + cg8) = o;
    }
  }
}

__device__ __forceinline__ void nsa_compress(KP p, int l, char* smem, int job) {
  const int tid = otid(), lane = tid & 63, wv = tid >> 6, l15 = lane & 15, quad = lane >> 4;
  const int which = job >> 6, b = (job >> 5) & 1, g = (job >> 4) & 1, tile = job & 15;
  const u16* proj = (const u16*)(p->ws + OFF_PROJ);
  const u16* W1T = (const u16*)(p->ws + OFF_W + W_C1) + (size_t)which * 64 * 2048;
  const u16* W2T = (const u16*)(p->ws + OFF_W + W_C2) + which * 4096;
  const float* pe = p->cmp_pe + (size_t)(l * 2 + which) * 32 * 64;
  const int blk0 = tile * 64 + wv * 16;
  int blk = blk0 + l15;
  int blkc = blk < 1023 ? blk : 1022;
  const u16* arow = proj + ((size_t)b * T + blkc * 16) * PJ + (which ? C_VCMP : C_KCMP) + g * 64;
  f32x4 acc[4];
#pragma unroll
  for (int n = 0; n < 4; ++n) acc[n] = f32x4{0.f, 0.f, 0.f, 0.f};
  for (int ks0 = 0; ks0 < 64; ks0 += 4) {
    uint4 raw[4];
    float4 pea[4], peb[4];
    bf16x8 bfr[4][4];
#pragma unroll
    for (int u = 0; u < 4; ++u) {
      const int ks = ks0 + u, tok = ks >> 1, d0 = (ks & 1) * 32 + quad * 8;
      raw[u] = *(const uint4*)(arow + (size_t)tok * PJ + d0);
      pea[u] = *(const float4*)(pe + tok * 64 + d0);
      peb[u] = *(const float4*)(pe + tok * 64 + d0 + 4);
#pragma unroll
      for (int n = 0; n < 4; ++n) bfr[u][n] = *(const bf16x8*)(W1T + (size_t)(n * 16 + l15) * 2048 + ks * 32 + quad * 8);
    }
#pragma unroll
    for (int u = 0; u < 4; ++u) {
      union { bf16x8 v; u32 w[4]; } af;
      af.w[0] = pack2(bf2f(raw[u].x & 0xffff) + pea[u].x, bf2f(raw[u].x >> 16) + pea[u].y);
      af.w[1] = pack2(bf2f(raw[u].y & 0xffff) + pea[u].z, bf2f(raw[u].y >> 16) + pea[u].w);
      af.w[2] = pack2(bf2f(raw[u].z & 0xffff) + peb[u].x, bf2f(raw[u].z >> 16) + peb[u].y);
      af.w[3] = pack2(bf2f(raw[u].w & 0xffff) + peb[u].z, bf2f(raw[u].w >> 16) + peb[u].w);
#pragma unroll
      for (int n = 0; n < 4; ++n) acc[n] = mfma16(af.v, bfr[u][n], acc[n]);
    }
  }
  u16* hid = (u16*)smem + wv * 16 * 72;
#pragma unroll
  for (int n = 0; n < 4; ++n)
#pragma unroll
    for (int r = 0; r < 4; ++r) {
      float x = acc[n][r];
      float u = 0.7978845608028654f * (x + 0.044715f * x * x * x);
      float gl = 0.5f * x * (1.f + tanhf(u));
      hid[(quad * 4 + r) * 72 + n * 16 + l15] = f2bf(gl);
    }
  __syncthreads();
  f32x4 o2[4];
#pragma unroll
  for (int n = 0; n < 4; ++n) o2[n] = f32x4{0.f, 0.f, 0.f, 0.f};
#pragma unroll
  for (int ks = 0; ks < 2; ++ks) {
    bf16x8 af = *(const bf16x8*)(hid + l15 * 72 + ks * 32 + quad * 8);
#pragma unroll
    for (int n = 0; n < 4; ++n) {
      bf16x8 bfr = *(const bf16x8*)(W2T + (n * 16 + l15) * 64 + ks * 32 + quad * 8);
      o2[n] = mfma16(af, bfr, o2[n]);
    }
  }
  __syncthreads();
  if (which == 0) {
    u16* KC = (u16*)(p->ws + OFF_KC) + (size_t)(b * 2 + g) * 1024 * 64;
    const float* kg = p->nsa_k_norm + (l * 3 + 0) * 64;
#pragma unroll
    for (int r = 0; r < 4; ++r) {
      float ss = 0.f;
#pragma unroll
      for (int n = 0; n < 4; ++n) ss += o2[n][r] * o2[n][r];
      ss += __shfl_xor(ss, 1); ss += __shfl_xor(ss, 2); ss += __shfl_xor(ss, 4); ss += __shfl_xor(ss, 8);
      float rs = rsqrtf(ss * (1.f / 64.f) + 1e-6f);
      int row = blk0 + quad * 4 + r;
#pragma unroll
      for (int n = 0; n < 4; ++n) {
        float v = row < 1023 ? o2[n][r] * rs * kg[n * 16 + l15] : 0.f;
        KC[(size_t)row * 64 + n * 16 + l15] = f2bf(v);
      }
    }
  } else {
    u16* VCT = (u16*)(p->ws + OFF_KC + 524288) + (size_t)(b * 2 + g) * 64 * 1024;
#pragma unroll
    for (int r = 0; r < 4; ++r) {
      int row = blk0 + quad * 4 + r;
#pragma unroll
      for (int n = 0; n < 4; ++n) {
        float v = row < 1023 ? o2[n][r] : 0.f;
        const int k32_ = row & 31;
        const int kp_ = k32_ < 16 ? (k32_ >> 2) * 8 + (k32_ & 3) : ((k32_ - 16) >> 2) * 8 + 4 + (k32_ & 3);
        VCT[(size_t)(n * 16 + l15) * 1024 + (row & ~31) + kp_] = f2bf(v);
      }
    }
  }
}

template <int MODE, int NT>
__device__ __forceinline__ void flash2(const u16* __restrict__ Kg, int kld, const u16* __restrict__ VTg, int vblk,
                                       int vld, int h0, int h1, char* sStage, const u16* sQw, f32x4 (&O)[4][NT],
                                       float (&lsum)[NT], const float (&inv)[NT], const u32* sSelw, float* slc,
                                       int tq0) {
  const int tid = otid(), lane = tid & 63, wv = tid >> 6, l15 = lane & 15, quad = lane >> 4;
  const int krow = tid >> 3, kc = tid & 7;
  const u16* kptr = Kg + (size_t)krow * kld + kc * 8;
  const int kw = krow * 128 + ((kc ^ ((krow >> 1) & 7)) * 16);
  const int vd = tid >> 2, vc = tid & 3;
  const u16* vptr = VTg + (size_t)vd * vld + vc * 8;
  const int vw = 4096 + vd * 64 + ((vc ^ ((0x1320 >> (4 * ((vd >> 2) & 3))) & 3)) * 16);
  const int jb0 = h0 >> 1, nst = (h1 >> 1) - jb0 + 1;
  uint4 S0k0, S0k1, S0v0, S0v1, S1k0, S1k1, S1v0, S1v1;
#define F2_LOAD(S, i_)                                                                             \
  do {                                                                                             \
    const int jb_ = jb0 + (i_);                                                                    \
    S##k0 = *(const uint4*)(kptr + (size_t)(jb_ * 64) * kld);                                      \
    S##k1 = *(const uint4*)(kptr + (size_t)(jb_ * 64 + 32) * kld);                                 \
    if (MODE != 2) {                                                                               \
      S##v0 = *(const uint4*)(vptr + (size_t)jb_ * vblk);                                          \
      S##v1 = *(const uint4*)(vptr + (size_t)jb_ * vblk + 32);                                     \
    }                                                                                              \
  } while (0)
#define F2_WRITE(S, slot_)                                                     \
  do {                                                                         \
    char* sl_ = sStage + (slot_) * 16384;                                      \
    *(uint4*)(sl_ + kw) = S##k0;                                               \
    *(uint4*)(sl_ + 8192 + kw) = S##k1;                                        \
    if (MODE != 2) {                                                           \
      *(uint4*)(sl_ + vw) = S##v0;                                             \
      *(uint4*)(sl_ + 8192 + vw) = S##v1;                                      \
    }                                                                          \
  } while (0)
  if (0 < nst) F2_LOAD(S0, 0);
  if (1 < nst) F2_LOAD(S1, 1);
  const int koff = l15 * 128;
  const int ksw = (l15 >> 1) & 7;
  const int voff = 4096 + l15 * 64 + ((quad ^ ((0x1320 >> (4 * ((l15 >> 2) & 3))) & 3)) * 16);
  const int tq0u = __builtin_amdgcn_readfirstlane(tq0);
  const int lim0u = tq0u >= 31 ? ((tq0u - 31) >> 4) : -1;
  bf16x8 bqr[NT][2];
#pragma unroll
  for (int nt = 0; nt < NT; ++nt) {
    bqr[nt][0] = *(const bf16x8*)(sQw + (nt * 16 + l15) * 72 + quad * 8);
    bqr[nt][1] = *(const bf16x8*)(sQw + (nt * 16 + l15) * 72 + 32 + quad * 8);
  }
  f32x4 Lacc[NT];
#pragma unroll
  for (int nt = 0; nt < NT; ++nt) Lacc[nt] = f32x4{0.f, 0.f, 0.f, 0.f};
  bf16x8 ones_;
  { u32 o1 = 0x3f803f80u; asm volatile("" : "+v"(o1)); union { bf16x8 v; u32 u[4]; } oo; oo.u[0] = o1; oo.u[1] = o1; oo.u[2] = o1; oo.u[3] = o1; ones_ = oo.v; }
  auto compute = [&](const int h, const char* st) __attribute__((always_inline)) {
    bool interior;
    if (MODE == 0) interior = (h * 32 + 31 <= tq0u) && (h * 32 > tq0u + NT * 4 - 1 - 512);
    else if (MODE == 1) interior = (h * 32 + 31 <= tq0u);
    else interior = (h * 32 + 31 <= lim0u);
    bool bv[NT], an[NT];
    bool anyw = false;
#pragma unroll
    for (int nt = 0; nt < NT; ++nt) {
      if (MODE == 1) {
        u32 w = sSelw[(nt * 4 + (l15 >> 2)) * 8 + (h >> 6)];
        bv[nt] = (w >> ((h >> 1) & 31)) & 1u;
      } else {
        bv[nt] = true;
      }
      an[nt] = MODE == 1 ? (bool)__any(bv[nt]) : true;
      anyw |= an[nt];
    }
    if (anyw) {
      bf16x8 kf[2][2], vf[4];
#pragma unroll
      for (int m2 = 0; m2 < 2; ++m2)
#pragma unroll
        for (int ks = 0; ks < 2; ++ks)
          kf[m2][ks] = *(const bf16x8*)(st + koff + m2 * 2048 + (((ks * 4 + quad) ^ ksw) * 16));
      if (MODE != 2) {
#pragma unroll
        for (int dt = 0; dt < 4; ++dt) vf[dt] = *(const bf16x8*)(st + voff + dt * 1024);
      }
#pragma unroll
      for (int nt = 0; nt < NT; ++nt) {
        if (!an[nt]) continue;
        const int t = tq0 + nt * 4 + (l15 >> 2);
        const bf16x8 bq0 = bqr[nt][0], bq1 = bqr[nt][1];
        f32x4 s[2];
#pragma unroll
        for (int m2 = 0; m2 < 2; ++m2) {
          s[m2] = f32x4{0.f, 0.f, 0.f, 0.f};
          s[m2] = mfma16(kf[m2][0], bq0, s[m2]);
          s[m2] = mfma16(kf[m2][1], bq1, s[m2]);
        }
        const float bias = MODE == 3 ? inv[nt] : 0.f;
        if (interior) {
#pragma unroll
          for (int m2 = 0; m2 < 2; ++m2)
#pragma unroll
            for (int r = 0; r < 4; ++r)
              s[m2][r] = MODE <= 1 ? __builtin_amdgcn_exp2f(s[m2][r])
                                   : __builtin_amdgcn_exp2f(fmaf(s[m2][r], SC2, bias));
        } else {
          int base;
          if (MODE <= 1) base = h * 32 + quad * 4 - t;
          else base = h * 32 + quad * 4 - (t >= 31 ? ((t - 31) >> 4) : -1);
          asm volatile("" : "+v"(base));
#pragma unroll
          for (int m2 = 0; m2 < 2; ++m2)
#pragma unroll
            for (int r = 0; r < 4; ++r) {
              const int C = m2 * 16 + r;
              bool valid;
              if (MODE == 0) valid = base <= -C && base > -512 - C;
              else valid = base <= -C;
              float pvv = MODE <= 1 ? __builtin_amdgcn_exp2f(s[m2][r]) : __builtin_amdgcn_exp2f(fmaf(s[m2][r], SC2, bias));
              s[m2][r] = valid ? pvv : 0.f;
            }
        }
        if (MODE == 2) {
          float ls = ((s[0][0] + s[0][1]) + (s[0][2] + s[0][3])) + ((s[1][0] + s[1][1]) + (s[1][2] + s[1][3]));
          lsum[nt] += ls;
        }
        if (MODE == 3) {
#pragma unroll
          for (int m2 = 0; m2 < 2; ++m2) {
            float ow = s[m2][0] + s[m2][1] + s[m2][2] + 0.5f * s[m2][3];
            float sp = 0.5f * s[m2][3];
            ow += dpp_xor1(ow); ow += dpp_xor2(ow);
            sp += dpp_xor1(sp); sp += dpp_xor2(sp);
            if ((l15 & 3) == 0) {
              const int j = h * 8 + m2 * 4 + quad;
              slc[(nt * 4 + (l15 >> 2)) * 256 + j] = ow;
              if (j + 1 < 256) slc[1024 + (nt * 4 + (l15 >> 2)) * 256 + j + 1] = sp;
            }
          }
        }
        if (MODE != 2) {
          bf16x8 P = pack8(s[0], s[1]);
          if (MODE == 1) {
            union { bf16x8 v; u32 u[4]; } pm; pm.v = P;
            const u32 keep = bv[nt] ? 0xffffffffu : 0u;
            pm.u[0] &= keep; pm.u[1] &= keep; pm.u[2] &= keep; pm.u[3] &= keep;
            P = pm.v;
          }
#pragma unroll
          for (int dt = 0; dt < 4; ++dt) O[dt][nt] = mfma16(vf[dt], P, O[dt][nt]);
          if (MODE <= 1) Lacc[nt] = mfma16(ones_, P, Lacc[nt]);
        }
      }
    }
  };
  if (0 < nst) F2_WRITE(S0, 0);
  if (2 < nst) F2_LOAD(S0, 2);
  RAW_BAR();
#define F2_ITER(u_, SN, sn_)                                            \
  if (i + (u_) < nst) {                                                 \
    const int ii_ = i + (u_);                                           \
    if (ii_ + 1 < nst) F2_WRITE(SN, sn_);                               \
    if (ii_ + 3 < nst) F2_LOAD(SN, ii_ + 3);                            \
    compute(2 * (jb0 + ii_), sStage + (u_) * 16384);                    \
    compute(2 * (jb0 + ii_) + 1, sStage + (u_) * 16384 + 8192);         \
    RAW_BAR();                                                          \
  }
  for (int i = 0; i < nst; i += 2) {
    F2_ITER(0, S1, 1)
    F2_ITER(1, S0, 0)
  }
  if (MODE <= 1) {
#pragma unroll
    for (int nt = 0; nt < NT; ++nt) lsum[nt] += Lacc[nt][0] * 0.25f;
  }
}

__device__ __forceinline__ void nsa_phase_c(KP p, int l, char* smem) {
  const int tid = otid(), lane = tid & 63, wv = tid >> 6, l15 = lane & 15, quad = lane >> 4;
  char* sStage = smem;
  u16* sQw = (u16*)(smem + 32768) + wv * 16 * 72;
  float* own = (float*)(smem + 32768 + 9216) + wv * 2048;
  float* spl = own + 1024;
  const u16* proj = (const u16*)(p->ws + OFF_PROJ);
  const float* small_ = (const float*)(p->ws + OFF_SMALL);
  float* OC = (float*)(p->ws + OFF_OC);
  u32* SEL = (u32*)(p->ws + OFF_SEL);
  for (int job = obid(); job < 4096; job += gridDim.x) {
    const int qt = 1023 - (job >> 2), bg = job & 3, b = bg >> 1, g = bg & 1;
    const int t0 = qt * 16 + wv * 4;
    const int ql = l15 >> 2, r_ = l15 & 3, head = g * 4 + r_;
    const int t = t0 + ql;
    const size_t tok = (size_t)b * T + t;
    const u16* KC = (const u16*)(p->ws + OFF_KC) + (size_t)bg * 1024 * 64;
    const u16* VCT = (const u16*)(p->ws + OFF_KC + 524288) + (size_t)bg * 64 * 1024;
    {
      const u16* qrow = proj + tok * PJ + C_NQ + head * 64;
      *(bf16x8*)(sQw + l15 * 72 + quad * 8) = *(const bf16x8*)(qrow + quad * 8);
      *(bf16x8*)(sQw + l15 * 72 + 32 + quad * 8) = *(const bf16x8*)(qrow + 32 + quad * 8);
    }
    const int tmax = qt * 16 + 15;
    const int nvmax = tmax >= 31 ? ((tmax - 31) >> 4) + 1 : 0;
    const int h1 = ((nvmax + 31) >> 5) - 1;
    f32x4 O[4][1];
    float lsum[1] = {0.f}, inv[1] = {0.f};
#pragma unroll
    for (int dt = 0; dt < 4; ++dt) O[dt][0] = f32x4{0.f, 0.f, 0.f, 0.f};
    if (h1 >= 0) {
      flash2<2, 1>(KC, 64, VCT, 64, 1024, 0, h1, sStage, sQw, O, lsum, inv, nullptr, own, t0);
      float ls = lsum[0];
      ls += __shfl_xor(ls, 16);
      ls += __shfl_xor(ls, 32);
      inv[0] = ls > 0.f ? -log2f(ls) : -1000.f;
      flash2<3, 1>(KC, 64, VCT, 64, 1024, 0, h1, sStage, sQw, O, lsum, inv, nullptr, own, t0);
    }
    {
      float gc = ZTEST == 1 ? 0.f : sigmoidf_(small_[tok * 32 + 8 + head * 3 + 0]);
#pragma unroll
      for (int dt = 0; dt < 4; ++dt) {
        float4 o = make_float4(O[dt][0][0] * gc, O[dt][0][1] * gc, O[dt][0][2] * gc, O[dt][0][3] * gc);
        *(float4*)(OC + tok * 512 + head * 64 + dt * 16 + quad * 4) = o;
      }
    }
    __builtin_amdgcn_wave_barrier();
    for (int q = 0; q < 4; ++q) {
      const int tq = t0 + q, cur = tq >> 6;
      u32 word = 0;
      if (cur <= 15) {
        if (lane == 0) word = (2u << cur) - 1u;
      } else {
        u32 key[4];
#pragma unroll
        for (int k = 0; k < 4; ++k) {
          int j = lane + 64 * k;
          float v = own[q * 256 + j] + spl[q * 256 + j];
          key[k] = (j >= 1 && j <= cur - 2) ? (__float_as_uint(fmaxf(v, 0.f)) + 1u) : 0u;
        }
        u32 T = 0u;
        for (int bit = 30; bit >= 0; --bit) {
          const u32 cand = T | (1u << bit);
          int cnt = 0;
#pragma unroll
          for (int k = 0; k < 4; ++k) cnt += __popcll(__ballot(key[k] >= cand));
          if (cnt >= 13) T = cand;
        }
        int ngt = 0;
#pragma unroll
        for (int k = 0; k < 4; ++k) ngt += __popcll(__ballot(key[k] > T));
        int quota = 13 - ngt;
        const unsigned long long lt = (1ull << lane) - 1ull;
#pragma unroll
        for (int k = 0; k < 4; ++k) {
          const unsigned long long me = __ballot(key[k] == T);
          const bool take = key[k] > T || (key[k] == T && (int)__popcll(me & lt) < quota);
          const int ne = (int)__popcll(me);
          quota = quota > ne ? quota - ne : 0;
          const unsigned long long sm = __ballot(take);
          if (lane == 2 * k) word = (u32)sm;
          if (lane == 2 * k + 1) word = (u32)(sm >> 32);
        }
        if (lane == 0) word |= 1u;
        if (lane == (cur >> 5)) word |= 1u << (cur & 31);
        if (lane == ((cur - 1) >> 5)) word |= 1u << ((cur - 1) & 31);
      }
      if (lane < 8) SEL[(((size_t)b * 16384 + tq) * 2 + g) * 8 + lane] = word;
    }
    __builtin_amdgcn_wave_barrier();
  }
}

__device__ __forceinline__ void nsa_s_tile(KP p, int l, char* smem, int tile) {
  const int cur = 255 - (tile >> 2), bg = tile & 3, b = bg >> 1, g = bg & 1;
  const int tid = otid(), lane = tid & 63, wv = tid >> 6, l15 = lane & 15, quad = lane >> 4;
  char* sStage = smem;
  u16* sQw = (u16*)(smem + 32768) + wv * 64 * 72;
  u32* sSel = (u32*)(smem + 32768 + 36864);
  const u32* sSelw = sSel + wv * 16 * 8;
  const u16* proj = (const u16*)(p->ws + OFF_PROJ);
  const float* small_ = (const float*)(p->ws + OFF_SMALL);
  const float* rope = (const float*)(p->ws + OFF_ROPE);
  float* OC = (float*)(p->ws + OFF_OC);
  u16* mix = (u16*)(p->ws + OFF_H);
  const size_t tokb = (size_t)b * T;
  const int tq0 = cur * 64 + wv * 16;
  const int r_ = l15 & 3, head = g * 4 + r_;
  {
    const u32* SEL = (const u32*)(p->ws + OFF_SEL);
    int q = tid >> 2, w2 = (tid & 3) * 2;
    uint2 v = *(const uint2*)(SEL + ((tokb + cur * 64 + q) * 2 + g) * 8 + w2);
    *(uint2*)(sSel + q * 8 + w2) = v;
  }
#pragma unroll
  for (int nt = 0; nt < 4; ++nt) {
    const size_t tok = tokb + tq0 + nt * 4 + (l15 >> 2);
    const u16* qrow = proj + tok * PJ + C_NQ + head * 64;
    u16* qd = sQw + (nt * 16 + l15) * 72;
    {
      union { bf16x8 v; u16 h[8]; } xi, xo;
      xi.v = *(const bf16x8*)(qrow + 32 + quad * 8);
#pragma unroll
      for (int i = 0; i < 8; ++i) xo.h[i] = f2bf(bf2f(xi.h[i]) * SC2);
      *(bf16x8*)(qd + 32 + quad * 8) = xo.v;
    }
    if (quad >= 2) {
      union { bf16x8 v; u16 h[8]; } xi, xo;
      xi.v = *(const bf16x8*)(qrow + quad * 8);
#pragma unroll
      for (int i = 0; i < 8; ++i) xo.h[i] = f2bf(bf2f(xi.h[i]) * SC2);
      *(bf16x8*)(qd + quad * 8) = xo.v;
    } else {
      union { bf16x8 v; u16 h[8]; } x1, x2, o;
      x1.v = *(const bf16x8*)(qrow);
      x2.v = *(const bf16x8*)(qrow + 8);
      const float* rp = rope + tok * 16;
#pragma unroll
      for (int i = 0; i < 8; ++i) {
        float a = bf2f(x1.h[i]), bb = bf2f(x2.h[i]), c = rp[i], sn = rp[8 + i];
        o.h[i] = f2bf((quad == 0 ? a * c - bb * sn : bb * c + a * sn) * SC2);
      }
      *(bf16x8*)(qd + quad * 8) = o.v;
    }
  }
  f32x4 O[4][4];
  float lsum[4], inv[4] = {0.f, 0.f, 0.f, 0.f};
#pragma unroll
  for (int dt = 0; dt < 4; ++dt)
#pragma unroll
    for (int nt = 0; nt < 4; ++nt) O[dt][nt] = f32x4{0.f, 0.f, 0.f, 0.f};
#pragma unroll
  for (int nt = 0; nt < 4; ++nt) lsum[nt] = 0.f;
  {
    const u16* Kg = proj + tokb * PJ + C_KWIN + g * 64;
    const u16* VTg = (const u16*)(p->ws + OFF_VT + 8 * MiB) + (size_t)(bg * 256) * 4096;
    int h0 = 2 * cur - 16 < 0 ? 0 : 2 * cur - 16;
    flash2<0, 4>(Kg, PJ, VTg, 4096, 64, h0, 2 * cur + 1, sStage, sQw, O, lsum, inv, sSelw, nullptr, tq0);
  }
#pragma unroll
  for (int nt = 0; nt < 4; ++nt) {
    const size_t tok = tokb + tq0 + nt * 4 + (l15 >> 2);
    float ls = lsum[nt];
    ls += __shfl_xor(ls, 16);
    ls += __shfl_xor(ls, 32);
    float sc = ZTEST == 2 ? 0.f : sigmoidf_(small_[tok * 32 + 8 + head * 3 + 2]) / ls;
#pragma unroll
    for (int dt = 0; dt < 4; ++dt) {
      float4* op = (float4*)(OC + tok * 512 + head * 64 + dt * 16 + quad * 4);
      float4 o = *op;
      o.x += O[dt][nt][0] * sc; o.y += O[dt][nt][1] * sc; o.z += O[dt][nt][2] * sc; o.w += O[dt][nt][3] * sc;
      *op = o;
      O[dt][nt] = f32x4{0.f, 0.f, 0.f, 0.f};
    }
    lsum[nt] = 0.f;
  }
  {
    const u16* Kg = proj + tokb * PJ + C_KSLC + g * 64;
    const u16* VTg = (const u16*)(p->ws + OFF_VT) + (size_t)(bg * 256) * 4096;
    flash2<1, 4>(Kg, PJ, VTg, 4096, 64, 0, 2 * cur + 1, sStage, sQw, O, lsum, inv, sSelw, nullptr, tq0);
  }
#pragma unroll
  for (int nt = 0; nt < 4; ++nt) {
    const size_t tok = tokb + tq0 + nt * 4 + (l15 >> 2);
    float ls = lsum[nt];
    ls += __shfl_xor(ls, 16);
    ls += __shfl_xor(ls, 32);
    float sc = ZTEST == 3 ? 0.f : sigmoidf_(small_[tok * 32 + 8 + head * 3 + 1]) / ls;
#pragma unroll
    for (int dt = 0; dt < 4; ++dt) {
      float4 o = *(const float4*)(OC + tok * 512 + head * 64 + dt * 16 + quad * 4);
      uint2 w;
      w.x = pack2(o.x + O[dt][nt][0] * sc, o.y + O[dt][nt][1] * sc);
      w.y = pack2(o.z + O[dt][nt][2] * sc, o.w + O[dt][nt][3] * sc);
      *(uint2*)(mix + tok * DM + 256 + head * 64 + dt * 16 + quad * 4) = w;
    }
  }
}


#define XB_TMO      128
#define XB_XCNT(j)  (256  + 64 * (j))
#define XB_XSUB(j)  (1280 + 64 * (j))
#define XB_XGEN(j)  (2304 + 64 * (j))
#define XB_TOP      3328
#define XB_TOPGEN   3392
#define XCD_BAR_WORDS 3456
#define XB_SPIN_CAP (1u << 18)
#define LAS __attribute__((address_space(3)))
__device__ __forceinline__ unsigned xb_ld(unsigned* p) { return __hip_atomic_load(p, __ATOMIC_RELAXED, __HIP_MEMORY_SCOPE_AGENT); }
__device__ __forceinline__ unsigned xb_add(unsigned* p, unsigned v) { return __hip_atomic_fetch_add(p, v, __ATOMIC_RELAXED, __HIP_MEMORY_SCOPE_AGENT); }
__device__ __forceinline__ unsigned xb_xcc_id() { return (unsigned)__builtin_amdgcn_s_getreg((3 << 11) | 20) & 0xFu; }
#define XB_SPIN(cond, bar) do { unsigned _sp = 0; while (cond) { __builtin_amdgcn_s_sleep(1); \
    if ((++_sp & 255u) == 0u) { if (xb_ld(&(bar)[XB_TMO])) break; if (_sp > XB_SPIN_CAP) { atomicAdd(&(bar)[XB_TMO], 1u); break; } } } } while (0)
struct XcdBarrier { unsigned* bar; unsigned x; volatile LAS unsigned* st; };
__device__ __forceinline__ XcdBarrier xcd_barrier_post(unsigned* bar, volatile LAS unsigned* st) {
  XcdBarrier b; b.bar = bar; b.x = xb_xcc_id(); b.st = st;
  if (threadIdx.x == 0) (void)xb_add(&bar[XB_XCNT(b.x)], 1u);
  return b;
}
__device__ __forceinline__ void xcd_barrier_complete(unsigned* bar, unsigned x, unsigned& nloc, unsigned& nx) {
  const unsigned G = gridDim.x * gridDim.y * gridDim.z;
  unsigned sum, cnt, mine, sp = 0u;
  for (;;) {
    sum = 0u; cnt = 0u; mine = 0u;
#pragma unroll
    for (unsigned j = 0; j < 16; ++j) { const unsigned c = xb_ld(&bar[XB_XCNT(j)]); sum += c; cnt += (c > 0u) ? 1u : 0u; mine = (j == x) ? c : mine; }
    if (sum == G) break;
    __builtin_amdgcn_s_sleep(1);
    if ((++sp & 255u) == 0u) { if (xb_ld(&bar[XB_TMO])) break; if (sp > XB_SPIN_CAP) { atomicAdd(&bar[XB_TMO], 1u); break; } }
  }
  nloc = mine > 0u ? mine : 1u; nx = cnt > 0u ? cnt : 1u;
}
__device__ __forceinline__ void xcd_barrier(const XcdBarrier& b) {
  asm volatile("s_waitcnt vmcnt(0)" ::: "memory");
  __syncthreads();
  if (threadIdx.x == 0) {
    unsigned* bar = b.bar;
    __builtin_amdgcn_s_waitcnt(0);
    unsigned nloc = b.st[0], nx = b.st[1];
    if (nloc == 0u) { xcd_barrier_complete(bar, b.x, nloc, nx); b.st[0] = nloc; b.st[1] = nx; }
    const unsigned old = xb_add(&bar[XB_XSUB(b.x)], 1u);
    const unsigned gen = old / nloc;
    if (old + 1u == (gen + 1u) * nloc) {
      __builtin_amdgcn_fence(__ATOMIC_RELEASE, "agent");
      asm volatile("s_waitcnt vmcnt(0)" ::: "memory");
      const unsigned og = xb_add(&bar[XB_TOP], 1u);
      const unsigned tg = og / nx;
      if (og + 1u == (tg + 1u) * nx) xb_add(&bar[XB_TOPGEN], 1u);
      else XB_SPIN(xb_ld(&bar[XB_TOPGEN]) == tg, bar);
      __builtin_amdgcn_fence(__ATOMIC_ACQUIRE, "agent");
      xb_add(&bar[XB_XGEN(b.x)], 1u);
      asm volatile("s_waitcnt vmcnt(0)" ::: "memory");
    } else {
      XB_SPIN(xb_ld(&bar[XB_XGEN(b.x)]) == gen, bar);
      __builtin_amdgcn_fence(__ATOMIC_ACQUIRE, "agent");
      asm volatile("s_waitcnt vmcnt(0)" ::: "memory");
    }
  }
  __syncthreads();
}
#ifndef REPE
#define REPE 1
#endif
#ifndef REP3C
#define REP3C 1
#endif
#ifndef REP3
#define REP3 1
#endif
#ifndef XSYNC
#define XSYNC 0
#endif
#ifndef REP4
#define REP4 1
#endif
#ifndef REPSCAN
#define REPSCAN 1
#endif
#ifndef REPG
#define REPG 1
#endif
__global__ void __launch_bounds__(256, 2) hymba_mega(Params p_unused) {
  cg::grid_group grid = cg::this_grid();
  __shared__ uint4 xb_words;
  if (threadIdx.x == 0) xb_words = make_uint4(0u, 0u, 0u, 0u);
  __syncthreads();
  XcdBarrier xb = xcd_barrier_post((unsigned*)(kargs()->ws + OFF_CNT + 4096), (volatile LAS unsigned*)&xb_words);
  __shared__ __attribute__((aligned(16))) char smem[77824];
  __shared__ int s_tile;
  { KP p = kargs(); rope_table(p); }
  grid.sync();
#pragma unroll 1
  for (int l = 0; l < DEPTH; ++l) {
    {
      KP p = kargs();
      if (blockIdx.x == 0 && threadIdx.x == 0) { u32 z0 = 0u; asm volatile("" : "+v"(z0)); ((u32*)(p->ws + OFF_CNT))[0] = z0; }
      for (int re = 0; re < REPE; ++re) {
      convert_weights(p, l, smem);
      rmsnorm_rows(l == 0 ? p->x_in : p->out, p->attn_norm + l * DM, (u16*)(p->ws + OFF_H));
      }
    }
    xcd_barrier(xb);
    {
      KP p = kargs();
      for (int rep = 0; rep < REPG; ++rep)
      gemm_phase((const u16*)(p->ws + OFF_H), DM, (const u16*)(p->ws + OFF_W + W_IN), DM, DM, 128, 25, smem,
                 EpiInProj{(u16*)(p->ws + OFF_PROJ), (float*)(p->ws + OFF_SMALL)});
    }
    xcd_barrier(xb);
    {
      KP p = kargs();
      for (int job = obid(); job < 2048 + 512 + 128; job += gridDim.x) {
        if (job < 2048) gdn_chunk_prep(p, l, smem, job);
        else if (job < 2560) nsa_token_prep(p, l, smem, job - 2048);
        else nsa_compress(p, l, smem, job - 2560);
      }
    }
    xcd_barrier(xb);
#ifndef REP45
#define REP45 1
#endif
    for (int rep = 0; rep < REP45; ++rep) {
    {
      KP p = kargs();
      if (blockIdx.x == 0 && threadIdx.x == 0) { u32 z0 = 0u; asm volatile("" : "+v"(z0)); ((u32*)(p->ws + OFF_CNT))[0] = z0; }
      for (int r4 = 0; r4 < REP4; ++r4) nsa_phase_c(p, l, smem);
    }
    xcd_barrier(xb);
    {
      KP p = kargs();
      if (obid() < 32) for (int rs = 0; rs < REPSCAN; ++rs) gdn_scan(p, smem, obid());
      u32* CNT = (u32*)(p->ws + OFF_CNT);
      for (;;) {
        __syncthreads();
        if (threadIdx.x == 0) s_tile = (int)atomicAdd(&CNT[0], 1u);
        __syncthreads();
        int tile = s_tile;
        if (tile >= 1024) break;
        nsa_s_tile(p, l, smem, tile);
      }
    }
    xcd_barrier(xb);
    }
    {
      KP p = kargs();
      for (int re = 0; re < REPE; ++re) gdn_finalize(p, l);
      for (int xs = 0; xs < XSYNC; ++xs) xcd_barrier(xb);
    }
    xcd_barrier(xb);
    {
      KP p = kargs();
      gemm_phase((const u16*)(p->ws + OFF_H), DM, (const u16*)(p->ws + OFF_W + W_OUT), DM, DM, 128, 8, smem,
                 EpiResid{l == 0 ? p->x_in : p->out, p->out});
    }
    xcd_barrier(xb);
    {
      KP p = kargs();
      for (int re = 0; re < REPE; ++re) rmsnorm_rows(p->out, p->ffn_norm + l * DM, (u16*)(p->ws + OFF_H));
    }
    xcd_barrier(xb);
    {
      KP p = kargs();
      for (int rep = 0; rep < REPG; ++rep)
      gemm_phase((const u16*)(p->ws + OFF_H), DM, (const u16*)(p->ws + OFF_W + W_GU), DM, DM, 128, 44, smem,
                 EpiSwiGLU{(u16*)(p->ws + OFF_PROJ)});
    }
    xcd_barrier(xb);
    {
      KP p = kargs();
      gemm_phase((const u16*)(p->ws + OFF_PROJ), DFF, (const u16*)(p->ws + OFF_W + W_DOWN), DFF, DFF, 128, 8, smem,
                 EpiResid{p->out, p->out});
    }
    xcd_barrier(xb);
  }
}

extern "C" void kernel_launch(void* const* d_in, const int* in_sizes, int n_in, void* d_out, int out_size, void* d_ws,
                              size_t ws_size, hipStream_t stream) {
  static int grid_blocks = 0;
  if (!grid_blocks) {
    int dev = 0, cus = 0, per_cu = 0;
    hipGetDevice(&dev);
    hipDeviceGetAttribute(&cus, hipDeviceAttributeMultiprocessorCount, dev);
    hipOccupancyMaxActiveBlocksPerMultiprocessor(&per_cu, hymba_mega, 256, 0);
    if (per_cu > 2) per_cu = 2;
    if (per_cu < 1) per_cu = 1;
    grid_blocks = cus * per_cu;
    grid_blocks &= ~7;
  }
  Params p;
  memset(&p, 0, sizeof(p));
  p.x_in = (const float*)d_in[0]; p.positions = (const int*)d_in[1]; p.attn_norm = (const float*)d_in[2];
  p.w_in = (const float*)d_in[3]; p.gdn_conv_w = (const float*)d_in[4]; p.gdn_a_log = (const float*)d_in[5];
  p.gdn_dt_bias = (const float*)d_in[6]; p.gdn_norm = (const float*)d_in[7]; p.nsa_q_norm = (const float*)d_in[8];
  p.nsa_k_norm = (const float*)d_in[9]; p.cmp_pe = (const float*)d_in[10]; p.cmp_w1 = (const float*)d_in[11];
  p.cmp_w2 = (const float*)d_in[12]; p.conv_w = (const float*)d_in[13]; p.w_out = (const float*)d_in[14];
  p.ffn_norm = (const float*)d_in[15]; p.w_gate_up = (const float*)d_in[16]; p.w_down = (const float*)d_in[17];
  p.out = (float*)d_out; p.ws = (char*)d_ws;
  hipMemsetAsync((char*)d_ws + OFF_CNT, 0, 4096 + XCD_BAR_WORDS * 4, stream);
  void* args[] = {&p};
  hipError_t e = hipLaunchCooperativeKernel((void*)hymba_mega, dim3(grid_blocks), dim3(256), args, 0, stream);
  if (e != hipSuccess) fprintf(stderr, "cooperative launch failed: %s (grid %d)\n", hipGetErrorString(e), grid_blocks);
}
```

```cpp
#include <hip/hip_runtime.h>
#include <hip/hip_cooperative_groups.h>
#include <cstdio>
#include <cstring>
namespace cg = cooperative_groups;

#ifndef ZTEST
#define ZTEST 0
#endif
typedef unsigned short u16;
typedef unsigned int u32;
typedef __attribute__((ext_vector_type(8))) short bf16x8;
typedef __attribute__((ext_vector_type(4))) short bf16x4;
typedef __attribute__((ext_vector_type(4))) float f32x4;

constexpr int NB = 2, T = 16384, NTOK = NB * T, DM = 1024, DFF = 2816, DEPTH = 4;
constexpr int PJ = 3072;
constexpr int C_GQ = 0, C_GK = 256, C_GV = 512, C_GZ = 768, C_NQ = 1024, C_KCMP = 1536, C_VCMP = 1664,
              C_KSLC = 1792, C_VSLC = 1920, C_KWIN = 2048, C_VWIN = 2176, C_CB = 2304, C_CC = 2560, C_CX = 2816;
constexpr size_t MiB = 1ull << 20;
constexpr size_t OFF_H = 0, OFF_PROJ = 64 * MiB, OFF_SMALL = 256 * MiB, OFF_W = 260 * MiB, OFF_GDN = 288 * MiB,
                 OFF_OG = 384 * MiB, OFF_OC = 416 * MiB, OFF_VT = 480 * MiB, OFF_KC = 496 * MiB, OFF_SEL = 497 * MiB,
                 OFF_ROPE = 499 * MiB, OFF_GL = 501 * MiB, OFF_CNT = 501 * MiB + 65536;
constexpr size_t W_IN = 0, W_OUT = 6553600, W_GU = 8650752, W_DOWN = 20185088, W_C1 = 25952256, W_C2 = 26476544;
constexpr int CHUNK_B = 49152;
constexpr float SC2 = 0.125f * 1.4426950408889634f;

struct Params {
  const float* x_in; const int* positions; const float* attn_norm; const float* w_in; const float* gdn_conv_w;
  const float* gdn_a_log; const float* gdn_dt_bias; const float* gdn_norm; const float* nsa_q_norm;
  const float* nsa_k_norm; const float* cmp_pe; const float* cmp_w1; const float* cmp_w2; const float* conv_w;
  const float* w_out; const float* ffn_norm; const float* w_gate_up; const float* w_down;
  float* out; char* ws;
};


__device__ __forceinline__ int otid() { int t = threadIdx.x; asm volatile("" : "+v"(t)); return t; }
__device__ __forceinline__ int obid() { int t = blockIdx.x; asm volatile("" : "+s"(t)); return t; }
typedef const __attribute__((address_space(4))) Params* KP;
__device__ __forceinline__ KP kargs() {
  KP k = (KP)__builtin_amdgcn_kernarg_segment_ptr();
  asm volatile("" : "+s"(k));
  return k;
}

typedef __bf16 bf2_t __attribute__((ext_vector_type(2)));
typedef float f2_t __attribute__((ext_vector_type(2)));
__device__ __forceinline__ u32 pack2(float a, float b) {
  f2_t v = {a, b};
  bf2_t r = __builtin_convertvector(v, bf2_t);
  return __builtin_bit_cast(u32, r);
}
__device__ __forceinline__ u16 f2bf(float f) { return (u16)(pack2(f, 0.f) & 0xffffu); }
__device__ __forceinline__ float bf2f(u16 h) { return __uint_as_float(((u32)h) << 16); }
template <int CTRL>
__device__ __forceinline__ float dppf(float v) {
  return __int_as_float(__builtin_amdgcn_update_dpp(0, __float_as_int(v), CTRL, 0xF, 0xF, true));
}
__device__ __forceinline__ float row16_sum(float v) {
  v += dppf<0x128>(v); v += dppf<0x124>(v); v += dppf<0x4E>(v); v += dppf<0xB1>(v);
  return v;
}
__device__ __forceinline__ float wave_sum(float v) {
  v = row16_sum(v);
  const int iv = __float_as_int(v);
  return __int_as_float(__builtin_amdgcn_readlane(iv, 0)) + __int_as_float(__builtin_amdgcn_readlane(iv, 16)) +
         __int_as_float(__builtin_amdgcn_readlane(iv, 32)) + __int_as_float(__builtin_amdgcn_readlane(iv, 48));
}
__device__ __forceinline__ float dpp_xor1(float v) {
  return __int_as_float(__builtin_amdgcn_update_dpp(0, __float_as_int(v), 0xB1, 0xF, 0xF, true));
}
__device__ __forceinline__ float dpp_xor2(float v) {
  return __int_as_float(__builtin_amdgcn_update_dpp(0, __float_as_int(v), 0x4E, 0xF, 0xF, true));
}
__device__ __forceinline__ float sigmoidf_(float x) { return 1.f * __builtin_amdgcn_rcpf(1.f + __expf(-x)); }
__device__ __forceinline__ f32x4 mfma16(bf16x8 a, bf16x8 b, f32x4 c) {
  return __builtin_amdgcn_mfma_f32_16x16x32_bf16(a, b, c, 0, 0, 0);
}
__device__ __forceinline__ bf16x8 pack8(f32x4 a, f32x4 b) {
  union { bf16x8 v; u32 u[4]; } r;
  r.u[0] = pack2(a[0], a[1]); r.u[1] = pack2(a[2], a[3]);
  r.u[2] = pack2(b[0], b[1]); r.u[3] = pack2(b[2], b[3]);
  return r.v;
}

__device__ __forceinline__ void rmsnorm_rows(const float* __restrict__ x, const float* __restrict__ gain, u16* __restrict__ h) {
  int lane = otid() & 63;
  int gw = obid() * 4 + (otid() >> 6), nw = gridDim.x * 4;
  for (int row = gw; row < NTOK; row += nw) {
    const float4* xr = (const float4*)(x + (size_t)row * DM);
    float4 v[4];
    float ss = 0.f;
#pragma unroll
    for (int i = 0; i < 4; ++i) {
      v[i] = xr[lane + 64 * i];
      ss += v[i].x * v[i].x + v[i].y * v[i].y + v[i].z * v[i].z + v[i].w * v[i].w;
    }
    ss = wave_sum(ss);
    float rs = rsqrtf(ss * (1.f / DM) + 1e-6f);
#pragma unroll
    for (int i = 0; i < 4; ++i) {
      float4 g = ((const float4*)gain)[lane + 64 * i];
      uint2 o;
      o.x = pack2(v[i].x * rs * g.x, v[i].y * rs * g.y);
      o.y = pack2(v[i].z * rs * g.z, v[i].w * rs * g.w);
      *(uint2*)(h + (size_t)row * DM + (lane + 64 * i) * 4) = o;
    }
  }
}

struct MapId { __device__ int operator()(int n) const { return n; } };
struct MapIn {
  __device__ int operator()(int n) const {
    if (n < 1024) return n;
    if (n < 2304) return n + 8;
    if (n < 3072) return n + 32;
    if (n < 3080) return n - 3072 + 1024;
    if (n < 3104) return n - 3080 + 2312;
    return -1;
  }
};
struct MapGU {
  __device__ int operator()(int n) const {
    int grp = n >> 6, r = n & 63;
    return r < 32 ? grp * 32 + r : DFF + grp * 32 + (r - 32);
  }
};
template <class Map>
__device__ __forceinline__ void transpose_tile(const float* __restrict__ src, int lds_, Map map, u16* __restrict__ dst, int ldd, int n0,
                               int k0, float* t) {
  int tid = otid();
#pragma unroll
  for (int i = 0; i < 16; ++i) {
    int k = i * 4 + (tid >> 6), n = tid & 63;
    int sn = map(n0 + n);
    t[k * 65 + n] = sn >= 0 ? src[(size_t)(k0 + k) * lds_ + sn] : 0.f;
  }
  __syncthreads();
#pragma unroll 4
  for (int i = 0; i < 16; ++i) {
    int n = i * 4 + (tid >> 6), k = tid & 63;
    dst[(size_t)(n0 + n) * ldd + k0 + k] = f2bf(t[k * 65 + n]);
  }
  __syncthreads();
}

__device__ __forceinline__ void convert_weights(KP p, int l, char* smem) {
  float* t = (float*)smem;
  char* W = p->ws + OFF_W;
  const int J0 = 800, J1 = J0 + 256, J2 = J1 + 1408, J3 = J2 + 704, J4 = J3 + 64, J5 = J4 + 2;
  for (int job = obid(); job < J5; job += gridDim.x) {
    if (job < J0) {
      transpose_tile(p->w_in + (size_t)l * DM * 3104, 3104, MapIn(), (u16*)(W + W_IN), 1024, (job >> 4) * 64,
                     (job & 15) * 64, t);
    } else if (job < J1) {
      int j = job - J0;
      transpose_tile(p->w_out + (size_t)l * DM * DM, 1024, MapId(), (u16*)(W + W_OUT), 1024, (j >> 4) * 64,
                     (j & 15) * 64, t);
    } else if (job < J2) {
      int j = job - J1;
      transpose_tile(p->w_gate_up + (size_t)l * DM * 2 * DFF, 2 * DFF, MapGU(), (u16*)(W + W_GU), 1024, (j >> 4) * 64,
                     (j & 15) * 64, t);
    } else if (job < J3) {
      int j = job - J2;
      transpose_tile(p->w_down + (size_t)l * DFF * DM, 1024, MapId(), (u16*)(W + W_DOWN), DFF, (j / 44) * 64,
                     (j % 44) * 64, t);
    } else if (job < J4) {
      int j = job - J3;
      int which = j >> 5, kt = j & 31;
      transpose_tile(p->cmp_w1 + (size_t)(l * 2 + which) * 2048 * 64, 64, MapId(),
                     (u16*)(W + W_C1) + (size_t)which * 64 * 2048, 2048, 0, kt * 64, t);
    } else {
      int which = job - J4;
      transpose_tile(p->cmp_w2 + (size_t)(l * 2 + which) * 64 * 64, 64, MapId(), (u16*)(W + W_C2) + which * 4096, 64, 0,
                     0, t);
    }
  }
}

#define WAIT_VM(n) asm volatile("s_waitcnt vmcnt(" #n ")" ::: "memory")
#define RAW_BAR() do { asm volatile("s_waitcnt lgkmcnt(0)" ::: "memory"); __builtin_amdgcn_s_barrier(); } while (0)
typedef __attribute__((ext_vector_type(16))) float f32x16;
template <class Epi>
__device__ __forceinline__ void gemm_phase(const u16* __restrict__ A, int lda, const u16* __restrict__ Bt, int ldb, int K, int ntm,
                           int ntn, char* smem, Epi epi) {
  const int tid = otid(), lane = tid & 63, wv = tid >> 6;
  const int wm = wv >> 1, wn = wv & 1, l31 = lane & 31, hi = lane >> 5;
  const int ntiles = ntm * ntn, nk = K >> 5;
  const int lrow = tid >> 3, lc8 = tid & 7;
  const int woff = lrow * 64 + (((lc8 & 3) ^ ((lrow >> 2) & 3)) * 16);
  const bool wodd = (lc8 >> 2) != 0;
  const int sw = (l31 >> 2) & 3;
  const int arow = (wm * 128 + l31) * 64, brow = 16384 + (wn * 64 + l31) * 64;
#define TILE_DECODE(id_, row0_, col0_, tn_)                                                  \
  do {                                                                                       \
    int xcd_ = (id_) & 7, loc_ = (id_) >> 3;                                                 \
    int per_rb_ = 8 * ntn;                                                                   \
    int rb_ = loc_ / per_rb_, rem_ = loc_ % per_rb_;                                         \
    int cb_ = rem_ >> 6, rem2_ = rem_ & 63;                                                  \
    int width_ = (cb_ + 1) * 8 <= ntn ? 8 : ntn - cb_ * 8;                                   \
    int tm_l_ = rb_ * 8 + rem2_ / width_;                                                    \
    tn_ = cb_ * 8 + rem2_ % width_;                                                          \
    row0_ = (tm_l_ * 8 + xcd_) * 256;                                                        \
    col0_ = tn_ * 128;                                                                       \
  } while (0)
#define W_LOAD(w_)                                                           \
  do {                                                                       \
    const u16* pa_ = gA + (w_) * 64;                                         \
    const u16* pb_ = gB + (w_) * 64;                                         \
    Ra0 = *(const uint4*)(pa_);           Ra1 = *(const uint4*)(pa_ + a32);  \
    Ra2 = *(const uint4*)(pa_ + 2 * a32); Ra3 = *(const uint4*)(pa_ + 3 * a32); \
    Ra4 = *(const uint4*)(pa_ + 4 * a32); Ra5 = *(const uint4*)(pa_ + 5 * a32); \
    Ra6 = *(const uint4*)(pa_ + 6 * a32); Ra7 = *(const uint4*)(pa_ + 7 * a32); \
    Rb0 = *(const uint4*)(pb_);           Rb1 = *(const uint4*)(pb_ + b32);  \
    Rb2 = *(const uint4*)(pb_ + 2 * b32); Rb3 = *(const uint4*)(pb_ + 3 * b32); \
  } while (0)
#define MF(accv, bv, av) accv = __builtin_amdgcn_mfma_f32_32x32x16_bf16(bv, av, accv, 0, 0, 0)
#define SB() __builtin_amdgcn_sched_barrier(0)
#define G_ITER(sl_, ODD, wnext_)                                                                 \
  do {                                                                                           \
    const char* st_ = smem + (sl_) * 24576;                                                      \
    const int s1_ = (sl_) + 1 >= 3 ? (sl_) - 2 : (sl_) + 1, s2_ = (sl_) + 2 >= 3 ? (sl_) - 1 : (sl_) + 2; \
    char* wr_ = smem + (wodd ? s2_ : s1_) * 24576 + woff;                                        \
    const int p0_ = ((0 + hi) ^ sw) * 16, p1_ = ((2 + hi) ^ sw) * 16;                            \
    bf16x8 b00 = *(const bf16x8*)(st_ + brow + p0_), b01 = *(const bf16x8*)(st_ + brow + 2048 + p0_); \
    bf16x8 a00 = *(const bf16x8*)(st_ + arow + p0_), a01 = *(const bf16x8*)(st_ + arow + 2048 + p0_); \
    bf16x8 a02 = *(const bf16x8*)(st_ + arow + 4096 + p0_), a03 = *(const bf16x8*)(st_ + arow + 6144 + p0_); \
    SB();                                                                                        \
    MF(acc[0][0], b00, a00); MF(acc[0][1], b01, a00);                                            \
    bf16x8 b10 = *(const bf16x8*)(st_ + brow + p1_), b11 = *(const bf16x8*)(st_ + brow + 2048 + p1_); \
    SB();                                                                                        \
    MF(acc[1][0], b00, a01); MF(acc[1][1], b01, a01);                                            \
    bf16x8 a10 = *(const bf16x8*)(st_ + arow + p1_), a11 = *(const bf16x8*)(st_ + arow + 2048 + p1_); \
    SB();                                                                                        \
    MF(acc[2][0], b00, a02); MF(acc[2][1], b01, a02);                                            \
    bf16x8 a12 = *(const bf16x8*)(st_ + arow + 4096 + p1_), a13 = *(const bf16x8*)(st_ + arow + 6144 + p1_); \
    SB();                                                                                        \
    MF(acc[3][0], b00, a03); MF(acc[3][1], b01, a03);                                            \
    if (ODD) { *(uint4*)(wr_) = Ra0; *(uint4*)(wr_ + 2048) = Ra1; *(uint4*)(wr_ + 4096) = Ra2; } \
    SB();                                                                                        \
    MF(acc[0][0], b10, a10); MF(acc[0][1], b11, a10);                                            \
    if (ODD) { *(uint4*)(wr_ + 6144) = Ra3; *(uint4*)(wr_ + 8192) = Ra4; *(uint4*)(wr_ + 10240) = Ra5; } \
    SB();                                                                                        \
    MF(acc[1][0], b10, a11); MF(acc[1][1], b11, a11);                                            \
    if (ODD) { *(uint4*)(wr_ + 12288) = Ra6; *(uint4*)(wr_ + 14336) = Ra7; *(uint4*)(wr_ + 16384) = Rb0; } \
    SB();                                                                                        \
    MF(acc[2][0], b10, a12); MF(acc[2][1], b11, a12);                                            \
    if (ODD) { *(uint4*)(wr_ + 18432) = Rb1; *(uint4*)(wr_ + 20480) = Rb2; *(uint4*)(wr_ + 22528) = Rb3; } \
    SB();                                                                                        \
    MF(acc[3][0], b10, a13); MF(acc[3][1], b11, a13);                                            \
    if (ODD) { const int wl_ = (wnext_) < nw ? (wnext_) : nw - 1; W_LOAD(wl_); }                 \
    RAW_BAR();                                                                                   \
  } while (0)
  const size_t a32 = (size_t)32 * lda, b32 = (size_t)32 * ldb;
  const int nw = nk >> 1;
  int id = obid();
  int row0 = 0, col0 = 0, tn = 0;
  const u16 *gA = A, *gB = Bt;
  uint4 Ra0, Ra1, Ra2, Ra3, Ra4, Ra5, Ra6, Ra7, Rb0, Rb1, Rb2, Rb3;
  if (id < ntiles) {
    TILE_DECODE(id, row0, col0, tn);
    gA = A + (size_t)(row0 + lrow) * lda + lc8 * 8;
    gB = Bt + (size_t)(col0 + lrow) * ldb + lc8 * 8;
    W_LOAD(0);
  }
  while (id < ntiles) {
    f32x16 acc[4][2];
#pragma unroll
    for (int m = 0; m < 4; ++m)
#pragma unroll
      for (int n = 0; n < 2; ++n)
#pragma unroll
        for (int r = 0; r < 16; ++r) acc[m][n][r] = 0.f;
    {
      char* wr_ = smem + (wodd ? 1 : 0) * 24576 + woff;
      *(uint4*)(wr_) = Ra0; *(uint4*)(wr_ + 2048) = Ra1; *(uint4*)(wr_ + 4096) = Ra2; *(uint4*)(wr_ + 6144) = Ra3;
      *(uint4*)(wr_ + 8192) = Ra4; *(uint4*)(wr_ + 10240) = Ra5; *(uint4*)(wr_ + 12288) = Ra6; *(uint4*)(wr_ + 14336) = Ra7;
      *(uint4*)(wr_ + 16384) = Rb0; *(uint4*)(wr_ + 18432) = Rb1; *(uint4*)(wr_ + 20480) = Rb2; *(uint4*)(wr_ + 22528) = Rb3;
    }
    W_LOAD(1);
    RAW_BAR();
    __builtin_amdgcn_s_setprio(1);
    int sl = 0;
    for (int w = 0; w < nw; ++w) {
      G_ITER(sl, false, 0);
      sl = sl + 1 >= 3 ? 0 : sl + 1;
      G_ITER(sl, true, w + 2);
      sl = sl + 1 >= 3 ? 0 : sl + 1;
    }
    __builtin_amdgcn_s_setprio(0);
    const int erow = row0 + wm * 128 + l31, ecol = col0 + wn * 64 + hi * 4, etn = tn;
    id += gridDim.x;
    if (id < ntiles) {
      TILE_DECODE(id, row0, col0, tn);
      gA = A + (size_t)(row0 + lrow) * lda + lc8 * 8;
      gB = Bt + (size_t)(col0 + lrow) * ldb + lc8 * 8;
      W_LOAD(0);
    }
    epi(acc, erow, ecol, etn);
  }
}

struct EpiInProj {
  u16* proj; float* small_;
  __device__ __forceinline__ void operator()(f32x16 (&acc)[4][2], int rbase, int cbase, int tn) const {
    if (tn < 24) {
#pragma unroll
      for (int m = 0; m < 4; ++m)
#pragma unroll
        for (int n = 0; n < 2; ++n)
#pragma unroll
          for (int g = 0; g < 4; ++g) {
            uint2 o;
            o.x = pack2(acc[m][n][g * 4 + 0], acc[m][n][g * 4 + 1]);
            o.y = pack2(acc[m][n][g * 4 + 2], acc[m][n][g * 4 + 3]);
            *(uint2*)(proj + (size_t)(rbase + m * 32) * PJ + cbase + n * 32 + g * 8) = o;
          }
    } else {
#pragma unroll
      for (int m = 0; m < 4; ++m)
#pragma unroll
        for (int g = 0; g < 4; ++g) {
          int c = cbase + g * 8 - 3072;
          if (c < 32)
            *(float4*)(small_ + (size_t)(rbase + m * 32) * 32 + c) =
                make_float4(acc[m][0][g * 4 + 0], acc[m][0][g * 4 + 1], acc[m][0][g * 4 + 2], acc[m][0][g * 4 + 3]);
        }
    }
  }
};
struct EpiResid {
  const float* xin; float* xout;
  __device__ __forceinline__ void operator()(f32x16 (&acc)[4][2], int rbase, int cbase, int tn) const {
#pragma unroll
    for (int m = 0; m < 4; ++m)
#pragma unroll
      for (int n = 0; n < 2; ++n)
#pragma unroll
        for (int g = 0; g < 4; ++g) {
          size_t idx = (size_t)(rbase + m * 32) * DM + cbase + n * 32 + g * 8;
          float4 x = *(const float4*)(xin + idx);
          x.x += acc[m][n][g * 4 + 0]; x.y += acc[m][n][g * 4 + 1]; x.z += acc[m][n][g * 4 + 2]; x.w += acc[m][n][g * 4 + 3];
          *(float4*)(xout + idx) = x;
        }
  }
};
struct EpiSwiGLU {
  u16* act;
  __device__ __forceinline__ void operator()(f32x16 (&acc)[4][2], int rbase, int cbase, int tn) const {
    int grp = cbase >> 6, c4 = cbase & 7;
#pragma unroll
    for (int m = 0; m < 4; ++m)
#pragma unroll
      for (int g = 0; g < 4; ++g) {
        float v[4];
#pragma unroll
        for (int r = 0; r < 4; ++r) {
          float gt = acc[m][0][g * 4 + r], up = acc[m][1][g * 4 + r];
          v[r] = gt * __builtin_amdgcn_rcpf(1.f + __expf(-gt)) * up;
        }
        uint2 o;
        o.x = pack2(v[0], v[1]);
        o.y = pack2(v[2], v[3]);
        *(uint2*)(act + (size_t)(rbase + m * 32) * DFF + grp * 32 + g * 8 + c4) = o;
      }
  }
};

__device__ __forceinline__ void gdn_chunk_prep(KP p, int l, char* smem, int job) {
  const int b = job >> 10, h = (job >> 8) & 3, c = job & 255;
  const int tid = otid(), lane = tid & 63, wv = tid >> 6;
  float* sq = (float*)smem;
  float* sk = sq + 64 * 65;
  float* sv = sk + 64 * 65;
  float* sA = sv + 64 * 65;
  float* sgc = sA + 64 * 64;
  float* sbeta = sgc + 64;
  float* seg = sbeta + 64;
  float* sf2 = seg + 64;
  const u16* proj = (const u16*)(p->ws + OFF_PROJ);
  const float* small_ = (const float*)(p->ws + OFF_SMALL);
  const size_t tok0 = (size_t)b * T + c * 64;
  char* cb = p->ws + OFF_GDN + (size_t)((b * 4 + h) * 256 + c) * CHUNK_B;
  float* UT = (float*)cb;
  u16* NW = (u16*)(cb + 16384);
  u16* QD = (u16*)(cb + 24576);
  u16* KDT = (u16*)(cb + 32768);
  u16* QKM = (u16*)(cb + 40960);
  {
    const int d = lane, i0 = wv * 16;
    const int tl0 = c * 64 + i0;
    u16 raw[3][19];
#pragma unroll
    for (int seg_ = 0; seg_ < 3; ++seg_) {
      const int ch = seg_ * 256 + h * 64 + d;
#pragma unroll
      for (int i = 0; i < 19; ++i) {
        const int rel = i0 + i - 3;
        const size_t tk = (tl0 + i - 3 >= 0) ? (tok0 + rel) : tok0;
        raw[seg_][i] = proj[tk * PJ + ch];
      }
    }
#pragma unroll
    for (int seg_ = 0; seg_ < 3; ++seg_) {
      const int ch = seg_ * 256 + h * 64 + d;
      const float* cw = p->gdn_conv_w + (size_t)l * 4 * 768 + ch;
      const float w0 = cw[0], w1 = cw[768], w2 = cw[1536], w3 = cw[2304];
      float* dst = seg_ == 0 ? sq : (seg_ == 1 ? sk : sv);
      float xv[19];
#pragma unroll
      for (int i = 0; i < 19; ++i) xv[i] = (tl0 + i - 3 >= 0) ? bf2f(raw[seg_][i]) : 0.f;
#pragma unroll
      for (int i = 0; i < 16; ++i) {
        float y = w0 * xv[i] + w1 * xv[i + 1] + w2 * xv[i + 2] + w3 * xv[i + 3];
        dst[(i0 + i) * 65 + d] = y * __builtin_amdgcn_rcpf(1.f + __expf(-y));
      }
    }
  }
  if (tid < 64) {
    float gb = small_[(tok0 + tid) * 32 + h], ga = small_[(tok0 + tid) * 32 + 4 + h];
    float xx = ga + p->gdn_dt_bias[l * 4 + h];
    float sp = fmaxf(xx, 0.f) + log1pf(__expf(-fabsf(xx)));
    float g = -__expf(p->gdn_a_log[l * 4 + h]) * sp;
#pragma unroll
    for (int o = 1; o < 64; o <<= 1) {
      float t = __shfl_up(g, o);
      if (lane >= o) g += t;
    }
    float beta = sigmoidf_(gb);
    float eg = __expf(g);
    sgc[tid] = g; sbeta[tid] = beta; seg[tid] = eg; sf2[tid] = beta * eg;
    if (tid == 63) ((float*)(p->ws + OFF_GL))[(b * 4 + h) * 256 + c] = eg;
  }
  __syncthreads();
  if (tid < 128) {
    float* rowp = (tid < 64 ? sq : sk) + (tid & 63) * 65;
    float ss = 0.f;
#pragma unroll 16
    for (int d = 0; d < 64; ++d) ss += rowp[d] * rowp[d];
    const float sc = rsqrtf(ss + 1e-6f) * (tid < 64 ? 0.125f : 1.f);
#pragma unroll 16
    for (int d = 0; d < 64; ++d) rowp[d] *= sc;
  }
  __syncthreads();
  {
    int ti = tid >> 4, tj = tid & 15;
    float kk[4][4], qk[4][4];
#pragma unroll
    for (int a = 0; a < 4; ++a)
#pragma unroll
      for (int bb = 0; bb < 4; ++bb) { kk[a][bb] = 0.f; qk[a][bb] = 0.f; }
    if (tj <= ti) {
      for (int d = 0; d < 64; ++d) {
        float ki[4], kj[4], qi[4];
#pragma unroll
        for (int a = 0; a < 4; ++a) {
          ki[a] = sk[(ti * 4 + a) * 65 + d];
          qi[a] = sq[(ti * 4 + a) * 65 + d];
          kj[a] = sk[(tj * 4 + a) * 65 + d];
        }
#pragma unroll
        for (int a = 0; a < 4; ++a)
#pragma unroll
          for (int bb = 0; bb < 4; ++bb) { kk[a][bb] += ki[a] * kj[bb]; qk[a][bb] += qi[a] * kj[bb]; }
      }
    }
#pragma unroll
    for (int a = 0; a < 4; ++a) {
      int i = ti * 4 + a;
      float gi = sgc[i], bi = sbeta[i];
      uint2 o;
      float qv[4];
#pragma unroll
      for (int bb = 0; bb < 4; ++bb) {
        int j = tj * 4 + bb;
        float dec = (j <= i) ? __expf(gi - sgc[j]) : 0.f;
        sA[i * 64 + j] = (j < i) ? bi * kk[a][bb] * dec : 0.f;
        qv[bb] = qk[a][bb] * dec;
      }
      o.x = pack2(qv[0], qv[1]); o.y = pack2(qv[2], qv[3]);
      *(uint2*)(QKM + i * 64 + tj * 4) = o;
    }
  }
  {
    float gl = sgc[63];
    for (int idx = tid; idx < 4096; idx += 256) {
      int i = idx >> 6, d = idx & 63;
      QD[idx] = f2bf(sq[i * 65 + d] * seg[i]);
      KDT[idx] = f2bf(sk[d * 65 + i] * __expf(gl - sgc[d]));
    }
  }
  __syncthreads();
  if (tid < 128) {
    int cidx = tid;
    const float* src = cidx < 64 ? sv + cidx : sk + (cidx - 64);
    const float* fac = cidx < 64 ? sbeta : sf2;
    float x[64];
#pragma unroll
    for (int i = 0; i < 64; ++i) {
      float s0 = src[i * 65] * fac[i], s1 = 0.f, s2 = 0.f, s3 = 0.f;
#pragma unroll
      for (int j = 0; j < i; ++j) {
        if ((j & 3) == 0) s0 -= sA[i * 64 + j] * x[j];
        else if ((j & 3) == 1) s1 -= sA[i * 64 + j] * x[j];
        else if ((j & 3) == 2) s2 -= sA[i * 64 + j] * x[j];
        else s3 -= sA[i * 64 + j] * x[j];
      }
      x[i] = (s0 + s1) + (s2 + s3);
    }
    if (cidx < 64) {
#pragma unroll
      for (int i = 0; i < 64; i += 4) *(float4*)(UT + cidx * 64 + i) = make_float4(x[i], x[i + 1], x[i + 2], x[i + 3]);
    } else {
#pragma unroll
      for (int i = 0; i < 64; ++i) NW[i * 64 + (cidx - 64)] = f2bf(-x[i]);
    }
  }
  __syncthreads();
}

__device__ __forceinline__ void gdn_scan(KP p, char* smem, int sid) {
  const int b = sid >> 4, h = (sid >> 2) & 3, v0 = (sid & 3) * 16;
  const int tid = otid(), lane = tid & 63, wv = tid >> 6, l15 = lane & 15, quad = lane >> 4;
  u16* Sb = (u16*)smem;
  u16* Vb = Sb + 16 * 72;
  f32x4 S = {0.f, 0.f, 0.f, 0.f};
  { u32 z0 = 0u; asm volatile("" : "+v"(z0)); *(uint2*)(Sb + l15 * 72 + 16 * wv + quad * 4) = make_uint2(z0, z0); }
  __syncthreads();
  const char* gbase = p->ws + OFF_GDN + (size_t)((b * 4 + h) * 256) * CHUNK_B;
  const float* GL = (const float*)(p->ws + OFF_GL) + (b * 4 + h) * 256;
  float* OG = (float*)(p->ws + OFF_OG);
  const int arow = (16 * wv + l15) * 64 + quad * 8;
  f32x4 u, un;
  bf16x8 wA[2], qdA[2], qkA[2], kdA[2], wAn[2], qdAn[2], qkAn[2], kdAn[2];
  float gl, gln;
  {
    const char* cb = gbase;
    u = *(const f32x4*)((const float*)cb + (v0 + l15) * 64 + 16 * wv + quad * 4);
#pragma unroll
    for (int ks = 0; ks < 2; ++ks) {
      wA[ks] = *(const bf16x8*)((const u16*)(cb + 16384) + arow + ks * 32);
      qdA[ks] = *(const bf16x8*)((const u16*)(cb + 24576) + arow + ks * 32);
      kdA[ks] = *(const bf16x8*)((const u16*)(cb + 32768) + arow + ks * 32);
      qkA[ks] = *(const bf16x8*)((const u16*)(cb + 40960) + arow + ks * 32);
    }
    gl = GL[0];
  }
  for (int c = 0; c < 256; ++c) {
    if (c + 1 < 256) {
      const char* cb = gbase + (size_t)(c + 1) * CHUNK_B;
      un = *(const f32x4*)((const float*)cb + (v0 + l15) * 64 + 16 * wv + quad * 4);
#pragma unroll
      for (int ks = 0; ks < 2; ++ks) {
        wAn[ks] = *(const bf16x8*)((const u16*)(cb + 16384) + arow + ks * 32);
        qdAn[ks] = *(const bf16x8*)((const u16*)(cb + 24576) + arow + ks * 32);
        kdAn[ks] = *(const bf16x8*)((const u16*)(cb + 32768) + arow + ks * 32);
        qkAn[ks] = *(const bf16x8*)((const u16*)(cb + 40960) + arow + ks * 32);
      }
      gln = GL[c + 1];
    }
    bf16x8 sB0 = *(const bf16x8*)(Sb + l15 * 72 + quad * 8);
    bf16x8 sB1 = *(const bf16x8*)(Sb + l15 * 72 + 32 + quad * 8);
    f32x4 vn = u;
    vn = mfma16(wA[0], sB0, vn);
    vn = mfma16(wA[1], sB1, vn);
    f32x4 o = {0.f, 0.f, 0.f, 0.f};
    o = mfma16(qdA[0], sB0, o);
    o = mfma16(qdA[1], sB1, o);
    *(uint2*)(Vb + l15 * 72 + 16 * wv + quad * 4) = make_uint2(pack2(vn[0], vn[1]), pack2(vn[2], vn[3]));
    __syncthreads();
    bf16x8 vB0 = *(const bf16x8*)(Vb + l15 * 72 + quad * 8);
    bf16x8 vB1 = *(const bf16x8*)(Vb + l15 * 72 + 32 + quad * 8);
    o = mfma16(qkA[0], vB0, o);
    o = mfma16(qkA[1], vB1, o);
    S[0] *= gl; S[1] *= gl; S[2] *= gl; S[3] *= gl;
    S = mfma16(kdA[0], vB0, S);
    S = mfma16(kdA[1], vB1, S);
    *(uint2*)(Sb + l15 * 72 + 16 * wv + quad * 4) = make_uint2(pack2(S[0], S[1]), pack2(S[2], S[3]));
    size_t orow = (size_t)b * T + c * 64 + 16 * wv + quad * 4;
#pragma unroll
    for (int r = 0; r < 4; ++r) OG[(orow + r) * 256 + h * 64 + v0 + l15] = o[r];
    __syncthreads();
    u = un; gl = gln;
#pragma unroll
    for (int ks = 0; ks < 2; ++ks) { wA[ks] = wAn[ks]; qdA[ks] = qdAn[ks]; kdA[ks] = kdAn[ks]; qkA[ks] = qkAn[ks]; }
  }
}

__device__ __forceinline__ void gdn_finalize(KP p, int l) {
  const int lane = otid() & 63, sub = lane >> 4, q4 = (lane & 15) * 4;
  const int gw = obid() * 4 + (otid() >> 6), nw = gridDim.x * 4;
  const float* OG = (const float*)(p->ws + OFF_OG);
  const u16* proj = (const u16*)(p->ws + OFF_PROJ);
  u16* mix = (u16*)(p->ws + OFF_H);
  const float4 gn = *(const float4*)(p->gdn_norm + l * 64 + q4);
  for (int base = gw * 16; base < NTOK * 4; base += nw * 16) {
    float4 o[4];
    uint2 zr[4];
#pragma unroll
    for (int u = 0; u < 4; ++u) {
      const int row = base + u * 4 + sub, t = row >> 2, h = row & 3;
      o[u] = *(const float4*)(OG + (size_t)row * 64 + q4);
      zr[u] = *(const uint2*)(proj + (size_t)t * PJ + C_GZ + h * 64 + q4);
    }
#pragma unroll
    for (int u = 0; u < 4; ++u) {
      const int row = base + u * 4 + sub, t = row >> 2, h = row & 3;
      float ss = o[u].x * o[u].x + o[u].y * o[u].y + o[u].z * o[u].z + o[u].w * o[u].w;
      ss = row16_sum(ss);
      const float rs = rsqrtf(ss * (1.f / 64.f) + 1e-6f);
      const float z0 = bf2f(zr[u].x & 0xffff), z1 = bf2f(zr[u].x >> 16), z2 = bf2f(zr[u].y & 0xffff), z3 = bf2f(zr[u].y >> 16);
      const float y0 = o[u].x * rs * gn.x * (z0 * __builtin_amdgcn_rcpf(1.f + __expf(-z0)));
      const float y1 = o[u].y * rs * gn.y * (z1 * __builtin_amdgcn_rcpf(1.f + __expf(-z1)));
      const float y2 = o[u].z * rs * gn.z * (z2 * __builtin_amdgcn_rcpf(1.f + __expf(-z2)));
      const float y3 = o[u].w * rs * gn.w * (z3 * __builtin_amdgcn_rcpf(1.f + __expf(-z3)));
      uint2 w;
      w.x = pack2(ZTEST == 4 ? 0.f : y0, ZTEST == 4 ? 0.f : y1);
      w.y = pack2(ZTEST == 4 ? 0.f : y2, ZTEST == 4 ? 0.f : y3);
      *(uint2*)(mix + (size_t)t * DM + h * 64 + q4) = w;
    }
  }
}

__device__ __forceinline__ void rope_table(KP p) {
  float* rp = (float*)(p->ws + OFF_ROPE);
  int gt = obid() * blockDim.x + otid(), nt = gridDim.x * blockDim.x;
  for (int idx = gt; idx < NTOK * 8; idx += nt) {
    int t = idx >> 3, i = idx & 7;
    float inv = (float)pow(500000.0, -(double)i / 8.0);
    float ang = (float)p->positions[t] * inv;
    rp[t * 16 + i] = (float)cos((double)ang);
    rp[t * 16 + 8 + i] = (float)sin((double)ang);
  }
}

__device__ __forceinline__ void nsa_token_prep(KP p, int l, char* smem, int tb) {
  const int tid = otid(), lane = tid & 63, wv = tid >> 6;
  const int b = tb >> 8, blk = tb & 255;
  u16* proj = (u16*)(p->ws + OFF_PROJ);
  const float* rope = (const float*)(p->ws + OFF_ROPE);
  const size_t tok0 = (size_t)tb * 64;
  for (int r = tid; r < 768; r += 256) {
    int i = r / 12, which = r % 12;
    size_t t = tok0 + i;
    int col; const float* gain;
    if (which < 8) { col = C_NQ + which * 64; gain = p->nsa_q_norm + l * 64; }
    else if (which < 10) { col = C_KSLC + (which - 8) * 64; gain = p->nsa_k_norm + (l * 3 + 1) * 64; }
    else { col = C_KWIN + (which - 10) * 64; gain = p->nsa_k_norm + (l * 3 + 2) * 64; }
    u16* rowp = proj + t * PJ + col;
    union { uint4 q; u16 h[8]; } v[8];
    float ss = 0.f;
#pragma unroll
    for (int c = 0; c < 8; ++c) {
      v[c].q = *(const uint4*)(rowp + c * 8);
#pragma unroll
      for (int e = 0; e < 8; ++e) { float x = bf2f(v[c].h[e]); ss += x * x; }
    }
    const float rs = rsqrtf(ss * (1.f / 64.f) + 1e-6f);
    float y0[16];
#pragma unroll
    for (int e = 0; e < 16; ++e) y0[e] = bf2f(v[e >> 3].h[e & 7]) * rs * gain[e];
    if (which >= 8) {
      const float* rp = rope + t * 16;
#pragma unroll
      for (int e = 0; e < 8; ++e) {
        float c = rp[e], sn = rp[8 + e];
        float a1 = y0[e], a2 = y0[8 + e];
        y0[e] = a1 * c - a2 * sn;
        y0[8 + e] = a2 * c + a1 * sn;
      }
    }
#pragma unroll
    for (int c = 0; c < 8; ++c) {
      uint4 o;
      float y[8];
#pragma unroll
      for (int e = 0; e < 8; ++e) y[e] = c < 2 ? y0[c * 8 + e] : bf2f(v[c].h[e]) * rs * gain[c * 8 + e];
      o.x = pack2(y[0], y[1]); o.y = pack2(y[2], y[3]); o.z = pack2(y[4], y[5]); o.w = pack2(y[6], y[7]);
      *(uint4*)(rowp + c * 8) = o;
    }
  }
  {
    u16* tt = (u16*)smem;
    uint4 vr[4][2];
#pragma unroll
    for (int z = 0; z < 4; ++z) {
      const int col = ((z >> 1) ? C_VWIN : C_VSLC) + (z & 1) * 64;
#pragma unroll
      for (int k = 0; k < 2; ++k) {
        const int q = tid + k * 256, i = q >> 3, c8 = q & 7;
        vr[z][k] = *(const uint4*)(proj + (tok0 + i) * PJ + col + c8 * 8);
      }
    }
#pragma unroll
    for (int z = 0; z < 4; ++z)
#pragma unroll
      for (int k = 0; k < 2; ++k) {
        const int q = tid + k * 256, i = q >> 3, c8 = q & 7;
        *(uint4*)(tt + (z * 64 + i) * 72 + c8 * 8) = vr[z][k];
      }
    __syncthreads();
#pragma unroll
    for (int z = 0; z < 4; ++z) {
      const int tensor = z >> 1, g = z & 1;
      u16* dst = (u16*)(p->ws + OFF_VT + (size_t)tensor * 8 * MiB) + ((size_t)((b * 2 + g) * 256 + blk)) * 4096;
#pragma unroll
      for (int k = 0; k < 2; ++k) {
        const int q = tid + k * 256, d = q >> 3, i8 = q & 7;
        union { uint4 v; u16 h[8]; } o;
#pragma unroll
        for (int e = 0; e < 8; ++e) {
          const int ok_ = (i8 >> 2) * 32 + (e < 4 ? (i8 & 3) * 4 + e : 16 + (i8 & 3) * 4 + e - 4);
          o.h[e] = tt[(z * 64 + ok_) * 72 + d];
        }
        *(uint4*)(dst + d * 64 + i8 * 8) = o.v;
      }
    }
    __syncthreads();
  }
  {
    const int cg8 = (tid & 31) * 8, t8 = (tid >> 5) * 8;
    u16* mix = (u16*)(p->ws + OFF_H);
    union U8 { uint4 v; u16 h[8]; };
    U8 cc[10], cx[10], cb[8];
#pragma unroll
    for (int k = 0; k < 10; ++k) {
      const int rel = t8 + k - 2;
      const bool ok = (blk > 0) || (rel >= 0);
      const size_t tk = ok ? (tok0 + rel) : tok0;
      cc[k].v = *(const uint4*)(proj + tk * PJ + C_CC + cg8);
      cx[k].v = *(const uint4*)(proj + tk * PJ + C_CX + cg8);
    }
#pragma unroll
    for (int k = 0; k < 8; ++k) cb[k].v = *(const uint4*)(proj + (tok0 + t8 + k) * PJ + C_CB + cg8);
    float w0[8], w1[8], w2[8];
    {
      const float* cw = p->conv_w + (size_t)l * 3 * 256 + cg8;
#pragma unroll
      for (int e = 0; e < 8; ++e) { w0[e] = cw[e]; w1[e] = cw[256 + e]; w2[e] = cw[512 + e]; }
    }
    float pr[10][8];
#pragma unroll
    for (int k = 0; k < 10; ++k) {
      const bool ok = (blk > 0) || (t8 + k - 2 >= 0);
#pragma unroll
      for (int e = 0; e < 8; ++e) pr[k][e] = ok ? bf2f(cc[k].h[e]) * bf2f(cx[k].h[e]) : 0.f;
    }
#pragma unroll
    for (int k = 0; k < 8; ++k) {
      float y[8];
#pragma unroll
      for (int e = 0; e < 8; ++e)
        y[e] = bf2f(cb[k].h[e]) * (w0[e] * pr[k][e] + w1[e] * pr[k + 1][e] + w2[e] * pr[k + 2][e]);
      uint4 o;
      o.x = pack2(y[0], y[1]); o.y = pack2(y[2], y[3]); o.z = pack2(y[4], y[5]); o.w = pack2(y[6], y[7]);
      *(uint4*)(mix + (tok0 + t8 + k) * DM + 768 + cg8) = o;
    }
  }
}

__device__ __forceinline__ void nsa_compress(KP p, int l, char* smem, int job) {
  const int tid = otid(), lane = tid & 63, wv = tid >> 6, l15 = lane & 15, quad = lane >> 4;
  const int which = job >> 6, b = (job >> 5) & 1, g = (job >> 4) & 1, tile = job & 15;
  const u16* proj = (const u16*)(p->ws + OFF_PROJ);
  const u16* W1T = (const u16*)(p->ws + OFF_W + W_C1) + (size_t)which * 64 * 2048;
  const u16* W2T = (const u16*)(p->ws + OFF_W + W_C2) + which * 4096;
  const float* pe = p->cmp_pe + (size_t)(l * 2 + which) * 32 * 64;
  const int blk0 = tile * 64 + wv * 16;
  int blk = blk0 + l15;
  int blkc = blk < 1023 ? blk : 1022;
  const u16* arow = proj + ((size_t)b * T + blkc * 16) * PJ + (which ? C_VCMP : C_KCMP) + g * 64;
  f32x4 acc[4];
#pragma unroll
  for (int n = 0; n < 4; ++n) acc[n] = f32x4{0.f, 0.f, 0.f, 0.f};
  for (int ks0 = 0; ks0 < 64; ks0 += 4) {
    uint4 raw[4];
    float4 pea[4], peb[4];
    bf16x8 bfr[4][4];
#pragma unroll
    for (int u = 0; u < 4; ++u) {
      const int ks = ks0 + u, tok = ks >> 1, d0 = (ks & 1) * 32 + quad * 8;
      raw[u] = *(const uint4*)(arow + (size_t)tok * PJ + d0);
      pea[u] = *(const float4*)(pe + tok * 64 + d0);
      peb[u] = *(const float4*)(pe + tok * 64 + d0 + 4);
#pragma unroll
      for (int n = 0; n < 4; ++n) bfr[u][n] = *(const bf16x8*)(W1T + (size_t)(n * 16 + l15) * 2048 + ks * 32 + quad * 8);
    }
#pragma unroll
    for (int u = 0; u < 4; ++u) {
      union { bf16x8 v; u32 w[4]; } af;
      af.w[0] = pack2(bf2f(raw[u].x & 0xffff) + pea[u].x, bf2f(raw[u].x >> 16) + pea[u].y);
      af.w[1] = pack2(bf2f(raw[u].y & 0xffff) + pea[u].z, bf2f(raw[u].y >> 16) + pea[u].w);
      af.w[2] = pack2(bf2f(raw[u].z & 0xffff) + peb[u].x, bf2f(raw[u].z >> 16) + peb[u].y);
      af.w[3] = pack2(bf2f(raw[u].w & 0xffff) + peb[u].z, bf2f(raw[u].w >> 16) + peb[u].w);
#pragma unroll
      for (int n = 0; n < 4; ++n) acc[n] = mfma16(af.v, bfr[u][n], acc[n]);
    }
  }
  u16* hid = (u16*)smem + wv * 16 * 72;
#pragma unroll
  for (int n = 0; n < 4; ++n)
#pragma unroll
    for (int r = 0; r < 4; ++r) {
      float x = acc[n][r];
      float u = 0.7978845608028654f * (x + 0.044715f * x * x * x);
      float gl = 0.5f * x * (1.f + tanhf(u));
      hid[(quad * 4 + r) * 72 + n * 16 + l15] = f2bf(gl);
    }
  __syncthreads();
  f32x4 o2[4];
#pragma unroll
  for (int n = 0; n < 4; ++n) o2[n] = f32x4{0.f, 0.f, 0.f, 0.f};
#pragma unroll
  for (int ks = 0; ks < 2; ++ks) {
    bf16x8 af = *(const bf16x8*)(hid + l15 * 72 + ks * 32 + quad * 8);
#pragma unroll
    for (int n = 0; n < 4; ++n) {
      bf16x8 bfr = *(const bf16x8*)(W2T + (n * 16 + l15) * 64 + ks * 32 + quad * 8);
      o2[n] = mfma16(af, bfr, o2[n]);
    }
  }
  __syncthreads();
  if (which == 0) {
    u16* KC = (u16*)(p->ws + OFF_KC) + (size_t)(b * 2 + g) * 1024 * 64;
    const float* kg = p->nsa_k_norm + (l * 3 + 0) * 64;
#pragma unroll
    for (int r = 0; r < 4; ++r) {
      float ss = 0.f;
#pragma unroll
      for (int n = 0; n < 4; ++n) ss += o2[n][r] * o2[n][r];
      ss = row16_sum(ss);
      float rs = rsqrtf(ss * (1.f / 64.f) + 1e-6f);
      int row = blk0 + quad * 4 + r;
#pragma unroll
      for (int n = 0; n < 4; ++n) {
        float v = row < 1023 ? o2[n][r] * rs * kg[n * 16 + l15] : 0.f;
        KC[(size_t)row * 64 + n * 16 + l15] = f2bf(v);
      }
    }
  } else {
    u16* VCT = (u16*)(p->ws + OFF_KC + 524288) + (size_t)(b * 2 + g) * 64 * 1024;
#pragma unroll
    for (int r = 0; r < 4; ++r) {
      int row = blk0 + quad * 4 + r;
#pragma unroll
      for (int n = 0; n < 4; ++n) {
        float v = row < 1023 ? o2[n][r] : 0.f;
        const int k32_ = row & 31;
        const int kp_ = k32_ < 16 ? (k32_ >> 2) * 8 + (k32_ & 3) : ((k32_ - 16) >> 2) * 8 + 4 + (k32_ & 3);
        VCT[(size_t)(n * 16 + l15) * 1024 + (row & ~31) + kp_] = f2bf(v);
      }
    }
  }
}

template <int MODE, int NT>
__device__ __forceinline__ void flash2(const u16* __restrict__ Kg, int kld, const u16* __restrict__ VTg, int vblk,
                                       int vld, int h0, int h1, char* sStage, const u16* sQw, f32x4 (&O)[4][NT],
                                       float (&lsum)[NT], const float (&inv)[NT], const u32* sSelw, float* slc,
                                       int tq0) {
  const int tid = otid(), lane = tid & 63, wv = tid >> 6, l15 = lane & 15, quad = lane >> 4;
  const int krow = tid >> 3, kc = tid & 7;
  const u16* kptr = Kg + (size_t)krow * kld + kc * 8;
  const int kw = krow * 128 + ((kc ^ ((krow >> 1) & 7)) * 16);
  const int vd = tid >> 2, vc = tid & 3;
  const u16* vptr = VTg + (size_t)vd * vld + vc * 8;
  const int vw = 4096 + vd * 64 + ((vc ^ ((0x1320 >> (4 * ((vd >> 2) & 3))) & 3)) * 16);
  const int jb0 = h0 >> 1, nst = (h1 >> 1) - jb0 + 1;
  uint4 S0k0, S0k1, S0v0, S0v1, S1k0, S1k1, S1v0, S1v1;
#define F2_LOAD(S, i_)                                                                             \
  do {                                                                                             \
    const int jb_ = jb0 + (i_);                                                                    \
    S##k0 = *(const uint4*)(kptr + (size_t)(jb_ * 64) * kld);                                      \
    S##k1 = *(const uint4*)(kptr + (size_t)(jb_ * 64 + 32) * kld);                                 \
    if (MODE != 2) {                                                                               \
      S##v0 = *(const uint4*)(vptr + (size_t)jb_ * vblk);                                          \
      S##v1 = *(const uint4*)(vptr + (size_t)jb_ * vblk + 32);                                     \
    }                                                                                              \
  } while (0)
#define F2_WRITE(S, slot_)                                                     \
  do {                                                                         \
    char* sl_ = sStage + (slot_) * 16384;                                      \
    *(uint4*)(sl_ + kw) = S##k0;                                               \
    *(uint4*)(sl_ + 8192 + kw) = S##k1;                                        \
    if (MODE != 2) {                                                           \
      *(uint4*)(sl_ + vw) = S##v0;                                             \
      *(uint4*)(sl_ + 8192 + vw) = S##v1;                                      \
    }                                                                          \
  } while (0)
  if (0 < nst) F2_LOAD(S0, 0);
  if (1 < nst) F2_LOAD(S1, 1);
  const int koff = l15 * 128;
  const int ksw = (l15 >> 1) & 7;
  const int voff = 4096 + l15 * 64 + ((quad ^ ((0x1320 >> (4 * ((l15 >> 2) & 3))) & 3)) * 16);
  const int tq0u = __builtin_amdgcn_readfirstlane(tq0);
  const int lim0u = tq0u >= 31 ? ((tq0u - 31) >> 4) : -1;
  bf16x8 bqr[NT][2];
#pragma unroll
  for (int nt = 0; nt < NT; ++nt) {
    bqr[nt][0] = *(const bf16x8*)(sQw + (nt * 16 + l15) * 72 + quad * 8);
    bqr[nt][1] = *(const bf16x8*)(sQw + (nt * 16 + l15) * 72 + 32 + quad * 8);
  }
  f32x4 Lacc[NT];
#pragma unroll
  for (int nt = 0; nt < NT; ++nt) Lacc[nt] = f32x4{0.f, 0.f, 0.f, 0.f};
  bf16x8 ones_;
  { u32 o1 = 0x3f803f80u; asm volatile("" : "+v"(o1)); union { bf16x8 v; u32 u[4]; } oo; oo.u[0] = o1; oo.u[1] = o1; oo.u[2] = o1; oo.u[3] = o1; ones_ = oo.v; }
  auto compute = [&](const int h, const char* st) __attribute__((always_inline)) {
    bool interior;
    if (MODE == 0) interior = (h * 32 + 31 <= tq0u) && (h * 32 > tq0u + NT * 4 - 1 - 512);
    else if (MODE == 1) interior = (h * 32 + 31 <= tq0u);
    else interior = (h * 32 + 31 <= lim0u);
    bool bv[NT], an[NT];
    bool anyw = false;
#pragma unroll
    for (int nt = 0; nt < NT; ++nt) {
      if (MODE == 1) {
        u32 w = sSelw[(nt * 4 + (l15 >> 2)) * 8 + (h >> 6)];
        bv[nt] = (w >> ((h >> 1) & 31)) & 1u;
      } else {
        bv[nt] = true;
      }
      an[nt] = MODE == 1 ? (bool)__any(bv[nt]) : true;
      anyw |= an[nt];
    }
    if (anyw) {
      bf16x8 kf[2][2], vf[4];
#pragma unroll
      for (int m2 = 0; m2 < 2; ++m2)
#pragma unroll
        for (int ks = 0; ks < 2; ++ks)
          kf[m2][ks] = *(const bf16x8*)(st + koff + m2 * 2048 + (((ks * 4 + quad) ^ ksw) * 16));
      if (MODE != 2) {
#pragma unroll
        for (int dt = 0; dt < 4; ++dt) vf[dt] = *(const bf16x8*)(st + voff + dt * 1024);
      }
#pragma unroll
      for (int nt = 0; nt < NT; ++nt) {
        if (!an[nt]) continue;
        const int t = tq0 + nt * 4 + (l15 >> 2);
        const bf16x8 bq0 = bqr[nt][0], bq1 = bqr[nt][1];
        f32x4 s[2];
#pragma unroll
        for (int m2 = 0; m2 < 2; ++m2) {
          s[m2] = f32x4{0.f, 0.f, 0.f, 0.f};
          s[m2] = mfma16(kf[m2][0], bq0, s[m2]);
          s[m2] = mfma16(kf[m2][1], bq1, s[m2]);
        }
        const float bias = MODE == 3 ? inv[nt] : 0.f;
        if (interior) {
#pragma unroll
          for (int m2 = 0; m2 < 2; ++m2)
#pragma unroll
            for (int r = 0; r < 4; ++r)
              s[m2][r] = MODE <= 1 ? __builtin_amdgcn_exp2f(s[m2][r])
                                   : __builtin_amdgcn_exp2f(fmaf(s[m2][r], SC2, bias));
        } else {
          int base;
          if (MODE <= 1) base = h * 32 + quad * 4 - t;
          else base = h * 32 + quad * 4 - (t >= 31 ? ((t - 31) >> 4) : -1);
          asm volatile("" : "+v"(base));
#pragma unroll
          for (int m2 = 0; m2 < 2; ++m2)
#pragma unroll
            for (int r = 0; r < 4; ++r) {
              const int C = m2 * 16 + r;
              bool valid;
              if (MODE == 0) valid = base <= -C && base > -512 - C;
              else valid = base <= -C;
              float pvv = MODE <= 1 ? __builtin_amdgcn_exp2f(s[m2][r]) : __builtin_amdgcn_exp2f(fmaf(s[m2][r], SC2, bias));
              s[m2][r] = valid ? pvv : 0.f;
            }
        }
        if (MODE == 2) {
          bf16x8 P2 = pack8(s[0], s[1]);
          Lacc[nt] = mfma16(ones_, P2, Lacc[nt]);
        }
        if (MODE == 3) {
#pragma unroll
          for (int m2 = 0; m2 < 2; ++m2) {
            float ow = s[m2][0] + s[m2][1] + s[m2][2] + 0.5f * s[m2][3];
            float sp = 0.5f * s[m2][3];
            ow += dpp_xor1(ow); ow += dpp_xor2(ow);
            sp += dpp_xor1(sp); sp += dpp_xor2(sp);
            if ((l15 & 3) == 0) {
              const int j = h * 8 + m2 * 4 + quad;
              slc[(nt * 4 + (l15 >> 2)) * 256 + j] = ow;
              if (j + 1 < 256) slc[1024 + (nt * 4 + (l15 >> 2)) * 256 + j + 1] = sp;
            }
          }
        }
        if (MODE != 2) {
          bf16x8 P = pack8(s[0], s[1]);
          if (MODE == 1) {
            union { bf16x8 v; u32 u[4]; } pm; pm.v = P;
            const u32 keep = bv[nt] ? 0xffffffffu : 0u;
            pm.u[0] &= keep; pm.u[1] &= keep; pm.u[2] &= keep; pm.u[3] &= keep;
            P = pm.v;
          }
#pragma unroll
          for (int dt = 0; dt < 4; ++dt) O[dt][nt] = mfma16(vf[dt], P, O[dt][nt]);
          if (MODE <= 1) Lacc[nt] = mfma16(ones_, P, Lacc[nt]);
        }
      }
    }
  };
  if (0 < nst) F2_WRITE(S0, 0);
  if (2 < nst) F2_LOAD(S0, 2);
  RAW_BAR();
#define F2_ITER(u_, SN, sn_)                                            \
  if (i + (u_) < nst) {                                                 \
    const int ii_ = i + (u_);                                           \
    if (ii_ + 1 < nst) F2_WRITE(SN, sn_);                               \
    if (ii_ + 3 < nst) F2_LOAD(SN, ii_ + 3);                            \
    compute(2 * (jb0 + ii_), sStage + (u_) * 16384);                    \
    compute(2 * (jb0 + ii_) + 1, sStage + (u_) * 16384 + 8192);         \
    RAW_BAR();                                                          \
  }
  for (int i = 0; i < nst; i += 2) {
    F2_ITER(0, S1, 1)
    F2_ITER(1, S0, 0)
  }
  if (MODE <= 2) {
#pragma unroll
    for (int nt = 0; nt < NT; ++nt) lsum[nt] += Lacc[nt][0];
  }
}

__device__ __forceinline__ void nsa_phase_c(KP p, int l, char* smem) {
  const int tid = otid(), lane = tid & 63, wv = tid >> 6, l15 = lane & 15, quad = lane >> 4;
  char* sStage = smem;
  u16* sQw = (u16*)(smem + 32768) + wv * 16 * 72;
  float* own = (float*)(smem + 32768 + 9216) + wv * 2048;
  float* spl = own + 1024;
  const u16* proj = (const u16*)(p->ws + OFF_PROJ);
  const float* small_ = (const float*)(p->ws + OFF_SMALL);
  float* OC = (float*)(p->ws + OFF_OC);
  u32* SEL = (u32*)(p->ws + OFF_SEL);
  for (int job = obid(); job < 4096; job += gridDim.x) {
    const int qt = 1023 - (job >> 2), bg = job & 3, b = bg >> 1, g = bg & 1;
    const int t0 = qt * 16 + wv * 4;
    const int ql = l15 >> 2, r_ = l15 & 3, head = g * 4 + r_;
    const int t = t0 + ql;
    const size_t tok = (size_t)b * T + t;
    const u16* KC = (const u16*)(p->ws + OFF_KC) + (size_t)bg * 1024 * 64;
    const u16* VCT = (const u16*)(p->ws + OFF_KC + 524288) + (size_t)bg * 64 * 1024;
    {
      const u16* qrow = proj + tok * PJ + C_NQ + head * 64;
      *(bf16x8*)(sQw + l15 * 72 + quad * 8) = *(const bf16x8*)(qrow + quad * 8);
      *(bf16x8*)(sQw + l15 * 72 + 32 + quad * 8) = *(const bf16x8*)(qrow + 32 + quad * 8);
    }
    const int tmax = qt * 16 + 15;
    const int nvmax = tmax >= 31 ? ((tmax - 31) >> 4) + 1 : 0;
    const int h1 = ((nvmax + 31) >> 5) - 1;
    f32x4 O[4][1];
    float lsum[1] = {0.f}, inv[1] = {0.f};
#pragma unroll
    for (int dt = 0; dt < 4; ++dt) O[dt][0] = f32x4{0.f, 0.f, 0.f, 0.f};
    if (h1 >= 0) {
      flash2<2, 1>(KC, 64, VCT, 64, 1024, 0, h1, sStage, sQw, O, lsum, inv, nullptr, own, t0);
      float ls = lsum[0];
      inv[0] = ls > 0.f ? -log2f(ls) : -1000.f;
      flash2<3, 1>(KC, 64, VCT, 64, 1024, 0, h1, sStage, sQw, O, lsum, inv, nullptr, own, t0);
    }
    {
      float gc = ZTEST == 1 ? 0.f : sigmoidf_(small_[tok * 32 + 8 + head * 3 + 0]);
#pragma unroll
      for (int dt = 0; dt < 4; ++dt) {
        float4 o = make_float4(O[dt][0][0] * gc, O[dt][0][1] * gc, O[dt][0][2] * gc, O[dt][0][3] * gc);
        *(float4*)(OC + tok * 512 + head * 64 + dt * 16 + quad * 4) = o;
      }
    }
    __builtin_amdgcn_wave_barrier();
    for (int q = 0; q < 4; ++q) {
      const int tq = t0 + q, cur = tq >> 6;
      u32 word = 0;
      if (cur <= 15) {
        if (lane == 0) word = (2u << cur) - 1u;
      } else {
        u32 key[4];
#pragma unroll
        for (int k = 0; k < 4; ++k) {
          int j = lane + 64 * k;
          float v = own[q * 256 + j] + spl[q * 256 + j];
          key[k] = (j >= 1 && j <= cur - 2) ? (__float_as_uint(fmaxf(v, 0.f)) + 1u) : 0u;
        }
        u32 T = 0u;
        for (int bit = 30; bit >= 0; --bit) {
          const u32 cand = T | (1u << bit);
          int cnt = 0;
#pragma unroll
          for (int k = 0; k < 4; ++k) cnt += __popcll(__ballot(key[k] >= cand));
          if (cnt >= 13) T = cand;
        }
        int ngt = 0;
#pragma unroll
        for (int k = 0; k < 4; ++k) ngt += __popcll(__ballot(key[k] > T));
        int quota = 13 - ngt;
        const unsigned long long lt = (1ull << lane) - 1ull;
#pragma unroll
        for (int k = 0; k < 4; ++k) {
          const unsigned long long me = __ballot(key[k] == T);
          const bool take = key[k] > T || (key[k] == T && (int)__popcll(me & lt) < quota);
          const int ne = (int)__popcll(me);
          quota = quota > ne ? quota - ne : 0;
          const unsigned long long sm = __ballot(take);
          if (lane == 2 * k) word = (u32)sm;
          if (lane == 2 * k + 1) word = (u32)(sm >> 32);
        }
        if (lane == 0) word |= 1u;
        if (lane == (cur >> 5)) word |= 1u << (cur & 31);
        if (lane == ((cur - 1) >> 5)) word |= 1u << ((cur - 1) & 31);
      }
      if (lane < 8) SEL[(((size_t)b * 16384 + tq) * 2 + g) * 8 + lane] = word;
    }
    __builtin_amdgcn_wave_barrier();
  }
}

__device__ __forceinline__ void nsa_s_tile(KP p, int l, char* smem, int tile) {
  const int cur = 255 - (tile >> 2), bg = tile & 3, b = bg >> 1, g = bg & 1;
  const int tid = otid(), lane = tid & 63, wv = tid >> 6, l15 = lane & 15, quad = lane >> 4;
  char* sStage = smem;
  u16* sQw = (u16*)(smem + 32768) + wv * 64 * 72;
  u32* sSel = (u32*)(smem + 32768 + 36864);
  const u32* sSelw = sSel + wv * 16 * 8;
  const u16* proj = (const u16*)(p->ws + OFF_PROJ);
  const float* small_ = (const float*)(p->ws + OFF_SMALL);
  const float* rope = (const float*)(p->ws + OFF_ROPE);
  float* OC = (float*)(p->ws + OFF_OC);
  u16* mix = (u16*)(p->ws + OFF_H);
  const size_t tokb = (size_t)b * T;
  const int tq0 = cur * 64 + wv * 16;
  const int r_ = l15 & 3, head = g * 4 + r_;
  {
    const u32* SEL = (const u32*)(p->ws + OFF_SEL);
    int q = tid >> 2, w2 = (tid & 3) * 2;
    uint2 v = *(const uint2*)(SEL + ((tokb + cur * 64 + q) * 2 + g) * 8 + w2);
    *(uint2*)(sSel + q * 8 + w2) = v;
  }
#pragma unroll
  for (int nt = 0; nt < 4; ++nt) {
    const size_t tok = tokb + tq0 + nt * 4 + (l15 >> 2);
    const u16* qrow = proj + tok * PJ + C_NQ + head * 64;
    u16* qd = sQw + (nt * 16 + l15) * 72;
    {
      union { bf16x8 v; u16 h[8]; } xi, xo;
      xi.v = *(const bf16x8*)(qrow + 32 + quad * 8);
#pragma unroll
      for (int i = 0; i < 8; ++i) xo.h[i] = f2bf(bf2f(xi.h[i]) * SC2);
      *(bf16x8*)(qd + 32 + quad * 8) = xo.v;
    }
    if (quad >= 2) {
      union { bf16x8 v; u16 h[8]; } xi, xo;
      xi.v = *(const bf16x8*)(qrow + quad * 8);
#pragma unroll
      for (int i = 0; i < 8; ++i) xo.h[i] = f2bf(bf2f(xi.h[i]) * SC2);
      *(bf16x8*)(qd + quad * 8) = xo.v;
    } else {
      union { bf16x8 v; u16 h[8]; } x1, x2, o;
      x1.v = *(const bf16x8*)(qrow);
      x2.v = *(const bf16x8*)(qrow + 8);
      const float* rp = rope + tok * 16;
#pragma unroll
      for (int i = 0; i < 8; ++i) {
        float a = bf2f(x1.h[i]), bb = bf2f(x2.h[i]), c = rp[i], sn = rp[8 + i];
        o.h[i] = f2bf((quad == 0 ? a * c - bb * sn : bb * c + a * sn) * SC2);
      }
      *(bf16x8*)(qd + quad * 8) = o.v;
    }
  }
  f32x4 O[4][4];
  float lsum[4], inv[4] = {0.f, 0.f, 0.f, 0.f};
#pragma unroll
  for (int dt = 0; dt < 4; ++dt)
#pragma unroll
    for (int nt = 0; nt < 4; ++nt) O[dt][nt] = f32x4{0.f, 0.f, 0.f, 0.f};
#pragma unroll
  for (int nt = 0; nt < 4; ++nt) lsum[nt] = 0.f;
  {
    const u16* Kg = proj + tokb * PJ + C_KWIN + g * 64;
    const u16* VTg = (const u16*)(p->ws + OFF_VT + 8 * MiB) + (size_t)(bg * 256) * 4096;
    int h0 = 2 * cur - 16 < 0 ? 0 : 2 * cur - 16;
    flash2<0, 4>(Kg, PJ, VTg, 4096, 64, h0, 2 * cur + 1, sStage, sQw, O, lsum, inv, sSelw, nullptr, tq0);
  }
#pragma unroll
  for (int nt = 0; nt < 4; ++nt) {
    const size_t tok = tokb + tq0 + nt * 4 + (l15 >> 2);
    float ls = lsum[nt];
    float sc = ZTEST == 2 ? 0.f : sigmoidf_(small_[tok * 32 + 8 + head * 3 + 2]) / ls;
#pragma unroll
    for (int dt = 0; dt < 4; ++dt) {
      float4* op = (float4*)(OC + tok * 512 + head * 64 + dt * 16 + quad * 4);
      float4 o = *op;
      o.x += O[dt][nt][0] * sc; o.y += O[dt][nt][1] * sc; o.z += O[dt][nt][2] * sc; o.w += O[dt][nt][3] * sc;
      *op = o;
      O[dt][nt] = f32x4{0.f, 0.f, 0.f, 0.f};
    }
    lsum[nt] = 0.f;
  }
  {
    const u16* Kg = proj + tokb * PJ + C_KSLC + g * 64;
    const u16* VTg = (const u16*)(p->ws + OFF_VT) + (size_t)(bg * 256) * 4096;
    flash2<1, 4>(Kg, PJ, VTg, 4096, 64, 0, 2 * cur + 1, sStage, sQw, O, lsum, inv, sSelw, nullptr, tq0);
  }
#pragma unroll
  for (int nt = 0; nt < 4; ++nt) {
    const size_t tok = tokb + tq0 + nt * 4 + (l15 >> 2);
    float ls = lsum[nt];
    float sc = ZTEST == 3 ? 0.f : sigmoidf_(small_[tok * 32 + 8 + head * 3 + 1]) / ls;
#pragma unroll
    for (int dt = 0; dt < 4; ++dt) {
      float4 o = *(const float4*)(OC + tok * 512 + head * 64 + dt * 16 + quad * 4);
      uint2 w;
      w.x = pack2(o.x + O[dt][nt][0] * sc, o.y + O[dt][nt][1] * sc);
      w.y = pack2(o.z + O[dt][nt][2] * sc, o.w + O[dt][nt][3] * sc);
      *(uint2*)(mix + tok * DM + 256 + head * 64 + dt * 16 + quad * 4) = w;
    }
  }
}


#define XB_TMO      128
#define XB_XCNT(j)  (256  + 64 * (j))
#define XB_XSUB(j)  (1280 + 64 * (j))
#define XB_XGEN(j)  (2304 + 64 * (j))
#define XB_TOP      3328
#define XB_TOPGEN   3392
#define XCD_BAR_WORDS 3456
#define XB_SPIN_CAP (1u << 18)
#define LAS __attribute__((address_space(3)))
__device__ __forceinline__ unsigned xb_ld(unsigned* p) { return __hip_atomic_load(p, __ATOMIC_RELAXED, __HIP_MEMORY_SCOPE_AGENT); }
__device__ __forceinline__ unsigned xb_add(unsigned* p, unsigned v) { return __hip_atomic_fetch_add(p, v, __ATOMIC_RELAXED, __HIP_MEMORY_SCOPE_AGENT); }
__device__ __forceinline__ unsigned xb_xcc_id() { return (unsigned)__builtin_amdgcn_s_getreg((3 << 11) | 20) & 0xFu; }
#define XB_SPIN(cond, bar) do { unsigned _sp = 0; while (cond) { __builtin_amdgcn_s_sleep(1); \
    if ((++_sp & 255u) == 0u) { if (xb_ld(&(bar)[XB_TMO])) break; if (_sp > XB_SPIN_CAP) { atomicAdd(&(bar)[XB_TMO], 1u); break; } } } } while (0)
struct XcdBarrier { unsigned* bar; unsigned x; volatile LAS unsigned* st; };
__device__ __forceinline__ XcdBarrier xcd_barrier_post(unsigned* bar, volatile LAS unsigned* st) {
  XcdBarrier b; b.bar = bar; b.x = xb_xcc_id(); b.st = st;
  if (threadIdx.x == 0) (void)xb_add(&bar[XB_XCNT(b.x)], 1u);
  return b;
}
__device__ __forceinline__ void xcd_barrier_complete(unsigned* bar, unsigned x, unsigned& nloc, unsigned& nx) {
  const unsigned G = gridDim.x * gridDim.y * gridDim.z;
  unsigned sum, cnt, mine, sp = 0u;
  for (;;) {
    sum = 0u; cnt = 0u; mine = 0u;
#pragma unroll
    for (unsigned j = 0; j < 16; ++j) { const unsigned c = xb_ld(&bar[XB_XCNT(j)]); sum += c; cnt += (c > 0u) ? 1u : 0u; mine = (j == x) ? c : mine; }
    if (sum == G) break;
    __builtin_amdgcn_s_sleep(1);
    if ((++sp & 255u) == 0u) { if (xb_ld(&bar[XB_TMO])) break; if (sp > XB_SPIN_CAP) { atomicAdd(&bar[XB_TMO], 1u); break; } }
  }
  nloc = mine > 0u ? mine : 1u; nx = cnt > 0u ? cnt : 1u;
}
__device__ __forceinline__ void xcd_barrier(const XcdBarrier& b) {
  asm volatile("s_waitcnt vmcnt(0)" ::: "memory");
  __syncthreads();
  if (threadIdx.x == 0) {
    unsigned* bar = b.bar;
    __builtin_amdgcn_s_waitcnt(0);
    unsigned nloc = b.st[0], nx = b.st[1];
    if (nloc == 0u) { xcd_barrier_complete(bar, b.x, nloc, nx); b.st[0] = nloc; b.st[1] = nx; }
    const unsigned old = xb_add(&bar[XB_XSUB(b.x)], 1u);
    const unsigned gen = old / nloc;
    if (old + 1u == (gen + 1u) * nloc) {
      __builtin_amdgcn_fence(__ATOMIC_RELEASE, "agent");
      asm volatile("s_waitcnt vmcnt(0)" ::: "memory");
      const unsigned og = xb_add(&bar[XB_TOP], 1u);
      const unsigned tg = og / nx;
      if (og + 1u == (tg + 1u) * nx) xb_add(&bar[XB_TOPGEN], 1u);
      else XB_SPIN(xb_ld(&bar[XB_TOPGEN]) == tg, bar);
      __builtin_amdgcn_fence(__ATOMIC_ACQUIRE, "agent");
      xb_add(&bar[XB_XGEN(b.x)], 1u);
      asm volatile("s_waitcnt vmcnt(0)" ::: "memory");
    } else {
      XB_SPIN(xb_ld(&bar[XB_XGEN(b.x)]) == gen, bar);
      __builtin_amdgcn_fence(__ATOMIC_ACQUIRE, "agent");
      asm volatile("s_waitcnt vmcnt(0)" ::: "memory");
    }
  }
  __syncthreads();
}
#ifndef REPE
#define REPE 1
#endif
#ifndef REP3C
#define REP3C 1
#endif
#ifndef REP3
#define REP3 1
#endif
#ifndef XSYNC
#define XSYNC 0
#endif
#ifndef REP4
#define REP4 1
#endif
#ifndef REPSCAN
#define REPSCAN 1
#endif
#ifndef REPG
#define REPG 1
#endif
__global__ void __launch_bounds__(256, 2) hymba_mega(Params p_unused) {
  cg::grid_group grid = cg::this_grid();
  __shared__ uint4 xb_words;
  if (threadIdx.x == 0) xb_words = make_uint4(0u, 0u, 0u, 0u);
  __syncthreads();
  XcdBarrier xb = xcd_barrier_post((unsigned*)(kargs()->ws + OFF_CNT + 4096), (volatile LAS unsigned*)&xb_words);
  __shared__ __attribute__((aligned(16))) char smem[77824];
  __shared__ int s_tile;
  { KP p = kargs(); rope_table(p); }
  grid.sync();
#pragma unroll 1
  for (int l = 0; l < DEPTH; ++l) {
    {
      KP p = kargs();
      if (blockIdx.x == 0 && threadIdx.x == 0) { u32 z0 = 0u; asm volatile("" : "+v"(z0)); ((u32*)(p->ws + OFF_CNT))[0] = z0; }
      for (int re = 0; re < REPE; ++re) {
      convert_weights(p, l, smem);
      rmsnorm_rows(l == 0 ? p->x_in : p->out, p->attn_norm + l * DM, (u16*)(p->ws + OFF_H));
      }
    }
    xcd_barrier(xb);
    {
      KP p = kargs();
      for (int rep = 0; rep < REPG; ++rep)
      gemm_phase((const u16*)(p->ws + OFF_H), DM, (const u16*)(p->ws + OFF_W + W_IN), DM, DM, 128, 25, smem,
                 EpiInProj{(u16*)(p->ws + OFF_PROJ), (float*)(p->ws + OFF_SMALL)});
    }
    xcd_barrier(xb);
    {
      KP p = kargs();
      for (int job = obid(); job < 2048 + 512 + 128; job += gridDim.x) {
        if (job < 2048) gdn_chunk_prep(p, l, smem, job);
        else if (job < 2560) nsa_token_prep(p, l, smem, job - 2048);
        else nsa_compress(p, l, smem, job - 2560);
      }
    }
    xcd_barrier(xb);
#ifndef REP45
#define REP45 1
#endif
    for (int rep = 0; rep < REP45; ++rep) {
    {
      KP p = kargs();
      if (blockIdx.x == 0 && threadIdx.x == 0) { u32 z0 = 0u; asm volatile("" : "+v"(z0)); ((u32*)(p->ws + OFF_CNT))[0] = z0; }
      for (int r4 = 0; r4 < REP4; ++r4) nsa_phase_c(p, l, smem);
    }
    xcd_barrier(xb);
    {
      KP p = kargs();
      if (obid() < 32) for (int rs = 0; rs < REPSCAN; ++rs) gdn_scan(p, smem, obid());
      u32* CNT = (u32*)(p->ws + OFF_CNT);
      for (;;) {
        __syncthreads();
        if (threadIdx.x == 0) s_tile = (int)atomicAdd(&CNT[0], 1u);
        __syncthreads();
        int tile = s_tile;
        if (tile >= 1024) break;
        nsa_s_tile(p, l, smem, tile);
      }
    }
    xcd_barrier(xb);
    }
    {
      KP p = kargs();
      for (int re = 0; re < REPE; ++re) gdn_finalize(p, l);
      for (int xs = 0; xs < XSYNC; ++xs) xcd_barrier(xb);
    }
    xcd_barrier(xb);
    {
      KP p = kargs();
      gemm_phase((const u16*)(p->ws + OFF_H), DM, (const u16*)(p->ws + OFF_W + W_OUT), DM, DM, 128, 8, smem,
                 EpiResid{l == 0 ? p->x_in : p->out, p->out});
    }
    xcd_barrier(xb);
    {
      KP p = kargs();
      for (int re = 0; re < REPE; ++re) rmsnorm_rows(p->out, p->ffn_norm + l * DM, (u16*)(p->ws + OFF_H));
    }
    xcd_barrier(xb);
    {
      KP p = kargs();
      for (int rep = 0; rep < REPG; ++rep)
      gemm_phase((const u16*)(p->ws + OFF_H), DM, (const u16*)(p->ws + OFF_W + W_GU), DM, DM, 128, 44, smem,
                 EpiSwiGLU{(u16*)(p->ws + OFF_PROJ)});
    }
    xcd_barrier(xb);
    {
      KP p = kargs();
      gemm_phase((const u16*)(p->ws + OFF_PROJ), DFF, (const u16*)(p->ws + OFF_W + W_DOWN), DFF, DFF, 128, 8, smem,
                 EpiResid{p->out, p->out});
    }
    xcd_barrier(xb);
  }
}

extern "C" void kernel_launch(void* const* d_in, const int* in_sizes, int n_in, void* d_out, int out_size, void* d_ws,
                              size_t ws_size, hipStream_t stream) {
  static int grid_blocks = 0;
  if (!grid_blocks) {
    int dev = 0, cus = 0, per_cu = 0;
    hipGetDevice(&dev);
    hipDeviceGetAttribute(&cus, hipDeviceAttributeMultiprocessorCount, dev);
    hipOccupancyMaxActiveBlocksPerMultiprocessor(&per_cu, hymba_mega, 256, 0);
    if (per_cu > 2) per_cu = 2;
    if (per_cu < 1) per_cu = 1;
    grid_blocks = cus * per_cu;
    grid_blocks &= ~7;
  }
  Params p;
  memset(&p, 0, sizeof(p));
  p.x_in = (const float*)d_in[0]; p.positions = (const int*)d_in[1]; p.attn_norm = (const float*)d_in[2];
  p.w_in = (const float*)d_in[3]; p.gdn_conv_w = (const float*)d_in[4]; p.gdn_a_log = (const float*)d_in[5];
  p.gdn_dt_bias = (const float*)d_in[6]; p.gdn_norm = (const float*)d_in[7]; p.nsa_q_norm = (const float*)d_in[8];
  p.nsa_k_norm = (const float*)d_in[9]; p.cmp_pe = (const float*)d_in[10]; p.cmp_w1 = (const float*)d_in[11];
  p.cmp_w2 = (const float*)d_in[12]; p.conv_w = (const float*)d_in[13]; p.w_out = (const float*)d_in[14];
  p.ffn_norm = (const float*)d_in[15]; p.w_gate_up = (const float*)d_in[16]; p.w_down = (const float*)d_in[17];
  p.out = (float*)d_out; p.ws = (char*)d_ws;
  hipMemsetAsync((char*)d_ws + OFF_CNT, 0, 4096 + XCD_BAR_WORDS * 4, stream);
  void* args[] = {&p};
  hipError_t e = hipLaunchCooperativeKernel((void*)hymba_mega, dim3(grid_blocks), dim3(256), args, 0, stream);
  if (e != hipSuccess) fprintf(stderr, "cooperative launch failed: %s (grid %d)\n", hipGetErrorString(e), grid_blocks);
}
```
